# Optimizing an MI355X kernel written in HIP

```python
import jax, jax.numpy as jnp
from jax import lax
import numpy as np

D_MODEL = 1024
BATCH = 4
SEQ = 4096
DEPTH = 4

CHUNK = 64
Q_BLOCK = 128

D_MIX = D_MODEL
MLA_HEADS = 8
QK_NOPE = 64
QK_ROPE = 32
V_DIM = 64
Q_LORA = 256
KV_LORA = 128
ROPE_THETA = 10000.0
SGU_GROUPS = 4
SGU_GROUP_DIM = 64
SGU_WIDTH = SGU_GROUPS * SGU_GROUP_DIM
SGU_BLOCK = 128
LRU_HEADS = 4
LRU_HEAD_DIM = 64
LRU_WIDTH = LRU_HEADS * LRU_HEAD_DIM
CONV_W = 4
LRU_C = 8.0
D_IN = Q_LORA + KV_LORA + QK_ROPE + 2 * SGU_WIDTH + 2 * LRU_WIDTH
IN_SPLITS = (Q_LORA,
             Q_LORA + KV_LORA,
             Q_LORA + KV_LORA + QK_ROPE,
             Q_LORA + KV_LORA + QK_ROPE + SGU_WIDTH,
             Q_LORA + KV_LORA + QK_ROPE + 2 * SGU_WIDTH,
             Q_LORA + KV_LORA + QK_ROPE + 2 * SGU_WIDTH + LRU_WIDTH)
D_FF = 2816
N_EXPERTS = 8
TOP_K = 2
D_FF_EXPERT = 1408
N_DENSE = (DEPTH + 1) // 2
N_MOE = DEPTH // 2
NEG_INF = -1e30

kernel_name = "hybrid_mla_sgu_rglru_moe_trunk"


def rms_norm(x, g, eps=1e-6):
    xf = x.astype(jnp.float32)
    y = xf * lax.rsqrt(jnp.mean(xf * xf, axis=-1, keepdims=True) + eps)
    return (y * g.astype(jnp.float32)).astype(x.dtype)


def layer_norm(x, g, b, eps=1e-5):
    xf = x.astype(jnp.float32)
    mu = jnp.mean(xf, axis=-1, keepdims=True)
    var = jnp.mean(jnp.square(xf - mu), axis=-1, keepdims=True)
    y = (xf - mu) * lax.rsqrt(var + eps) * g.astype(jnp.float32) + b.astype(jnp.float32)
    return y.astype(x.dtype)


def rope_tables(seq):
    pos = jnp.arange(seq, dtype=jnp.float32)
    inv = ROPE_THETA ** (-jnp.arange(0, QK_ROPE, 2, dtype=jnp.float32) / QK_ROPE)
    ang = pos[:, None] * inv[None, :]
    return jnp.cos(ang), jnp.sin(ang)


def apply_rope(x, cos, sin):
    half = x.shape[-1] // 2
    x1 = x[..., :half].astype(jnp.float32)
    x2 = x[..., half:].astype(jnp.float32)
    return jnp.concatenate([x1 * cos - x2 * sin, x2 * cos + x1 * sin], axis=-1).astype(x.dtype)


def chunk_causal_attention(q, k, v):
    B, S, H, Dq = q.shape
    n_qb = S // Q_BLOCK
    scale = Dq ** -0.5
    qb = q.reshape(B, n_qb, Q_BLOCK, H, Dq).transpose(1, 0, 3, 2, 4)
    kt = k.transpose(0, 2, 1, 3)
    vt = v.transpose(0, 2, 1, 3)
    key_chunk = jnp.arange(S) // CHUNK

    def one_block(args):
        q_blk, blk = args
        s = jnp.einsum('bhqd,bhkd->bhqk', q_blk, kt, preferred_element_type=jnp.float32) * scale
        q_chunk = (blk * Q_BLOCK + jnp.arange(Q_BLOCK)) // CHUNK
        mask = key_chunk[None, :] <= q_chunk[:, None]
        p = jax.nn.softmax(jnp.where(mask, s, NEG_INF), axis=-1).astype(vt.dtype)
        return jnp.einsum('bhqk,bhkd->bhqd', p, vt)

    o = lax.map(one_block, (qb, jnp.arange(n_qb)))
    return o.transpose(1, 0, 3, 2, 4).reshape(B, S, H, vt.shape[-1])


def mla_mixer(z_q, z_kv, z_kr, q_norm_g, w_uq, kv_norm_g, w_ukv, cos, sin):
    B, S, _ = z_q.shape
    q = (rms_norm(z_q, q_norm_g) @ w_uq).reshape(B, S, MLA_HEADS, QK_NOPE + QK_ROPE)
    q_rope = apply_rope(q[..., QK_NOPE:], cos[:, None, :], sin[:, None, :])
    q = jnp.concatenate([q[..., :QK_NOPE], q_rope], axis=-1)
    kv = (rms_norm(z_kv, kv_norm_g) @ w_ukv).reshape(B, S, MLA_HEADS, QK_NOPE + V_DIM)
    k_rope = apply_rope(z_kr, cos, sin)
    k = jnp.concatenate([kv[..., :QK_NOPE],
                         jnp.broadcast_to(k_rope[:, :, None, :], (B, S, MLA_HEADS, QK_ROPE))], axis=-1)
    v = kv[..., QK_NOPE:]
    o = chunk_causal_attention(q, k, v)
    return o.reshape(B, S, MLA_HEADS * V_DIM)


def sgu_mixer(z_u, z_v, ln_g, ln_b, w_s, b_s):
    B, S, _ = z_u.shape
    u = jax.nn.gelu(z_u)
    v = layer_norm(jax.nn.gelu(z_v), ln_g, ln_b)
    vb = v.reshape(B, S // SGU_BLOCK, SGU_BLOCK, SGU_GROUPS, SGU_GROUP_DIM)
    w = w_s * jnp.tril(jnp.ones((SGU_BLOCK, SGU_BLOCK), dtype=w_s.dtype))[None]
    mixed = jnp.einsum('gts,bnsgc->bntgc', w, vb) + b_s.T[None, None, :, :, None]
    return u * mixed.reshape(B, S, SGU_WIDTH)


def rglru_mixer(z_x, z_y, conv_w, conv_b, wa, ba, wx, bx, lam):
    B, S, W = z_x.shape
    xp = jnp.pad(z_x, ((0, 0), (CONV_W - 1, 0), (0, 0)))
    xc = conv_b + xp[:, 0:S, :] * conv_w[0]
    for tap in range(1, CONV_W):
        xc = xc + xp[:, tap:tap + S, :] * conv_w[tap]
    xh = xc.reshape(B, S, LRU_HEADS, LRU_HEAD_DIM)
    r = jax.nn.sigmoid(jnp.einsum('bshi,hij->bshj', xh, wa).reshape(B, S, W) + ba)
    i = jax.nn.sigmoid(jnp.einsum('bshi,hij->bshj', xh, wx).reshape(B, S, W) + bx)
    log_a = -LRU_C * r.astype(jnp.float32) * jax.nn.softplus(-lam.astype(jnp.float32))
    a = jnp.exp(log_a)
    b = jnp.sqrt(-jnp.expm1(2.0 * log_a)) * (i * xc).astype(jnp.float32)

    def combine(left, right):
        a_l, b_l = left
        a_r, b_r = right
        return a_l * a_r, a_r * b_l + b_r

    _, h = lax.associative_scan(combine, (a, b), axis=1)
    return h.astype(z_x.dtype) * jax.nn.gelu(z_y)


def swiglu(h, wg, wu, wd):
    return (jax.nn.silu(h @ wg) * (h @ wu)) @ wd


def moe_swiglu(h, router, wg, wu, wd):
    B, S, D = h.shape
    t = h.reshape(B * S, D)
    logits = (t @ router).astype(jnp.float32)
    top_v, top_i = lax.top_k(logits, TOP_K)
    gates = jax.nn.softmax(top_v, axis=-1)
    comb = jnp.sum(jax.nn.one_hot(top_i, N_EXPERTS, dtype=jnp.float32) * gates[..., None], axis=1)
    comb = comb.astype(t.dtype)
    out = jnp.zeros_like(t)
    for e in range(N_EXPERTS):
        out = out + comb[:, e:e + 1] * swiglu(t, wg[e], wu[e], wd[e])
    return out.reshape(B, S, D)


def setup_inputs(seed: int = 0) -> dict:
    key = jax.random.key(seed)
    ks = iter(jax.random.split(key, 48))
    f32 = jnp.float32

    def nrm(shape, fan_in, mult=1.0):
        return jax.random.normal(next(ks), shape, f32) * (mult * fan_in ** -0.5)

    def gain(shape):
        return 1.0 + 0.02 * jax.random.normal(next(ks), shape, f32)

    def small(shape, s=0.02):
        return s * jax.random.normal(next(ks), shape, f32)

    L = DEPTH
    u = jax.random.uniform(next(ks), (L, LRU_WIDTH), f32, minval=0.9, maxval=0.999)
    p = u ** (1.0 / LRU_C)
    lam = jnp.log(p) - jnp.log1p(-p)
    return {
        "x": jax.random.normal(next(ks), (BATCH, SEQ, D_MODEL), f32),
        "c": jax.random.normal(next(ks), (BATCH, D_MODEL), f32),
        "w_mod": nrm((L, D_MODEL, 6 * D_MODEL), D_MODEL, 0.5),
        "b_mod": small((L, 6 * D_MODEL)),
        "pre_mix_g": gain((L, D_MODEL)),
        "post_mix_g": gain((L, D_MODEL)),
        "w_in": nrm((L, D_MODEL, D_IN), D_MODEL),
        "q_norm_g": gain((L, Q_LORA)),
        "w_uq": nrm((L, Q_LORA, MLA_HEADS * (QK_NOPE + QK_ROPE)), Q_LORA),
        "kv_norm_g": gain((L, KV_LORA)),
        "w_ukv": nrm((L, KV_LORA, MLA_HEADS * (QK_NOPE + V_DIM)), KV_LORA),
        "sgu_ln_g": gain((L, SGU_WIDTH)),
        "sgu_ln_b": small((L, SGU_WIDTH)),
        "sgu_w": nrm((L, SGU_GROUPS, SGU_BLOCK, SGU_BLOCK), SGU_BLOCK),
        "sgu_b": gain((L, SGU_GROUPS, SGU_BLOCK)),
        "conv_w": nrm((L, CONV_W, LRU_WIDTH), CONV_W),
        "conv_b": small((L, LRU_WIDTH)),
        "lru_wa": nrm((L, LRU_HEADS, LRU_HEAD_DIM, LRU_HEAD_DIM), LRU_HEAD_DIM),
        "lru_ba": small((L, LRU_WIDTH)),
        "lru_wx": nrm((L, LRU_HEADS, LRU_HEAD_DIM, LRU_HEAD_DIM), LRU_HEAD_DIM),
        "lru_bx": small((L, LRU_WIDTH)),
        "lru_lambda": lam,
        "w_o": nrm((L, D_MIX, D_MODEL), D_MIX),
        "pre_ffn_g": gain((L, D_MODEL)),
        "post_ffn_g": gain((L, D_MODEL)),
        "ffn_w_gate": nrm((N_DENSE, D_MODEL, D_FF), D_MODEL),
        "ffn_w_up": nrm((N_DENSE, D_MODEL, D_FF), D_MODEL),
        "ffn_w_down": nrm((N_DENSE, D_FF, D_MODEL), D_FF),
        "moe_router": nrm((N_MOE, D_MODEL, N_EXPERTS), D_MODEL),
        "moe_w_gate": nrm((N_MOE, N_EXPERTS, D_MODEL, D_FF_EXPERT), D_MODEL),
        "moe_w_up": nrm((N_MOE, N_EXPERTS, D_MODEL, D_FF_EXPERT), D_MODEL),
        "moe_w_down": nrm((N_MOE, N_EXPERTS, D_FF_EXPERT, D_MODEL), D_FF_EXPERT),
    }


def reference(x, c, w_mod, b_mod, pre_mix_g, post_mix_g, w_in, q_norm_g, w_uq, kv_norm_g, w_ukv,
              sgu_ln_g, sgu_ln_b, sgu_w, sgu_b, conv_w, conv_b, lru_wa, lru_ba, lru_wx, lru_bx,
              lru_lambda, w_o, pre_ffn_g, post_ffn_g, ffn_w_gate, ffn_w_up, ffn_w_down,
              moe_router, moe_w_gate, moe_w_up, moe_w_down):
    S = x.shape[1]
    cos, sin = rope_tables(S)
    cond = jax.nn.silu(c)
    for l in range(DEPTH):
        mod = cond @ w_mod[l] + b_mod[l]
        sh_m, sc_m, g_m, sh_f, sc_f, g_f = [m[:, None, :] for m in jnp.split(mod, 6, axis=-1)]

        h = rms_norm(x, pre_mix_g[l]) * (1.0 + sc_m) + sh_m
        z = h @ w_in[l]
        z_q, z_kv, z_kr, z_u, z_v, z_x, z_y = jnp.split(z, IN_SPLITS, axis=-1)
        y_mla = mla_mixer(z_q, z_kv, z_kr, q_norm_g[l], w_uq[l], kv_norm_g[l], w_ukv[l], cos, sin)
        y_sgu = sgu_mixer(z_u, z_v, sgu_ln_g[l], sgu_ln_b[l], sgu_w[l], sgu_b[l])
        y_lru = rglru_mixer(z_x, z_y, conv_w[l], conv_b[l], lru_wa[l], lru_ba[l],
                            lru_wx[l], lru_bx[l], lru_lambda[l])
        y = jnp.concatenate([y_mla, y_sgu, y_lru], axis=-1) @ w_o[l]
        x = x + g_m * rms_norm(y, post_mix_g[l])

        h = rms_norm(x, pre_ffn_g[l]) * (1.0 + sc_f) + sh_f
        if l % 2 == 0:
            f = swiglu(h, ffn_w_gate[l // 2], ffn_w_up[l // 2], ffn_w_down[l // 2])
        else:
            f = moe_swiglu(h, moe_router[l // 2], moe_w_gate[l // 2], moe_w_up[l // 2], moe_w_down[l // 2])
        x = x + g_f * rms_norm(f, post_ffn_g[l])
    return x
```

```cpp
#include <hip/hip_runtime.h>
#include <cstdio>
#include <cstdint>

#define LAS __attribute__((address_space(3)))
#define GAS __attribute__((address_space(1)))
typedef unsigned short bf16;
typedef short bf16x8 __attribute__((ext_vector_type(8)));
typedef short s16x4 __attribute__((ext_vector_type(4)));
typedef float f32x4 __attribute__((ext_vector_type(4)));
typedef float f32x2 __attribute__((ext_vector_type(2)));
typedef float f32x16 __attribute__((ext_vector_type(16)));
typedef unsigned u32x4 __attribute__((ext_vector_type(4)));
typedef unsigned u32x2 __attribute__((ext_vector_type(2)));
typedef unsigned long long u64;

constexpr int D = 1024, NB = 4, SEQ = 4096, M = NB * SEQ, DEPTH = 4;
constexpr int NH = 8, QKD = 96, VD = 64, QL = 256, KVL = 128, ROPE = 32;
constexpr int SGW = 256, LRW = 256, DIN = 1440, DINP = 1536;
constexpr int DFF = 2816, NE = 8, DFE = 1408;
constexpr int ECAP = 16384;
constexpr int MAXT = 136;
constexpr float LOG2E = 1.4426950408889634f;
constexpr float QSCALE = 0.10206207261596577f * LOG2E;

typedef __bf16 bf16x2_t __attribute__((ext_vector_type(2)));
__device__ __forceinline__ unsigned cvt_pk(float lo, float hi) { f32x2 v = {lo, hi}; bf16x2_t b = __builtin_convertvector(v, bf16x2_t); return __builtin_bit_cast(unsigned, b); }
__device__ __forceinline__ float bf2f(unsigned short v) { return __uint_as_float((unsigned)v << 16); }
__device__ __forceinline__ float bflo(unsigned v) { return __uint_as_float(v << 16); }
__device__ __forceinline__ float bfhi(unsigned v) { return __uint_as_float(v & 0xffff0000u); }
__device__ __forceinline__ float fexp2(float x) { return __builtin_amdgcn_exp2f(x); }
__device__ __forceinline__ float frcp(float x) { return __builtin_amdgcn_rcpf(x); }
__device__ __forceinline__ float sigmoidf_(float x) { return frcp(1.0f + fexp2(-x * LOG2E)); }
__device__ __forceinline__ float siluf_(float x) { return x * sigmoidf_(x); }
__device__ __forceinline__ float gelu_tanh(float x) { const float u = 0.7978845608028654f * (x + 0.044715f * x * x * x); return x * frcp(1.0f + fexp2(-2.0f * LOG2E * u)); }
__device__ __forceinline__ float shx(float v, int lane, int o) { return __builtin_bit_cast(float, __builtin_amdgcn_ds_bpermute((lane ^ o) << 2, __builtin_bit_cast(int, v))); }
__device__ __forceinline__ float wave_sum_dpp(float v) {
    int x = __builtin_bit_cast(int, v);
#define DPP_ADD(ctrl, rmask) x = __builtin_bit_cast(int, __builtin_bit_cast(float, x) + __builtin_bit_cast(float, __builtin_amdgcn_update_dpp(0, x, (ctrl), (rmask), 0xf, false)))
    DPP_ADD(0x111, 0xf); DPP_ADD(0x112, 0xf); DPP_ADD(0x114, 0xf); DPP_ADD(0x118, 0xf);
    DPP_ADD(0x142, 0xa);
    DPP_ADD(0x143, 0xc);
#undef DPP_ADD
    return __builtin_bit_cast(float, __builtin_amdgcn_readlane(x, 63));
}
__device__ __forceinline__ float wave_max_dpp(float v) {
    int x = __builtin_bit_cast(int, v);
#define DPP_MAX(ctrl, rmask) x = __builtin_bit_cast(int, __builtin_fmaxf(__builtin_bit_cast(float, x), __builtin_bit_cast(float, __builtin_amdgcn_update_dpp(0, x, (ctrl), (rmask), 0xf, false))))
    DPP_MAX(0x111, 0xf); DPP_MAX(0x112, 0xf); DPP_MAX(0x114, 0xf); DPP_MAX(0x118, 0xf);
    DPP_MAX(0x142, 0xa);
    DPP_MAX(0x143, 0xc);
#undef DPP_MAX
    return __builtin_bit_cast(float, __builtin_amdgcn_readlane(x, 63));
}
__device__ __forceinline__ float wave_sum(float v, int lane) {
#pragma unroll
    for (int o = 1; o < 64; o <<= 1) v += shx(v, lane, o);
    return v;
}
__device__ __forceinline__ int opaque_tid() { int t = threadIdx.x; asm volatile("" : "+v"(t)); return t; }
#define LDS_WAIT() asm volatile("s_waitcnt lgkmcnt(0)" ::: "memory")
#define VM_WAIT() asm volatile("s_waitcnt vmcnt(0)" ::: "memory")

#define XB_TMO      128
#define XB_XCNT(j)  (256  + 64 * (j))
#define XB_XSUB(j)  (1280 + 64 * (j))
#define XB_XGEN(j)  (2304 + 64 * (j))
#define XB_TOP      3328
#define XB_TOPGEN   3392
#define XB_PTOP(p)  (3456 + 64 * (p))
#define XB_PGEN(p)  (3712 + 64 * (p))
#define XCD_BAR_WORDS 3456
#define XB_SPIN_CAP (1u << 18)

__device__ __forceinline__ unsigned xb_ld(unsigned* p)              { return __hip_atomic_load(p, __ATOMIC_RELAXED, __HIP_MEMORY_SCOPE_AGENT); }
__device__ __forceinline__ unsigned xb_add(unsigned* p, unsigned v) { return __hip_atomic_fetch_add(p, v, __ATOMIC_RELAXED, __HIP_MEMORY_SCOPE_AGENT); }
__device__ __forceinline__ unsigned xb_xcc_id() { return (unsigned)__builtin_amdgcn_s_getreg((3 << 11) | 20) & 0xFu; }
#define XB_SPIN(cond, bar) do { unsigned _sp = 0; while (cond) { __builtin_amdgcn_s_sleep(1); \
    if ((++_sp & 255u) == 0u) { if (xb_ld(&(bar)[XB_TMO])) break; if (_sp > XB_SPIN_CAP) { atomicAdd(&(bar)[XB_TMO], 1u); break; } } } } while (0)

struct XcdBarrier {
    unsigned* bar; unsigned x;
    volatile LAS unsigned* st;
};

__device__ __forceinline__ XcdBarrier xcd_barrier_post(unsigned* bar, volatile LAS unsigned* st) {
    XcdBarrier b; b.bar = bar; b.x = xb_xcc_id(); b.st = st;
    if (opaque_tid() == 0) (void)xb_add(&bar[XB_XCNT(b.x)], 1u);
    return b;
}
__device__ __forceinline__ void xcd_barrier_complete(unsigned* bar, unsigned x, unsigned& nloc, unsigned& nx) {
    const unsigned G = 256u;
    unsigned sum, cnt, mine, sp = 0u;
    for (;;) {
        sum = 0u; cnt = 0u; mine = 0u;
#pragma unroll
        for (unsigned j = 0; j < 16; ++j) { const unsigned c = xb_ld(&bar[XB_XCNT(j)]); sum += c; cnt += (c > 0u) ? 1u : 0u; mine = (j == x) ? c : mine; }
        if (sum == G) break;
        __builtin_amdgcn_s_sleep(1);
        if ((++sp & 255u) == 0u) { if (xb_ld(&bar[XB_TMO])) break; if (sp > XB_SPIN_CAP) { atomicAdd(&bar[XB_TMO], 1u); break; } }
    }
    nloc = mine > 0u ? mine : 1u; nx = cnt > 0u ? cnt : 1u;
}

__device__ __forceinline__ void xcd_barrier(const XcdBarrier& b) {
    asm volatile("s_waitcnt vmcnt(0)" ::: "memory");
    __syncthreads();
    if (opaque_tid() == 0) {
        unsigned* bar = b.bar;
        __builtin_amdgcn_s_waitcnt(0);
        unsigned nloc = b.st[0], nx = b.st[1];
        if (nloc == 0u) { xcd_barrier_complete(bar, b.x, nloc, nx); b.st[0] = nloc; b.st[1] = nx; }
        const unsigned old = xb_add(&bar[XB_XSUB(b.x)], 1u);
        const unsigned gen = old / nloc;
        if (old + 1u == (gen + 1u) * nloc) {
            __builtin_amdgcn_fence(__ATOMIC_RELEASE, "agent");
            asm volatile("s_waitcnt vmcnt(0)" ::: "memory");
            const unsigned og = xb_add(&bar[XB_TOP], 1u);
            const unsigned tg = og / nx;
            if (og + 1u == (tg + 1u) * nx) xb_add(&bar[XB_TOPGEN], 1u);
            else XB_SPIN(xb_ld(&bar[XB_TOPGEN]) == tg, bar);
            __builtin_amdgcn_fence(__ATOMIC_ACQUIRE, "agent");
            xb_add(&bar[XB_XGEN(b.x)], 1u);
            asm volatile("s_waitcnt vmcnt(0)" ::: "memory");
        } else {
            XB_SPIN(xb_ld(&bar[XB_XGEN(b.x)]) == gen, bar);
            __builtin_amdgcn_fence(__ATOMIC_ACQUIRE, "agent");
            asm volatile("s_waitcnt vmcnt(0)" ::: "memory");
        }
    }
    __syncthreads();
}

__device__ __forceinline__ void xcd_pair_barrier(const XcdBarrier& b, unsigned p) {
    asm volatile("s_waitcnt vmcnt(0)" ::: "memory");
    __syncthreads();
    if (opaque_tid() == 0) {
        unsigned* bar = b.bar;
        __builtin_amdgcn_s_waitcnt(0);
        const unsigned nloc = b.st[0];
        const unsigned old = xb_add(&bar[XB_XSUB(b.x)], 1u);
        const unsigned gen = old / nloc;
        if (old + 1u == (gen + 1u) * nloc) {
            __builtin_amdgcn_fence(__ATOMIC_RELEASE, "agent");
            asm volatile("s_waitcnt vmcnt(0)" ::: "memory");
            const unsigned og = xb_add(&bar[XB_PTOP(p)], 1u);
            const unsigned tg = og / 2u;
            if (og + 1u == (tg + 1u) * 2u) xb_add(&bar[XB_PGEN(p)], 1u);
            else XB_SPIN(xb_ld(&bar[XB_PGEN(p)]) == tg, bar);
            __builtin_amdgcn_fence(__ATOMIC_ACQUIRE, "agent");
            xb_add(&bar[XB_XGEN(b.x)], 1u);
            asm volatile("s_waitcnt vmcnt(0)" ::: "memory");
        } else {
            XB_SPIN(xb_ld(&bar[XB_XGEN(b.x)]) == gen, bar);
            __builtin_amdgcn_fence(__ATOMIC_ACQUIRE, "agent");
            asm volatile("s_waitcnt vmcnt(0)" ::: "memory");
        }
    }
    __syncthreads();
}
__device__ __forceinline__ void xcd_local_barrier(const XcdBarrier& b) {
    asm volatile("s_waitcnt vmcnt(0)" ::: "memory");
    __syncthreads();
    if (opaque_tid() == 0) {
        unsigned* bar = b.bar;
        __builtin_amdgcn_s_waitcnt(0);
        const unsigned nloc = b.st[0];
        const unsigned old = xb_add(&bar[XB_XSUB(b.x)], 1u);
        const unsigned gen = old / nloc;
        if (old + 1u == (gen + 1u) * nloc) xb_add(&bar[XB_XGEN(b.x)], 1u);
        else XB_SPIN(xb_ld(&bar[XB_XGEN(b.x)]) == gen, bar);
        __builtin_amdgcn_fence(__ATOMIC_ACQUIRE, "agent");
        asm volatile("s_waitcnt vmcnt(0)" ::: "memory");
    }
    __syncthreads();
}

constexpr size_t MiB = 1u << 20;
constexpr size_t WS_CTL = 0, CTL_ZERO_BYTES = 65536;
constexpr int CW_CURSOR = 4096;
constexpr size_t WS_MOD = 65536;
constexpr size_t WS_COS = WS_MOD + 393216, WS_SIN = WS_COS + 262144;
constexpr size_t WS_SSQQ = WS_SIN + 262144, WS_SSQK = WS_SSQQ + 131072;
constexpr size_t WS_IDX = WS_SSQK + 131072;
constexpr size_t WS_SLOT = WS_IDX + 524288, WS_GATEW = WS_SLOT + 131072;
static_assert(WS_GATEW + 131072 <= 2 * MiB, "small arrays");
constexpr size_t WS_W = 2 * MiB;
constexpr size_t LW_WIN = 0, LW_WUQ = LW_WIN + (size_t)DINP * D, LW_WUK = LW_WUQ + 768 * 256, LW_WUV = LW_WUK + 512 * 256, LW_WO = LW_WUV + 512 * 256,
                 LW_SGW = LW_WO + (size_t)D * D, LW_LWA = LW_SGW + 4 * 128 * 128, LW_LWX = LW_LWA + 4 * 64 * 64, LW_SIZE = ((LW_LWX + 4 * 64 * 64 + 65535) / 65536) * 65536;
static_assert(WS_W % 131072 == 0 && (LW_SIZE * 2) % 131072 == 0 && (LW_WUQ * 2) % 131072 == 0 && (LW_WUK * 2) % 131072 == 0 && (LW_WUV * 2) % 131072 == 0, "q/k/v tile alignment");
constexpr size_t DW_GU = 0, DW_D = DW_GU + (size_t)2 * DFF * D, DW_SIZE = DW_D + (size_t)D * DFF;
constexpr size_t MW_GU = 0, MW_D = MW_GU + (size_t)NE * 2 * DFE * D, MW_SIZE = MW_D + (size_t)NE * D * DFE;
constexpr int DFEP = 1536;
constexpr size_t DW8_GU = 0, DW8_D = DW8_GU + (size_t)2 * DFF * D;
constexpr size_t MW8_GU = 0, MW8_D = MW8_GU + (size_t)NE * 2 * DFE * D;
static_assert(MW8_D + (size_t)NE * D * DFEP <= ((size_t)NE * 2 * DFE * D + (size_t)NE * D * DFE) * 2, "fp8 MoE block fits");
constexpr size_t DW8_CS = 12 * MiB;
constexpr size_t DW8_RS = 13 * MiB, DW8_RSS = 14 * MiB;
constexpr size_t MW8_CS = 40 * MiB;
static_assert(DW8_D + (size_t)D * DFF <= DW8_CS && DW8_RSS + (size_t)8 * ECAP * 4 <= ((size_t)2 * DFF * D + (size_t)D * DFF) * 2, "dense block slack");
static_assert(MW8_D + (size_t)NE * D * DFEP <= MW8_CS && MW8_CS + (size_t)NE * 2 * DFE * 4 <= ((size_t)NE * 2 * DFE * D + (size_t)NE * D * DFE) * 2, "MoE block slack");
constexpr size_t WOFF_DENSE = 4 * LW_SIZE, WOFF_MOE = WOFF_DENSE + 2 * DW_SIZE, W_ELEMS = WOFF_MOE + 2 * MW_SIZE;
static_assert(WS_W + W_ELEMS * 2 <= 192 * MiB, "weight arena");
constexpr size_t WS_H = 192 * MiB, WS_YO = 224 * MiB, WS_RA = 288 * MiB;
constexpr size_t WS_ZQ = WS_RA, WS_ZKV = WS_ZQ + 8 * MiB, WS_KR = WS_ZKV + 8 * MiB, WS_U = WS_KR + 1 * MiB, WS_GV = WS_U + 8 * MiB, WS_ZX = WS_GV + 8 * MiB, WS_GY = WS_ZX + 8 * MiB,
                 WS_Q = WS_GY + 8 * MiB, WS_KN = WS_Q + 24 * MiB, WS_VT = WS_KN + 16 * MiB, WS_Y = WS_VT + 16 * MiB, WS_HL = WS_Y + 32 * MiB, WS_PP = WS_HL + 16 * MiB, WS_END = WS_PP + 16 * MiB;
constexpr size_t WS_ACT = WS_RA, WS_YD = WS_RA + 94 * MiB;
constexpr size_t WS_ACTD = WS_END, WS_END2 = WS_ACTD + 44 * MiB;
static_assert((size_t)M * DFF <= 44 * MiB, "dense activation buffer");
static_assert((size_t)MAXT * 256 * DFE * 2 <= 94 * MiB && (size_t)M * DFF * 2 <= 94 * MiB && WS_YD + (size_t)MAXT * 256 * D * 2 <= WS_END, "FFN overlay");

constexpr int RING_BYTES = 131072;
constexpr int MISC_OFF = RING_BYTES;
constexpr int LDS_BYTES = 147456;


namespace pg8 {
constexpr int BM = 256, BK = 64, HALF = 128, HTB = HALF * BK * 2  , STAGE_BYTES = 8 * HTB, NXCD = 8, WGM = 8;
__device__ __forceinline__ int lds_byte(int r, int c) { const int st = (r >> 4) * 2 + (c >> 5), rr = r & 15, cc = c & 31, ob = rr * 64 + cc * 2; return st * 1024 + (ob ^ (((ob >> 9) & 1) << 5)); }
__device__ __forceinline__ void stage_rc(int b, int& R, int& C) { const int st = b / 1024, sb = b % 1024, swz = sb ^ (((sb >> 9) & 1) << 5); R = (st >> 1) * 16 + swz / 64; C = (st & 1) * 32 + (swz % 64) / 2; }
__device__ __forceinline__ int perm32(int rho) { const int n = rho >> 4, i = rho & 15; return 8 * (i >> 2) + 4 * n + (i & 3); }

typedef int i32x8 __attribute__((ext_vector_type(8)));
typedef int i32x4v __attribute__((ext_vector_type(4)));
__device__ __forceinline__ i32x8 cat8(const bf16x8 a, const bf16x8 b) { const i32x4v x = __builtin_bit_cast(i32x4v, a), y = __builtin_bit_cast(i32x4v, b); return __builtin_shufflevector(x, y, 0, 1, 2, 3, 4, 5, 6, 7); }
__device__ __forceinline__ unsigned pk4_fp8(const f32x4 v) {
    float lim = 448.f; asm volatile("" : "+s"(lim));
    const float a = __builtin_fminf(__builtin_fmaxf(v[0], -lim), lim), b = __builtin_fminf(__builtin_fmaxf(v[1], -lim), lim), c = __builtin_fminf(__builtin_fmaxf(v[2], -lim), lim), d = __builtin_fminf(__builtin_fmaxf(v[3], -lim), lim);
    int w = __builtin_amdgcn_cvt_pk_fp8_f32(a, b, 0, false); w = __builtin_amdgcn_cvt_pk_fp8_f32(c, d, w, true); return (unsigned)w; }
__device__ __forceinline__ unsigned pk4_i8(const f32x4 v) {
    const unsigned b0 = __builtin_bit_cast(unsigned, v[0] + 12582912.0f), b1 = __builtin_bit_cast(unsigned, v[1] + 12582912.0f), b2 = __builtin_bit_cast(unsigned, v[2] + 12582912.0f), b3 = __builtin_bit_cast(unsigned, v[3] + 12582912.0f);
    const unsigned lo = __builtin_amdgcn_perm(b1, b0, 0x0c0c0400u), hi = __builtin_amdgcn_perm(b3, b2, 0x0c0c0400u);
    return __builtin_amdgcn_perm(hi, lo, 0x05040100u); }
__device__ __forceinline__ f32x4 i2f4(const f32x4 a) { const i32x4v q = __builtin_bit_cast(i32x4v, a); return (f32x4){(float)q[0], (float)q[1], (float)q[2], (float)q[3]}; }
constexpr float F8_WSC = 64.0f, F8_HSC = 4.0f, F8_ASC = 8.0f;
struct Unit { int pm, pn, x0, x1, x2, x3, co; };
struct Gemm { const void* A; const void* Bt; int K; int ld = 0; };

struct StaticOrder {
    static constexpr bool GATHER = false;
    int nM, nN, nwg, G, c, lim;
    __device__ void init(int Mr, int N, int G_, int c_) { nM = Mr / BM; nN = N / BM; nwg = nM * nN; G = G_; c = c_; lim = nwg; }
    __device__ bool next_tail(Unit& u) const { const int L = lim + 8 * ((c >> 3) >> 1) + (c & 7); if (L >= nwg) return false; map(L, u); u.co = ((c >> 3) & 1) * HALF; return true; }
    __device__ bool next(int i, Unit& u) const {
        const long L = (long)i * G + c; if (L >= lim) return false;
        map((int)L, u); return true; }
    __device__ void map(int Lq, Unit& u) const {
        int wgid = Lq; { const int q = nwg / NXCD, r = nwg % NXCD, xcd = wgid % NXCD, off = wgid / NXCD; wgid = (xcd < r ? xcd * (q + 1) : r * (q + 1) + (xcd - r) * q) + off; }
        const int nig = WGM * nN, gid = wgid / nig, fm = gid * WGM, gsz = (nM - fm) < WGM ? (nM - fm) : WGM;
        u.pm = fm + ((wgid % nig) % gsz); u.pn = (wgid % nig) / gsz; u.x0 = u.pm; u.x1 = u.pn; u.x2 = 0; u.x3 = 0; u.co = 0;
    }
    __device__ __forceinline__ int src_row(const Unit&, int) const { return 0; }
};

struct QkvOrder {
    static constexpr bool GATHER = false;
    int G, c, tq_a, tq_b, tk_a, tk_b, tv_a, tv_b;
    __device__ bool next(int i, Unit& u) const {
        const int L = i * G + c; if (L >= 448) return false;
        if (L < 192) { const int pm = L / 3, pn = L - 3 * pm; u.pm = tq_a + pm; u.pn = tq_b + pn; u.x0 = pm; u.x1 = pn; u.x2 = 0; }
        else if (L < 320) { const int j = L - 192, pm = j >> 1, pn = j & 1; u.pm = tk_a + pm; u.pn = tk_b + pn; u.x0 = pm; u.x1 = pn; u.x2 = 1; }
        else { const int j = L - 320, pn = j >> 1, pm = j & 1; u.pm = tv_a + pm; u.pn = tv_b + pn; u.x0 = pm; u.x1 = pn; u.x2 = 2; }
        u.x3 = 0; return true;
    }
    __device__ __forceinline__ int src_row(const Unit&, int) const { return 0; }
};
template <class S> struct TailOrder {
    static constexpr bool GATHER = false;
    const S& s;
    __device__ __forceinline__ bool next(int i, Unit& u) const { return i == 0 && s.next_tail(u); }
    __device__ __forceinline__ int src_row(const Unit&, int) const { return 0; }
};

template <class Epi, class Sched, bool ALIGN_EPI, int NBJ = 2, int QM = 0>
__device__ __forceinline__ void gemm_phase(LAS unsigned char* lds, const Gemm g, const Sched& S, const Epi& E) {
    const int tid = opaque_tid(), wid = __builtin_amdgcn_readfirstlane(tid >> 6), lane = tid & 63, wr = wid >> 2, wc = wid & 3, fr = lane & 15, fq = lane >> 4;
    constexpr bool F8 = (QM == 1); const int K = g.K, LD = g.ld ? g.ld : g.K, RB = QM ? LD : 2 * LD  , nt = (QM ? K : 2 * K) / 128;
    constexpr bool GA = Sched::GATHER;
    unsigned voffA, voffB;
    { int R, C; stage_rc(tid * 16, R, C); const int Rb = Epi::PERM ? ((R & ~31) + perm32(R & 31)) : R; voffA = (unsigned)(R * RB + 2 * C); voffB = (unsigned)(Rb * RB + 2 * C); }
    const size_t dstep = (size_t)64 * RB;
    u32x4 vG;
    LAS u32x4* gstash = (LAS u32x4*)(lds + STAGE_BYTES + 4096 + tid * 16);
    const size_t kstep = (size_t)(BK * 2);
    const size_t hstep = GA ? 0 : (size_t)HALF * RB;
    const size_t tstep = (size_t)BM * RB;
    const unsigned ldsw = (unsigned)wid * 1024u;
    const int aoff = lds_byte(wr * 64 + fr, fq * 8), boff = lds_byte(wc * 32 + fr, fq * 8);
#define PG8_SA(b, h) (((b) * 2 + (h)) * HTB)
#define PG8_SB(b, h) ((4 + (b) * 2 + (h)) * HTB)
#define PG8_STAGE(bufoff, gbase, voff) do { _Pragma("unroll") for (int _i = 0; _i < 2; ++_i) \
        __builtin_amdgcn_global_load_lds((const unsigned*)((const char*)(gbase) + _i * dstep + (voff)), (LAS unsigned*)(lds + (bufoff) + ldsw + _i * 8192), 16, 0, 0); } while (0)
#define PG8_STAGE_A(bufoff, gbase, h, NX) do { if constexpr (GA) { _Pragma("unroll") for (int _i = 0; _i < 2; ++_i) \
            __builtin_amdgcn_global_load_lds((const unsigned*)((const char*)(gbase) + vG[(h) * 2 + _i]), (LAS unsigned*)(lds + (bufoff) + ldsw + _i * 8192), 16, 0, 0); } \
        else { PG8_STAGE(bufoff, (const char*)(gbase) + (h) * hstep, voffA); } } while (0)
#define PG8_LDA(dst, b, h) do { _Pragma("unroll") for (int m = 0; m < 4; ++m) _Pragma("unroll") for (int k = 0; k < 2; ++k) dst[m][k] = *(const LAS bf16x8*)(lds + PG8_SA(b, h) + aoff + m * 2048 + k * 1024); } while (0)
#define PG8_LDB(dst, b, h) do { _Pragma("unroll") for (int n = 0; n < 2; ++n) _Pragma("unroll") for (int k = 0; k < 2; ++k) dst[n][k] = *(const LAS bf16x8*)(lds + PG8_SB(b, h) + boff + n * 2048 + k * 1024); } while (0)
#define PG8_MMA(ai, bj, At, Bt) do { __builtin_amdgcn_s_setprio(1); _Pragma("unroll") for (int m = 0; m < 4; ++m) _Pragma("unroll") for (int n = 0; n < 2; ++n) { \
        if constexpr (F8) acc[ai][bj][m][n] = __builtin_amdgcn_mfma_scale_f32_16x16x128_f8f6f4(cat8(Bt[n][0], Bt[n][1]), cat8(At[m][0], At[m][1]), acc[ai][bj][m][n], 0, 0, 0, 0, 0, 0);     \
        else if constexpr (QM == 2) { _Pragma("unroll") for (int k = 0; k < 2; ++k) acc[ai][bj][m][n] = __builtin_bit_cast(f32x4, __builtin_amdgcn_mfma_i32_16x16x64_i8(__builtin_bit_cast(i32x4v, Bt[n][k]), __builtin_bit_cast(i32x4v, At[m][k]), __builtin_bit_cast(i32x4v, acc[ai][bj][m][n]), 0, 0, 0)); } \
        else { _Pragma("unroll") for (int k = 0; k < 2; ++k) acc[ai][bj][m][n] = __builtin_amdgcn_mfma_f32_16x16x32_bf16(Bt[n][k], At[m][k], acc[ai][bj][m][n], 0, 0, 0); } } __builtin_amdgcn_s_setprio(0); } while (0)
#define PG8_WAIT_V(n) asm volatile("s_waitcnt vmcnt(" #n ")" ::: "memory")
#define PG8_WAIT_L(n) asm volatile("s_waitcnt lgkmcnt(" #n ")" ::: "memory")
#define PG8_WAIT_VN do { if constexpr (NBJ == 2) PG8_WAIT_V(8); else PG8_WAIT_V(6); } while (0)
#define PG8_BAR __builtin_amdgcn_s_barrier()
#define PG8_SCHED __builtin_amdgcn_sched_barrier(0)
#define PG8_GOFF(dst, u) do { if constexpr (GA) { int _t = tid, _R, _C; asm volatile("" : "+v"(_t)); stage_rc(_t * 16, _R, _C);     \
        _Pragma("unroll") for (int _h = 0; _h < 2; ++_h) _Pragma("unroll") for (int _i = 0; _i < 2; ++_i) \
        dst[_h * 2 + _i] = (unsigned)S.src_row(u, _h * HALF + _i * 64 + _R) * (unsigned)RB + 2u * (unsigned)_C; } } while (0)
    Unit cur, nxt; int ui = 0;
    if (!S.next(0, cur)) return;
    f32x4 acc[2][2][4][2];
#pragma unroll
    for (int a = 0; a < 2; ++a)
#pragma unroll
        for (int b = 0; b < 2; ++b)
#pragma unroll
            for (int m = 0; m < 4; ++m)
#pragma unroll
                for (int n = 0; n < 2; ++n) acc[a][b][m][n] = (f32x4){0.f, 0.f, 0.f, 0.f};
    bf16x8 At[4][2], B0[2][2], B1[2][2];
    const char* cA = (const char*)g.A + (GA ? (size_t)0 : (size_t)cur.pm * tstep); const char* cB = (const char*)g.Bt + (size_t)cur.pn * tstep + (size_t)(cur.co / HALF) * ((size_t)HALF * RB);
    PG8_GOFF(vG, cur);
    PG8_STAGE(PG8_SB(0, 0), cB, voffB); if constexpr (NBJ == 2) PG8_STAGE(PG8_SB(0, 1), cB + (size_t)HALF * RB, voffB); PG8_STAGE_A(PG8_SA(0, 0), cA, 0, false); PG8_STAGE_A(PG8_SA(0, 1), cA, 1, false);
    if (wr == 1) PG8_BAR;
    PG8_WAIT_V(2); PG8_BAR;
    PG8_STAGE(PG8_SB(1, 0), cB + kstep, voffB); PG8_STAGE_A(PG8_SA(1, 0), cA + kstep, 0, false); if constexpr (NBJ == 2) PG8_STAGE(PG8_SB(1, 1), cB + (size_t)HALF * RB + kstep, voffB);
    if constexpr (NBJ == 2) PG8_WAIT_V(6); else PG8_WAIT_V(4);
    PG8_BAR;
    const size_t bh = (size_t)HALF * RB;
    for (;;) {
        const bool has_next = S.next(ui + 1, nxt);
        if constexpr (GA) { u32x4 nx = vG; if (has_next) { PG8_GOFF(nx, nxt); } *gstash = nx; }
        const char* nA = has_next ? (const char*)g.A + (GA ? (size_t)0 : (size_t)nxt.pm * tstep) : cA; const char* nB = has_next ? (const char*)g.Bt + (size_t)nxt.pn * tstep + (size_t)(nxt.co / HALF) * ((size_t)HALF * RB) : cB;
#pragma nounroll
        for (int t = 0; t < nt; t += 2) {
            const bool last = (t == nt - 2);
            const bool tail = last && !has_next;
            if constexpr (GA) asm volatile("" : "+v"(voffB), "+v"(vG));
            else asm volatile("" : "+v"(voffA), "+v"(voffB));
            const char* a1 = cA + (size_t)(t + 1) * kstep;
            const char* a2 = last ? nA : cA + (size_t)(t + 2) * kstep; const char* b2 = last ? nB : cB + (size_t)(t + 2) * kstep;
            const char* a3 = a2 + kstep; const char* b3 = b2 + kstep;
            PG8_LDB(B0, 0, 0); if constexpr (NBJ == 2) PG8_LDB(B1, 0, 1); PG8_SCHED; PG8_LDA(At, 0, 0); PG8_STAGE_A(PG8_SA(1, 1), a1, 1, false);
            if constexpr (GA) { if (last) vG = *gstash; }
            PG8_WAIT_VN; PG8_WAIT_L(0); PG8_BAR; PG8_MMA(0, 0, At, B0); if constexpr (NBJ == 2) PG8_MMA(0, 1, At, B1); PG8_BAR; PG8_SCHED;
            PG8_LDA(At, 0, 1); if (!tail) { PG8_STAGE(PG8_SB(0, 0), b2, voffB); if constexpr (NBJ == 2) PG8_STAGE(PG8_SB(0, 1), b2 + bh, voffB); PG8_STAGE_A(PG8_SA(0, 0), a2, 0, last); }
            if (tail) PG8_WAIT_V(2); else PG8_WAIT_VN;
            PG8_WAIT_L(0); PG8_BAR; PG8_MMA(1, 0, At, B0); if constexpr (NBJ == 2) PG8_MMA(1, 1, At, B1); PG8_BAR; PG8_SCHED;
            PG8_LDB(B0, 1, 0); if constexpr (NBJ == 2) PG8_LDB(B1, 1, 1); PG8_SCHED; PG8_LDA(At, 1, 0); if (!tail) PG8_STAGE_A(PG8_SA(0, 1), a2, 1, last);
            if (tail) PG8_WAIT_V(0); else PG8_WAIT_VN;
            PG8_WAIT_L(0); PG8_BAR; PG8_MMA(0, 0, At, B0); if constexpr (NBJ == 2) PG8_MMA(0, 1, At, B1); PG8_BAR; PG8_SCHED;
            PG8_LDA(At, 1, 1); if (!tail) { PG8_STAGE(PG8_SB(1, 0), b3, voffB); if constexpr (NBJ == 2) PG8_STAGE(PG8_SB(1, 1), b3 + bh, voffB); PG8_STAGE_A(PG8_SA(1, 0), a3, 0, last); }
            if (tail) PG8_WAIT_V(0); else PG8_WAIT_VN;
            PG8_WAIT_L(0); PG8_BAR; PG8_MMA(1, 0, At, B0); if constexpr (NBJ == 2) PG8_MMA(1, 1, At, B1); PG8_BAR; PG8_SCHED;
        }
        if constexpr (ALIGN_EPI) { if (wr == 0) PG8_BAR; }
        { int l2 = lane; asm volatile("" : "+v"(l2)); E.template operator()<NBJ>(acc, cur, wr, wc, l2 & 15, l2 >> 4); }
        if (!has_next) break;
#pragma unroll
        for (int a = 0; a < 2; ++a)
#pragma unroll
            for (int b = 0; b < 2; ++b)
#pragma unroll
                for (int m = 0; m < 4; ++m)
#pragma unroll
                    for (int n = 0; n < 2; ++n) acc[a][b][m][n] = (f32x4){0.f, 0.f, 0.f, 0.f};
        cur = nxt; cA = nA; cB = nB; ++ui;
        if constexpr (ALIGN_EPI) { if (wr == 1) PG8_BAR; }
    }
    PG8_WAIT_V(0);
    if constexpr (!ALIGN_EPI) { if (wr == 0) PG8_BAR; }
    PG8_BAR;
#undef PG8_SA
#undef PG8_SB
#undef PG8_STAGE
#undef PG8_STAGE_A
#undef PG8_LDA
#undef PG8_LDB
#undef PG8_MMA
#undef PG8_WAIT_V
#undef PG8_WAIT_L
#undef PG8_WAIT_VN
#undef PG8_BAR
#undef PG8_SCHED
#undef PG8_GOFF
}

typedef f32x4 AccT[2][2][4][2];
__device__ __forceinline__ u32x4 pack8(const f32x4 v0, const f32x4 v1) { u32x4 w; w.x = cvt_pk(v0[0], v0[1]); w.y = cvt_pk(v0[2], v0[3]); w.z = cvt_pk(v1[0], v1[1]); w.w = cvt_pk(v1[2], v1[3]); return w; }
__device__ __forceinline__ float rstd_from(u64 ssq, float inv_n) { return __builtin_amdgcn_rsqf((float)ssq * (1.0f / 4294967296.0f) * inv_n + 1e-6f); }
__device__ __forceinline__ f32x4 gelu4(f32x4 v) {
    constexpr float K1 = -2.0f * LOG2E * 0.7978845608028654f, K2 = K1 * 0.044715f;
    typedef float f32x2_ __attribute__((ext_vector_type(2)));
    f32x2_ k1 = (f32x2_){K1, K1}, k2 = (f32x2_){K2, K2}; asm volatile("" : "+s"(k1), "+s"(k2));
    const f32x4 k1v = __builtin_shufflevector(k1, k1, 0, 1, 0, 1), k2v = __builtin_shufflevector(k2, k2, 0, 1, 0, 1);
    const f32x4 t = v * ((v * v) * k2v + k1v);
    f32x4 d = (f32x4){fexp2(t[0]), fexp2(t[1]), fexp2(t[2]), fexp2(t[3])}; d = d + 1.0f;
    const f32x4 s = (f32x4){frcp(d[0]), frcp(d[1]), frcp(d[2]), frcp(d[3])};
    return v * s; }

struct EpiF32 {
    static constexpr bool PERM = false;
    float* O; int ldc;
    template <int NBJ = 2> __device__ __forceinline__ void operator()(const AccT& acc, const Unit& u, int wr, int wc, int fr, int fq) const {
#pragma unroll
        for (int ai = 0; ai < 2; ++ai)
#pragma unroll
            for (int m = 0; m < 4; ++m) { float* rowp = O + (size_t)(u.x0 * BM + ai * HALF + wr * 64 + m * 16 + fr) * ldc + u.x1 * BM + wc * 32 + 4 * fq;
#pragma unroll
                for (int bj = 0; bj < 2; ++bj)
#pragma unroll
                    for (int n = 0; n < 2; ++n) *(f32x4*)(rowp + bj * HALF + n * 16) = acc[ai][bj][m][n]; }
    }
};
struct EpiBf {
    static constexpr bool PERM = true;
    bf16* O; int ldc;
    template <int NBJ = 2> __device__ __forceinline__ void operator()(const AccT& acc, const Unit& u, int wr, int wc, int fr, int fq) const {
#pragma unroll
        for (int ai = 0; ai < 2; ++ai)
#pragma unroll
            for (int m = 0; m < 4; ++m) { bf16* rowp = O + (size_t)(u.x0 * BM + ai * HALF + wr * 64 + m * 16 + fr) * ldc + u.x1 * BM + wc * 32 + 8 * fq;
#pragma unroll
                for (int bj = 0; bj < NBJ; ++bj) *(u32x4*)(rowp + u.co + bj * HALF) = pack8(acc[ai][bj][m][0], acc[ai][bj][m][1]); }
    }
};
struct EpiSwiglu {
    static constexpr bool PERM = true;
    bf16* O; int ldc;
    template <int NBJ = 2> __device__ __forceinline__ void operator()(const AccT& acc, const Unit& u, int wr, int wc, int fr, int fq) const {
#pragma unroll
        for (int ai = 0; ai < 2; ++ai)
#pragma unroll
            for (int m = 0; m < 4; ++m) { bf16* rowp = O + (size_t)(u.x0 * BM + ai * HALF + wr * 64 + m * 16 + fr) * ldc + u.x1 * HALF + wc * 32 + 8 * fq;
                f32x4 a0, a1;
#pragma unroll
                for (int e = 0; e < 4; ++e) { a0[e] = siluf_(acc[ai][0][m][0][e]) * acc[ai][1][m][0][e]; a1[e] = siluf_(acc[ai][0][m][1][e]) * acc[ai][1][m][1][e]; }
                *(u32x4*)rowp = pack8(a0, a1); }
    }
};
struct EpiBfS {
    static constexpr bool PERM = true;
    bf16* O; int ldc; float sc;
    template <int NBJ = 2> __device__ __forceinline__ void operator()(const AccT& acc, const Unit& u, int wr, int wc, int fr, int fq) const {
#pragma unroll
        for (int ai = 0; ai < 2; ++ai)
#pragma unroll
            for (int m = 0; m < 4; ++m) { bf16* rowp = O + (size_t)(u.x0 * BM + ai * HALF + wr * 64 + m * 16 + fr) * ldc + u.x1 * BM + wc * 32 + 8 * fq;
#pragma unroll
                for (int bj = 0; bj < NBJ; ++bj) *(u32x4*)(rowp + u.co + bj * HALF) = pack8(acc[ai][bj][m][0] * sc, acc[ai][bj][m][1] * sc); }
    }
};
struct EpiSwiglu8 {
    static constexpr bool PERM = true;
    unsigned char* O; int ldc, zt;
    template <int NBJ = 2> __device__ __forceinline__ void operator()(const AccT& acc, const Unit& u, int wr, int wc, int fr, int fq) const {
        constexpr float sg = 1.0f / (F8_HSC * F8_WSC), su = F8_ASC / (F8_HSC * F8_WSC);
#pragma unroll
        for (int ai = 0; ai < 2; ++ai)
#pragma unroll
            for (int m = 0; m < 4; ++m) { unsigned char* rowp = O + (size_t)(u.x0 * BM + ai * HALF + wr * 64 + m * 16 + fr) * ldc + u.x1 * HALF + wc * 32 + 8 * fq;
                f32x4 a0, a1;
#pragma unroll
                for (int e = 0; e < 4; ++e) { a0[e] = siluf_(acc[ai][0][m][0][e] * sg) * (acc[ai][1][m][0][e] * su); a1[e] = siluf_(acc[ai][0][m][1][e] * sg) * (acc[ai][1][m][1][e] * su); }
                u32x2 w; w.x = pk4_fp8(a0); w.y = pk4_fp8(a1); *(u32x2*)rowp = w;
                if (u.x1 == zt) *(u32x2*)(rowp + HALF) = (u32x2){0u, 0u}; }
    }
};
template <bool SLOT> struct EpiSwigluI8 {
    static constexpr bool PERM = true;
    unsigned char* O; int ldc, zt; const float* rs; const float* cs;
    template <int NBJ = 2> __device__ __forceinline__ void operator()(const AccT& acc, const Unit& u, int wr, int wc, int fr, int fq) const {
        const float* cp = cs + (size_t)u.pn * BM + wc * 32 + 8 * fq;
        const f32x4 cg0 = *(const f32x4*)cp, cg1 = *(const f32x4*)(cp + 4), cu0 = *(const f32x4*)(cp + HALF) * F8_ASC, cu1 = *(const f32x4*)(cp + HALF + 4) * F8_ASC;
        float rr[2][4];
#pragma unroll
        for (int ai = 0; ai < 2; ++ai)
#pragma unroll
            for (int m = 0; m < 4; ++m) { const int rl = ai * HALF + wr * 64 + m * 16 + fr; rr[ai][m] = SLOT ? ((rl < u.x3) ? rs[u.x2 + rl] : 0.f) : rs[u.x0 * BM + rl]; }
#pragma unroll
        for (int ai = 0; ai < 2; ++ai)
#pragma unroll
            for (int m = 0; m < 4; ++m) { const int rl = ai * HALF + wr * 64 + m * 16 + fr;
                unsigned char* rowp = O + (size_t)(u.x0 * BM + rl) * ldc + u.x1 * HALF + wc * 32 + 8 * fq;
                const float r = rr[ai][m];
                const f32x4 g0 = i2f4(acc[ai][0][m][0]) * (cg0 * r), g1 = i2f4(acc[ai][0][m][1]) * (cg1 * r), u0 = i2f4(acc[ai][1][m][0]) * (cu0 * r), u1 = i2f4(acc[ai][1][m][1]) * (cu1 * r);
                f32x4 nl2 = (f32x4){-LOG2E, -LOG2E, -LOG2E, -LOG2E}; asm volatile("" : "+v"(nl2));
                const f32x4 t0 = g0 * nl2, t1 = g1 * nl2;
                f32x4 d0, d1;
#pragma unroll
                for (int e = 0; e < 4; ++e) { d0[e] = fexp2(t0[e]); d1[e] = fexp2(t1[e]); }
                d0 = d0 + 1.0f; d1 = d1 + 1.0f;
                f32x4 s0, s1;
#pragma unroll
                for (int e = 0; e < 4; ++e) { s0[e] = frcp(d0[e]); s1[e] = frcp(d1[e]); }
                f32x4 a0 = (g0 * u0) * s0, a1 = (g1 * u1) * s1;
                float lim = 448.f; asm volatile("" : "+v"(lim));
#pragma unroll
                for (int e = 0; e < 4; ++e) { a0[e] = __builtin_amdgcn_fmed3f(a0[e], -lim, lim); a1[e] = __builtin_amdgcn_fmed3f(a1[e], -lim, lim); }
                u32x2 w;
                { int w0 = __builtin_amdgcn_cvt_pk_fp8_f32(a0[0], a0[1], 0, false); w0 = __builtin_amdgcn_cvt_pk_fp8_f32(a0[2], a0[3], w0, true);
                  int w1 = __builtin_amdgcn_cvt_pk_fp8_f32(a1[0], a1[1], 0, false); w1 = __builtin_amdgcn_cvt_pk_fp8_f32(a1[2], a1[3], w1, true); w.x = (unsigned)w0; w.y = (unsigned)w1; }
                *(u32x2*)rowp = w;
                if (u.x1 == zt) *(u32x2*)(rowp + HALF) = (u32x2){0u, 0u}; }
    }
};
struct EpiIn {
    static constexpr bool PERM = true;
    unsigned char* ws; const float* rs; const float* cs;
    template <int NBJ = 2> __device__ __forceinline__ void operator()(const AccT& acc, const Unit& u, int wr, int wc, int fr, int fq) const {
        const int pn = u.pn;
        f32x4 c0[NBJ], c1[NBJ];
        { const float* cp = cs + (size_t)pn * BM + u.co + wc * 32 + 8 * fq;
#pragma unroll
          for (int bj = 0; bj < NBJ; ++bj) { c0[bj] = *(const f32x4*)(cp + bj * HALF); c1[bj] = *(const f32x4*)(cp + bj * HALF + 4); } }
        float rr[2][4];
#pragma unroll
        for (int ai = 0; ai < 2; ++ai)
#pragma unroll
            for (int m = 0; m < 4; ++m) rr[ai][m] = rs[u.pm * BM + ai * HALF + wr * 64 + m * 16 + fr];
        bf16 *ZQ = (bf16*)(ws + WS_ZQ), *ZKV = (bf16*)(ws + WS_ZKV), *KR = (bf16*)(ws + WS_KR), *U = (bf16*)(ws + WS_U), *GV = (bf16*)(ws + WS_GV), *ZX = (bf16*)(ws + WS_ZX), *GY = (bf16*)(ws + WS_GY);
        u64 *ssq_q = (u64*)(ws + WS_SSQQ), *ssq_kv = (u64*)(ws + WS_SSQK); const float *cosT = (const float*)(ws + WS_COS), *sinT = (const float*)(ws + WS_SIN);
        const bool krope = (pn == 1 && wc == 0 && (NBJ == 2 || (u.co >> 7) == 1));
#pragma unroll
        for (int ai = 0; ai < 2; ++ai) {
            f32x4 cc[4], sn[4];
            if (krope) {
#pragma unroll
                for (int m = 0; m < 4; ++m) { const int pos = (u.pm * BM + ai * HALF + wr * 64 + m * 16 + fr) & (SEQ - 1); cc[m] = *(const f32x4*)(cosT + pos * 16 + 4 * fq); sn[m] = *(const f32x4*)(sinT + pos * 16 + 4 * fq); } }
#pragma unroll
            for (int m = 0; m < 4; ++m) {
                const int row = u.pm * BM + ai * HALF + wr * 64 + m * 16 + fr; const int cl = wc * 32 + 8 * fq; const float rsc = rr[ai][m];
                const int hb = u.co >> 7;
                if (pn == 0 || pn == 1) {
                    bf16* dst = (pn == 0 ? ZQ : ZKV) + (size_t)row * 256 + cl;
                    float ss = 0.f;
#pragma unroll
                    for (int bj = 0; bj < NBJ; ++bj) { const f32x4 v0 = i2f4(acc[ai][bj][m][0]) * (c0[bj] * rsc), v1 = i2f4(acc[ai][bj][m][1]) * (c1[bj] * rsc);
                        *(u32x4*)(dst + (bj + hb) * HALF) = pack8(v0, v1);
                        if (pn == 0 || bj + hb == 0) ss += (v0[0] * v0[0] + v0[1] * v0[1]) + (v0[2] * v0[2] + v0[3] * v0[3]) + (v1[0] * v1[0] + v1[1] * v1[1]) + (v1[2] * v1[2] + v1[3] * v1[3]); }
                    ss += shx(ss, fq * 16 + fr, 16); ss += shx(ss, fq * 16 + fr, 32);
                    if (fq == 0 && (pn == 0 || hb == 0)) atomicAdd((pn == 0 ? ssq_q : ssq_kv) + row, (u64)(ss * 4294967296.0f));
                    if (krope) {
                        const f32x4 x1 = i2f4(acc[ai][NBJ == 2 ? 1 : 0][m][0]) * (c0[NBJ == 2 ? 1 : 0] * rsc), x2 = i2f4(acc[ai][NBJ == 2 ? 1 : 0][m][1]) * (c1[NBJ == 2 ? 1 : 0] * rsc);
                        const f32x4 c = cc[m], s = sn[m];
                        const f32x4 o1 = x1 * c - x2 * s, o2 = x2 * c + x1 * s;
                        u32x2 w1, w2; w1.x = cvt_pk(o1[0], o1[1]); w1.y = cvt_pk(o1[2], o1[3]); w2.x = cvt_pk(o2[0], o2[1]); w2.y = cvt_pk(o2[2], o2[3]);
                        *(u32x2*)(KR + (size_t)row * 32 + 4 * fq) = w1; *(u32x2*)(KR + (size_t)row * 32 + 16 + 4 * fq) = w2; }
                } else {
                    bf16* dst = (pn == 2 ? U : pn == 3 ? GV : pn == 4 ? ZX : GY) + (size_t)row * 256 + cl;
#pragma unroll
                    for (int bj = 0; bj < NBJ; ++bj) { f32x4 v0 = i2f4(acc[ai][bj][m][0]) * (c0[bj] * rsc), v1 = i2f4(acc[ai][bj][m][1]) * (c1[bj] * rsc);
                        if (pn != 4) { v0 = gelu4(v0); v1 = gelu4(v1); }
                        *(u32x4*)(dst + (bj + hb) * HALF) = pack8(v0, v1); }
                }
            }
        }
    }
};
struct EpiQ {
    static constexpr bool PERM = true;
    unsigned char* ws;
    template <int NBJ = 2> __device__ __forceinline__ void operator()(const AccT& acc, const Unit& u, int wr, int wc, int fr, int fq) const {
        bf16* Q = (bf16*)(ws + WS_Q); const u64* ssq = (const u64*)(ws + WS_SSQQ); const float *cosT = (const float*)(ws + WS_COS), *sinT = (const float*)(ws + WS_SIN);
        u64 sq[2][4];
#pragma unroll
        for (int ai = 0; ai < 2; ++ai)
#pragma unroll
            for (int m = 0; m < 4; ++m) sq[ai][m] = ssq[u.x0 * BM + ai * HALF + wr * 64 + m * 16 + fr];
        const bool rope = ((u.x1 * 8 + wc) % 3 == 2) || ((u.x1 * 8 + 4 + wc) % 3 == 2);
#pragma unroll
        for (int ai = 0; ai < 2; ++ai) {
            f32x4 cc[4], sn[4];
            if (rope) {
#pragma unroll
                for (int m = 0; m < 4; ++m) { const int pos = (u.x0 * BM + ai * HALF + wr * 64 + m * 16 + fr) & (SEQ - 1); cc[m] = *(const f32x4*)(cosT + pos * 16 + 4 * fq); sn[m] = *(const f32x4*)(sinT + pos * 16 + 4 * fq); } }
#pragma unroll
            for (int m = 0; m < 4; ++m) {
                const int row = u.x0 * BM + ai * HALF + wr * 64 + m * 16 + fr; const float sc = rstd_from(sq[ai][m], 1.0f / 256.0f) * QSCALE;
#pragma unroll
                for (int bj = 0; bj < 2; ++bj) {
                    const int c32 = u.x1 * 8 + bj * 4 + wc, head = c32 / 3, part = c32 - 3 * head;
                    const f32x4 v0 = acc[ai][bj][m][0] * sc, v1 = acc[ai][bj][m][1] * sc; bf16* dst = Q + (size_t)row * 768 + head * 96;
                    if (part < 2) *(u32x4*)(dst + part * 32 + 8 * fq) = pack8(v0, v1);
                    else { const f32x4 c = cc[m], s = sn[m];
                        const f32x4 o1 = v0 * c - v1 * s, o2 = v1 * c + v0 * s;
                        u32x2 w1, w2; w1.x = cvt_pk(o1[0], o1[1]); w1.y = cvt_pk(o1[2], o1[3]); w2.x = cvt_pk(o2[0], o2[1]); w2.y = cvt_pk(o2[2], o2[3]);
                        *(u32x2*)(dst + 64 + 4 * fq) = w1; *(u32x2*)(dst + 80 + 4 * fq) = w2; }
                }
            }
            asm volatile("" ::: "memory");
        }
    }
};
struct EpiK {
    static constexpr bool PERM = true;
    unsigned char* ws;
    template <int NBJ = 2> __device__ __forceinline__ void operator()(const AccT& acc, const Unit& u, int wr, int wc, int fr, int fq) const {
        bf16* KN = (bf16*)(ws + WS_KN); const u64* ssq = (const u64*)(ws + WS_SSQK);
        u64 sq[2][4];
#pragma unroll
        for (int ai = 0; ai < 2; ++ai)
#pragma unroll
            for (int m = 0; m < 4; ++m) sq[ai][m] = ssq[u.x0 * BM + ai * HALF + wr * 64 + m * 16 + fr];
#pragma unroll
        for (int ai = 0; ai < 2; ++ai)
#pragma unroll
            for (int m = 0; m < 4; ++m) {
                const int row = u.x0 * BM + ai * HALF + wr * 64 + m * 16 + fr; const float sc = rstd_from(sq[ai][m], 1.0f / 128.0f);
                bf16* dst = KN + (size_t)row * 512 + u.x1 * BM + wc * 32 + 8 * fq;
#pragma unroll
                for (int bj = 0; bj < 2; ++bj) *(u32x4*)(dst + bj * HALF) = pack8(acc[ai][bj][m][0] * sc, acc[ai][bj][m][1] * sc);
            }
    }
};
struct EpiVT {
    static constexpr bool PERM = true;
    unsigned char* ws;
    template <int NBJ = 2> __device__ __forceinline__ void operator()(const AccT& acc, const Unit& u, int wr, int wc, int fr, int fq) const {
        bf16* VT = (bf16*)(ws + WS_VT); const u64* ssq = (const u64*)(ws + WS_SSQK);
#pragma unroll
        for (int bj = 0; bj < 2; ++bj) {
            const int tk = u.x1 * BM + bj * HALF + wc * 32 + 8 * fq; f32x4 s0, s1;
#pragma unroll
            for (int e = 0; e < 4; ++e) { s0[e] = rstd_from(ssq[tk + e], 1.0f / 128.0f); s1[e] = rstd_from(ssq[tk + 4 + e], 1.0f / 128.0f); }
#pragma unroll
            for (int ai = 0; ai < 2; ++ai)
#pragma unroll
                for (int m = 0; m < 4; ++m) { const int vr = u.x0 * BM + ai * HALF + wr * 64 + m * 16 + fr;
                    *(u32x4*)(VT + (size_t)vr * M + tk) = pack8(acc[ai][bj][m][0] * s0, acc[ai][bj][m][1] * s1); }
        }
    }
};
struct EpiQKV {
    static constexpr bool PERM = true;
    unsigned char* ws;
    template <int NBJ = 2> __device__ __forceinline__ void operator()(const AccT& acc, const Unit& u, int wr, int wc, int fr, int fq) const {
        if (u.x2 == 0) { EpiQ e{ws}; e(acc, u, wr, wc, fr, fq); }
        else if (u.x2 == 1) { EpiK e{ws}; e(acc, u, wr, wc, fr, fq); }
        else { EpiVT e{ws}; e(acc, u, wr, wc, fr, fq); }
    }
};
}

namespace att {
constexpr int KP = 208, VP = 144;
constexpr int KT = 64 * KP, VTB = 64 * VP;
constexpr int LDS_NEED = 2 * KT + 2 * VTB;
constexpr float THR = 8.0f;
__device__ __forceinline__ float max3(float a, float b, float c) { return __builtin_fmaxf(__builtin_fmaxf(a, b), c); }
__device__ __forceinline__ float rowmax32(const f32x16& p0, const f32x16& p1) {
    float a = max3(p0[0], p0[1], p1[0]), b = max3(p0[2], p0[3], p1[1]); a = max3(a, p1[2], p1[3]);
#pragma unroll
    for (int r = 4; r < 16; r += 4) { a = max3(a, p0[r], p0[r + 1]); b = max3(b, p0[r + 2], p0[r + 3]); a = max3(a, p1[r], p1[r + 1]); b = max3(b, p1[r + 2], p1[r + 3]); }
    const float m = __builtin_fmaxf(a, b);
    auto rr = __builtin_amdgcn_permlane32_swap(__float_as_uint(m), __float_as_uint(m), false, false);
    return __builtin_fmaxf(__uint_as_float(rr[0]), __uint_as_float(rr[1]));
}
__device__ __forceinline__ void attn_unit(LAS unsigned char* lds, int b, int h, int qb, const bf16* __restrict__ Q, const bf16* __restrict__ KN, const bf16* __restrict__ KR, const bf16* __restrict__ VT, bf16* __restrict__ Y) {
    const int tid = opaque_tid(), lane = tid & 63, r32 = lane & 31, hi = lane >> 5, w = __builtin_amdgcn_readfirstlane(tid >> 6);
    const int mrow = b * SEQ + qb * 256 + w * 32 + r32;
    const int nt_wg = 4 * qb + 4, nt_w = 4 * qb + (w >> 1) + 1;
    bf16x8 qf[6];
#pragma unroll
    for (int s = 0; s < 6; ++s) qf[s] = *(const bf16x8*)(Q + (size_t)mrow * 768 + h * 96 + 16 * s + 8 * hi);
    f32x16 o0 = {}, o1 = {}; float mref = 0.f, lsum = 0.f;
    const int kr0 = tid / 12, kc0 = tid % 12, kr1 = (tid + 512) / 12, kc1 = (tid + 512) % 12; const bool k2 = tid < 256;
    const int vd = tid >> 3, vc = tid & 7;
    const bf16* kp0 = (kc0 < 8) ? KN + ((size_t)b * SEQ + kr0) * 512 + h * 64 + kc0 * 8 : KR + ((size_t)b * SEQ + kr0) * 32 + (kc0 - 8) * 8; const size_t ks0 = (kc0 < 8) ? 64 * 512 : 64 * 32;
    const bf16* kp1 = (kc1 < 8) ? KN + ((size_t)b * SEQ + kr1) * 512 + h * 64 + kc1 * 8 : KR + ((size_t)b * SEQ + kr1) * 32 + (kc1 - 8) * 8; const size_t ks1 = (kc1 < 8) ? 64 * 512 : 64 * 32;
    const bf16* vp = VT + (size_t)(h * 64 + vd) * M + (size_t)b * SEQ + vc * 8;
    const int kw0 = kr0 * KP + kc0 * 16, kw1 = kr1 * KP + kc1 * 16, vw = 2 * KT + vd * VP + (vc >> 1) * 32 + (vc & 1) * 8;
    u32x4 kgA0, kgA1, vgA, kgB0, kgB1, vgB;
#define AT_GLOADK(S, t) do { kg##S##0 = *(const u32x4*)(kp0 + (size_t)(t) * ks0); if (k2) kg##S##1 = *(const u32x4*)(kp1 + (size_t)(t) * ks1); } while (0)
#define AT_GLOADV(S, t) do { vg##S = *(const u32x4*)(vp + (size_t)(t) * 64); } while (0)
#define AT_WRITEK(S, buf) do { *(LAS u32x4*)(lds + (buf) * KT + kw0) = kg##S##0; if (k2) *(LAS u32x4*)(lds + (buf) * KT + kw1) = kg##S##1; } while (0)
#define AT_WRITEV(S, buf) do { *(LAS u32x2*)(lds + (buf) * VTB + vw) = (u32x2){vg##S.x, vg##S.y}; *(LAS u32x2*)(lds + (buf) * VTB + vw + 16) = (u32x2){vg##S.z, vg##S.w}; } while (0)
    const int kro = r32 * KP + 16 * hi, vro = 2 * KT + r32 * VP + 16 * hi;
#define AT_QK(P0, P1, kb_, CIN) do { const LAS unsigned char* kb__ = lds + (kb_) * KT + kro; \
        _Pragma("unroll") for (int s = 0; s < 6; ++s) { const bf16x8 ka0 = *(const LAS bf16x8*)(kb__ + 32 * s), ka1 = *(const LAS bf16x8*)(kb__ + 32 * KP + 32 * s); \
            if (s == 0) { P0 = __builtin_amdgcn_mfma_f32_32x32x16_bf16(ka0, qf[0], CIN, 0, 0, 0); P1 = __builtin_amdgcn_mfma_f32_32x32x16_bf16(ka1, qf[0], CIN, 0, 0, 0); } \
            else { P0 = __builtin_amdgcn_mfma_f32_32x32x16_bf16(ka0, qf[s], P0, 0, 0, 0); P1 = __builtin_amdgcn_mfma_f32_32x32x16_bf16(ka1, qf[s], P1, 0, 0, 0); } } } while (0)
    AT_GLOADK(A, 0); AT_GLOADV(A, 0); AT_WRITEK(A, 0); AT_WRITEV(A, 0); AT_GLOADK(A, 1); AT_WRITEK(A, 1);
    AT_GLOADK(B, 2); AT_GLOADV(B, 1);
    __syncthreads();
    f32x16 pA, pB, negm = {};
    AT_QK(pA, pB, 0, negm);
    float rm = rowmax32(pA, pB);
    mref = rm;
    f32x16 pA1 = pB;
    f32x16 pB1 = {};
#pragma unroll
    for (int r = 0; r < 16; ++r) { pA[r] -= rm; pA1[r] -= rm; negm[r] = -rm; }
    rm = 0.f;
    __syncthreads();
#define AT_STEP(C0, C1, N0, N1, t, LS, WS) do { \
        if ((t) + 3 < nt_wg) AT_GLOADK(LS, (t) + 3); \
        if ((t) + 2 < nt_wg) AT_GLOADV(LS, (t) + 2); \
        if ((t) < nt_w) { \
            if ((t) > 0 && __builtin_amdgcn_ballot_w64(rm > THR) != 0ull) {     \
                const float dl = __builtin_fmaxf(rm, 0.f), f = fexp2(-dl); mref += dl; lsum *= f; \
                _Pragma("unroll") for (int r = 0; r < 16; ++r) { C0[r] -= dl; C1[r] -= dl; o0[r] *= f; o1[r] *= f; negm[r] = -mref; } } \
            AT_QK(N0, N1, ((t) + 1) & 1, negm);                   \
            _Pragma("unroll") for (int r = 0; r < 16; ++r) { C0[r] = fexp2(C0[r]); C1[r] = fexp2(C1[r]); } \
            bf16x8 pb[4]; \
            _Pragma("unroll") for (int ks = 0; ks < 2; ++ks) { u32x4 wv, wx; \
                wv.x = cvt_pk(C0[8 * ks + 0], C0[8 * ks + 1]); wv.y = cvt_pk(C0[8 * ks + 2], C0[8 * ks + 3]); wv.z = cvt_pk(C0[8 * ks + 4], C0[8 * ks + 5]); wv.w = cvt_pk(C0[8 * ks + 6], C0[8 * ks + 7]); \
                wx.x = cvt_pk(C1[8 * ks + 0], C1[8 * ks + 1]); wx.y = cvt_pk(C1[8 * ks + 2], C1[8 * ks + 3]); wx.z = cvt_pk(C1[8 * ks + 4], C1[8 * ks + 5]); wx.w = cvt_pk(C1[8 * ks + 6], C1[8 * ks + 7]); \
                pb[ks] = __builtin_bit_cast(bf16x8, wv); pb[2 + ks] = __builtin_bit_cast(bf16x8, wx); } \
            { const LAS unsigned char* vb__ = lds + ((t) & 1) * VTB + vro; \
              _Pragma("unroll") for (int ks = 0; ks < 4; ++ks) { \
                const bf16x8 va0 = *(const LAS bf16x8*)(vb__ + 32 * ks), va1 = *(const LAS bf16x8*)(vb__ + 32 * VP + 32 * ks); \
                o0 = __builtin_amdgcn_mfma_f32_32x32x16_bf16(va0, pb[ks], o0, 0, 0, 0); o1 = __builtin_amdgcn_mfma_f32_32x32x16_bf16(va1, pb[ks], o1, 0, 0, 0); } } \
            { float sa = 0.f, sb = 0.f; \
              _Pragma("unroll") for (int r = 0; r < 16; r += 2) { sa += C0[r] + C1[r]; sb += C0[r + 1] + C1[r + 1]; } \
              lsum += sa + sb; } \
            rm = rowmax32(N0, N1); \
              \
            __builtin_amdgcn_sched_group_barrier(0x100, 5, 0);     \
            _Pragma("unroll") for (int g_ = 0; g_ < 12; ++g_) { __builtin_amdgcn_sched_group_barrier(0x008, 1, 0); __builtin_amdgcn_sched_group_barrier(0x100, 1, 0); __builtin_amdgcn_sched_group_barrier(0x402, 4, 0); } \
            _Pragma("unroll") for (int g_ = 0; g_ < 8; ++g_) { __builtin_amdgcn_sched_group_barrier(0x008, 1, 0); __builtin_amdgcn_sched_group_barrier(0x100, 1, 0); __builtin_amdgcn_sched_group_barrier(0x402, 6, 0); } \
        } \
        if ((t) + 2 < nt_wg) AT_WRITEK(WS, (t) & 1); \
        if ((t) + 1 < nt_wg) AT_WRITEV(WS, ((t) + 1) & 1); \
        __syncthreads(); \
    } while (0)
    for (int t = 0; t < nt_wg; t += 2) {
        AT_STEP(pA, pA1, pB, pB1, t, A, B);
        AT_STEP(pB, pB1, pA, pA1, t + 1, B, A);
    }
#undef AT_STEP
#undef AT_QK
#undef AT_GLOADK
#undef AT_GLOADV
#undef AT_WRITEK
#undef AT_WRITEV
    float ltot = lsum; { auto rr = __builtin_amdgcn_permlane32_swap(__float_as_uint(lsum), __float_as_uint(lsum), false, false); ltot = __uint_as_float(rr[0]) + __uint_as_float(rr[1]); }
    const float inv = 1.0f / ltot;
    bf16* yrow = Y + (size_t)mrow * D + h * 64 + 4 * hi;
#pragma unroll
    for (int i = 0; i < 4; ++i) {
        u32x2 w0, w1; w0.x = cvt_pk(o0[4 * i] * inv, o0[4 * i + 1] * inv); w0.y = cvt_pk(o0[4 * i + 2] * inv, o0[4 * i + 3] * inv);
        w1.x = cvt_pk(o1[4 * i] * inv, o1[4 * i + 1] * inv); w1.y = cvt_pk(o1[4 * i + 2] * inv, o1[4 * i + 3] * inv);
        *(u32x2*)(yrow + 8 * i) = w0; *(u32x2*)(yrow + 32 + 8 * i) = w1;
    }
}
}

namespace sgu {
constexpr int VTP = 272;
constexpr int LDS_NEED = 128 * VTP;
__device__ __forceinline__ void unit(LAS unsigned char* lds, int m0, int gh, const bf16* __restrict__ GV, const bf16* __restrict__ U, const bf16* __restrict__ WS, const float* __restrict__ ln_g, const float* __restrict__ ln_b, const float* __restrict__ sb, bf16* __restrict__ Y) {
    const int tid = opaque_tid(), lane = tid & 63, r32 = lane & 31, hi = lane >> 5, w = __builtin_amdgcn_readfirstlane(tid >> 6);
    {
        const int cg = lane & 15, rsub = lane >> 4; const bool mine = (cg >> 3) == gh; const int cl = 16 * (cg & 7);
        f32x4 gq[4], bq[4];
#pragma unroll
        for (int q = 0; q < 4; ++q) { gq[q] = *(const f32x4*)(ln_g + 16 * cg + 4 * q); bq[q] = *(const f32x4*)(ln_b + 16 * cg + 4 * q); }
#pragma unroll
        for (int it = 0; it < 4; ++it) {
            const int s = w * 16 + it * 4 + rsub; const u32x4 r0 = *(const u32x4*)(GV + (size_t)(m0 + s) * 256 + 16 * cg), r1 = *(const u32x4*)(GV + (size_t)(m0 + s) * 256 + 16 * cg + 8);
            f32x4 x[4] = {{bflo(r0.x), bfhi(r0.x), bflo(r0.y), bfhi(r0.y)}, {bflo(r0.z), bfhi(r0.z), bflo(r0.w), bfhi(r0.w)}, {bflo(r1.x), bfhi(r1.x), bflo(r1.y), bfhi(r1.y)}, {bflo(r1.z), bfhi(r1.z), bflo(r1.w), bfhi(r1.w)}};
            float sm = 0.f;
#pragma unroll
            for (int q = 0; q < 4; ++q) sm += (x[q][0] + x[q][1]) + (x[q][2] + x[q][3]);
#pragma unroll
            for (int o = 1; o < 16; o <<= 1) sm += shx(sm, lane, o);
            const float mean = sm * (1.0f / 256.0f); float sq = 0.f;
#pragma unroll
            for (int q = 0; q < 4; ++q) { x[q] = x[q] - mean; sq += (x[q][0] * x[q][0] + x[q][1] * x[q][1]) + (x[q][2] * x[q][2] + x[q][3] * x[q][3]); }
#pragma unroll
            for (int o = 1; o < 16; o <<= 1) sq += shx(sq, lane, o);
            const float rstd = __builtin_amdgcn_rsqf(sq * (1.0f / 256.0f) + 1e-5f);
            if (mine) {
#pragma unroll
                for (int q = 0; q < 4; ++q) { const f32x4 y = x[q] * rstd * gq[q] + bq[q];
#pragma unroll
                    for (int e = 0; e < 4; ++e) *(LAS bf16*)(lds + (cl + 4 * q + e) * VTP + s * 2) = (bf16)(cvt_pk(y[e], 0.f) & 0xffffu); } }
        }
    }
    __syncthreads();
    const int gl = w >> 2, g = 2 * gh + gl, T = w & 3, nks = 2 * (T + 1);
    const bf16* wrow = WS + ((size_t)g * 128 + 32 * T + r32) * 128 + 8 * hi;
    bf16x8 af[8];
#pragma unroll
    for (int ks = 0; ks < 8; ++ks) af[ks] = (ks < nks) ? *(const bf16x8*)(wrow + 16 * ks) : (bf16x8){0, 0, 0, 0, 0, 0, 0, 0};
    f32x16 acc[2] = {};
#pragma unroll
    for (int ks = 0; ks < 8; ++ks) if (ks < nks) {
#pragma unroll
        for (int cb = 0; cb < 2; ++cb) { const bf16x8 bv = *(const LAS bf16x8*)(lds + (gl * 64 + 32 * cb + r32) * VTP + (16 * ks + 8 * hi) * 2);
            acc[cb] = __builtin_amdgcn_mfma_f32_32x32x16_bf16(af[ks], bv, acc[cb], 0, 0, 0); } }
    {
        constexpr int SP = 144;
        LAS unsigned char* sc = lds + 40960 + w * (32 * SP);
        const bf16* urow = U + (size_t)(m0 + 32 * T) * 256 + g * 64; bf16* yrow = Y + (size_t)(m0 + 32 * T) * D + 512 + g * 64;
#pragma unroll
        for (int i = 0; i < 4; ++i) { const int t = i * 8 + (lane >> 3), ch = lane & 7; *(LAS u32x4*)(sc + t * SP + ch * 16) = *(const u32x4*)(urow + (size_t)t * 256 + ch * 8); }
        float bv[16];
#pragma unroll
        for (int r = 0; r < 16; ++r) bv[r] = sb[g * 128 + 32 * T + (r & 3) + 8 * (r >> 2) + 4 * hi];
        asm volatile("" ::: "memory");
#pragma unroll
        for (int cb = 0; cb < 2; ++cb)
#pragma unroll
            for (int r = 0; r < 16; ++r) { const int t = (r & 3) + 8 * (r >> 2) + 4 * hi; LAS bf16* p = (LAS bf16*)(sc + t * SP + (32 * cb + r32) * 2);
                const float y = bf2f(*p) * (acc[cb][r] + bv[r]); *p = (bf16)(cvt_pk(y, 0.f) & 0xffffu); }
        asm volatile("" ::: "memory");
#pragma unroll
        for (int i = 0; i < 4; ++i) { const int t = i * 8 + (lane >> 3), ch = lane & 7; *(u32x4*)(yrow + (size_t)t * D + ch * 8) = *(const LAS u32x4*)(sc + t * SP + ch * 16); }
    }
    __syncthreads();
}
}

namespace lru {
constexpr int XP = 528;
constexpr int AP = 132;
constexpr int OFF_A = 64 * XP, OFF_B = OFF_A + 64 * AP * 4, LDS_NEED = OFF_B + 64 * AP * 4;
__device__ __forceinline__ void local_unit(LAS unsigned char* lds, int b, int c, const bf16* ZX, const float* conv_w, const float* conv_b, const bf16* WA, const bf16* WX,
                                           const float* ba, const float* bx, const float* lam, float* HL, float* PP) {
    const int tid = opaque_tid(), lane = tid & 63, r32 = lane & 31, hi = lane >> 5, w = __builtin_amdgcn_readfirstlane(tid >> 6);
    const int m0 = b * SEQ + c * 64;
    {
        const int cp = tid & 127, tq = tid >> 7, ch = 2 * cp;
        float w0[4], w1[4];
#pragma unroll
        for (int k = 0; k < 4; ++k) { w0[k] = conv_w[k * 256 + ch]; w1[k] = conv_w[k * 256 + ch + 1]; }
        const float cb0 = conv_b[ch], cb1 = conv_b[ch + 1];
        float z0[3], z1[3];
#pragma unroll
        for (int k = 0; k < 3; ++k) { const int tt = c * 64 + tq * 16 - 3 + k; unsigned raw = 0u; if (tt >= 0) raw = *(const unsigned*)(ZX + (size_t)(b * SEQ + tt) * 256 + ch); z0[k] = bflo(raw); z1[k] = bfhi(raw); }
#pragma unroll
        for (int i = 0; i < 16; ++i) { const int t = tq * 16 + i; const unsigned raw = *(const unsigned*)(ZX + (size_t)(m0 + t) * 256 + ch); const float a0 = bflo(raw), a1 = bfhi(raw);
            const float x0 = cb0 + z0[0] * w0[0] + z0[1] * w0[1] + z0[2] * w0[2] + a0 * w0[3], x1 = cb1 + z1[0] * w1[0] + z1[1] * w1[1] + z1[2] * w1[2] + a1 * w1[3];
            *(LAS unsigned*)(lds + t * XP + ch * 2) = cvt_pk(x0, x1);
            z0[0] = z0[1]; z0[1] = z0[2]; z0[2] = a0; z1[0] = z1[1]; z1[1] = z1[2]; z1[2] = a1; }
    }
    __syncthreads();
    LAS float* A32 = (LAS float*)(lds + OFF_A); LAS float* B32 = (LAS float*)(lds + OFF_B);
    for (int half = 0; half < 2; ++half) {
        {
            const int head = 2 * half + (w >> 2), tb = (w >> 1) & 1, jb = w & 1;
            f32x16 ar = {}, ai = {};
            bf16x8 wa[4], wx[4];
#pragma unroll
            for (int ks = 0; ks < 4; ++ks) { wa[ks] = *(const bf16x8*)(WA + ((size_t)head * 64 + 32 * jb + r32) * 64 + 16 * ks + 8 * hi); wx[ks] = *(const bf16x8*)(WX + ((size_t)head * 64 + 32 * jb + r32) * 64 + 16 * ks + 8 * hi); }
#pragma unroll
            for (int ks = 0; ks < 4; ++ks) {
                const bf16x8 xa = *(const LAS bf16x8*)(lds + (32 * tb + r32) * XP + (head * 64 + 16 * ks + 8 * hi) * 2);
                ar = __builtin_amdgcn_mfma_f32_32x32x16_bf16(xa, wa[ks], ar, 0, 0, 0); ai = __builtin_amdgcn_mfma_f32_32x32x16_bf16(xa, wx[ks], ai, 0, 0, 0);
            }
            const int ch = head * 64 + 32 * jb + r32, chl = ch - 128 * half;
            const float bav = ba[ch], bxv = bx[ch], lm = lam[ch];
            const float nsp = -8.0f * (fmaxf(-lm, 0.f) + log1pf(__expf(-fabsf(lm))));
#pragma unroll
            for (int r = 0; r < 16; ++r) { const int t = 32 * tb + (r & 3) + 8 * (r >> 2) + 4 * hi;
                const float rg = sigmoidf_(ar[r] + bav), ig = sigmoidf_(ai[r] + bxv), la = rg * nsp;
                const float x2 = 2.0f * la;
                const float a = __expf(la);
                const float om = (x2 > -0.25f) ? -x2 * (1.0f + x2 * (0.5f + x2 * (0.16666667f + x2 * (0.041666668f + x2 * (0.0083333338f + x2 * 0.0013888889f))))) : 1.0f - a * a;
                const float s = sqrtf(fmaxf(om, 0.f));
                const float xc = bf2f(*(const LAS bf16*)(lds + t * XP + ch * 2));
                A32[t * AP + chl] = a; B32[t * AP + chl] = s * (ig * xc); }
        }
        __syncthreads();
        {
            const int chs = tid & 127, seg = tid >> 7; LAS float* sum = (LAS float*)(lds + LDS_NEED);
            float av[16], bv[16];
#pragma unroll
            for (int i = 0; i < 16; ++i) { av[i] = A32[(16 * seg + i) * AP + chs]; bv[i] = B32[(16 * seg + i) * AP + chs]; }
            float hh = 0.f, pp = 1.f;
#pragma unroll
            for (int i = 0; i < 16; ++i) { hh = av[i] * hh + bv[i]; pp *= av[i]; bv[i] = hh; av[i] = pp; }
            sum[(seg * 2) * 128 + chs] = hh; sum[(seg * 2 + 1) * 128 + chs] = pp;
            __syncthreads();
            float Hin = 0.f, Pin = 1.f;
#pragma unroll
            for (int s = 0; s < 3; ++s) if (s < seg) { const float hs = sum[(s * 2) * 128 + chs], ps = sum[(s * 2 + 1) * 128 + chs]; Hin = ps * Hin + hs; Pin *= ps; }
            float* hl = HL + (size_t)(m0 + 16 * seg) * 256 + 128 * half + chs; float* pq = PP + (size_t)(m0 + 16 * seg) * 256 + 128 * half + chs;
#pragma unroll
            for (int i = 0; i < 16; ++i) { hl[(size_t)i * 256] = bv[i] + av[i] * Hin; pq[(size_t)i * 256] = av[i] * Pin; }
        }
        __syncthreads();
    }
}
__device__ __forceinline__ void fix_unit(LAS unsigned char* lds, int b, int c, const float* __restrict__ HL, const float* __restrict__ PP, const bf16* __restrict__ GY, bf16* __restrict__ Y) {
    const int tid = opaque_tid(); const int m0 = b * SEQ + c * 64; LAS float* hin = (LAS float*)lds;
    {
        const int ch = tid & 255, half = tid >> 8, c0 = half ? (c >> 1) : 0, c1 = half ? c : (c >> 1);
        float h = 0.f, pa = 1.f; const float* pq = PP + (size_t)(b * SEQ + 63) * 256 + ch; const float* hq = HL + (size_t)(b * SEQ + 63) * 256 + ch;
        int cc = c0;
        for (; cc + 8 <= c1; cc += 8) { float pv[8], hv[8];
#pragma unroll
            for (int j = 0; j < 8; ++j) { pv[j] = pq[(size_t)(cc + j) * 64 * 256]; hv[j] = hq[(size_t)(cc + j) * 64 * 256]; }
#pragma unroll
            for (int j = 0; j < 8; ++j) { h = pv[j] * h + hv[j]; pa *= pv[j]; } }
        for (; cc < c1; ++cc) { const float pv = pq[(size_t)cc * 64 * 256]; h = pv * h + hq[(size_t)cc * 64 * 256]; pa *= pv; }
        if (half) { hin[256 + ch] = h; hin[512 + ch] = pa; }
        __syncthreads();
        if (!half) hin[ch] = hin[512 + ch] * h + hin[256 + ch];
    }
    __syncthreads();
#pragma unroll
    for (int k = 0; k < 8; ++k) { const int item = tid + 512 * k, t = item >> 6, cg = item & 63; const size_t mo = (size_t)(m0 + t) * 256 + 4 * cg;
        const f32x4 hl = *(const f32x4*)(HL + mo), pp = *(const f32x4*)(PP + mo), hi4 = *(const LAS f32x4*)(hin + 4 * cg); const u32x2 gy = *(const u32x2*)(GY + mo);
        const f32x4 hv = hl + pp * hi4; u32x2 o; o.x = cvt_pk(hv[0] * bflo(gy.x), hv[1] * bfhi(gy.x)); o.y = cvt_pk(hv[2] * bflo(gy.y), hv[3] * bfhi(gy.y));
        *(u32x2*)(Y + (size_t)(m0 + t) * D + 768 + 4 * cg) = o; }
    __syncthreads();
}
}

struct MoeOrder {
    static constexpr bool GATHER = false;
    const volatile LAS int* tab; int npn, G, c, lim;
    __device__ __forceinline__ bool next_tail(pg8::Unit& u) const { const int L = lim + (c >> 1); if (L >= __builtin_amdgcn_readfirstlane(tab[24]) * npn) return false; map(L, u); u.co = (c & 1) * pg8::HALF; return true; }
    __device__ __forceinline__ bool next(int i, pg8::Unit& u) const {
        const int L = i * G + c, TT = __builtin_amdgcn_readfirstlane(tab[24]); if (L >= TT * npn || L >= lim) return false;
        map(L, u); return true; }
    __device__ __forceinline__ void map(int L, pg8::Unit& u) const {
        const int ti = L / npn, pnl = L - ti * npn; int e = 0;
#pragma unroll
        for (int j = 1; j < 8; ++j) e += (ti >= tab[16 + j]) ? 1 : 0;
        e = __builtin_amdgcn_readfirstlane(e);
        const int lt = ti - __builtin_amdgcn_readfirstlane(tab[16 + e]);
        u.pm = ti; u.pn = e * npn + pnl; u.x0 = ti; u.x1 = pnl; u.x2 = e * ECAP + lt * 256; u.x3 = __builtin_amdgcn_readfirstlane(tab[32 + e]) - lt * 256; u.co = 0;
    }
    __device__ __forceinline__ int src_row(const pg8::Unit&, int) const { return 0; }
};
struct MoeGatherOrder : MoeOrder {
    static constexpr bool GATHER = true;
    const int* idx;
    __device__ __forceinline__ int src_row(const pg8::Unit& u, int r) const { return (r < u.x3) ? idx[u.x2 + r] : 0; }
};

struct RowArgs {
    const float* xin; float* X; bf16* Xb; const bf16* Ysrc; const bf16* YD;     const int* slot; const float* gatew;
    const float* gate; const float* postg;
    const float* preg; const float* sc; const float* sh;
    bf16* H; const float* router; unsigned* cursor; int* idx; int* slot_w; float* gatew_w; u64* ssq_q; u64* ssq_kv; float* rs; float* rss;
};
template <int MODE>
__device__ __forceinline__ void row_phase(LAS unsigned char* lds, const volatile LAS int* tab, int vcu, const RowArgs& a, bool need_h, bool route) {
    const int tid = opaque_tid(), lane = tid & 63, w = __builtin_amdgcn_readfirstlane(tid >> 6);
    LAS float* rt = (LAS float*)lds; LAS int* e01 = (LAS int*)(lds + 32768); LAS float* rsl = (LAS float*)(lds + 32768 + 256);
    if (route) { for (int i = tid; i < 8192; i += 512) rt[(i & 7) * 1024 + (i >> 3)] = a.router[i]; __syncthreads(); }
    f32x4 cg[4], cb[4], cs[4];
#pragma unroll
#define RC(j) (512 * ((j) >> 1) + 8 * lane + 4 * ((j) & 1))
    for (int j = 0; j < 4; ++j) { const int col = RC(j);
        if (MODE != 0) cg[j] = *(const f32x4*)(a.gate + col) * *(const f32x4*)(a.postg + col);
        if (need_h) { cb[j] = *(const f32x4*)(a.preg + col) * (*(const f32x4*)(a.sc + col) + 1.0f); cs[j] = *(const f32x4*)(a.sh + col); } }
    const int row0 = vcu * 64 + w * 8;
    int slotv0 = 0, slotv1 = 0; float gv0 = 0.f, gv1 = 0.f;
    if (MODE == 3) { const int rr = row0 + (lane & 7); slotv0 = a.slot[rr * 2]; slotv1 = a.slot[rr * 2 + 1]; gv0 = a.gatew[rr * 2]; gv1 = a.gatew[rr * 2 + 1]; }
    f32x4 nx0[2][4]; u32x4 nxb[2][2], nyp[2][2], nyq[2][2];
#define ROW_LOAD(S, rw, ii) do { \
        if (MODE == 0) { _Pragma("unroll") for (int j = 0; j < 4; ++j) nx0[S][j] = __builtin_nontemporal_load((const f32x4*)(a.xin + (size_t)(rw) * D + RC(j))); } \
        else { _Pragma("unroll") for (int jj = 0; jj < 2; ++jj) nxb[S][jj] = __builtin_nontemporal_load((const u32x4*)(a.Xb + (size_t)(rw) * D + 512 * jj + 8 * lane)); } \
        if (MODE == 3) { const int s0_ = __builtin_amdgcn_readlane(slotv0, (ii)), s1_ = __builtin_amdgcn_readlane(slotv1, (ii)); \
            const size_t r0_ = (size_t)tab[16 + (s0_ >> 14)] * 256 + (s0_ & (ECAP - 1)), r1_ = (size_t)tab[16 + (s1_ >> 14)] * 256 + (s1_ & (ECAP - 1)); \
            _Pragma("unroll") for (int jj = 0; jj < 2; ++jj) { nyp[S][jj] = __builtin_nontemporal_load((const u32x4*)(a.YD + r0_ * D + 512 * jj + 8 * lane)); nyq[S][jj] = __builtin_nontemporal_load((const u32x4*)(a.YD + r1_ * D + 512 * jj + 8 * lane)); } } \
        else if (MODE != 0) { _Pragma("unroll") for (int jj = 0; jj < 2; ++jj) nyp[S][jj] = __builtin_nontemporal_load((const u32x4*)(a.Ysrc + (size_t)(rw) * D + 512 * jj + 8 * lane)); } } while (0)
    ROW_LOAD(0, row0, 0); ROW_LOAD(1, row0 + 1, 1);
#pragma unroll
    for (int i = 0; i < 8; ++i) {
        const int row = row0 + i; constexpr int dummy_ = 0; (void)dummy_;
        f32x4 x[4]; u32x2 yp[4], yq[4];
#pragma unroll
        for (int jj = 0; jj < 2; ++jj) {
            if (MODE == 0) { x[2 * jj] = nx0[i & 1][2 * jj]; x[2 * jj + 1] = nx0[i & 1][2 * jj + 1]; }
            else { const u32x4 q_ = nxb[i & 1][jj]; x[2 * jj] = (f32x4){bflo(q_.x), bfhi(q_.x), bflo(q_.y), bfhi(q_.y)}; x[2 * jj + 1] = (f32x4){bflo(q_.z), bfhi(q_.z), bflo(q_.w), bfhi(q_.w)}; }
            yp[2 * jj] = (u32x2){nyp[i & 1][jj].x, nyp[i & 1][jj].y}; yp[2 * jj + 1] = (u32x2){nyp[i & 1][jj].z, nyp[i & 1][jj].w}; yq[2 * jj] = (u32x2){nyq[i & 1][jj].x, nyq[i & 1][jj].y}; yq[2 * jj + 1] = (u32x2){nyq[i & 1][jj].z, nyq[i & 1][jj].w}; }
        if (i + 2 < 8) { if (i & 1) ROW_LOAD(1, row + 2, i + 2); else ROW_LOAD(0, row + 2, i + 2); }
        if (MODE != 0) {
            f32x4 y[4];
            if (MODE == 3) {
                const float g0 = __builtin_bit_cast(float, __builtin_amdgcn_readlane(__builtin_bit_cast(int, gv0), i)), g1 = __builtin_bit_cast(float, __builtin_amdgcn_readlane(__builtin_bit_cast(int, gv1), i));
#pragma unroll
                for (int j = 0; j < 4; ++j) y[j] = (f32x4){bflo(yp[j].x), bfhi(yp[j].x), bflo(yp[j].y), bfhi(yp[j].y)} * g0 + (f32x4){bflo(yq[j].x), bfhi(yq[j].x), bflo(yq[j].y), bfhi(yq[j].y)} * g1;
            } else {
#pragma unroll
                for (int j = 0; j < 4; ++j) y[j] = (f32x4){bflo(yp[j].x), bfhi(yp[j].x), bflo(yp[j].y), bfhi(yp[j].y)};
            }
            float ss = 0.f;
#pragma unroll
            for (int j = 0; j < 4; ++j) ss += (y[j][0] * y[j][0] + y[j][1] * y[j][1]) + (y[j][2] * y[j][2] + y[j][3] * y[j][3]);
            const float r = __builtin_amdgcn_rsqf(wave_sum_dpp(ss) * (1.0f / D) + 1e-6f);
#pragma unroll
            for (int j = 0; j < 4; ++j) x[j] = x[j] + cg[j] * (y[j] * r);
        }
        if (a.X) {
#pragma unroll
            for (int j = 0; j < 4; ++j) *(f32x4*)(a.X + (size_t)row * D + RC(j)) = x[j];
        } else {
#pragma unroll
            for (int jj = 0; jj < 2; ++jj) __builtin_nontemporal_store(pg8::pack8(x[2 * jj], x[2 * jj + 1]), (u32x4*)(a.Xb + (size_t)row * D + 512 * jj + 8 * lane)); }
        if (need_h) {
            float ss = 0.f;
#pragma unroll
            for (int j = 0; j < 4; ++j) ss += (x[j][0] * x[j][0] + x[j][1] * x[j][1]) + (x[j][2] * x[j][2] + x[j][3] * x[j][3]);
            const float r = __builtin_amdgcn_rsqf(wave_sum_dpp(ss) * (1.0f / D) + 1e-6f);
            f32x4 hv[4];
#pragma unroll
            for (int j = 0; j < 4; ++j) hv[j] = (x[j] * r) * cb[j] + cs[j];
            float qinv = 0.f;
            {
                float am = 0.f;
#pragma unroll
                for (int j = 0; j < 4; ++j) am = __builtin_fmaxf(am, __builtin_fmaxf(__builtin_fmaxf(__builtin_fabsf(hv[j][0]), __builtin_fabsf(hv[j][1])), __builtin_fmaxf(__builtin_fabsf(hv[j][2]), __builtin_fabsf(hv[j][3]))));
                am = __builtin_fmaxf(wave_max_dpp(am), 1e-30f); qinv = 127.0f / am;
                if (lane == 0) { const float s = am * (1.0f / 127.0f); a.rs[row] = s; if (route) rsl[w * 8 + i] = s; } }
#pragma unroll
            for (int jj = 0; jj < 2; ++jj) {
                u32x2 o; o.x = pg8::pk4_i8(hv[2 * jj] * qinv); o.y = pg8::pk4_i8(hv[2 * jj + 1] * qinv); *(u32x2*)((unsigned char*)a.H + (size_t)row * D + 512 * jj + 8 * lane) = o; }
            if (route) {
                float pe[8];
#pragma unroll
                for (int e = 0; e < 8; ++e) { float p = 0.f;
#pragma unroll
                    for (int j = 0; j < 4; ++j) { const f32x4 rv = *(const LAS f32x4*)(rt + e * 1024 + RC(j)); p += (hv[j][0] * rv[0] + hv[j][1] * rv[1]) + (hv[j][2] * rv[2] + hv[j][3] * rv[3]); }
                    pe[e] = p; }
                float q4[4], q2[2], q1;
                { const bool up = (lane & 32) != 0;
#pragma unroll
                  for (int j = 0; j < 4; ++j) { const float keep = up ? pe[4 + j] : pe[j], give = up ? pe[j] : pe[4 + j]; q4[j] = keep + shx(give, lane, 32); } }
                { const bool up = (lane & 16) != 0;
#pragma unroll
                  for (int j = 0; j < 2; ++j) { const float keep = up ? q4[2 + j] : q4[j], give = up ? q4[j] : q4[2 + j]; q2[j] = keep + shx(give, lane, 16); } }
                { const bool up = (lane & 8) != 0; const float keep = up ? q2[1] : q2[0], give = up ? q2[0] : q2[1]; q1 = keep + shx(give, lane, 8); }
                q1 += shx(q1, lane, 4); q1 += shx(q1, lane, 2); q1 += shx(q1, lane, 1);
                float lg[8];
#pragma unroll
                for (int e = 0; e < 8; ++e) lg[e] = __builtin_bit_cast(float, __builtin_amdgcn_readlane(__builtin_bit_cast(int, q1), 8 * e));
                int e0 = 0; float v0 = lg[0];
#pragma unroll
                for (int e = 1; e < 8; ++e) if (lg[e] > v0) { v0 = lg[e]; e0 = e; }
                int e1 = -1; float v1 = -3.0e38f;
#pragma unroll
                for (int e = 0; e < 8; ++e) if (e != e0 && lg[e] > v1) { v1 = lg[e]; e1 = e; }
                const float g0 = 1.0f / (1.0f + __expf(v1 - v0)), g1 = 1.0f - g0;
                if (lane == 0) { e01[w * 8 + i] = e0 | (e1 << 8); a.gatew_w[row * 2] = g0; a.gatew_w[row * 2 + 1] = g1; }
            }
        }
        if (MODE == 1 && lane == 0) { a.ssq_q[row] = 0ull; a.ssq_kv[row] = 0ull; }
    }
    if (route) {
        __syncthreads();
        if (w == 0) {
            const int pk = e01[lane], e0 = pk & 255, e1 = pk >> 8, token = vcu * 64 + lane; const u64 lt = (1ull << lane) - 1ull;
            int p0 = 0, p1 = 0, mycnt = 0;
#pragma unroll
            for (int e = 0; e < 8; ++e) {
                const u64 m0 = __ballot(e0 == e), m1 = __ballot(e1 == e); const int c0 = __popcll(m0), c1 = __popcll(m1);
                if (lane == e) mycnt = c0 + c1;
                if (e0 == e) p0 = __popcll(m0 & lt);
                if (e1 == e) p1 = c0 + __popcll(m1 & lt);
            }
            unsigned mybase = 0u; if (lane < 8 && mycnt > 0) mybase = atomicAdd(a.cursor + lane, (unsigned)mycnt);
#pragma unroll
            for (int e = 0; e < 8; ++e) { const int base = __builtin_amdgcn_readlane((int)mybase, e); if (e0 == e) p0 += base; if (e1 == e) p1 += base; }
            a.idx[e0 * ECAP + p0] = token; a.idx[e1 * ECAP + p1] = token;
            a.slot_w[token * 2] = e0 * ECAP + p0; a.slot_w[token * 2 + 1] = e1 * ECAP + p1;
            { const float s = rsl[lane]; a.rss[e0 * ECAP + p0] = s; a.rss[e1 * ECAP + p1] = s; }
        }
        __syncthreads();
    }
}

__device__ __forceinline__ int rperm(int jj) { return 8 * ((jj & 15) >> 2) + 4 * (jj >> 4) + (jj & 3); }
__device__ __forceinline__ int map_row(int kind, int n) {
    if (kind == 1) return 256 * (n >> 7) + (n & 127);
    if (kind == 2) return 256 * (n >> 7) + 128 + (n & 127);
    if (kind == 3) return n < 384 ? n : (n < 416 ? 384 + rperm(n - 384) : n + 96);
    if (kind == 4) { const int h = n / 96, j = n - 96 * h; return j < 64 ? n : h * 96 + 64 + rperm(j - 64); }
    return n;
}
template <bool F8 = false>
__device__ __forceinline__ void tr_item(const float* W, int ldn, void* WTv, int ldk, const float* gain, int kind, LAS float* scr, int kb, int nb, int lane) {
    const int k0 = 64 * kb, n0 = 32 * nb;
#pragma unroll
    for (int i = 0; i < 32; ++i) { const int kk = 2 * i + (lane >> 5); float v = __builtin_nontemporal_load(W + (size_t)(k0 + kk) * ldn + n0 + (lane & 31)); if (gain) v *= gain[k0 + kk]; scr[kk * 33 + (lane & 31)] = v; }
    LDS_WAIT(); asm volatile("" ::: "memory");
    const int c = lane & 7;
#pragma unroll
    for (int j = 0; j < 4; ++j) { const int n = (lane >> 3) + 8 * j; const LAS float* s = scr + (8 * c) * 33 + n;
        if constexpr (F8) { u32x2 o; o.x = pg8::pk4_fp8((f32x4){s[0 * 33], s[1 * 33], s[2 * 33], s[3 * 33]} * pg8::F8_WSC); o.y = pg8::pk4_fp8((f32x4){s[4 * 33], s[5 * 33], s[6 * 33], s[7 * 33]} * pg8::F8_WSC);
            *(u32x2*)((unsigned char*)WTv + (size_t)map_row(kind, n0 + n) * ldk + k0 + 8 * c) = o; }
        else { bf16* WT = (bf16*)WTv; u32x4 o; o.x = cvt_pk(s[0 * 33], s[1 * 33]); o.y = cvt_pk(s[2 * 33], s[3 * 33]); o.z = cvt_pk(s[4 * 33], s[5 * 33]); o.w = cvt_pk(s[6 * 33], s[7 * 33]);
            *(u32x4*)(WT + (size_t)map_row(kind, n0 + n) * ldk + k0 + 8 * c) = o; } }
    LDS_WAIT(); asm volatile("" ::: "memory");
}
__device__ __forceinline__ void colq_item(const float* W, int ldn, unsigned char* WT, float* CS, int kind, int nb, LAS float* red, int tid) {
    const int lane = tid & 63, w = tid >> 6, n = lane & 31, kh = lane >> 5, kb = 128 * w + 64 * kh;
    const float* src = W + (size_t)kb * ldn + nb * 32 + n;
    float v[64];
#pragma unroll
    for (int j = 0; j < 64; ++j) v[j] = __builtin_nontemporal_load(src + (size_t)j * ldn);
    float m = 0.f;
#pragma unroll
    for (int j = 0; j < 64; ++j) m = __builtin_fmaxf(m, __builtin_fabsf(v[j]));
    m = __builtin_fmaxf(m, shx(m, lane, 32));
    if (kh == 0) red[w * 32 + n] = m;
    __syncthreads();
    float cm = red[n];
#pragma unroll
    for (int ww = 1; ww < 8; ++ww) cm = __builtin_fmaxf(cm, red[ww * 32 + n]);
    cm = __builtin_fmaxf(cm, 1e-30f);
    const float inv = 127.0f / cm; const int row = map_row(kind, nb * 32 + n);
    if (w == 0 && kh == 0) CS[row] = cm * (1.0f / 127.0f);
    unsigned char* dst = WT + (size_t)row * 1024 + kb;
#pragma unroll
    for (int c = 0; c < 4; ++c) { u32x4 o;
        o.x = pg8::pk4_i8((f32x4){v[16 * c + 0], v[16 * c + 1], v[16 * c + 2], v[16 * c + 3]} * inv); o.y = pg8::pk4_i8((f32x4){v[16 * c + 4], v[16 * c + 5], v[16 * c + 6], v[16 * c + 7]} * inv);
        o.z = pg8::pk4_i8((f32x4){v[16 * c + 8], v[16 * c + 9], v[16 * c + 10], v[16 * c + 11]} * inv); o.w = pg8::pk4_i8((f32x4){v[16 * c + 12], v[16 * c + 13], v[16 * c + 14], v[16 * c + 15]} * inv);
        *(u32x4*)(dst + 16 * c) = o; }
    __syncthreads();
}
__device__ __forceinline__ void sincos_acc(float ang, float& s, float& c) {
    const double a = (double)ang; const double kq = __builtin_rint(a * 0.63661977236758134308); const double r = (a - kq * 1.57079632679489655800e+00) - kq * 6.12323399573676603587e-17;
    const float x = (float)r, x2 = x * x;
    const float sp = x + x * x2 * (-1.6666667163e-01f + x2 * (8.3333337680e-03f + x2 * (-1.9841270114e-04f + x2 * 2.7557314297e-06f)));
    const float cp = 1.0f + x2 * (-0.5f + x2 * (4.1666667908e-02f + x2 * (-1.3888889225e-03f + x2 * (2.4801587642e-05f + x2 * -2.7557314297e-07f))));
    const int q = ((int)kq) & 3;
    s = (q == 0) ? sp : (q == 1) ? cp : (q == 2) ? -sp : -cp;
    c = (q == 0) ? cp : (q == 1) ? -sp : (q == 2) ? -cp : sp;
}

struct Args { const float* in[32]; float* out; unsigned char* ws; };
enum { I_X = 0, I_C, I_WMOD, I_BMOD, I_PREMIX, I_POSTMIX, I_WIN, I_QNG, I_WUQ, I_KVNG, I_WUKV, I_SGLNG, I_SGLNB, I_SGW, I_SGB, I_CONVW, I_CONVB, I_LWA, I_LBA, I_LWX, I_LBX, I_LAM,
       I_WO, I_PREFFN, I_POSTFFN, I_FG, I_FU, I_FD, I_ROUTER, I_MG, I_MU, I_MD };

#define WSL GAS unsigned char* wslg_ = (GAS unsigned char*)args.ws; int zi_ = 0, bxo = bx_, vcuo = vcu_, Go = G_; asm volatile("" : "+s"(wslg_), "+s"(zi_), "+s"(bxo), "+s"(vcuo), "+s"(Go)); unsigned char* wsl = (unsigned char*)wslg_
#define AIN(i) ((const float*)(GAS const float*)args.in[(i) + zi_])
#define W_ctl ((unsigned*)(wsl + WS_CTL))
#define W_MOD ((float*)(wsl + WS_MOD))
#define W_cosT ((float*)(wsl + WS_COS))
#define W_sinT ((float*)(wsl + WS_SIN))
#define W_ssq_q ((u64*)(wsl + WS_SSQQ))
#define W_ssq_kv ((u64*)(wsl + WS_SSQK))
#define W_IDX ((int*)(wsl + WS_IDX))
#define W_SLOT ((int*)(wsl + WS_SLOT))
#define W_GATEW ((float*)(wsl + WS_GATEW))
#define W_WB ((bf16*)(wsl + WS_W))
#define W_H ((bf16*)(wsl + WS_H))
#define W_YO ((bf16*)(wsl + WS_YO))
#define W_ZQ ((bf16*)(wsl + WS_ZQ))
#define W_ZKV ((bf16*)(wsl + WS_ZKV))
#define W_KR ((bf16*)(wsl + WS_KR))
#define W_U ((bf16*)(wsl + WS_U))
#define W_GV ((bf16*)(wsl + WS_GV))
#define W_ZX ((bf16*)(wsl + WS_ZX))
#define W_GY ((bf16*)(wsl + WS_GY))
#define W_Q ((bf16*)(wsl + WS_Q))
#define W_KN ((bf16*)(wsl + WS_KN))
#define W_VT ((bf16*)(wsl + WS_VT))
#define W_Y ((bf16*)(wsl + WS_Y))
#define W_HL ((float*)(wsl + WS_HL))
#define W_PP ((float*)(wsl + WS_PP))
#define W_ACT ((bf16*)(wsl + WS_ACT))
#define W_YD ((bf16*)(wsl + WS_YD))
#define W_DW8(i) ((unsigned char*)(W_WB + WOFF_DENSE + (size_t)(i) * DW_SIZE))
#define W_MW8(i) ((unsigned char*)(W_WB + WOFF_MOE + (size_t)(i) * MW_SIZE))
#define W_ACT8 ((unsigned char*)(wsl + WS_ACT))
#define W_ACT8D ((unsigned char*)(wsl + WS_ACTD))
#define W_X ((float*)(GAS float*)args.out)
#define W_XB ((bf16*)(wsl + WS_YO + 32 * MiB))
__global__ void __launch_bounds__(512, 2) trunk_fwd(Args args) {
    extern __shared__ __attribute__((aligned(16))) unsigned char lds_raw[];
    LAS unsigned char* lds = (LAS unsigned char*)lds_raw;
    volatile LAS unsigned* MISC = (volatile LAS unsigned*)(lds + MISC_OFF);
    const volatile LAS int* tab = (const volatile LAS int*)(lds + MISC_OFF);
    const int wave = __builtin_amdgcn_readfirstlane(threadIdx.x >> 6);
    constexpr int G_ = 256;
    if (gridDim.x != G_) return;
    const int bx_ = blockIdx.x, vcu_ = (bx_ % 8) * (G_ / 8) + bx_ / 8;
    for (int u = threadIdx.x; u < (LDS_BYTES - MISC_OFF) / 4; u += 512) MISC[u] = 0u;
    __syncthreads();
    { WSL; (void)xcd_barrier_post(W_ctl, MISC); }
    { WSL; if (opaque_tid() == 0 && bx_ < 8) __hip_atomic_store(W_ctl + 6000 + bx_, xb_xcc_id() + 1u, __ATOMIC_RELAXED, __HIP_MEMORY_SCOPE_AGENT); }
#define GRID_BAR() do { WSL; XcdBarrier b_; b_.bar = W_ctl; b_.x = xb_xcc_id(); b_.st = MISC; xcd_barrier(b_); } while (0)
#define GRID_BAR_P() do { WSL; XcdBarrier b_; b_.bar = W_ctl; b_.x = xb_xcc_id(); b_.st = MISC; if (MISC[9]) xcd_pair_barrier(b_, (unsigned)((bx_ & 7) >> 1)); else xcd_barrier(b_); } while (0)
#define GRID_BAR_L() do { WSL; XcdBarrier b_; b_.bar = W_ctl; b_.x = xb_xcc_id(); b_.st = MISC; if (MISC[8]) xcd_local_barrier(b_); else xcd_barrier(b_); } while (0)

    {
        WSL; const int tid = opaque_tid(), lane = tid & 63;
        LAS float* scr = (LAS float*)(lds + wave * 8448);
        const int gw = vcuo * 8 + wave, NGW = Go * 8;
        constexpr int N0 = 4 * 720, N1 = 4 * 96, N2 = 4 * 64, N3 = 4 * 512, N4 = 2 * 1408, N7 = 16 * 704;
        constexpr int NITEMS = N1 + N2 + N3 + N4 + N7;
        { LAS float* red = (LAS float*)(lds + 102400);
          for (int it = vcuo; it < 352 + 1408 + 180; it += Go) {
              if (it >= 352 + 1408) { const int r = it - 1760, l = r / 45, nb = r % 45; unsigned char* wt = (unsigned char*)(W_WB + l * LW_SIZE + LW_WIN);
                  colq_item(AIN(I_WIN) + (size_t)l * D * DIN, DIN, wt, (float*)(wt + (size_t)DINP * D), 3, nb, red, tid); }
              else if (it < 352) { const int i = it / 176, r = it % 176, kind = 1 + r / 88, nb = r % 88;
                  colq_item(AIN(kind == 1 ? I_FG : I_FU) + (size_t)i * D * DFF, DFF, W_DW8(i) + DW8_GU, (float*)(W_DW8(i) + DW8_CS), kind, nb, red, tid); }
              else { const int r = it - 352, ie = r / 88, q = r % 88, kind = 1 + q / 44, nb = q % 44;
                  colq_item(AIN(kind == 1 ? I_MG : I_MU) + (size_t)ie * D * DFE, DFE, W_MW8(ie >> 3) + MW8_GU + (size_t)(ie & 7) * 2 * DFE * D, (float*)(W_MW8(ie >> 3) + MW8_CS) + (ie & 7) * 2 * DFE, kind, nb, red, tid); } } }
        for (int it = NGW - 1 - gw; it < NITEMS; it += NGW) {
            int r = it;
            if (r < N1) { const int l = r / 96, q = r % 96; tr_item(AIN(I_WUQ) + (size_t)l * 256 * 768, 768, W_WB + l * LW_SIZE + LW_WUQ, 256, AIN(I_QNG) + l * 256, 4, scr, q / 24, q % 24, lane); continue; } r -= N1;
            if (r < N2) { const int l = r / 64, q = r % 64, kb = q / 32, nb = q % 32;
                const bool isv = ((nb & 3) >= 2); bf16* dst = W_WB + l * LW_SIZE + (isv ? LW_WUV : LW_WUK) + (size_t)((nb >> 2) * 64 + (nb & 1) * 32) * 256;
                tr_item(AIN(I_WUKV) + (size_t)l * 128 * 1024 + nb * 32, 1024, dst, 256, AIN(I_KVNG) + l * 128, 0, scr, kb, 0, lane); continue; } r -= N2;
            if (r < N3) { const int l = r / 512, q = r % 512; tr_item(AIN(I_WO) + (size_t)l * D * D, D, W_WB + l * LW_SIZE + LW_WO, D, nullptr, 0, scr, q / 32, q % 32, lane); continue; } r -= N3;
            if (r < N4) { const int i = r / 1408, q = r % 1408; tr_item<true>(AIN(I_FD) + (size_t)i * DFF * D, D, W_DW8(i) + DW8_D, DFF, nullptr, 0, scr, q / 32, q % 32, lane); continue; } r -= N4;
            { const int ie = r / 704, q = r % 704, i = ie >> 3, e = ie & 7; tr_item<true>(AIN(I_MD) + (size_t)ie * DFE * D, D, W_MW8(i) + MW8_D + (size_t)e * D * DFEP, DFEP, nullptr, 0, scr, q / 32, q % 32, lane); }
        }
        const int gt = vcuo * 512 + tid, NGT = Go * 512;
        for (int i = gt; i < 4 * 96 * 64; i += NGT) {
            const int l = i / (96 * 64), q = i % (96 * 64); unsigned char* wt = (unsigned char*)(W_WB + l * LW_SIZE + LW_WIN);
            *(u32x4*)(wt + (size_t)(416 + q / 64) * D + (q % 64) * 16) = (u32x4){0u, 0u, 0u, 0u}; if ((q % 64) == 0) ((float*)(wt + (size_t)DINP * D))[416 + q / 64] = 0.f; }
        for (int i = gt; i < 4 * 2 * 512 * 16; i += NGT) {
            const int l = i / (2 * 512 * 16), q = i % (2 * 512 * 16), mtx = q / (512 * 16), rr = (q / 16) % 512, ch = q % 16;
            *(u32x4*)(W_WB + l * LW_SIZE + (mtx ? LW_WUV : LW_WUK) + (size_t)rr * 256 + 128 + ch * 8) = (u32x4){0u, 0u, 0u, 0u}; }
        for (int i = gt; i < 2 * NE * D * 8; i += NGT) {
            const int ie = i / (D * 8), q = i % (D * 8); *(u32x4*)(W_MW8(ie >> 3) + MW8_D + ((size_t)(ie & 7) * D + (q >> 3)) * DFEP + DFE + (q & 7) * 16) = (u32x4){0u, 0u, 0u, 0u}; }
        for (int i = gt; i < 4 * 4 * 128 * 128; i += NGT) {
            const int l = i / 65536, q = i % 65536, t = (q >> 7) & 127, s = q & 127; const float v = (s <= t) ? AIN(I_SGW)[i] : 0.f;
            W_WB[l * LW_SIZE + LW_SGW + q] = (bf16)(cvt_pk(v, 0.f) & 0xffffu); }
        for (int i = gt; i < 4 * 2 * 4 * 64 * 64; i += NGT) {
            const int l = i / 32768, q = i % 32768, mtx = q / 16384, hq = (q / 4096) & 3, j = (q >> 6) & 63, ii = q & 63;
            const float v = AIN(mtx ? I_LWX : I_LWA)[(size_t)l * 16384 + hq * 4096 + ii * 64 + j];
            W_WB[l * LW_SIZE + (mtx ? LW_LWX : LW_LWA) + hq * 4096 + j * 64 + ii] = (bf16)(cvt_pk(v, 0.f) & 0xffffu); }
        for (int i = gt; i < SEQ * 16; i += NGT) {
            const int pos = i >> 4, j = i & 15; const float inv = exp2f(-(float)j * (13.287712379549449f / 16.0f)); float s, c; sincos_acc((float)pos * inv, s, c); W_cosT[i] = c; W_sinT[i] = s; }
        __syncthreads();
        LAS float* cond = (LAS float*)(lds + 69632); LAS float* red = (LAS float*)(lds + 69632 + 16384);
        for (int i = tid; i < NB * D; i += 512) cond[i] = siluf_(AIN(I_C)[i]);
        __syncthreads();
        for (int item = Go - 1 - vcuo; item < 4 * 96; item += Go) {
            const int l = item / 96, c0 = (item % 96) * 64; const float* Wm = AIN(I_WMOD) + (size_t)l * D * 6144 + c0 + lane;
            float a0 = 0.f, a1 = 0.f, a2 = 0.f, a3 = 0.f;
#pragma unroll 16
            for (int k = wave * 128; k < wave * 128 + 128; ++k) { const float wv = __builtin_nontemporal_load(Wm + (size_t)k * 6144); a0 += cond[k] * wv; a1 += cond[D + k] * wv; a2 += cond[2 * D + k] * wv; a3 += cond[3 * D + k] * wv; }
            red[(wave * 4 + 0) * 64 + lane] = a0; red[(wave * 4 + 1) * 64 + lane] = a1; red[(wave * 4 + 2) * 64 + lane] = a2; red[(wave * 4 + 3) * 64 + lane] = a3;
            __syncthreads();
            if (tid < 256) { const int b = tid >> 6, col = tid & 63; float s = AIN(I_BMOD)[l * 6144 + c0 + col];
#pragma unroll
                for (int ww = 0; ww < 8; ++ww) s += red[(ww * 4 + b) * 64 + col];
                W_MOD[(size_t)(l * 4 + b) * 6144 + c0 + col] = s; }
            __syncthreads();
        }
    }
    { WSL; if (opaque_tid() == 0) { unsigned gx; XB_SPIN((gx = xb_ld(W_ctl + 6000 + (bx_ & 7))) == 0u, W_ctl); if (gx != xb_xcc_id() + 1u) atomicOr(W_ctl + 6016, 1u); } }
    GRID_BAR();
    { WSL; if (opaque_tid() == 0) { const unsigned ok = (xb_ld(W_ctl + 6016) == 0u) ? 1u : 0u; unsigned pok = 1u;
#pragma unroll
        for (unsigned j = 0; j < 16; ++j) { const unsigned c = xb_ld(W_ctl + XB_XCNT(j)); if (c != 0u && c != 32u) pok = 0u; }
        MISC[8] = ok; MISC[9] = ok & pok; } } __syncthreads();
    {
        WSL; const int tid = opaque_tid();
        const int b = vcuo >> 6; const float* md = W_MOD + (size_t)(0 * 4 + b) * 6144;
        RowArgs ra{}; ra.xin = AIN(I_X); ra.X = nullptr; ra.Xb = W_XB; ra.preg = AIN(I_PREMIX); ra.sc = md + 1024; ra.sh = md; ra.H = W_H; ra.ssq_q = W_ssq_q; ra.ssq_kv = W_ssq_kv; ra.rs = (float*)(W_DW8(0) + DW8_RS);
        row_phase<0>(lds, tab, vcuo, ra, true, false);
        if (tid < 64) { W_ssq_q[vcuo * 64 + tid] = 0ull; W_ssq_kv[vcuo * 64 + tid] = 0ull; }
    }
    GRID_BAR_L();


    { constexpr int l = 0;

        const bool moe = (l & 1) != 0; const int fi = l >> 1;
#define LW (W_WB + (size_t)l * LW_SIZE)
#define md (W_MOD + (size_t)(l * 4 + (vcuo >> 6)) * 6144)
        { WSL; pg8::Gemm g{W_H, LW + LW_WIN, D}; pg8::StaticOrder S; S.init(M, DINP, Go, bxo); S.lim = (S.nwg / Go) * Go;
          pg8::EpiIn E{wsl, (const float*)(W_DW8(0) + DW8_RS), (const float*)((unsigned char*)(LW + LW_WIN) + (size_t)DINP * D)};
          pg8::gemm_phase<pg8::EpiIn, pg8::StaticOrder, true, 2, 2>(lds, g, S, E);
          pg8::TailOrder<pg8::StaticOrder> T{S};
          pg8::gemm_phase<pg8::EpiIn, pg8::TailOrder<pg8::StaticOrder>, false, 1, 2>(lds, g, T, E); }
        if (l == 2) GRID_BAR(); else GRID_BAR_L();
        { WSL; pg8::Gemm g{W_ZQ, LW + LW_WUQ, 256}; pg8::StaticOrder S; S.init(M, 768, Go, bxo); pg8::EpiQ E{wsl};
          pg8::gemm_phase<pg8::EpiQ, pg8::StaticOrder, true>(lds, g, S, E); }
        { WSL; pg8::Gemm g{W_ZKV, LW + LW_WUK, 128, 256};     pg8::StaticOrder S; S.init(M, 512, Go, (bxo + 64) % Go); pg8::EpiK E{wsl};
          pg8::gemm_phase<pg8::EpiK, pg8::StaticOrder, true>(lds, g, S, E); }
        { WSL; pg8::Gemm g{LW + LW_WUV, W_ZKV, 128, 256}; pg8::StaticOrder S; S.init(512, M, Go, (bxo + 192) % Go); pg8::EpiVT E{wsl};
          pg8::gemm_phase<pg8::EpiVT, pg8::StaticOrder, true>(lds, g, S, E); }
        { WSL; for (int uu = vcuo; uu < 256; uu += Go) {
            sgu::unit(lds, (uu >> 1) * 128, uu & 1, W_GV, W_U, LW + LW_SGW, AIN(I_SGLNG) + l * 256, AIN(I_SGLNB) + l * 256, AIN(I_SGB) + l * 512, W_Y); } }
        { WSL; for (int uu = vcuo; uu < 256; uu += Go) {
            lru::local_unit(lds, uu >> 6, uu & 63, W_ZX, AIN(I_CONVW) + l * 1024, AIN(I_CONVB) + l * 256, LW + LW_LWA, LW + LW_LWX,
                            AIN(I_LBA) + l * 256, AIN(I_LBX) + l * 256, AIN(I_LAM) + l * 256, W_HL, W_PP); } }
        GRID_BAR_P();
        { WSL; for (int uu = vcuo; uu < 256; uu += Go) { lru::fix_unit(lds, uu >> 6, uu & 63, W_HL, W_PP, W_GY, W_Y); } }
        { WSL; for (int uu = vcuo; uu < 256; uu += Go) { const int bh = uu >> 3, s = uu & 7;
            att::attn_unit(lds, bh >> 3, bh & 7, 15 - s, W_Q, W_KN, W_KR, W_VT, W_Y);
            att::attn_unit(lds, bh >> 3, bh & 7, s, W_Q, W_KN, W_KR, W_VT, W_Y); } }
        GRID_BAR_P();
        { WSL; pg8::Gemm g{W_Y, LW + LW_WO, D}; pg8::StaticOrder S; S.init(M, D, Go, bxo); pg8::EpiBf E{W_YO, D};
          pg8::gemm_phase<pg8::EpiBf, pg8::StaticOrder, false>(lds, g, S, E); }
        GRID_BAR_L();
        { WSL; RowArgs ra{}; ra.X = nullptr; ra.Xb = W_XB; ra.Ysrc = W_YO; ra.gate = md + 2048; ra.postg = AIN(I_POSTMIX) + l * D; ra.preg = AIN(I_PREFFN) + l * D; ra.sc = md + 4096; ra.sh = md + 3072; ra.H = W_H;
          ra.router = AIN(I_ROUTER) + (size_t)fi * D * NE; ra.cursor = W_ctl + CW_CURSOR + 64 * fi; ra.idx = W_IDX; ra.slot_w = W_SLOT; ra.gatew_w = W_GATEW; ra.ssq_q = W_ssq_q; ra.ssq_kv = W_ssq_kv; ra.rs = (float*)(W_DW8(0) + DW8_RS); ra.rss = (float*)(W_DW8(0) + DW8_RSS);
          row_phase<1>(lds, tab, vcuo, ra, true, moe); }
        if (moe) GRID_BAR(); else GRID_BAR_L();
        if (!moe) {
#define DW (W_WB + WOFF_DENSE + (size_t)fi * DW_SIZE)
            { WSL; pg8::Gemm g{W_H, W_DW8(fi) + DW8_GU, D}; pg8::StaticOrder S; S.init(M, 2 * DFF, Go, bxo); pg8::EpiSwigluI8<false> E{W_ACT8D, DFF, -1, (const float*)(W_DW8(0) + DW8_RS), (const float*)(W_DW8(fi) + DW8_CS)};
              pg8::gemm_phase<pg8::EpiSwigluI8<false>, pg8::StaticOrder, true, 2, 2>(lds, g, S, E); }
            GRID_BAR_L();
            { WSL; pg8::Gemm g{W_ACT8D, W_DW8(fi) + DW8_D, DFF}; pg8::StaticOrder S; S.init(M, D, Go, bxo); pg8::EpiBfS E{W_YO, D, 1.0f / (pg8::F8_ASC * pg8::F8_WSC)};
              pg8::gemm_phase<pg8::EpiBfS, pg8::StaticOrder, false, 2, 1>(lds, g, S, E); }
            GRID_BAR_L();
        } else {
#define MW (W_WB + WOFF_MOE + (size_t)fi * MW_SIZE)
            { const int ln = opaque_tid(); if (ln < 64) { WSL; volatile LAS int* tw = (volatile LAS int*)(lds + MISC_OFF);
                const int cnt = (ln < 8) ? (int)__hip_atomic_load(W_ctl + CW_CURSOR + 64 * fi + ln, __ATOMIC_RELAXED, __HIP_MEMORY_SCOPE_AGENT) : 0;
                const int nt = (cnt + 255) >> 8; int T = 0, tot = 0;
#pragma unroll
                for (int e = 0; e < 8; ++e) { const int v = __builtin_amdgcn_readlane(nt, e); if (e < ln) T += v; tot += v; }
                if (ln < 8) { tw[16 + ln] = T; tw[32 + ln] = cnt; }
                if (ln == 0) tw[24] = tot; } }
            __syncthreads();
            { WSL; pg8::Gemm g{W_H, W_MW8(fi) + MW8_GU, D}; MoeGatherOrder S{{tab, 11, Go, vcuo, 1 << 30}, W_IDX}; pg8::EpiSwigluI8<true> E{W_ACT8, DFEP, 10, (const float*)(W_DW8(0) + DW8_RSS), (const float*)(W_MW8(fi) + MW8_CS)};
              pg8::gemm_phase<pg8::EpiSwigluI8<true>, MoeGatherOrder, true, 2, 2>(lds, g, S, E); }
            GRID_BAR();
            { WSL; pg8::Gemm g{W_ACT8, W_MW8(fi) + MW8_D, DFEP}; MoeOrder S{tab, 4, Go, vcuo, 2 * Go}; pg8::EpiBfS E{W_YD, D, 1.0f / (pg8::F8_ASC * pg8::F8_WSC)};
              pg8::gemm_phase<pg8::EpiBfS, MoeOrder, true, 2, 1>(lds, g, S, E);
              pg8::TailOrder<MoeOrder> T{S};
              pg8::gemm_phase<pg8::EpiBfS, pg8::TailOrder<MoeOrder>, false, 1, 1>(lds, g, T, E); }
            GRID_BAR();
        }
        { WSL; const bool last = (l == DEPTH - 1); const float* mdn = W_MOD + (size_t)((last ? l : l + 1) * 4 + (vcuo >> 6)) * 6144;
          RowArgs ra{}; ra.X = last ? W_X : nullptr; ra.Xb = W_XB; ra.Ysrc = W_YO; ra.YD = W_YD; ra.slot = W_SLOT; ra.gatew = W_GATEW; ra.gate = md + 5120; ra.postg = AIN(I_POSTFFN) + l * D;
          ra.preg = AIN(I_PREMIX) + (last ? l : l + 1) * D; ra.sc = mdn + 1024; ra.sh = mdn; ra.H = W_H; ra.ssq_q = W_ssq_q; ra.ssq_kv = W_ssq_kv; ra.rs = (float*)(W_DW8(0) + DW8_RS);
          if (!moe) row_phase<2>(lds, tab, vcuo, ra, !last, false); else row_phase<3>(lds, tab, vcuo, ra, !last, false);
          if (!last) GRID_BAR_L(); }

    }
#undef LW
#undef md
#undef DW
#undef MW
    { constexpr int l = 1;

        const bool moe = (l & 1) != 0; const int fi = l >> 1;
#define LW (W_WB + (size_t)l * LW_SIZE)
#define md (W_MOD + (size_t)(l * 4 + (vcuo >> 6)) * 6144)
        { WSL; pg8::Gemm g{W_H, LW + LW_WIN, D}; pg8::StaticOrder S; S.init(M, DINP, Go, bxo); S.lim = (S.nwg / Go) * Go;
          pg8::EpiIn E{wsl, (const float*)(W_DW8(0) + DW8_RS), (const float*)((unsigned char*)(LW + LW_WIN) + (size_t)DINP * D)};
          pg8::gemm_phase<pg8::EpiIn, pg8::StaticOrder, true, 2, 2>(lds, g, S, E);
          pg8::TailOrder<pg8::StaticOrder> T{S};
          pg8::gemm_phase<pg8::EpiIn, pg8::TailOrder<pg8::StaticOrder>, false, 1, 2>(lds, g, T, E); }
        if (l == 2) GRID_BAR(); else GRID_BAR_L();
        { WSL; pg8::Gemm g{W_ZQ, LW + LW_WUQ, 256}; pg8::StaticOrder S; S.init(M, 768, Go, bxo); pg8::EpiQ E{wsl};
          pg8::gemm_phase<pg8::EpiQ, pg8::StaticOrder, true>(lds, g, S, E); }
        { WSL; pg8::Gemm g{W_ZKV, LW + LW_WUK, 128, 256};     pg8::StaticOrder S; S.init(M, 512, Go, (bxo + 64) % Go); pg8::EpiK E{wsl};
          pg8::gemm_phase<pg8::EpiK, pg8::StaticOrder, true>(lds, g, S, E); }
        { WSL; pg8::Gemm g{LW + LW_WUV, W_ZKV, 128, 256}; pg8::StaticOrder S; S.init(512, M, Go, (bxo + 192) % Go); pg8::EpiVT E{wsl};
          pg8::gemm_phase<pg8::EpiVT, pg8::StaticOrder, true>(lds, g, S, E); }
        { WSL; for (int uu = vcuo; uu < 256; uu += Go) {
            sgu::unit(lds, (uu >> 1) * 128, uu & 1, W_GV, W_U, LW + LW_SGW, AIN(I_SGLNG) + l * 256, AIN(I_SGLNB) + l * 256, AIN(I_SGB) + l * 512, W_Y); } }
        { WSL; for (int uu = vcuo; uu < 256; uu += Go) {
            lru::local_unit(lds, uu >> 6, uu & 63, W_ZX, AIN(I_CONVW) + l * 1024, AIN(I_CONVB) + l * 256, LW + LW_LWA, LW + LW_LWX,
                            AIN(I_LBA) + l * 256, AIN(I_LBX) + l * 256, AIN(I_LAM) + l * 256, W_HL, W_PP); } }
        GRID_BAR_P();
        { WSL; for (int uu = vcuo; uu < 256; uu += Go) { lru::fix_unit(lds, uu >> 6, uu & 63, W_HL, W_PP, W_GY, W_Y); } }
        { WSL; for (int uu = vcuo; uu < 256; uu += Go) { const int bh = uu >> 3, s = uu & 7;
            att::attn_unit(lds, bh >> 3, bh & 7, 15 - s, W_Q, W_KN, W_KR, W_VT, W_Y);
            att::attn_unit(lds, bh >> 3, bh & 7, s, W_Q, W_KN, W_KR, W_VT, W_Y); } }
        GRID_BAR_P();
        { WSL; pg8::Gemm g{W_Y, LW + LW_WO, D}; pg8::StaticOrder S; S.init(M, D, Go, bxo); pg8::EpiBf E{W_YO, D};
          pg8::gemm_phase<pg8::EpiBf, pg8::StaticOrder, false>(lds, g, S, E); }
        GRID_BAR_L();
        { WSL; RowArgs ra{}; ra.X = nullptr; ra.Xb = W_XB; ra.Ysrc = W_YO; ra.gate = md + 2048; ra.postg = AIN(I_POSTMIX) + l * D; ra.preg = AIN(I_PREFFN) + l * D; ra.sc = md + 4096; ra.sh = md + 3072; ra.H = W_H;
          ra.router = AIN(I_ROUTER) + (size_t)fi * D * NE; ra.cursor = W_ctl + CW_CURSOR + 64 * fi; ra.idx = W_IDX; ra.slot_w = W_SLOT; ra.gatew_w = W_GATEW; ra.ssq_q = W_ssq_q; ra.ssq_kv = W_ssq_kv; ra.rs = (float*)(W_DW8(0) + DW8_RS); ra.rss = (float*)(W_DW8(0) + DW8_RSS);
          row_phase<1>(lds, tab, vcuo, ra, true, moe); }
        if (moe) GRID_BAR(); else GRID_BAR_L();
        if (!moe) {
#define DW (W_WB + WOFF_DENSE + (size_t)fi * DW_SIZE)
            { WSL; pg8::Gemm g{W_H, W_DW8(fi) + DW8_GU, D}; pg8::StaticOrder S; S.init(M, 2 * DFF, Go, bxo); pg8::EpiSwigluI8<false> E{W_ACT8D, DFF, -1, (const float*)(W_DW8(0) + DW8_RS), (const float*)(W_DW8(fi) + DW8_CS)};
              pg8::gemm_phase<pg8::EpiSwigluI8<false>, pg8::StaticOrder, true, 2, 2>(lds, g, S, E); }
            GRID_BAR_L();
            { WSL; pg8::Gemm g{W_ACT8D, W_DW8(fi) + DW8_D, DFF}; pg8::StaticOrder S; S.init(M, D, Go, bxo); pg8::EpiBfS E{W_YO, D, 1.0f / (pg8::F8_ASC * pg8::F8_WSC)};
              pg8::gemm_phase<pg8::EpiBfS, pg8::StaticOrder, false, 2, 1>(lds, g, S, E); }
            GRID_BAR_L();
        } else {
#define MW (W_WB + WOFF_MOE + (size_t)fi * MW_SIZE)
            { const int ln = opaque_tid(); if (ln < 64) { WSL; volatile LAS int* tw = (volatile LAS int*)(lds + MISC_OFF);
                const int cnt = (ln < 8) ? (int)__hip_atomic_load(W_ctl + CW_CURSOR + 64 * fi + ln, __ATOMIC_RELAXED, __HIP_MEMORY_SCOPE_AGENT) : 0;
                const int nt = (cnt + 255) >> 8; int T = 0, tot = 0;
#pragma unroll
                for (int e = 0; e < 8; ++e) { const int v = __builtin_amdgcn_readlane(nt, e); if (e < ln) T += v; tot += v; }
                if (ln < 8) { tw[16 + ln] = T; tw[32 + ln] = cnt; }
                if (ln == 0) tw[24] = tot; } }
            __syncthreads();
            { WSL; pg8::Gemm g{W_H, W_MW8(fi) + MW8_GU, D}; MoeGatherOrder S{{tab, 11, Go, vcuo, 1 << 30}, W_IDX}; pg8::EpiSwigluI8<true> E{W_ACT8, DFEP, 10, (const float*)(W_DW8(0) + DW8_RSS), (const float*)(W_MW8(fi) + MW8_CS)};
              pg8::gemm_phase<pg8::EpiSwigluI8<true>, MoeGatherOrder, true, 2, 2>(lds, g, S, E); }
            GRID_BAR();
            { WSL; pg8::Gemm g{W_ACT8, W_MW8(fi) + MW8_D, DFEP}; MoeOrder S{tab, 4, Go, vcuo, 2 * Go}; pg8::EpiBfS E{W_YD, D, 1.0f / (pg8::F8_ASC * pg8::F8_WSC)};
              pg8::gemm_phase<pg8::EpiBfS, MoeOrder, true, 2, 1>(lds, g, S, E);
              pg8::TailOrder<MoeOrder> T{S};
              pg8::gemm_phase<pg8::EpiBfS, pg8::TailOrder<MoeOrder>, false, 1, 1>(lds, g, T, E); }
            GRID_BAR();
        }
        { WSL; const bool last = (l == DEPTH - 1); const float* mdn = W_MOD + (size_t)((last ? l : l + 1) * 4 + (vcuo >> 6)) * 6144;
          RowArgs ra{}; ra.X = last ? W_X : nullptr; ra.Xb = W_XB; ra.Ysrc = W_YO; ra.YD = W_YD; ra.slot = W_SLOT; ra.gatew = W_GATEW; ra.gate = md + 5120; ra.postg = AIN(I_POSTFFN) + l * D;
          ra.preg = AIN(I_PREMIX) + (last ? l : l + 1) * D; ra.sc = mdn + 1024; ra.sh = mdn; ra.H = W_H; ra.ssq_q = W_ssq_q; ra.ssq_kv = W_ssq_kv; ra.rs = (float*)(W_DW8(0) + DW8_RS);
          if (!moe) row_phase<2>(lds, tab, vcuo, ra, !last, false); else row_phase<3>(lds, tab, vcuo, ra, !last, false);
          if (!last) GRID_BAR_L(); }

    }
#undef LW
#undef md
#undef DW
#undef MW
    { constexpr int l = 2;

        const bool moe = (l & 1) != 0; const int fi = l >> 1;
#define LW (W_WB + (size_t)l * LW_SIZE)
#define md (W_MOD + (size_t)(l * 4 + (vcuo >> 6)) * 6144)
        { WSL; pg8::Gemm g{W_H, LW + LW_WIN, D}; pg8::StaticOrder S; S.init(M, DINP, Go, bxo); S.lim = (S.nwg / Go) * Go;
          pg8::EpiIn E{wsl, (const float*)(W_DW8(0) + DW8_RS), (const float*)((unsigned char*)(LW + LW_WIN) + (size_t)DINP * D)};
          pg8::gemm_phase<pg8::EpiIn, pg8::StaticOrder, true, 2, 2>(lds, g, S, E);
          pg8::TailOrder<pg8::StaticOrder> T{S};
          pg8::gemm_phase<pg8::EpiIn, pg8::TailOrder<pg8::StaticOrder>, false, 1, 2>(lds, g, T, E); }
        if (l == 2) GRID_BAR(); else GRID_BAR_L();
        { WSL; pg8::Gemm g{W_ZQ, LW + LW_WUQ, 256}; pg8::StaticOrder S; S.init(M, 768, Go, bxo); pg8::EpiQ E{wsl};
          pg8::gemm_phase<pg8::EpiQ, pg8::StaticOrder, true>(lds, g, S, E); }
        { WSL; pg8::Gemm g{W_ZKV, LW + LW_WUK, 128, 256};     pg8::StaticOrder S; S.init(M, 512, Go, (bxo + 64) % Go); pg8::EpiK E{wsl};
          pg8::gemm_phase<pg8::EpiK, pg8::StaticOrder, true>(lds, g, S, E); }
        { WSL; pg8::Gemm g{LW + LW_WUV, W_ZKV, 128, 256}; pg8::StaticOrder S; S.init(512, M, Go, (bxo + 192) % Go); pg8::EpiVT E{wsl};
          pg8::gemm_phase<pg8::EpiVT, pg8::StaticOrder, true>(lds, g, S, E); }
        { WSL; for (int uu = vcuo; uu < 256; uu += Go) {
            sgu::unit(lds, (uu >> 1) * 128, uu & 1, W_GV, W_U, LW + LW_SGW, AIN(I_SGLNG) + l * 256, AIN(I_SGLNB) + l * 256, AIN(I_SGB) + l * 512, W_Y); } }
        { WSL; for (int uu = vcuo; uu < 256; uu += Go) {
            lru::local_unit(lds, uu >> 6, uu & 63, W_ZX, AIN(I_CONVW) + l * 1024, AIN(I_CONVB) + l * 256, LW + LW_LWA, LW + LW_LWX,
                            AIN(I_LBA) + l * 256, AIN(I_LBX) + l * 256, AIN(I_LAM) + l * 256, W_HL, W_PP); } }
        GRID_BAR_P();
        { WSL; for (int uu = vcuo; uu < 256; uu += Go) { lru::fix_unit(lds, uu >> 6, uu & 63, W_HL, W_PP, W_GY, W_Y); } }
        { WSL; for (int uu = vcuo; uu < 256; uu += Go) { const int bh = uu >> 3, s = uu & 7;
            att::attn_unit(lds, bh >> 3, bh & 7, 15 - s, W_Q, W_KN, W_KR, W_VT, W_Y);
            att::attn_unit(lds, bh >> 3, bh & 7, s, W_Q, W_KN, W_KR, W_VT, W_Y); } }
        GRID_BAR_P();
        { WSL; pg8::Gemm g{W_Y, LW + LW_WO, D}; pg8::StaticOrder S; S.init(M, D, Go, bxo); pg8::EpiBf E{W_YO, D};
          pg8::gemm_phase<pg8::EpiBf, pg8::StaticOrder, false>(lds, g, S, E); }
        GRID_BAR_L();
        { WSL; RowArgs ra{}; ra.X = nullptr; ra.Xb = W_XB; ra.Ysrc = W_YO; ra.gate = md + 2048; ra.postg = AIN(I_POSTMIX) + l * D; ra.preg = AIN(I_PREFFN) + l * D; ra.sc = md + 4096; ra.sh = md + 3072; ra.H = W_H;
          ra.router = AIN(I_ROUTER) + (size_t)fi * D * NE; ra.cursor = W_ctl + CW_CURSOR + 64 * fi; ra.idx = W_IDX; ra.slot_w = W_SLOT; ra.gatew_w = W_GATEW; ra.ssq_q = W_ssq_q; ra.ssq_kv = W_ssq_kv; ra.rs = (float*)(W_DW8(0) + DW8_RS); ra.rss = (float*)(W_DW8(0) + DW8_RSS);
          row_phase<1>(lds, tab, vcuo, ra, true, moe); }
        if (moe) GRID_BAR(); else GRID_BAR_L();
        if (!moe) {
#define DW (W_WB + WOFF_DENSE + (size_t)fi * DW_SIZE)
            { WSL; pg8::Gemm g{W_H, W_DW8(fi) + DW8_GU, D}; pg8::StaticOrder S; S.init(M, 2 * DFF, Go, bxo); pg8::EpiSwigluI8<false> E{W_ACT8D, DFF, -1, (const float*)(W_DW8(0) + DW8_RS), (const float*)(W_DW8(fi) + DW8_CS)};
              pg8::gemm_phase<pg8::EpiSwigluI8<false>, pg8::StaticOrder, true, 2, 2>(lds, g, S, E); }
            GRID_BAR_L();
            { WSL; pg8::Gemm g{W_ACT8D, W_DW8(fi) + DW8_D, DFF}; pg8::StaticOrder S; S.init(M, D, Go, bxo); pg8::EpiBfS E{W_YO, D, 1.0f / (pg8::F8_ASC * pg8::F8_WSC)};
              pg8::gemm_phase<pg8::EpiBfS, pg8::StaticOrder, false, 2, 1>(lds, g, S, E); }
            GRID_BAR_L();
        } else {
#define MW (W_WB + WOFF_MOE + (size_t)fi * MW_SIZE)
            { const int ln = opaque_tid(); if (ln < 64) { WSL; volatile LAS int* tw = (volatile LAS int*)(lds + MISC_OFF);
                const int cnt = (ln < 8) ? (int)__hip_atomic_load(W_ctl + CW_CURSOR + 64 * fi + ln, __ATOMIC_RELAXED, __HIP_MEMORY_SCOPE_AGENT) : 0;
                const int nt = (cnt + 255) >> 8; int T = 0, tot = 0;
#pragma unroll
                for (int e = 0; e < 8; ++e) { const int v = __builtin_amdgcn_readlane(nt, e); if (e < ln) T += v; tot += v; }
                if (ln < 8) { tw[16 + ln] = T; tw[32 + ln] = cnt; }
                if (ln == 0) tw[24] = tot; } }
            __syncthreads();
            { WSL; pg8::Gemm g{W_H, W_MW8(fi) + MW8_GU, D}; MoeGatherOrder S{{tab, 11, Go, vcuo, 1 << 30}, W_IDX}; pg8::EpiSwigluI8<true> E{W_ACT8, DFEP, 10, (const float*)(W_DW8(0) + DW8_RSS), (const float*)(W_MW8(fi) + MW8_CS)};
              pg8::gemm_phase<pg8::EpiSwigluI8<true>, MoeGatherOrder, true, 2, 2>(lds, g, S, E); }
            GRID_BAR();
            { WSL; pg8::Gemm g{W_ACT8, W_MW8(fi) + MW8_D, DFEP}; MoeOrder S{tab, 4, Go, vcuo, 2 * Go}; pg8::EpiBfS E{W_YD, D, 1.0f / (pg8::F8_ASC * pg8::F8_WSC)};
              pg8::gemm_phase<pg8::EpiBfS, MoeOrder, true, 2, 1>(lds, g, S, E);
              pg8::TailOrder<MoeOrder> T{S};
              pg8::gemm_phase<pg8::EpiBfS, pg8::TailOrder<MoeOrder>, false, 1, 1>(lds, g, T, E); }
            GRID_BAR();
        }
        { WSL; const bool last = (l == DEPTH - 1); const float* mdn = W_MOD + (size_t)((last ? l : l + 1) * 4 + (vcuo >> 6)) * 6144;
          RowArgs ra{}; ra.X = last ? W_X : nullptr; ra.Xb = W_XB; ra.Ysrc = W_YO; ra.YD = W_YD; ra.slot = W_SLOT; ra.gatew = W_GATEW; ra.gate = md + 5120; ra.postg = AIN(I_POSTFFN) + l * D;
          ra.preg = AIN(I_PREMIX) + (last ? l : l + 1) * D; ra.sc = mdn + 1024; ra.sh = mdn; ra.H = W_H; ra.ssq_q = W_ssq_q; ra.ssq_kv = W_ssq_kv; ra.rs = (float*)(W_DW8(0) + DW8_RS);
          if (!moe) row_phase<2>(lds, tab, vcuo, ra, !last, false); else row_phase<3>(lds, tab, vcuo, ra, !last, false);
          if (!last) GRID_BAR_L(); }

    }
#undef LW
#undef md
#undef DW
#undef MW
    { constexpr int l = 3;

        const bool moe = (l & 1) != 0; const int fi = l >> 1;
#define LW (W_WB + (size_t)l * LW_SIZE)
#define md (W_MOD + (size_t)(l * 4 + (vcuo >> 6)) * 6144)
        { WSL; pg8::Gemm g{W_H, LW + LW_WIN, D}; pg8::StaticOrder S; S.init(M, DINP, Go, bxo); S.lim = (S.nwg / Go) * Go;
          pg8::EpiIn E{wsl, (const float*)(W_DW8(0) + DW8_RS), (const float*)((unsigned char*)(LW + LW_WIN) + (size_t)DINP * D)};
          pg8::gemm_phase<pg8::EpiIn, pg8::StaticOrder, true, 2, 2>(lds, g, S, E);
          pg8::TailOrder<pg8::StaticOrder> T{S};
          pg8::gemm_phase<pg8::EpiIn, pg8::TailOrder<pg8::StaticOrder>, false, 1, 2>(lds, g, T, E); }
        if (l == 2) GRID_BAR(); else GRID_BAR_L();
        { WSL; pg8::Gemm g{W_ZQ, LW + LW_WUQ, 256}; pg8::StaticOrder S; S.init(M, 768, Go, bxo); pg8::EpiQ E{wsl};
          pg8::gemm_phase<pg8::EpiQ, pg8::StaticOrder, true>(lds, g, S, E); }
        { WSL; pg8::Gemm g{W_ZKV, LW + LW_WUK, 128, 256};     pg8::StaticOrder S; S.init(M, 512, Go, (bxo + 64) % Go); pg8::EpiK E{wsl};
          pg8::gemm_phase<pg8::EpiK, pg8::StaticOrder, true>(lds, g, S, E); }
        { WSL; pg8::Gemm g{LW + LW_WUV, W_ZKV, 128, 256}; pg8::StaticOrder S; S.init(512, M, Go, (bxo + 192) % Go); pg8::EpiVT E{wsl};
          pg8::gemm_phase<pg8::EpiVT, pg8::StaticOrder, true>(lds, g, S, E); }
        { WSL; for (int uu = vcuo; uu < 256; uu += Go) {
            sgu::unit(lds, (uu >> 1) * 128, uu & 1, W_GV, W_U, LW + LW_SGW, AIN(I_SGLNG) + l * 256, AIN(I_SGLNB) + l * 256, AIN(I_SGB) + l * 512, W_Y); } }
        { WSL; for (int uu = vcuo; uu < 256; uu += Go) {
            lru::local_unit(lds, uu >> 6, uu & 63, W_ZX, AIN(I_CONVW) + l * 1024, AIN(I_CONVB) + l * 256, LW + LW_LWA, LW + LW_LWX,
                            AIN(I_LBA) + l * 256, AIN(I_LBX) + l * 256, AIN(I_LAM) + l * 256, W_HL, W_PP); } }
        GRID_BAR_P();
        { WSL; for (int uu = vcuo; uu < 256; uu += Go) { lru::fix_unit(lds, uu >> 6, uu & 63, W_HL, W_PP, W_GY, W_Y); } }
        { WSL; for (int uu = vcuo; uu < 256; uu += Go) { const int bh = uu >> 3, s = uu & 7;
            att::attn_unit(lds, bh >> 3, bh & 7, 15 - s, W_Q, W_KN, W_KR, W_VT, W_Y);
            att::attn_unit(lds, bh >> 3, bh & 7, s, W_Q, W_KN, W_KR, W_VT, W_Y); } }
        GRID_BAR_P();
        { WSL; pg8::Gemm g{W_Y, LW + LW_WO, D}; pg8::StaticOrder S; S.init(M, D, Go, bxo); pg8::EpiBf E{W_YO, D};
          pg8::gemm_phase<pg8::EpiBf, pg8::StaticOrder, false>(lds, g, S, E); }
        GRID_BAR_L();
        { WSL; RowArgs ra{}; ra.X = nullptr; ra.Xb = W_XB; ra.Ysrc = W_YO; ra.gate = md + 2048; ra.postg = AIN(I_POSTMIX) + l * D; ra.preg = AIN(I_PREFFN) + l * D; ra.sc = md + 4096; ra.sh = md + 3072; ra.H = W_H;
          ra.router = AIN(I_ROUTER) + (size_t)fi * D * NE; ra.cursor = W_ctl + CW_CURSOR + 64 * fi; ra.idx = W_IDX; ra.slot_w = W_SLOT; ra.gatew_w = W_GATEW; ra.ssq_q = W_ssq_q; ra.ssq_kv = W_ssq_kv; ra.rs = (float*)(W_DW8(0) + DW8_RS); ra.rss = (float*)(W_DW8(0) + DW8_RSS);
          row_phase<1>(lds, tab, vcuo, ra, true, moe); }
        if (moe) GRID_BAR(); else GRID_BAR_L();
        if (!moe) {
#define DW (W_WB + WOFF_DENSE + (size_t)fi * DW_SIZE)
            { WSL; pg8::Gemm g{W_H, W_DW8(fi) + DW8_GU, D}; pg8::StaticOrder S; S.init(M, 2 * DFF, Go, bxo); pg8::EpiSwigluI8<false> E{W_ACT8D, DFF, -1, (const float*)(W_DW8(0) + DW8_RS), (const float*)(W_DW8(fi) + DW8_CS)};
              pg8::gemm_phase<pg8::EpiSwigluI8<false>, pg8::StaticOrder, true, 2, 2>(lds, g, S, E); }
            GRID_BAR_L();
            { WSL; pg8::Gemm g{W_ACT8D, W_DW8(fi) + DW8_D, DFF}; pg8::StaticOrder S; S.init(M, D, Go, bxo); pg8::EpiBfS E{W_YO, D, 1.0f / (pg8::F8_ASC * pg8::F8_WSC)};
              pg8::gemm_phase<pg8::EpiBfS, pg8::StaticOrder, false, 2, 1>(lds, g, S, E); }
            GRID_BAR_L();
        } else {
#define MW (W_WB + WOFF_MOE + (size_t)fi * MW_SIZE)
            { const int ln = opaque_tid(); if (ln < 64) { WSL; volatile LAS int* tw = (volatile LAS int*)(lds + MISC_OFF);
                const int cnt = (ln < 8) ? (int)__hip_atomic_load(W_ctl + CW_CURSOR + 64 * fi + ln, __ATOMIC_RELAXED, __HIP_MEMORY_SCOPE_AGENT) : 0;
                const int nt = (cnt + 255) >> 8; int T = 0, tot = 0;
#pragma unroll
                for (int e = 0; e < 8; ++e) { const int v = __builtin_amdgcn_readlane(nt, e); if (e < ln) T += v; tot += v; }
                if (ln < 8) { tw[16 + ln] = T; tw[32 + ln] = cnt; }
                if (ln == 0) tw[24] = tot; } }
            __syncthreads();
            { WSL; pg8::Gemm g{W_H, W_MW8(fi) + MW8_GU, D}; MoeGatherOrder S{{tab, 11, Go, vcuo, 1 << 30}, W_IDX}; pg8::EpiSwigluI8<true> E{W_ACT8, DFEP, 10, (const float*)(W_DW8(0) + DW8_RSS), (const float*)(W_MW8(fi) + MW8_CS)};
              pg8::gemm_phase<pg8::EpiSwigluI8<true>, MoeGatherOrder, true, 2, 2>(lds, g, S, E); }
            GRID_BAR();
            { WSL; pg8::Gemm g{W_ACT8, W_MW8(fi) + MW8_D, DFEP}; MoeOrder S{tab, 4, Go, vcuo, 2 * Go}; pg8::EpiBfS E{W_YD, D, 1.0f / (pg8::F8_ASC * pg8::F8_WSC)};
              pg8::gemm_phase<pg8::EpiBfS, MoeOrder, true, 2, 1>(lds, g, S, E);
              pg8::TailOrder<MoeOrder> T{S};
              pg8::gemm_phase<pg8::EpiBfS, pg8::TailOrder<MoeOrder>, false, 1, 1>(lds, g, T, E); }
            GRID_BAR();
        }
        { WSL; const bool last = (l == DEPTH - 1); const float* mdn = W_MOD + (size_t)((last ? l : l + 1) * 4 + (vcuo >> 6)) * 6144;
          RowArgs ra{}; ra.X = last ? W_X : nullptr; ra.Xb = W_XB; ra.Ysrc = W_YO; ra.YD = W_YD; ra.slot = W_SLOT; ra.gatew = W_GATEW; ra.gate = md + 5120; ra.postg = AIN(I_POSTFFN) + l * D;
          ra.preg = AIN(I_PREMIX) + (last ? l : l + 1) * D; ra.sc = mdn + 1024; ra.sh = mdn; ra.H = W_H; ra.ssq_q = W_ssq_q; ra.ssq_kv = W_ssq_kv; ra.rs = (float*)(W_DW8(0) + DW8_RS);
          if (!moe) row_phase<2>(lds, tab, vcuo, ra, !last, false); else row_phase<3>(lds, tab, vcuo, ra, !last, false);
          if (!last) GRID_BAR_L(); }

    }
#undef LW
#undef md
#undef DW
#undef MW
#undef GRID_BAR
}

extern "C" void kernel_launch(void* const* d_in, const int* in_sizes, int n_in, void* d_out, int out_size, void* d_ws, size_t ws_size, hipStream_t stream) {
    static int grid = 0;
    if (grid == 0) {
        if (n_in != 32 || in_sizes[0] != M * D || out_size != M * D || ws_size < WS_END2) { fprintf(stderr, "kernel_launch: unexpected problem (n_in %d, in0 %d, out %d, ws %zu < %zu); nothing launched\n", n_in, n_in > 0 ? in_sizes[0] : -1, out_size, ws_size, (size_t)WS_END); grid = -1; return; }
        int dev = 0, cus = 0, per_cu = 0;
        if (hipGetDevice(&dev) != hipSuccess || hipDeviceGetAttribute(&cus, hipDeviceAttributeMultiprocessorCount, dev) != hipSuccess) { grid = -1; return; }
        if (hipFuncSetAttribute((const void*)trunk_fwd, hipFuncAttributeMaxDynamicSharedMemorySize, LDS_BYTES) != hipSuccess) { fprintf(stderr, "kernel_launch: hipFuncSetAttribute failed\n"); grid = -1; return; }
        if (hipOccupancyMaxActiveBlocksPerMultiprocessor(&per_cu, (const void*)trunk_fwd, 512, LDS_BYTES) != hipSuccess || per_cu < 1) fprintf(stderr, "kernel_launch: note: occupancy query reports %d workgroups per CU\n", per_cu);
        (void)hipGetLastError();
        if (cus < 256) { fprintf(stderr, "kernel_launch: this kernel is laid out for 256 CUs (one workgroup each, 64 token rows per workgroup in the row phases); device has %d; nothing launched\n", cus); grid = -1; return; }
        grid = 256;
    }
    if (grid < 0) return;
    if (hipMemsetAsync((char*)d_ws + WS_CTL, 0, CTL_ZERO_BYTES, stream) != hipSuccess) return;
    Args a{};
    for (int i = 0; i < 32; ++i) a.in[i] = (const float*)d_in[i];
    a.out = (float*)d_out; a.ws = (unsigned char*)d_ws;
    hipLaunchKernelGGL(trunk_fwd, dim3(grid), dim3(512), LDS_BYTES, stream, a);
}
```

```cpp
#include <hip/hip_runtime.h>
#include <cstdio>
#include <cstdint>

#define LAS __attribute__((address_space(3)))
#define GAS __attribute__((address_space(1)))
typedef unsigned short bf16;
typedef short bf16x8 __attribute__((ext_vector_type(8)));
typedef short s16x4 __attribute__((ext_vector_type(4)));
typedef float f32x4 __attribute__((ext_vector_type(4)));
typedef float f32x2 __attribute__((ext_vector_type(2)));
typedef float f32x16 __attribute__((ext_vector_type(16)));
typedef unsigned u32x4 __attribute__((ext_vector_type(4)));
typedef unsigned u32x2 __attribute__((ext_vector_type(2)));
typedef unsigned long long u64;

constexpr int D = 1024, NB = 4, SEQ = 4096, M = NB * SEQ, DEPTH = 4;
constexpr int NH = 8, QKD = 96, VD = 64, QL = 256, KVL = 128, ROPE = 32;
constexpr int SGW = 256, LRW = 256, DIN = 1440, DINP = 1536;
constexpr int DFF = 2816, NE = 8, DFE = 1408;
constexpr int ECAP = 16384;
constexpr int MAXT = 136;
constexpr float LOG2E = 1.4426950408889634f;
constexpr float QSCALE = 0.10206207261596577f * LOG2E;

typedef __bf16 bf16x2_t __attribute__((ext_vector_type(2)));
__device__ __forceinline__ unsigned cvt_pk(float lo, float hi) { f32x2 v = {lo, hi}; bf16x2_t b = __builtin_convertvector(v, bf16x2_t); return __builtin_bit_cast(unsigned, b); }
__device__ __forceinline__ float bf2f(unsigned short v) { return __uint_as_float((unsigned)v << 16); }
__device__ __forceinline__ float bflo(unsigned v) { return __uint_as_float(v << 16); }
__device__ __forceinline__ float bfhi(unsigned v) { return __uint_as_float(v & 0xffff0000u); }
__device__ __forceinline__ float fexp2(float x) { return __builtin_amdgcn_exp2f(x); }
__device__ __forceinline__ float frcp(float x) { return __builtin_amdgcn_rcpf(x); }
__device__ __forceinline__ float sigmoidf_(float x) { return frcp(1.0f + fexp2(-x * LOG2E)); }
__device__ __forceinline__ float siluf_(float x) { return x * sigmoidf_(x); }
__device__ __forceinline__ float gelu_tanh(float x) { const float u = 0.7978845608028654f * (x + 0.044715f * x * x * x); return x * frcp(1.0f + fexp2(-2.0f * LOG2E * u)); }
__device__ __forceinline__ float shx(float v, int lane, int o) { return __builtin_bit_cast(float, __builtin_amdgcn_ds_bpermute((lane ^ o) << 2, __builtin_bit_cast(int, v))); }
__device__ __forceinline__ float wave_sum_dpp(float v) {
    int x = __builtin_bit_cast(int, v);
#define DPP_ADD(ctrl, rmask) x = __builtin_bit_cast(int, __builtin_bit_cast(float, x) + __builtin_bit_cast(float, __builtin_amdgcn_update_dpp(0, x, (ctrl), (rmask), 0xf, false)))
    DPP_ADD(0x111, 0xf); DPP_ADD(0x112, 0xf); DPP_ADD(0x114, 0xf); DPP_ADD(0x118, 0xf);
    DPP_ADD(0x142, 0xa);
    DPP_ADD(0x143, 0xc);
#undef DPP_ADD
    return __builtin_bit_cast(float, __builtin_amdgcn_readlane(x, 63));
}
__device__ __forceinline__ float wave_max_dpp(float v) {
    int x = __builtin_bit_cast(int, v);
#define DPP_MAX(ctrl, rmask) x = __builtin_bit_cast(int, __builtin_fmaxf(__builtin_bit_cast(float, x), __builtin_bit_cast(float, __builtin_amdgcn_update_dpp(0, x, (ctrl), (rmask), 0xf, false))))
    DPP_MAX(0x111, 0xf); DPP_MAX(0x112, 0xf); DPP_MAX(0x114, 0xf); DPP_MAX(0x118, 0xf);
    DPP_MAX(0x142, 0xa);
    DPP_MAX(0x143, 0xc);
#undef DPP_MAX
    return __builtin_bit_cast(float, __builtin_amdgcn_readlane(x, 63));
}
__device__ __forceinline__ float wave_sum(float v, int lane) {
#pragma unroll
    for (int o = 1; o < 64; o <<= 1) v += shx(v, lane, o);
    return v;
}
__device__ __forceinline__ int opaque_tid() { int t = threadIdx.x; asm volatile("" : "+v"(t)); return t; }
#define LDS_WAIT() asm volatile("s_waitcnt lgkmcnt(0)" ::: "memory")
#define VM_WAIT() asm volatile("s_waitcnt vmcnt(0)" ::: "memory")

#define XB_TMO      128
#define XB_XCNT(j)  (256  + 64 * (j))
#define XB_XSUB(j)  (1280 + 64 * (j))
#define XB_XGEN(j)  (2304 + 64 * (j))
#define XB_TOP      3328
#define XB_TOPGEN   3392
#define XB_PTOP(p)  (3456 + 64 * (p))
#define XB_PGEN(p)  (3712 + 64 * (p))
#define XCD_BAR_WORDS 3456
#define XB_SPIN_CAP (1u << 18)

__device__ __forceinline__ unsigned xb_ld(unsigned* p)              { return __hip_atomic_load(p, __ATOMIC_RELAXED, __HIP_MEMORY_SCOPE_AGENT); }
__device__ __forceinline__ unsigned xb_add(unsigned* p, unsigned v) { return __hip_atomic_fetch_add(p, v, __ATOMIC_RELAXED, __HIP_MEMORY_SCOPE_AGENT); }
__device__ __forceinline__ unsigned xb_xcc_id() { return (unsigned)__builtin_amdgcn_s_getreg((3 << 11) | 20) & 0xFu; }
#define XB_SPIN(cond, bar) do { unsigned _sp = 0; while (cond) { __builtin_amdgcn_s_sleep(1); \
    if ((++_sp & 255u) == 0u) { if (xb_ld(&(bar)[XB_TMO])) break; if (_sp > XB_SPIN_CAP) { atomicAdd(&(bar)[XB_TMO], 1u); break; } } } } while (0)

struct XcdBarrier {
    unsigned* bar; unsigned x;
    volatile LAS unsigned* st;
};

__device__ __forceinline__ XcdBarrier xcd_barrier_post(unsigned* bar, volatile LAS unsigned* st) {
    XcdBarrier b; b.bar = bar; b.x = xb_xcc_id(); b.st = st;
    if (opaque_tid() == 0) (void)xb_add(&bar[XB_XCNT(b.x)], 1u);
    return b;
}
__device__ __forceinline__ void xcd_barrier_complete(unsigned* bar, unsigned x, unsigned& nloc, unsigned& nx) {
    const unsigned G = 256u;
    unsigned sum, cnt, mine, sp = 0u;
    for (;;) {
        sum = 0u; cnt = 0u; mine = 0u;
#pragma unroll
        for (unsigned j = 0; j < 16; ++j) { const unsigned c = xb_ld(&bar[XB_XCNT(j)]); sum += c; cnt += (c > 0u) ? 1u : 0u; mine = (j == x) ? c : mine; }
        if (sum == G) break;
        __builtin_amdgcn_s_sleep(1);
        if ((++sp & 255u) == 0u) { if (xb_ld(&bar[XB_TMO])) break; if (sp > XB_SPIN_CAP) { atomicAdd(&bar[XB_TMO], 1u); break; } }
    }
    nloc = mine > 0u ? mine : 1u; nx = cnt > 0u ? cnt : 1u;
}

__device__ __forceinline__ void xcd_barrier(const XcdBarrier& b) {
    asm volatile("s_waitcnt vmcnt(0)" ::: "memory");
    __syncthreads();
    if (opaque_tid() == 0) {
        unsigned* bar = b.bar;
        __builtin_amdgcn_s_waitcnt(0);
        unsigned nloc = b.st[0], nx = b.st[1];
        if (nloc == 0u) { xcd_barrier_complete(bar, b.x, nloc, nx); b.st[0] = nloc; b.st[1] = nx; }
        const unsigned old = xb_add(&bar[XB_XSUB(b.x)], 1u);
        const unsigned gen = old / nloc;
        if (old + 1u == (gen + 1u) * nloc) {
            __builtin_amdgcn_fence(__ATOMIC_RELEASE, "agent");
            asm volatile("s_waitcnt vmcnt(0)" ::: "memory");
            const unsigned og = xb_add(&bar[XB_TOP], 1u);
            const unsigned tg = og / nx;
            if (og + 1u == (tg + 1u) * nx) xb_add(&bar[XB_TOPGEN], 1u);
            else XB_SPIN(xb_ld(&bar[XB_TOPGEN]) == tg, bar);
            __builtin_amdgcn_fence(__ATOMIC_ACQUIRE, "agent");
            xb_add(&bar[XB_XGEN(b.x)], 1u);
            asm volatile("s_waitcnt vmcnt(0)" ::: "memory");
        } else {
            XB_SPIN(xb_ld(&bar[XB_XGEN(b.x)]) == gen, bar);
            __builtin_amdgcn_fence(__ATOMIC_ACQUIRE, "agent");
            asm volatile("s_waitcnt vmcnt(0)" ::: "memory");
        }
    }
    __syncthreads();
}

__device__ __forceinline__ void xcd_pair_barrier(const XcdBarrier& b, unsigned p) {
    asm volatile("s_waitcnt vmcnt(0)" ::: "memory");
    __syncthreads();
    if (opaque_tid() == 0) {
        unsigned* bar = b.bar;
        __builtin_amdgcn_s_waitcnt(0);
        const unsigned nloc = b.st[0];
        const unsigned old = xb_add(&bar[XB_XSUB(b.x)], 1u);
        const unsigned gen = old / nloc;
        if (old + 1u == (gen + 1u) * nloc) {
            __builtin_amdgcn_fence(__ATOMIC_RELEASE, "agent");
            asm volatile("s_waitcnt vmcnt(0)" ::: "memory");
            const unsigned og = xb_add(&bar[XB_PTOP(p)], 1u);
            const unsigned tg = og / 2u;
            if (og + 1u == (tg + 1u) * 2u) xb_add(&bar[XB_PGEN(p)], 1u);
            else XB_SPIN(xb_ld(&bar[XB_PGEN(p)]) == tg, bar);
            __builtin_amdgcn_fence(__ATOMIC_ACQUIRE, "agent");
            xb_add(&bar[XB_XGEN(b.x)], 1u);
            asm volatile("s_waitcnt vmcnt(0)" ::: "memory");
        } else {
            XB_SPIN(xb_ld(&bar[XB_XGEN(b.x)]) == gen, bar);
            __builtin_amdgcn_fence(__ATOMIC_ACQUIRE, "agent");
            asm volatile("s_waitcnt vmcnt(0)" ::: "memory");
        }
    }
    __syncthreads();
}
__device__ __forceinline__ void xcd_local_barrier(const XcdBarrier& b) {
    asm volatile("s_waitcnt vmcnt(0)" ::: "memory");
    __syncthreads();
    if (opaque_tid() == 0) {
        unsigned* bar = b.bar;
        __builtin_amdgcn_s_waitcnt(0);
        const unsigned nloc = b.st[0];
        const unsigned old = xb_add(&bar[XB_XSUB(b.x)], 1u);
        const unsigned gen = old / nloc;
        if (old + 1u == (gen + 1u) * nloc) xb_add(&bar[XB_XGEN(b.x)], 1u);
        else XB_SPIN(xb_ld(&bar[XB_XGEN(b.x)]) == gen, bar);
        __builtin_amdgcn_fence(__ATOMIC_ACQUIRE, "agent");
        asm volatile("s_waitcnt vmcnt(0)" ::: "memory");
    }
    __syncthreads();
}

constexpr size_t MiB = 1u << 20;
constexpr size_t WS_CTL = 0, CTL_ZERO_BYTES = 65536;
constexpr int CW_CURSOR = 4096;
constexpr size_t WS_MOD = 65536;
constexpr size_t WS_COS = WS_MOD + 393216, WS_SIN = WS_COS + 262144;
constexpr size_t WS_SSQQ = WS_SIN + 262144, WS_SSQK = WS_SSQQ + 131072;
constexpr size_t WS_IDX = WS_SSQK + 131072;
constexpr size_t WS_SLOT = WS_IDX + 524288, WS_GATEW = WS_SLOT + 131072;
static_assert(WS_GATEW + 131072 <= 2 * MiB, "small arrays");
constexpr size_t WS_W = 2 * MiB;
constexpr size_t LW_WIN = 0, LW_WUQ = LW_WIN + (size_t)DINP * D, LW_WUK = LW_WUQ + 768 * 256, LW_WUV = LW_WUK + 512 * 256, LW_WO = LW_WUV + 512 * 256,
                 LW_SGW = LW_WO + (size_t)D * D, LW_LWA = LW_SGW + 4 * 128 * 128, LW_LWX = LW_LWA + 4 * 64 * 64, LW_SIZE = ((LW_LWX + 4 * 64 * 64 + 65535) / 65536) * 65536;
static_assert(WS_W % 131072 == 0 && (LW_SIZE * 2) % 131072 == 0 && (LW_WUQ * 2) % 131072 == 0 && (LW_WUK * 2) % 131072 == 0 && (LW_WUV * 2) % 131072 == 0, "q/k/v tile alignment");
constexpr size_t DW_GU = 0, DW_D = DW_GU + (size_t)2 * DFF * D, DW_SIZE = DW_D + (size_t)D * DFF;
constexpr size_t MW_GU = 0, MW_D = MW_GU + (size_t)NE * 2 * DFE * D, MW_SIZE = MW_D + (size_t)NE * D * DFE;
constexpr int DFEP = 1536;
constexpr size_t DW8_GU = 0, DW8_D = DW8_GU + (size_t)2 * DFF * D;
constexpr size_t MW8_GU = 0, MW8_D = MW8_GU + (size_t)NE * 2 * DFE * D;
static_assert(MW8_D + (size_t)NE * D * DFEP <= ((size_t)NE * 2 * DFE * D + (size_t)NE * D * DFE) * 2, "fp8 MoE block fits");
constexpr size_t DW8_CS = 12 * MiB;
constexpr size_t DW8_RS = 13 * MiB, DW8_RSS = 14 * MiB;
constexpr size_t MW8_CS = 40 * MiB;
static_assert(DW8_D + (size_t)D * DFF <= DW8_CS && DW8_RSS + (size_t)8 * ECAP * 4 <= ((size_t)2 * DFF * D + (size_t)D * DFF) * 2, "dense block slack");
static_assert(MW8_D + (size_t)NE * D * DFEP <= MW8_CS && MW8_CS + (size_t)NE * 2 * DFE * 4 <= ((size_t)NE * 2 * DFE * D + (size_t)NE * D * DFE) * 2, "MoE block slack");
constexpr size_t WOFF_DENSE = 4 * LW_SIZE, WOFF_MOE = WOFF_DENSE + 2 * DW_SIZE, W_ELEMS = WOFF_MOE + 2 * MW_SIZE;
static_assert(WS_W + W_ELEMS * 2 <= 192 * MiB, "weight arena");
constexpr size_t WS_H = 192 * MiB, WS_YO = 224 * MiB, WS_RA = 288 * MiB;
constexpr size_t WS_ZQ = WS_RA, WS_ZKV = WS_ZQ + 8 * MiB, WS_KR = WS_ZKV + 8 * MiB, WS_U = WS_KR + 1 * MiB, WS_GV = WS_U + 8 * MiB, WS_ZX = WS_GV + 8 * MiB, WS_GY = WS_ZX + 8 * MiB,
                 WS_Q = WS_GY + 8 * MiB, WS_KN = WS_Q + 24 * MiB, WS_VT = WS_KN + 16 * MiB, WS_Y = WS_VT + 16 * MiB, WS_HL = WS_Y + 32 * MiB, WS_PP = WS_HL + 16 * MiB, WS_END = WS_PP + 16 * MiB;
constexpr size_t WS_ACT = WS_RA, WS_YD = WS_RA + 94 * MiB;
constexpr size_t WS_ACTD = WS_END, WS_END2 = WS_ACTD + 44 * MiB;
static_assert((size_t)M * DFF <= 44 * MiB, "dense activation buffer");
static_assert((size_t)MAXT * 256 * DFE * 2 <= 94 * MiB && (size_t)M * DFF * 2 <= 94 * MiB && WS_YD + (size_t)MAXT * 256 * D * 2 <= WS_END, "FFN overlay");

constexpr int RING_BYTES = 131072;
constexpr int MISC_OFF = RING_BYTES;
constexpr int LDS_BYTES = 147456;


namespace pg8 {
constexpr int BM = 256, BK = 64, HALF = 128, HTB = HALF * BK * 2  , STAGE_BYTES = 8 * HTB, NXCD = 8, WGM = 8;
__device__ __forceinline__ int lds_byte(int r, int c) { const int st = (r >> 4) * 2 + (c >> 5), rr = r & 15, cc = c & 31, ob = rr * 64 + cc * 2; return st * 1024 + (ob ^ (((ob >> 9) & 1) << 5)); }
__device__ __forceinline__ void stage_rc(int b, int& R, int& C) { const int st = b / 1024, sb = b % 1024, swz = sb ^ (((sb >> 9) & 1) << 5); R = (st >> 1) * 16 + swz / 64; C = (st & 1) * 32 + (swz % 64) / 2; }
__device__ __forceinline__ int perm32(int rho) { const int n = rho >> 4, i = rho & 15; return 8 * (i >> 2) + 4 * n + (i & 3); }

typedef int i32x8 __attribute__((ext_vector_type(8)));
typedef int i32x4v __attribute__((ext_vector_type(4)));
__device__ __forceinline__ i32x8 cat8(const bf16x8 a, const bf16x8 b) { const i32x4v x = __builtin_bit_cast(i32x4v, a), y = __builtin_bit_cast(i32x4v, b); return __builtin_shufflevector(x, y, 0, 1, 2, 3, 4, 5, 6, 7); }
__device__ __forceinline__ unsigned pk4_fp8(const f32x4 v) {
    float lim = 448.f; asm volatile("" : "+s"(lim));
    const float a = __builtin_fminf(__builtin_fmaxf(v[0], -lim), lim), b = __builtin_fminf(__builtin_fmaxf(v[1], -lim), lim), c = __builtin_fminf(__builtin_fmaxf(v[2], -lim), lim), d = __builtin_fminf(__builtin_fmaxf(v[3], -lim), lim);
    int w = __builtin_amdgcn_cvt_pk_fp8_f32(a, b, 0, false); w = __builtin_amdgcn_cvt_pk_fp8_f32(c, d, w, true); return (unsigned)w; }
__device__ __forceinline__ unsigned pk4_i8(const f32x4 v) {
    const unsigned b0 = __builtin_bit_cast(unsigned, v[0] + 12582912.0f), b1 = __builtin_bit_cast(unsigned, v[1] + 12582912.0f), b2 = __builtin_bit_cast(unsigned, v[2] + 12582912.0f), b3 = __builtin_bit_cast(unsigned, v[3] + 12582912.0f);
    const unsigned lo = __builtin_amdgcn_perm(b1, b0, 0x0c0c0400u), hi = __builtin_amdgcn_perm(b3, b2, 0x0c0c0400u);
    return __builtin_amdgcn_perm(hi, lo, 0x05040100u); }
__device__ __forceinline__ f32x4 i2f4(const f32x4 a) { const i32x4v q = __builtin_bit_cast(i32x4v, a); return (f32x4){(float)q[0], (float)q[1], (float)q[2], (float)q[3]}; }
constexpr float F8_WSC = 64.0f, F8_HSC = 4.0f, F8_ASC = 8.0f;
struct Unit { int pm, pn, x0, x1, x2, x3, co; };
struct Gemm { const void* A; const void* Bt; int K; int ld = 0; };

struct StaticOrder {
    static constexpr bool GATHER = false;
    int nM, nN, nwg, G, c, lim;
    __device__ void init(int Mr, int N, int G_, int c_) { nM = Mr / BM; nN = N / BM; nwg = nM * nN; G = G_; c = c_; lim = nwg; }
    __device__ bool next_tail(Unit& u) const { const int L = lim + 8 * ((c >> 3) >> 1) + (c & 7); if (L >= nwg) return false; map(L, u); u.co = ((c >> 3) & 1) * HALF; return true; }
    __device__ bool next(int i, Unit& u) const {
        const long L = (long)i * G + c; if (L >= lim) return false;
        map((int)L, u); return true; }
    __device__ void map(int Lq, Unit& u) const {
        int wgid = Lq; { const int q = nwg / NXCD, r = nwg % NXCD, xcd = wgid % NXCD, off = wgid / NXCD; wgid = (xcd < r ? xcd * (q + 1) : r * (q + 1) + (xcd - r) * q) + off; }
        const int nig = WGM * nN, gid = wgid / nig, fm = gid * WGM, gsz = (nM - fm) < WGM ? (nM - fm) : WGM;
        u.pm = fm + ((wgid % nig) % gsz); u.pn = (wgid % nig) / gsz; u.x0 = u.pm; u.x1 = u.pn; u.x2 = 0; u.x3 = 0; u.co = 0;
    }
    __device__ __forceinline__ int src_row(const Unit&, int) const { return 0; }
};

struct QkvOrder {
    static constexpr bool GATHER = false;
    int G, c, tq_a, tq_b, tk_a, tk_b, tv_a, tv_b;
    __device__ bool next(int i, Unit& u) const {
        const int L = i * G + c; if (L >= 448) return false;
        if (L < 192) { const int pm = L / 3, pn = L - 3 * pm; u.pm = tq_a + pm; u.pn = tq_b + pn; u.x0 = pm; u.x1 = pn; u.x2 = 0; }
        else if (L < 320) { const int j = L - 192, pm = j >> 1, pn = j & 1; u.pm = tk_a + pm; u.pn = tk_b + pn; u.x0 = pm; u.x1 = pn; u.x2 = 1; }
        else { const int j = L - 320, pn = j >> 1, pm = j & 1; u.pm = tv_a + pm; u.pn = tv_b + pn; u.x0 = pm; u.x1 = pn; u.x2 = 2; }
        u.x3 = 0; return true;
    }
    __device__ __forceinline__ int src_row(const Unit&, int) const { return 0; }
};
template <class S> struct TailOrder {
    static constexpr bool GATHER = false;
    const S& s;
    __device__ __forceinline__ bool next(int i, Unit& u) const { return i == 0 && s.next_tail(u); }
    __device__ __forceinline__ int src_row(const Unit&, int) const { return 0; }
};

template <class Epi, class Sched, bool ALIGN_EPI, int NBJ = 2, int QM = 0>
__device__ __forceinline__ void gemm_phase(LAS unsigned char* lds, const Gemm g, const Sched& S, const Epi& E) {
    const int tid = opaque_tid(), wid = __builtin_amdgcn_readfirstlane(tid >> 6), lane = tid & 63, wr = wid >> 2, wc = wid & 3, fr = lane & 15, fq = lane >> 4;
    constexpr bool F8 = (QM == 1); const int K = g.K, LD = g.ld ? g.ld : g.K, RB = QM ? LD : 2 * LD  , nt = (QM ? K : 2 * K) / 128;
    constexpr bool GA = Sched::GATHER;
    unsigned voffA, voffB;
    { int R, C; stage_rc(tid * 16, R, C); const int Rb = Epi::PERM ? ((R & ~31) + perm32(R & 31)) : R; voffA = (unsigned)(R * RB + 2 * C); voffB = (unsigned)(Rb * RB + 2 * C); }
    const size_t dstep = (size_t)64 * RB;
    u32x4 vG;
    LAS u32x4* gstash = (LAS u32x4*)(lds + STAGE_BYTES + 4096 + tid * 16);
    const size_t kstep = (size_t)(BK * 2);
    const size_t hstep = GA ? 0 : (size_t)HALF * RB;
    const size_t tstep = (size_t)BM * RB;
    const unsigned ldsw = (unsigned)wid * 1024u;
    const int aoff = lds_byte(wr * 64 + fr, fq * 8), boff = lds_byte(wc * 32 + fr, fq * 8);
#define PG8_SA(b, h) (((b) * 2 + (h)) * HTB)
#define PG8_SB(b, h) ((4 + (b) * 2 + (h)) * HTB)
#define PG8_STAGE(bufoff, gbase, voff) do { _Pragma("unroll") for (int _i = 0; _i < 2; ++_i) \
        __builtin_amdgcn_global_load_lds((const unsigned*)((const char*)(gbase) + _i * dstep + (voff)), (LAS unsigned*)(lds + (bufoff) + ldsw + _i * 8192), 16, 0, 0); } while (0)
#define PG8_STAGE_A(bufoff, gbase, h, NX) do { if constexpr (GA) { _Pragma("unroll") for (int _i = 0; _i < 2; ++_i) \
            __builtin_amdgcn_global_load_lds((const unsigned*)((const char*)(gbase) + vG[(h) * 2 + _i]), (LAS unsigned*)(lds + (bufoff) + ldsw + _i * 8192), 16, 0, 0); } \
        else { PG8_STAGE(bufoff, (const char*)(gbase) + (h) * hstep, voffA); } } while (0)
#define PG8_LDA(dst, b, h) do { _Pragma("unroll") for (int m = 0; m < 4; ++m) _Pragma("unroll") for (int k = 0; k < 2; ++k) dst[m][k] = *(const LAS bf16x8*)(lds + PG8_SA(b, h) + aoff + m * 2048 + k * 1024); } while (0)
#define PG8_LDB(dst, b, h) do { _Pragma("unroll") for (int n = 0; n < 2; ++n) _Pragma("unroll") for (int k = 0; k < 2; ++k) dst[n][k] = *(const LAS bf16x8*)(lds + PG8_SB(b, h) + boff + n * 2048 + k * 1024); } while (0)
#define PG8_MMA(ai, bj, At, Bt) do { __builtin_amdgcn_s_setprio(1); _Pragma("unroll") for (int m = 0; m < 4; ++m) _Pragma("unroll") for (int n = 0; n < 2; ++n) { \
        if constexpr (F8) acc[ai][bj][m][n] = __builtin_amdgcn_mfma_scale_f32_16x16x128_f8f6f4(cat8(Bt[n][0], Bt[n][1]), cat8(At[m][0], At[m][1]), acc[ai][bj][m][n], 0, 0, 0, 0, 0, 0);     \
        else if constexpr (QM == 2) { _Pragma("unroll") for (int k = 0; k < 2; ++k) acc[ai][bj][m][n] = __builtin_bit_cast(f32x4, __builtin_amdgcn_mfma_i32_16x16x64_i8(__builtin_bit_cast(i32x4v, Bt[n][k]), __builtin_bit_cast(i32x4v, At[m][k]), __builtin_bit_cast(i32x4v, acc[ai][bj][m][n]), 0, 0, 0)); } \
        else { _Pragma("unroll") for (int k = 0; k < 2; ++k) acc[ai][bj][m][n] = __builtin_amdgcn_mfma_f32_16x16x32_bf16(Bt[n][k], At[m][k], acc[ai][bj][m][n], 0, 0, 0); } } __builtin_amdgcn_s_setprio(0); } while (0)
#define PG8_WAIT_V(n) asm volatile("s_waitcnt vmcnt(" #n ")" ::: "memory")
#define PG8_WAIT_L(n) asm volatile("s_waitcnt lgkmcnt(" #n ")" ::: "memory")
#define PG8_WAIT_VN do { if constexpr (NBJ == 2) PG8_WAIT_V(8); else PG8_WAIT_V(6); } while (0)
#define PG8_BAR __builtin_amdgcn_s_barrier()
#define PG8_SCHED __builtin_amdgcn_sched_barrier(0)
#define PG8_GOFF(dst, u) do { if constexpr (GA) { int _t = tid, _R, _C; asm volatile("" : "+v"(_t)); stage_rc(_t * 16, _R, _C);     \
        _Pragma("unroll") for (int _h = 0; _h < 2; ++_h) _Pragma("unroll") for (int _i = 0; _i < 2; ++_i) \
        dst[_h * 2 + _i] = (unsigned)S.src_row(u, _h * HALF + _i * 64 + _R) * (unsigned)RB + 2u * (unsigned)_C; } } while (0)
    Unit cur, nxt; int ui = 0;
    if (!S.next(0, cur)) return;
    f32x4 acc[2][2][4][2];
#pragma unroll
    for (int a = 0; a < 2; ++a)
#pragma unroll
        for (int b = 0; b < 2; ++b)
#pragma unroll
            for (int m = 0; m < 4; ++m)
#pragma unroll
                for (int n = 0; n < 2; ++n) acc[a][b][m][n] = (f32x4){0.f, 0.f, 0.f, 0.f};
    bf16x8 At[4][2], B0[2][2], B1[2][2];
    const char* cA = (const char*)g.A + (GA ? (size_t)0 : (size_t)cur.pm * tstep); const char* cB = (const char*)g.Bt + (size_t)cur.pn * tstep + (size_t)(cur.co / HALF) * ((size_t)HALF * RB);
    PG8_GOFF(vG, cur);
    PG8_STAGE(PG8_SB(0, 0), cB, voffB); if constexpr (NBJ == 2) PG8_STAGE(PG8_SB(0, 1), cB + (size_t)HALF * RB, voffB); PG8_STAGE_A(PG8_SA(0, 0), cA, 0, false); PG8_STAGE_A(PG8_SA(0, 1), cA, 1, false);
    if (wr == 1) PG8_BAR;
    PG8_WAIT_V(2); PG8_BAR;
    PG8_STAGE(PG8_SB(1, 0), cB + kstep, voffB); PG8_STAGE_A(PG8_SA(1, 0), cA + kstep, 0, false); if constexpr (NBJ == 2) PG8_STAGE(PG8_SB(1, 1), cB + (size_t)HALF * RB + kstep, voffB);
    if constexpr (NBJ == 2) PG8_WAIT_V(6); else PG8_WAIT_V(4);
    PG8_BAR;
    const size_t bh = (size_t)HALF * RB;
    for (;;) {
        const bool has_next = S.next(ui + 1, nxt);
        if constexpr (GA) { u32x4 nx = vG; if (has_next) { PG8_GOFF(nx, nxt); } *gstash = nx; }
        const char* nA = has_next ? (const char*)g.A + (GA ? (size_t)0 : (size_t)nxt.pm * tstep) : cA; const char* nB = has_next ? (const char*)g.Bt + (size_t)nxt.pn * tstep + (size_t)(nxt.co / HALF) * ((size_t)HALF * RB) : cB;
#pragma nounroll
        for (int t = 0; t < nt; t += 2) {
            const bool last = (t == nt - 2);
            const bool tail = last && !has_next;
            if constexpr (GA) asm volatile("" : "+v"(voffB), "+v"(vG));
            else asm volatile("" : "+v"(voffA), "+v"(voffB));
            const char* a1 = cA + (size_t)(t + 1) * kstep;
            const char* a2 = last ? nA : cA + (size_t)(t + 2) * kstep; const char* b2 = last ? nB : cB + (size_t)(t + 2) * kstep;
            const char* a3 = a2 + kstep; const char* b3 = b2 + kstep;
            PG8_LDB(B0, 0, 0); if constexpr (NBJ == 2) PG8_LDB(B1, 0, 1); PG8_SCHED; PG8_LDA(At, 0, 0); PG8_STAGE_A(PG8_SA(1, 1), a1, 1, false);
            if constexpr (GA) { if (last) vG = *gstash; }
            PG8_WAIT_VN; PG8_WAIT_L(0); PG8_BAR; PG8_MMA(0, 0, At, B0); if constexpr (NBJ == 2) PG8_MMA(0, 1, At, B1); PG8_BAR; PG8_SCHED;
            PG8_LDA(At, 0, 1); if (!tail) { PG8_STAGE(PG8_SB(0, 0), b2, voffB); if constexpr (NBJ == 2) PG8_STAGE(PG8_SB(0, 1), b2 + bh, voffB); PG8_STAGE_A(PG8_SA(0, 0), a2, 0, last); }
            if (tail) PG8_WAIT_V(2); else PG8_WAIT_VN;
            PG8_WAIT_L(0); PG8_BAR; PG8_MMA(1, 0, At, B0); if constexpr (NBJ == 2) PG8_MMA(1, 1, At, B1); PG8_BAR; PG8_SCHED;
            PG8_LDB(B0, 1, 0); if constexpr (NBJ == 2) PG8_LDB(B1, 1, 1); PG8_SCHED; PG8_LDA(At, 1, 0); if (!tail) PG8_STAGE_A(PG8_SA(0, 1), a2, 1, last);
            if (tail) PG8_WAIT_V(0); else PG8_WAIT_VN;
            PG8_WAIT_L(0); PG8_BAR; PG8_MMA(0, 0, At, B0); if constexpr (NBJ == 2) PG8_MMA(0, 1, At, B1); PG8_BAR; PG8_SCHED;
            PG8_LDA(At, 1, 1); if (!tail) { PG8_STAGE(PG8_SB(1, 0), b3, voffB); if constexpr (NBJ == 2) PG8_STAGE(PG8_SB(1, 1), b3 + bh, voffB); PG8_STAGE_A(PG8_SA(1, 0), a3, 0, last); }
            if (tail) PG8_WAIT_V(0); else PG8_WAIT_VN;
            PG8_WAIT_L(0); PG8_BAR; PG8_MMA(1, 0, At, B0); if constexpr (NBJ == 2) PG8_MMA(1, 1, At, B1); PG8_BAR; PG8_SCHED;
        }
        if constexpr (ALIGN_EPI) { if (wr == 0) PG8_BAR; }
        { int l2 = lane; asm volatile("" : "+v"(l2)); E.template operator()<NBJ>(acc, cur, wr, wc, l2 & 15, l2 >> 4); }
        if (!has_next) break;
#pragma unroll
        for (int a = 0; a < 2; ++a)
#pragma unroll
            for (int b = 0; b < 2; ++b)
#pragma unroll
                for (int m = 0; m < 4; ++m)
#pragma unroll
                    for (int n = 0; n < 2; ++n) acc[a][b][m][n] = (f32x4){0.f, 0.f, 0.f, 0.f};
        cur = nxt; cA = nA; cB = nB; ++ui;
        if constexpr (ALIGN_EPI) { if (wr == 1) PG8_BAR; }
    }
    PG8_WAIT_V(0);
    if constexpr (!ALIGN_EPI) { if (wr == 0) PG8_BAR; }
    PG8_BAR;
#undef PG8_SA
#undef PG8_SB
#undef PG8_STAGE
#undef PG8_STAGE_A
#undef PG8_LDA
#undef PG8_LDB
#undef PG8_MMA
#undef PG8_WAIT_V
#undef PG8_WAIT_L
#undef PG8_WAIT_VN
#undef PG8_BAR
#undef PG8_SCHED
#undef PG8_GOFF
}

typedef f32x4 AccT[2][2][4][2];
__device__ __forceinline__ u32x4 pack8(const f32x4 v0, const f32x4 v1) { u32x4 w; w.x = cvt_pk(v0[0], v0[1]); w.y = cvt_pk(v0[2], v0[3]); w.z = cvt_pk(v1[0], v1[1]); w.w = cvt_pk(v1[2], v1[3]); return w; }
__device__ __forceinline__ float rstd_from(u64 ssq, float inv_n) { return __builtin_amdgcn_rsqf((float)ssq * (1.0f / 4294967296.0f) * inv_n + 1e-6f); }
__device__ __forceinline__ f32x4 gelu4(f32x4 v) {
    constexpr float K1 = -2.0f * LOG2E * 0.7978845608028654f, K2 = K1 * 0.044715f;
    typedef float f32x2_ __attribute__((ext_vector_type(2)));
    f32x2_ k1 = (f32x2_){K1, K1}, k2 = (f32x2_){K2, K2}; asm volatile("" : "+s"(k1), "+s"(k2));
    const f32x4 k1v = __builtin_shufflevector(k1, k1, 0, 1, 0, 1), k2v = __builtin_shufflevector(k2, k2, 0, 1, 0, 1);
    const f32x4 t = v * ((v * v) * k2v + k1v);
    f32x4 d = (f32x4){fexp2(t[0]), fexp2(t[1]), fexp2(t[2]), fexp2(t[3])}; d = d + 1.0f;
    const f32x4 s = (f32x4){frcp(d[0]), frcp(d[1]), frcp(d[2]), frcp(d[3])};
    return v * s; }

struct EpiF32 {
    static constexpr bool PERM = false;
    float* O; int ldc;
    template <int NBJ = 2> __device__ __forceinline__ void operator()(const AccT& acc, const Unit& u, int wr, int wc, int fr, int fq) const {
#pragma unroll
        for (int ai = 0; ai < 2; ++ai)
#pragma unroll
            for (int m = 0; m < 4; ++m) { float* rowp = O + (size_t)(u.x0 * BM + ai * HALF + wr * 64 + m * 16 + fr) * ldc + u.x1 * BM + wc * 32 + 4 * fq;
#pragma unroll
                for (int bj = 0; bj < 2; ++bj)
#pragma unroll
                    for (int n = 0; n < 2; ++n) *(f32x4*)(rowp + bj * HALF + n * 16) = acc[ai][bj][m][n]; }
    }
};
struct EpiBf {
    static constexpr bool PERM = true;
    bf16* O; int ldc;
    template <int NBJ = 2> __device__ __forceinline__ void operator()(const AccT& acc, const Unit& u, int wr, int wc, int fr, int fq) const {
#pragma unroll
        for (int ai = 0; ai < 2; ++ai)
#pragma unroll
            for (int m = 0; m < 4; ++m) { bf16* rowp = O + (size_t)(u.x0 * BM + ai * HALF + wr * 64 + m * 16 + fr) * ldc + u.x1 * BM + wc * 32 + 8 * fq;
#pragma unroll
                for (int bj = 0; bj < NBJ; ++bj) *(u32x4*)(rowp + u.co + bj * HALF) = pack8(acc[ai][bj][m][0], acc[ai][bj][m][1]); }
    }
};
struct EpiSwiglu {
    static constexpr bool PERM = true;
    bf16* O; int ldc;
    template <int NBJ = 2> __device__ __forceinline__ void operator()(const AccT& acc, const Unit& u, int wr, int wc, int fr, int fq) const {
#pragma unroll
        for (int ai = 0; ai < 2; ++ai)
#pragma unroll
            for (int m = 0; m < 4; ++m) { bf16* rowp = O + (size_t)(u.x0 * BM + ai * HALF + wr * 64 + m * 16 + fr) * ldc + u.x1 * HALF + wc * 32 + 8 * fq;
                f32x4 a0, a1;
#pragma unroll
                for (int e = 0; e < 4; ++e) { a0[e] = siluf_(acc[ai][0][m][0][e]) * acc[ai][1][m][0][e]; a1[e] = siluf_(acc[ai][0][m][1][e]) * acc[ai][1][m][1][e]; }
                *(u32x4*)rowp = pack8(a0, a1); }
    }
};
struct EpiBfS {
    static constexpr bool PERM = true;
    bf16* O; int ldc; float sc;
    template <int NBJ = 2> __device__ __forceinline__ void operator()(const AccT& acc, const Unit& u, int wr, int wc, int fr, int fq) const {
#pragma unroll
        for (int ai = 0; ai < 2; ++ai)
#pragma unroll
            for (int m = 0; m < 4; ++m) { bf16* rowp = O + (size_t)(u.x0 * BM + ai * HALF + wr * 64 + m * 16 + fr) * ldc + u.x1 * BM + wc * 32 + 8 * fq;
#pragma unroll
                for (int bj = 0; bj < NBJ; ++bj) *(u32x4*)(rowp + u.co + bj * HALF) = pack8(acc[ai][bj][m][0] * sc, acc[ai][bj][m][1] * sc); }
    }
};
struct EpiSwiglu8 {
    static constexpr bool PERM = true;
    unsigned char* O; int ldc, zt;
    template <int NBJ = 2> __device__ __forceinline__ void operator()(const AccT& acc, const Unit& u, int wr, int wc, int fr, int fq) const {
        constexpr float sg = 1.0f / (F8_HSC * F8_WSC), su = F8_ASC / (F8_HSC * F8_WSC);
#pragma unroll
        for (int ai = 0; ai < 2; ++ai)
#pragma unroll
            for (int m = 0; m < 4; ++m) { unsigned char* rowp = O + (size_t)(u.x0 * BM + ai * HALF + wr * 64 + m * 16 + fr) * ldc + u.x1 * HALF + wc * 32 + 8 * fq;
                f32x4 a0, a1;
#pragma unroll
                for (int e = 0; e < 4; ++e) { a0[e] = siluf_(acc[ai][0][m][0][e] * sg) * (acc[ai][1][m][0][e] * su); a1[e] = siluf_(acc[ai][0][m][1][e] * sg) * (acc[ai][1][m][1][e] * su); }
                u32x2 w; w.x = pk4_fp8(a0); w.y = pk4_fp8(a1); *(u32x2*)rowp = w;
                if (u.x1 == zt) *(u32x2*)(rowp + HALF) = (u32x2){0u, 0u}; }
    }
};
template <bool SLOT> struct EpiSwigluI8 {
    static constexpr bool PERM = true;
    unsigned char* O; int ldc, zt; const float* rs; const float* cs;
    template <int NBJ = 2> __device__ __forceinline__ void operator()(const AccT& acc, const Unit& u, int wr, int wc, int fr, int fq) const {
        const float* cp = cs + (size_t)u.pn * BM + wc * 32 + 8 * fq;
        const f32x4 cg0 = *(const f32x4*)cp, cg1 = *(const f32x4*)(cp + 4), cu0 = *(const f32x4*)(cp + HALF) * F8_ASC, cu1 = *(const f32x4*)(cp + HALF + 4) * F8_ASC;
        float rr[2][4];
#pragma unroll
        for (int ai = 0; ai < 2; ++ai)
#pragma unroll
            for (int m = 0; m < 4; ++m) { const int rl = ai * HALF + wr * 64 + m * 16 + fr; rr[ai][m] = SLOT ? ((rl < u.x3) ? rs[u.x2 + rl] : 0.f) : rs[u.x0 * BM + rl]; }
#pragma unroll
        for (int ai = 0; ai < 2; ++ai)
#pragma unroll
            for (int m = 0; m < 4; ++m) { const int rl = ai * HALF + wr * 64 + m * 16 + fr;
                unsigned char* rowp = O + (size_t)(u.x0 * BM + rl) * ldc + u.x1 * HALF + wc * 32 + 8 * fq;
                const float r = rr[ai][m];
                const f32x4 g0 = i2f4(acc[ai][0][m][0]) * (cg0 * r), g1 = i2f4(acc[ai][0][m][1]) * (cg1 * r), u0 = i2f4(acc[ai][1][m][0]) * (cu0 * r), u1 = i2f4(acc[ai][1][m][1]) * (cu1 * r);
                f32x4 nl2 = (f32x4){-LOG2E, -LOG2E, -LOG2E, -LOG2E}; asm volatile("" : "+v"(nl2));
                const f32x4 t0 = g0 * nl2, t1 = g1 * nl2;
                f32x4 d0, d1;
#pragma unroll
                for (int e = 0; e < 4; ++e) { d0[e] = fexp2(t0[e]); d1[e] = fexp2(t1[e]); }
                d0 = d0 + 1.0f; d1 = d1 + 1.0f;
                f32x4 s0, s1;
#pragma unroll
                for (int e = 0; e < 4; ++e) { s0[e] = frcp(d0[e]); s1[e] = frcp(d1[e]); }
                f32x4 a0 = (g0 * u0) * s0, a1 = (g1 * u1) * s1;
                float lim = 448.f; asm volatile("" : "+v"(lim));
#pragma unroll
                for (int e = 0; e < 4; ++e) { a0[e] = __builtin_amdgcn_fmed3f(a0[e], -lim, lim); a1[e] = __builtin_amdgcn_fmed3f(a1[e], -lim, lim); }
                u32x2 w;
                { int w0 = __builtin_amdgcn_cvt_pk_fp8_f32(a0[0], a0[1], 0, false); w0 = __builtin_amdgcn_cvt_pk_fp8_f32(a0[2], a0[3], w0, true);
                  int w1 = __builtin_amdgcn_cvt_pk_fp8_f32(a1[0], a1[1], 0, false); w1 = __builtin_amdgcn_cvt_pk_fp8_f32(a1[2], a1[3], w1, true); w.x = (unsigned)w0; w.y = (unsigned)w1; }
                *(u32x2*)rowp = w;
                if (u.x1 == zt) *(u32x2*)(rowp + HALF) = (u32x2){0u, 0u}; }
    }
};
struct EpiIn {
    static constexpr bool PERM = true;
    unsigned char* ws; const float* rs; const float* cs;
    template <int NBJ = 2> __device__ __forceinline__ void operator()(const AccT& acc, const Unit& u, int wr, int wc, int fr, int fq) const {
        const int pn = u.pn;
        f32x4 c0[NBJ], c1[NBJ];
        { const float* cp = cs + (size_t)pn * BM + u.co + wc * 32 + 8 * fq;
#pragma unroll
          for (int bj = 0; bj < NBJ; ++bj) { c0[bj] = *(const f32x4*)(cp + bj * HALF); c1[bj] = *(const f32x4*)(cp + bj * HALF + 4); } }
        float rr[2][4];
#pragma unroll
        for (int ai = 0; ai < 2; ++ai)
#pragma unroll
            for (int m = 0; m < 4; ++m) rr[ai][m] = rs[u.pm * BM + ai * HALF + wr * 64 + m * 16 + fr];
        bf16 *ZQ = (bf16*)(ws + WS_ZQ), *ZKV = (bf16*)(ws + WS_ZKV), *KR = (bf16*)(ws + WS_KR), *U = (bf16*)(ws + WS_U), *GV = (bf16*)(ws + WS_GV), *ZX = (bf16*)(ws + WS_ZX), *GY = (bf16*)(ws + WS_GY);
        u64 *ssq_q = (u64*)(ws + WS_SSQQ), *ssq_kv = (u64*)(ws + WS_SSQK); const float *cosT = (const float*)(ws + WS_COS), *sinT = (const float*)(ws + WS_SIN);
        const bool krope = (pn == 1 && wc == 0 && (NBJ == 2 || (u.co >> 7) == 1));
#pragma unroll
        for (int ai = 0; ai < 2; ++ai) {
            f32x4 cc[4], sn[4];
            if (krope) {
#pragma unroll
                for (int m = 0; m < 4; ++m) { const int pos = (u.pm * BM + ai * HALF + wr * 64 + m * 16 + fr) & (SEQ - 1); cc[m] = *(const f32x4*)(cosT + pos * 16 + 4 * fq); sn[m] = *(const f32x4*)(sinT + pos * 16 + 4 * fq); } }
#pragma unroll
            for (int m = 0; m < 4; ++m) {
                const int row = u.pm * BM + ai * HALF + wr * 64 + m * 16 + fr; const int cl = wc * 32 + 8 * fq; const float rsc = rr[ai][m];
                const int hb = u.co >> 7;
                if (pn == 0 || pn == 1) {
                    bf16* dst = (pn == 0 ? ZQ : ZKV) + (size_t)row * 256 + cl;
                    float ss = 0.f;
#pragma unroll
                    for (int bj = 0; bj < NBJ; ++bj) { const f32x4 v0 = i2f4(acc[ai][bj][m][0]) * (c0[bj] * rsc), v1 = i2f4(acc[ai][bj][m][1]) * (c1[bj] * rsc);
                        *(u32x4*)(dst + (bj + hb) * HALF) = pack8(v0, v1);
                        if (pn == 0 || bj + hb == 0) ss += (v0[0] * v0[0] + v0[1] * v0[1]) + (v0[2] * v0[2] + v0[3] * v0[3]) + (v1[0] * v1[0] + v1[1] * v1[1]) + (v1[2] * v1[2] + v1[3] * v1[3]); }
                    ss += shx(ss, fq * 16 + fr, 16); ss += shx(ss, fq * 16 + fr, 32);
                    if (fq == 0 && (pn == 0 || hb == 0)) atomicAdd((pn == 0 ? ssq_q : ssq_kv) + row, (u64)(ss * 4294967296.0f));
                    if (krope) {
                        const f32x4 x1 = i2f4(acc[ai][NBJ == 2 ? 1 : 0][m][0]) * (c0[NBJ == 2 ? 1 : 0] * rsc), x2 = i2f4(acc[ai][NBJ == 2 ? 1 : 0][m][1]) * (c1[NBJ == 2 ? 1 : 0] * rsc);
                        const f32x4 c = cc[m], s = sn[m];
                        const f32x4 o1 = x1 * c - x2 * s, o2 = x2 * c + x1 * s;
                        u32x2 w1, w2; w1.x = cvt_pk(o1[0], o1[1]); w1.y = cvt_pk(o1[2], o1[3]); w2.x = cvt_pk(o2[0], o2[1]); w2.y = cvt_pk(o2[2], o2[3]);
                        *(u32x2*)(KR + (size_t)row * 32 + 4 * fq) = w1; *(u32x2*)(KR + (size_t)row * 32 + 16 + 4 * fq) = w2; }
                } else {
                    bf16* dst = (pn == 2 ? U : pn == 3 ? GV : pn == 4 ? ZX : GY) + (size_t)row * 256 + cl;
#pragma unroll
                    for (int bj = 0; bj < NBJ; ++bj) { f32x4 v0 = i2f4(acc[ai][bj][m][0]) * (c0[bj] * rsc), v1 = i2f4(acc[ai][bj][m][1]) * (c1[bj] * rsc);
                        if (pn != 4) { v0 = gelu4(v0); v1 = gelu4(v1); }
                        *(u32x4*)(dst + (bj + hb) * HALF) = pack8(v0, v1); }
                }
            }
        }
    }
};
struct EpiQ {
    static constexpr bool PERM = true;
    unsigned char* ws;
    template <int NBJ = 2> __device__ __forceinline__ void operator()(const AccT& acc, const Unit& u, int wr, int wc, int fr, int fq) const {
        bf16* Q = (bf16*)(ws + WS_Q); const u64* ssq = (const u64*)(ws + WS_SSQQ); const float *cosT = (const float*)(ws + WS_COS), *sinT = (const float*)(ws + WS_SIN);
        u64 sq[2][4];
#pragma unroll
        for (int ai = 0; ai < 2; ++ai)
#pragma unroll
            for (int m = 0; m < 4; ++m) sq[ai][m] = ssq[u.x0 * BM + ai * HALF + wr * 64 + m * 16 + fr];
        const bool rope = ((u.x1 * 8 + wc) % 3 == 2) || ((u.x1 * 8 + 4 + wc) % 3 == 2);
#pragma unroll
        for (int ai = 0; ai < 2; ++ai) {
            f32x4 cc[4], sn[4];
            if (rope) {
#pragma unroll
                for (int m = 0; m < 4; ++m) { const int pos = (u.x0 * BM + ai * HALF + wr * 64 + m * 16 + fr) & (SEQ - 1); cc[m] = *(const f32x4*)(cosT + pos * 16 + 4 * fq); sn[m] = *(const f32x4*)(sinT + pos * 16 + 4 * fq); } }
#pragma unroll
            for (int m = 0; m < 4; ++m) {
                const int row = u.x0 * BM + ai * HALF + wr * 64 + m * 16 + fr; const float sc = rstd_from(sq[ai][m], 1.0f / 256.0f) * QSCALE;
#pragma unroll
                for (int bj = 0; bj < 2; ++bj) {
                    const int c32 = u.x1 * 8 + bj * 4 + wc, head = c32 / 3, part = c32 - 3 * head;
                    const f32x4 v0 = acc[ai][bj][m][0] * sc, v1 = acc[ai][bj][m][1] * sc; bf16* dst = Q + (size_t)row * 768 + head * 96;
                    if (part < 2) *(u32x4*)(dst + part * 32 + 8 * fq) = pack8(v0, v1);
                    else { const f32x4 c = cc[m], s = sn[m];
                        const f32x4 o1 = v0 * c - v1 * s, o2 = v1 * c + v0 * s;
                        u32x2 w1, w2; w1.x = cvt_pk(o1[0], o1[1]); w1.y = cvt_pk(o1[2], o1[3]); w2.x = cvt_pk(o2[0], o2[1]); w2.y = cvt_pk(o2[2], o2[3]);
                        *(u32x2*)(dst + 64 + 4 * fq) = w1; *(u32x2*)(dst + 80 + 4 * fq) = w2; }
                }
            }
            asm volatile("" ::: "memory");
        }
    }
};
struct EpiK {
    static constexpr bool PERM = true;
    unsigned char* ws;
    template <int NBJ = 2> __device__ __forceinline__ void operator()(const AccT& acc, const Unit& u, int wr, int wc, int fr, int fq) const {
        bf16* KN = (bf16*)(ws + WS_KN); const u64* ssq = (const u64*)(ws + WS_SSQK);
        u64 sq[2][4];
#pragma unroll
        for (int ai = 0; ai < 2; ++ai)
#pragma unroll
            for (int m = 0; m < 4; ++m) sq[ai][m] = ssq[u.x0 * BM + ai * HALF + wr * 64 + m * 16 + fr];
#pragma unroll
        for (int ai = 0; ai < 2; ++ai)
#pragma unroll
            for (int m = 0; m < 4; ++m) {
                const int row = u.x0 * BM + ai * HALF + wr * 64 + m * 16 + fr; const float sc = rstd_from(sq[ai][m], 1.0f / 128.0f);
                bf16* dst = KN + (size_t)row * 512 + u.x1 * BM + wc * 32 + 8 * fq;
#pragma unroll
                for (int bj = 0; bj < 2; ++bj) *(u32x4*)(dst + bj * HALF) = pack8(acc[ai][bj][m][0] * sc, acc[ai][bj][m][1] * sc);
            }
    }
};
struct EpiVT {
    static constexpr bool PERM = true;
    unsigned char* ws;
    template <int NBJ = 2> __device__ __forceinline__ void operator()(const AccT& acc, const Unit& u, int wr, int wc, int fr, int fq) const {
        bf16* VT = (bf16*)(ws + WS_VT); const u64* ssq = (const u64*)(ws + WS_SSQK);
#pragma unroll
        for (int bj = 0; bj < 2; ++bj) {
            const int tk = u.x1 * BM + bj * HALF + wc * 32 + 8 * fq; f32x4 s0, s1;
#pragma unroll
            for (int e = 0; e < 4; ++e) { s0[e] = rstd_from(ssq[tk + e], 1.0f / 128.0f); s1[e] = rstd_from(ssq[tk + 4 + e], 1.0f / 128.0f); }
#pragma unroll
            for (int ai = 0; ai < 2; ++ai)
#pragma unroll
                for (int m = 0; m < 4; ++m) { const int vr = u.x0 * BM + ai * HALF + wr * 64 + m * 16 + fr;
                    *(u32x4*)(VT + (size_t)vr * M + tk) = pack8(acc[ai][bj][m][0] * s0, acc[ai][bj][m][1] * s1); }
        }
    }
};
struct EpiQKV {
    static constexpr bool PERM = true;
    unsigned char* ws;
    template <int NBJ = 2> __device__ __forceinline__ void operator()(const AccT& acc, const Unit& u, int wr, int wc, int fr, int fq) const {
        if (u.x2 == 0) { EpiQ e{ws}; e(acc, u, wr, wc, fr, fq); }
        else if (u.x2 == 1) { EpiK e{ws}; e(acc, u, wr, wc, fr, fq); }
        else { EpiVT e{ws}; e(acc, u, wr, wc, fr, fq); }
    }
};
}

namespace att {
constexpr int KP = 208, VP = 144;
constexpr int KT = 64 * KP, VTB = 64 * VP;
constexpr int LDS_NEED = 2 * KT + 2 * VTB;
constexpr float THR = 8.0f;
__device__ __forceinline__ float max3(float a, float b, float c) { return __builtin_fmaxf(__builtin_fmaxf(a, b), c); }
__device__ __forceinline__ float rowmax32(const f32x16& p0, const f32x16& p1) {
    float a = max3(p0[0], p0[1], p1[0]), b = max3(p0[2], p0[3], p1[1]); a = max3(a, p1[2], p1[3]);
#pragma unroll
    for (int r = 4; r < 16; r += 4) { a = max3(a, p0[r], p0[r + 1]); b = max3(b, p0[r + 2], p0[r + 3]); a = max3(a, p1[r], p1[r + 1]); b = max3(b, p1[r + 2], p1[r + 3]); }
    const float m = __builtin_fmaxf(a, b);
    auto rr = __builtin_amdgcn_permlane32_swap(__float_as_uint(m), __float_as_uint(m), false, false);
    return __builtin_fmaxf(__uint_as_float(rr[0]), __uint_as_float(rr[1]));
}
__device__ __forceinline__ void attn_unit(LAS unsigned char* lds, int b, int h, int qb, const bf16* __restrict__ Q, const bf16* __restrict__ KN, const bf16* __restrict__ KR, const bf16* __restrict__ VT, bf16* __restrict__ Y) {
    const int tid = opaque_tid(), lane = tid & 63, r32 = lane & 31, hi = lane >> 5, w = __builtin_amdgcn_readfirstlane(tid >> 6);
    const int mrow = b * SEQ + qb * 256 + w * 32 + r32;
    const int nt_wg = 4 * qb + 4, nt_w = 4 * qb + (w >> 1) + 1;
    bf16x8 qf[6];
#pragma unroll
    for (int s = 0; s < 6; ++s) qf[s] = *(const bf16x8*)(Q + (size_t)mrow * 768 + h * 96 + 16 * s + 8 * hi);
    f32x16 o0 = {}, o1 = {}; float mref = 0.f, lsum = 0.f;
    const int kr0 = tid / 12, kc0 = tid % 12, kr1 = (tid + 512) / 12, kc1 = (tid + 512) % 12; const bool k2 = tid < 256;
    const int vd = tid >> 3, vc = tid & 7;
    const bf16* kp0 = (kc0 < 8) ? KN + ((size_t)b * SEQ + kr0) * 512 + h * 64 + kc0 * 8 : KR + ((size_t)b * SEQ + kr0) * 32 + (kc0 - 8) * 8; const size_t ks0 = (kc0 < 8) ? 64 * 512 : 64 * 32;
    const bf16* kp1 = (kc1 < 8) ? KN + ((size_t)b * SEQ + kr1) * 512 + h * 64 + kc1 * 8 : KR + ((size_t)b * SEQ + kr1) * 32 + (kc1 - 8) * 8; const size_t ks1 = (kc1 < 8) ? 64 * 512 : 64 * 32;
    const bf16* vp = VT + (size_t)(h * 64 + vd) * M + (size_t)b * SEQ + vc * 8;
    const int kw0 = kr0 * KP + kc0 * 16, kw1 = kr1 * KP + kc1 * 16, vw = 2 * KT + vd * VP + (vc >> 1) * 32 + (vc & 1) * 8;
    u32x4 kgA0, kgA1, vgA, kgB0, kgB1, vgB;
#define AT_GLOADK(S, t) do { kg##S##0 = *(const u32x4*)(kp0 + (size_t)(t) * ks0); if (k2) kg##S##1 = *(const u32x4*)(kp1 + (size_t)(t) * ks1); } while (0)
#define AT_GLOADV(S, t) do { vg##S = *(const u32x4*)(vp + (size_t)(t) * 64); } while (0)
#define AT_WRITEK(S, buf) do { *(LAS u32x4*)(lds + (buf) * KT + kw0) = kg##S##0; if (k2) *(LAS u32x4*)(lds + (buf) * KT + kw1) = kg##S##1; } while (0)
#define AT_WRITEV(S, buf) do { *(LAS u32x2*)(lds + (buf) * VTB + vw) = (u32x2){vg##S.x, vg##S.y}; *(LAS u32x2*)(lds + (buf) * VTB + vw + 16) = (u32x2){vg##S.z, vg##S.w}; } while (0)
    const int kro = r32 * KP + 16 * hi, vro = 2 * KT + r32 * VP + 16 * hi;
#define AT_QK(P0, P1, kb_, CIN) do { const LAS unsigned char* kb__ = lds + (kb_) * KT + kro; \
        _Pragma("unroll") for (int s = 0; s < 6; ++s) { const bf16x8 ka0 = *(const LAS bf16x8*)(kb__ + 32 * s), ka1 = *(const LAS bf16x8*)(kb__ + 32 * KP + 32 * s); \
            if (s == 0) { P0 = __builtin_amdgcn_mfma_f32_32x32x16_bf16(ka0, qf[0], CIN, 0, 0, 0); P1 = __builtin_amdgcn_mfma_f32_32x32x16_bf16(ka1, qf[0], CIN, 0, 0, 0); } \
            else { P0 = __builtin_amdgcn_mfma_f32_32x32x16_bf16(ka0, qf[s], P0, 0, 0, 0); P1 = __builtin_amdgcn_mfma_f32_32x32x16_bf16(ka1, qf[s], P1, 0, 0, 0); } } } while (0)
    AT_GLOADK(A, 0); AT_GLOADV(A, 0); AT_WRITEK(A, 0); AT_WRITEV(A, 0); AT_GLOADK(A, 1); AT_WRITEK(A, 1);
    AT_GLOADK(B, 2); AT_GLOADV(B, 1);
    __syncthreads();
    f32x16 pA, pB, negm = {};
    AT_QK(pA, pB, 0, negm);
    float rm = rowmax32(pA, pB);
    mref = rm;
    f32x16 pA1 = pB;
    f32x16 pB1 = {};
#pragma unroll
    for (int r = 0; r < 16; ++r) { pA[r] -= rm; pA1[r] -= rm; negm[r] = -rm; }
    rm = 0.f;
    __syncthreads();
#define AT_STEP(C0, C1, N0, N1, t, LS, WS) do { \
        if ((t) + 3 < nt_wg) AT_GLOADK(LS, (t) + 3); \
        if ((t) + 2 < nt_wg) AT_GLOADV(LS, (t) + 2); \
        if ((t) < nt_w) { \
            if ((t) > 0 && __builtin_amdgcn_ballot_w64(rm > THR) != 0ull) {     \
                const float dl = __builtin_fmaxf(rm, 0.f), f = fexp2(-dl); mref += dl; lsum *= f; \
                _Pragma("unroll") for (int r = 0; r < 16; ++r) { C0[r] -= dl; C1[r] -= dl; o0[r] *= f; o1[r] *= f; negm[r] = -mref; } } \
            AT_QK(N0, N1, ((t) + 1) & 1, negm);                   \
            _Pragma("unroll") for (int r = 0; r < 16; ++r) { C0[r] = fexp2(C0[r]); C1[r] = fexp2(C1[r]); } \
            bf16x8 pb[4]; \
            _Pragma("unroll") for (int ks = 0; ks < 2; ++ks) { u32x4 wv, wx; \
                wv.x = cvt_pk(C0[8 * ks + 0], C0[8 * ks + 1]); wv.y = cvt_pk(C0[8 * ks + 2], C0[8 * ks + 3]); wv.z = cvt_pk(C0[8 * ks + 4], C0[8 * ks + 5]); wv.w = cvt_pk(C0[8 * ks + 6], C0[8 * ks + 7]); \
                wx.x = cvt_pk(C1[8 * ks + 0], C1[8 * ks + 1]); wx.y = cvt_pk(C1[8 * ks + 2], C1[8 * ks + 3]); wx.z = cvt_pk(C1[8 * ks + 4], C1[8 * ks + 5]); wx.w = cvt_pk(C1[8 * ks + 6], C1[8 * ks + 7]); \
                pb[ks] = __builtin_bit_cast(bf16x8, wv); pb[2 + ks] = __builtin_bit_cast(bf16x8, wx); } \
            { const LAS unsigned char* vb__ = lds + ((t) & 1) * VTB + vro; \
              _Pragma("unroll") for (int ks = 0; ks < 4; ++ks) { \
                const bf16x8 va0 = *(const LAS bf16x8*)(vb__ + 32 * ks), va1 = *(const LAS bf16x8*)(vb__ + 32 * VP + 32 * ks); \
                o0 = __builtin_amdgcn_mfma_f32_32x32x16_bf16(va0, pb[ks], o0, 0, 0, 0); o1 = __builtin_amdgcn_mfma_f32_32x32x16_bf16(va1, pb[ks], o1, 0, 0, 0); } } \
            { float sa = 0.f, sb = 0.f; \
              _Pragma("unroll") for (int r = 0; r < 16; r += 2) { sa += C0[r] + C1[r]; sb += C0[r + 1] + C1[r + 1]; } \
              lsum += sa + sb; } \
            rm = rowmax32(N0, N1); \
              \
            __builtin_amdgcn_sched_group_barrier(0x100, 5, 0);     \
            _Pragma("unroll") for (int g_ = 0; g_ < 12; ++g_) { __builtin_amdgcn_sched_group_barrier(0x008, 1, 0); __builtin_amdgcn_sched_group_barrier(0x100, 1, 0); __builtin_amdgcn_sched_group_barrier(0x402, 4, 0); } \
            _Pragma("unroll") for (int g_ = 0; g_ < 8; ++g_) { __builtin_amdgcn_sched_group_barrier(0x008, 1, 0); __builtin_amdgcn_sched_group_barrier(0x100, 1, 0); __builtin_amdgcn_sched_group_barrier(0x402, 6, 0); } \
        } \
        if ((t) + 2 < nt_wg) AT_WRITEK(WS, (t) & 1); \
        if ((t) + 1 < nt_wg) AT_WRITEV(WS, ((t) + 1) & 1); \
        __syncthreads(); \
    } while (0)
    for (int t = 0; t < nt_wg; t += 2) {
        AT_STEP(pA, pA1, pB, pB1, t, A, B);
        AT_STEP(pB, pB1, pA, pA1, t + 1, B, A);
    }
#undef AT_STEP
#undef AT_QK
#undef AT_GLOADK
#undef AT_GLOADV
#undef AT_WRITEK
#undef AT_WRITEV
    float ltot = lsum; { auto rr = __builtin_amdgcn_permlane32_swap(__float_as_uint(lsum), __float_as_uint(lsum), false, false); ltot = __uint_as_float(rr[0]) + __uint_as_float(rr[1]); }
    const float inv = 1.0f / ltot;
    bf16* yrow = Y + (size_t)mrow * D + h * 64 + 4 * hi;
#pragma unroll
    for (int i = 0; i < 4; ++i) {
        u32x2 w0, w1; w0.x = cvt_pk(o0[4 * i] * inv, o0[4 * i + 1] * inv); w0.y = cvt_pk(o0[4 * i + 2] * inv, o0[4 * i + 3] * inv);
        w1.x = cvt_pk(o1[4 * i] * inv, o1[4 * i + 1] * inv); w1.y = cvt_pk(o1[4 * i + 2] * inv, o1[4 * i + 3] * inv);
        *(u32x2*)(yrow + 8 * i) = w0; *(u32x2*)(yrow + 32 + 8 * i) = w1;
    }
}
}

namespace sgu {
constexpr int VTP = 272;
constexpr int LDS_NEED = 128 * VTP;
__device__ __forceinline__ void unit(LAS unsigned char* lds, int m0, int gh, const bf16* __restrict__ GV, const bf16* __restrict__ U, const bf16* __restrict__ WS, const float* __restrict__ ln_g, const float* __restrict__ ln_b, const float* __restrict__ sb, bf16* __restrict__ Y) {
    const int tid = opaque_tid(), lane = tid & 63, r32 = lane & 31, hi = lane >> 5, w = __builtin_amdgcn_readfirstlane(tid >> 6);
    {
        const int cg = lane & 15, rsub = lane >> 4; const bool mine = (cg >> 3) == gh; const int cl = 16 * (cg & 7);
        f32x4 gq[4], bq[4];
#pragma unroll
        for (int q = 0; q < 4; ++q) { gq[q] = *(const f32x4*)(ln_g + 16 * cg + 4 * q); bq[q] = *(const f32x4*)(ln_b + 16 * cg + 4 * q); }
#pragma unroll
        for (int it = 0; it < 4; ++it) {
            const int s = w * 16 + it * 4 + rsub; const u32x4 r0 = *(const u32x4*)(GV + (size_t)(m0 + s) * 256 + 16 * cg), r1 = *(const u32x4*)(GV + (size_t)(m0 + s) * 256 + 16 * cg + 8);
            f32x4 x[4] = {{bflo(r0.x), bfhi(r0.x), bflo(r0.y), bfhi(r0.y)}, {bflo(r0.z), bfhi(r0.z), bflo(r0.w), bfhi(r0.w)}, {bflo(r1.x), bfhi(r1.x), bflo(r1.y), bfhi(r1.y)}, {bflo(r1.z), bfhi(r1.z), bflo(r1.w), bfhi(r1.w)}};
            float sm = 0.f;
#pragma unroll
            for (int q = 0; q < 4; ++q) sm += (x[q][0] + x[q][1]) + (x[q][2] + x[q][3]);
#pragma unroll
            for (int o = 1; o < 16; o <<= 1) sm += shx(sm, lane, o);
            const float mean = sm * (1.0f / 256.0f); float sq = 0.f;
#pragma unroll
            for (int q = 0; q < 4; ++q) { x[q] = x[q] - mean; sq += (x[q][0] * x[q][0] + x[q][1] * x[q][1]) + (x[q][2] * x[q][2] + x[q][3] * x[q][3]); }
#pragma unroll
            for (int o = 1; o < 16; o <<= 1) sq += shx(sq, lane, o);
            const float rstd = __builtin_amdgcn_rsqf(sq * (1.0f / 256.0f) + 1e-5f);
            if (mine) {
#pragma unroll
                for (int q = 0; q < 4; ++q) { const f32x4 y = x[q] * rstd * gq[q] + bq[q];
#pragma unroll
                    for (int e = 0; e < 4; ++e) *(LAS bf16*)(lds + (cl + 4 * q + e) * VTP + s * 2) = (bf16)(cvt_pk(y[e], 0.f) & 0xffffu); } }
        }
    }
    __syncthreads();
    const int gl = w >> 2, g = 2 * gh + gl, T = w & 3, nks = 2 * (T + 1);
    const bf16* wrow = WS + ((size_t)g * 128 + 32 * T + r32) * 128 + 8 * hi;
    bf16x8 af[8];
#pragma unroll
    for (int ks = 0; ks < 8; ++ks) af[ks] = (ks < nks) ? *(const bf16x8*)(wrow + 16 * ks) : (bf16x8){0, 0, 0, 0, 0, 0, 0, 0};
    f32x16 acc[2] = {};
#pragma unroll
    for (int ks = 0; ks < 8; ++ks) if (ks < nks) {
#pragma unroll
        for (int cb = 0; cb < 2; ++cb) { const bf16x8 bv = *(const LAS bf16x8*)(lds + (gl * 64 + 32 * cb + r32) * VTP + (16 * ks + 8 * hi) * 2);
            acc[cb] = __builtin_amdgcn_mfma_f32_32x32x16_bf16(af[ks], bv, acc[cb], 0, 0, 0); } }
    {
        constexpr int SP = 144;
        LAS unsigned char* sc = lds + 40960 + w * (32 * SP);
        const bf16* urow = U + (size_t)(m0 + 32 * T) * 256 + g * 64; bf16* yrow = Y + (size_t)(m0 + 32 * T) * D + 512 + g * 64;
#pragma unroll
        for (int i = 0; i < 4; ++i) { const int t = i * 8 + (lane >> 3), ch = lane & 7; *(LAS u32x4*)(sc + t * SP + ch * 16) = *(const u32x4*)(urow + (size_t)t * 256 + ch * 8); }
        float bv[16];
#pragma unroll
        for (int r = 0; r < 16; ++r) bv[r] = sb[g * 128 + 32 * T + (r & 3) + 8 * (r >> 2) + 4 * hi];
        asm volatile("" ::: "memory");
#pragma unroll
        for (int cb = 0; cb < 2; ++cb)
#pragma unroll
            for (int r = 0; r < 16; ++r) { const int t = (r & 3) + 8 * (r >> 2) + 4 * hi; LAS bf16* p = (LAS bf16*)(sc + t * SP + (32 * cb + r32) * 2);
                const float y = bf2f(*p) * (acc[cb][r] + bv[r]); *p = (bf16)(cvt_pk(y, 0.f) & 0xffffu); }
        asm volatile("" ::: "memory");
#pragma unroll
        for (int i = 0; i < 4; ++i) { const int t = i * 8 + (lane >> 3), ch = lane & 7; *(u32x4*)(yrow + (size_t)t * D + ch * 8) = *(const LAS u32x4*)(sc + t * SP + ch * 16); }
    }
    __syncthreads();
}
}

namespace lru {
constexpr int XP = 528;
constexpr int AP = 132;
constexpr int OFF_A = 64 * XP, OFF_B = OFF_A + 64 * AP * 4, LDS_NEED = OFF_B + 64 * AP * 4;
__device__ __forceinline__ void local_unit(LAS unsigned char* lds, int b, int c, const bf16* ZX, const float* conv_w, const float* conv_b, const bf16* WA, const bf16* WX,
                                           const float* ba, const float* bx, const float* lam, float* HL, float* PP) {
    const int tid = opaque_tid(), lane = tid & 63, r32 = lane & 31, hi = lane >> 5, w = __builtin_amdgcn_readfirstlane(tid >> 6);
    const int m0 = b * SEQ + c * 64;
    {
        const int cp = tid & 127, tq = tid >> 7, ch = 2 * cp;
        float w0[4], w1[4];
#pragma unroll
        for (int k = 0; k < 4; ++k) { w0[k] = conv_w[k * 256 + ch]; w1[k] = conv_w[k * 256 + ch + 1]; }
        const float cb0 = conv_b[ch], cb1 = conv_b[ch + 1];
        float z0[3], z1[3];
#pragma unroll
        for (int k = 0; k < 3; ++k) { const int tt = c * 64 + tq * 16 - 3 + k; unsigned raw = 0u; if (tt >= 0) raw = *(const unsigned*)(ZX + (size_t)(b * SEQ + tt) * 256 + ch); z0[k] = bflo(raw); z1[k] = bfhi(raw); }
#pragma unroll
        for (int i = 0; i < 16; ++i) { const int t = tq * 16 + i; const unsigned raw = *(const unsigned*)(ZX + (size_t)(m0 + t) * 256 + ch); const float a0 = bflo(raw), a1 = bfhi(raw);
            const float x0 = cb0 + z0[0] * w0[0] + z0[1] * w0[1] + z0[2] * w0[2] + a0 * w0[3], x1 = cb1 + z1[0] * w1[0] + z1[1] * w1[1] + z1[2] * w1[2] + a1 * w1[3];
            *(LAS unsigned*)(lds + t * XP + ch * 2) = cvt_pk(x0, x1);
            z0[0] = z0[1]; z0[1] = z0[2]; z0[2] = a0; z1[0] = z1[1]; z1[1] = z1[2]; z1[2] = a1; }
    }
    __syncthreads();
    LAS float* A32 = (LAS float*)(lds + OFF_A); LAS float* B32 = (LAS float*)(lds + OFF_B);
    for (int half = 0; half < 2; ++half) {
        {
            const int head = 2 * half + (w >> 2), tb = (w >> 1) & 1, jb = w & 1;
            f32x16 ar = {}, ai = {};
            bf16x8 wa[4], wx[4];
#pragma unroll
            for (int ks = 0; ks < 4; ++ks) { wa[ks] = *(const bf16x8*)(WA + ((size_t)head * 64 + 32 * jb + r32) * 64 + 16 * ks + 8 * hi); wx[ks] = *(const bf16x8*)(WX + ((size_t)head * 64 + 32 * jb + r32) * 64 + 16 * ks + 8 * hi); }
#pragma unroll
            for (int ks = 0; ks < 4; ++ks) {
                const bf16x8 xa = *(const LAS bf16x8*)(lds + (32 * tb + r32) * XP + (head * 64 + 16 * ks + 8 * hi) * 2);
                ar = __builtin_amdgcn_mfma_f32_32x32x16_bf16(xa, wa[ks], ar, 0, 0, 0); ai = __builtin_amdgcn_mfma_f32_32x32x16_bf16(xa, wx[ks], ai, 0, 0, 0);
            }
            const int ch = head * 64 + 32 * jb + r32, chl = ch - 128 * half;
            const float bav = ba[ch], bxv = bx[ch], lm = lam[ch];
            const float nsp = -8.0f * (fmaxf(-lm, 0.f) + log1pf(__expf(-fabsf(lm))));
#pragma unroll
            for (int r = 0; r < 16; ++r) { const int t = 32 * tb + (r & 3) + 8 * (r >> 2) + 4 * hi;
                const float rg = sigmoidf_(ar[r] + bav), ig = sigmoidf_(ai[r] + bxv), la = rg * nsp;
                const float x2 = 2.0f * la;
                const float a = __expf(la);
                const float om = (x2 > -0.25f) ? -x2 * (1.0f + x2 * (0.5f + x2 * (0.16666667f + x2 * (0.041666668f + x2 * (0.0083333338f + x2 * 0.0013888889f))))) : 1.0f - a * a;
                const float s = sqrtf(fmaxf(om, 0.f));
                const float xc = bf2f(*(const LAS bf16*)(lds + t * XP + ch * 2));
                A32[t * AP + chl] = a; B32[t * AP + chl] = s * (ig * xc); }
        }
        __syncthreads();
        {
            const int chs = tid & 127, seg = tid >> 7; LAS float* sum = (LAS float*)(lds + LDS_NEED);
            float av[16], bv[16];
#pragma unroll
            for (int i = 0; i < 16; ++i) { av[i] = A32[(16 * seg + i) * AP + chs]; bv[i] = B32[(16 * seg + i) * AP + chs]; }
            float hh = 0.f, pp = 1.f;
#pragma unroll
            for (int i = 0; i < 16; ++i) { hh = av[i] * hh + bv[i]; pp *= av[i]; bv[i] = hh; av[i] = pp; }
            sum[(seg * 2) * 128 + chs] = hh; sum[(seg * 2 + 1) * 128 + chs] = pp;
            __syncthreads();
            float Hin = 0.f, Pin = 1.f;
#pragma unroll
            for (int s = 0; s < 3; ++s) if (s < seg) { const float hs = sum[(s * 2) * 128 + chs], ps = sum[(s * 2 + 1) * 128 + chs]; Hin = ps * Hin + hs; Pin *= ps; }
            float* hl = HL + (size_t)(m0 + 16 * seg) * 256 + 128 * half + chs; float* pq = PP + (size_t)(m0 + 16 * seg) * 256 + 128 * half + chs;
#pragma unroll
            for (int i = 0; i < 16; ++i) { hl[(size_t)i * 256] = bv[i] + av[i] * Hin; pq[(size_t)i * 256] = av[i] * Pin; }
        }
        __syncthreads();
    }
}
__device__ __forceinline__ void fix_unit(LAS unsigned char* lds, int b, int c, const float* __restrict__ HL, const float* __restrict__ PP, const bf16* __restrict__ GY, bf16* __restrict__ Y) {
    const int tid = opaque_tid(); const int m0 = b * SEQ + c * 64; LAS float* hin = (LAS float*)lds;
    {
        const int ch = tid & 255, half = tid >> 8, c0 = half ? (c >> 1) : 0, c1 = half ? c : (c >> 1);
        float h = 0.f, pa = 1.f; const float* pq = PP + (size_t)(b * SEQ + 63) * 256 + ch; const float* hq = HL + (size_t)(b * SEQ + 63) * 256 + ch;
        int cc = c0;
        for (; cc + 8 <= c1; cc += 8) { float pv[8], hv[8];
#pragma unroll
            for (int j = 0; j < 8; ++j) { pv[j] = pq[(size_t)(cc + j) * 64 * 256]; hv[j] = hq[(size_t)(cc + j) * 64 * 256]; }
#pragma unroll
            for (int j = 0; j < 8; ++j) { h = pv[j] * h + hv[j]; pa *= pv[j]; } }
        for (; cc < c1; ++cc) { const float pv = pq[(size_t)cc * 64 * 256]; h = pv * h + hq[(size_t)cc * 64 * 256]; pa *= pv; }
        if (half) { hin[256 + ch] = h; hin[512 + ch] = pa; }
        __syncthreads();
        if (!half) hin[ch] = hin[512 + ch] * h + hin[256 + ch];
    }
    __syncthreads();
#pragma unroll
    for (int k = 0; k < 8; ++k) { const int item = tid + 512 * k, t = item >> 6, cg = item & 63; const size_t mo = (size_t)(m0 + t) * 256 + 4 * cg;
        const f32x4 hl = *(const f32x4*)(HL + mo), pp = *(const f32x4*)(PP + mo), hi4 = *(const LAS f32x4*)(hin + 4 * cg); const u32x2 gy = *(const u32x2*)(GY + mo);
        const f32x4 hv = hl + pp * hi4; u32x2 o; o.x = cvt_pk(hv[0] * bflo(gy.x), hv[1] * bfhi(gy.x)); o.y = cvt_pk(hv[2] * bflo(gy.y), hv[3] * bfhi(gy.y));
        *(u32x2*)(Y + (size_t)(m0 + t) * D + 768 + 4 * cg) = o; }
    __syncthreads();
}
}

struct MoeOrder {
    static constexpr bool GATHER = false;
    const volatile LAS int* tab; int npn, G, c, lim;
    __device__ __forceinline__ bool next_tail(pg8::Unit& u) const { const int L = lim + (c >> 1); if (L >= __builtin_amdgcn_readfirstlane(tab[24]) * npn) return false; map(L, u); u.co = (c & 1) * pg8::HALF; return true; }
    __device__ __forceinline__ bool next(int i, pg8::Unit& u) const {
        const int L = i * G + c, TT = __builtin_amdgcn_readfirstlane(tab[24]); if (L >= TT * npn || L >= lim) return false;
        map(L, u); return true; }
    __device__ __forceinline__ void map(int L, pg8::Unit& u) const {
        const int ti = L / npn, pnl = L - ti * npn; int e = 0;
#pragma unroll
        for (int j = 1; j < 8; ++j) e += (ti >= tab[16 + j]) ? 1 : 0;
        e = __builtin_amdgcn_readfirstlane(e);
        const int lt = ti - __builtin_amdgcn_readfirstlane(tab[16 + e]);
        u.pm = ti; u.pn = e * npn + pnl; u.x0 = ti; u.x1 = pnl; u.x2 = e * ECAP + lt * 256; u.x3 = __builtin_amdgcn_readfirstlane(tab[32 + e]) - lt * 256; u.co = 0;
    }
    __device__ __forceinline__ int src_row(const pg8::Unit&, int) const { return 0; }
};
struct MoeGatherOrder : MoeOrder {
    static constexpr bool GATHER = true;
    const int* idx;
    __device__ __forceinline__ int src_row(const pg8::Unit& u, int r) const { return (r < u.x3) ? idx[u.x2 + r] : 0; }
};

struct RowArgs {
    const float* xin; float* X; bf16* Xb; const bf16* Ysrc; const bf16* YD;     const int* slot; const float* gatew;
    const float* gate; const float* postg;
    const float* preg; const float* sc; const float* sh;
    bf16* H; const float* router; unsigned* cursor; int* idx; int* slot_w; float* gatew_w; u64* ssq_q; u64* ssq_kv; float* rs; float* rss;
};
template <int MODE>
__device__ __forceinline__ void row_phase(LAS unsigned char* lds, const volatile LAS int* tab, int vcu, const RowArgs& a, bool need_h, bool route) {
    const int tid = opaque_tid(), lane = tid & 63, w = __builtin_amdgcn_readfirstlane(tid >> 6);
    LAS float* rt = (LAS float*)lds; LAS int* e01 = (LAS int*)(lds + 32768); LAS float* rsl = (LAS float*)(lds + 32768 + 256);
    if (route) { for (int i = tid; i < 8192; i += 512) rt[(i & 7) * 1024 + (i >> 3)] = a.router[i]; __syncthreads(); }
    f32x4 cg[4], cb[4], cs[4];
#pragma unroll
#define RC(j) (512 * ((j) >> 1) + 8 * lane + 4 * ((j) & 1))
    for (int j = 0; j < 4; ++j) { const int col = RC(j);
        if (MODE != 0) cg[j] = *(const f32x4*)(a.gate + col) * *(const f32x4*)(a.postg + col);
        if (need_h) { cb[j] = *(const f32x4*)(a.preg + col) * (*(const f32x4*)(a.sc + col) + 1.0f); cs[j] = *(const f32x4*)(a.sh + col); } }
    const int row0 = vcu * 64 + w * 8;
    int slotv0 = 0, slotv1 = 0; float gv0 = 0.f, gv1 = 0.f;
    if (MODE == 3) { const int rr = row0 + (lane & 7); slotv0 = a.slot[rr * 2]; slotv1 = a.slot[rr * 2 + 1]; gv0 = a.gatew[rr * 2]; gv1 = a.gatew[rr * 2 + 1]; }
    f32x4 nx0[2][4]; u32x4 nxb[2][2], nyp[2][2], nyq[2][2];
#define ROW_LOAD(S, rw, ii) do { \
        if (MODE == 0) { _Pragma("unroll") for (int j = 0; j < 4; ++j) nx0[S][j] = __builtin_nontemporal_load((const f32x4*)(a.xin + (size_t)(rw) * D + RC(j))); } \
        else { _Pragma("unroll") for (int jj = 0; jj < 2; ++jj) nxb[S][jj] = __builtin_nontemporal_load((const u32x4*)(a.Xb + (size_t)(rw) * D + 512 * jj + 8 * lane)); } \
        if (MODE == 3) { const int s0_ = __builtin_amdgcn_readlane(slotv0, (ii)), s1_ = __builtin_amdgcn_readlane(slotv1, (ii)); \
            const size_t r0_ = (size_t)tab[16 + (s0_ >> 14)] * 256 + (s0_ & (ECAP - 1)), r1_ = (size_t)tab[16 + (s1_ >> 14)] * 256 + (s1_ & (ECAP - 1)); \
            _Pragma("unroll") for (int jj = 0; jj < 2; ++jj) { nyp[S][jj] = __builtin_nontemporal_load((const u32x4*)(a.YD + r0_ * D + 512 * jj + 8 * lane)); nyq[S][jj] = __builtin_nontemporal_load((const u32x4*)(a.YD + r1_ * D + 512 * jj + 8 * lane)); } } \
        else if (MODE != 0) { _Pragma("unroll") for (int jj = 0; jj < 2; ++jj) nyp[S][jj] = __builtin_nontemporal_load((const u32x4*)(a.Ysrc + (size_t)(rw) * D + 512 * jj + 8 * lane)); } } while (0)
    ROW_LOAD(0, row0, 0); ROW_LOAD(1, row0 + 1, 1);
#pragma unroll
    for (int i = 0; i < 8; ++i) {
        const int row = row0 + i; constexpr int dummy_ = 0; (void)dummy_;
        f32x4 x[4]; u32x2 yp[4], yq[4];
#pragma unroll
        for (int jj = 0; jj < 2; ++jj) {
            if (MODE == 0) { x[2 * jj] = nx0[i & 1][2 * jj]; x[2 * jj + 1] = nx0[i & 1][2 * jj + 1]; }
            else { const u32x4 q_ = nxb[i & 1][jj]; x[2 * jj] = (f32x4){bflo(q_.x), bfhi(q_.x), bflo(q_.y), bfhi(q_.y)}; x[2 * jj + 1] = (f32x4){bflo(q_.z), bfhi(q_.z), bflo(q_.w), bfhi(q_.w)}; }
            yp[2 * jj] = (u32x2){nyp[i & 1][jj].x, nyp[i & 1][jj].y}; yp[2 * jj + 1] = (u32x2){nyp[i & 1][jj].z, nyp[i & 1][jj].w}; yq[2 * jj] = (u32x2){nyq[i & 1][jj].x, nyq[i & 1][jj].y}; yq[2 * jj + 1] = (u32x2){nyq[i & 1][jj].z, nyq[i & 1][jj].w}; }
        if (i + 2 < 8) { if (i & 1) ROW_LOAD(1, row + 2, i + 2); else ROW_LOAD(0, row + 2, i + 2); }
        if (MODE != 0) {
            f32x4 y[4];
            if (MODE == 3) {
                const float g0 = __builtin_bit_cast(float, __builtin_amdgcn_readlane(__builtin_bit_cast(int, gv0), i)), g1 = __builtin_bit_cast(float, __builtin_amdgcn_readlane(__builtin_bit_cast(int, gv1), i));
#pragma unroll
                for (int j = 0; j < 4; ++j) y[j] = (f32x4){bflo(yp[j].x), bfhi(yp[j].x), bflo(yp[j].y), bfhi(yp[j].y)} * g0 + (f32x4){bflo(yq[j].x), bfhi(yq[j].x), bflo(yq[j].y), bfhi(yq[j].y)} * g1;
            } else {
#pragma unroll
                for (int j = 0; j < 4; ++j) y[j] = (f32x4){bflo(yp[j].x), bfhi(yp[j].x), bflo(yp[j].y), bfhi(yp[j].y)};
            }
            float ss = 0.f;
#pragma unroll
            for (int j = 0; j < 4; ++j) ss += (y[j][0] * y[j][0] + y[j][1] * y[j][1]) + (y[j][2] * y[j][2] + y[j][3] * y[j][3]);
            const float r = __builtin_amdgcn_rsqf(wave_sum_dpp(ss) * (1.0f / D) + 1e-6f);
#pragma unroll
            for (int j = 0; j < 4; ++j) x[j] = x[j] + cg[j] * (y[j] * r);
        }
        if (a.X) {
#pragma unroll
            for (int j = 0; j < 4; ++j) *(f32x4*)(a.X + (size_t)row * D + RC(j)) = x[j];
        } else {
#pragma unroll
            for (int jj = 0; jj < 2; ++jj) __builtin_nontemporal_store(pg8::pack8(x[2 * jj], x[2 * jj + 1]), (u32x4*)(a.Xb + (size_t)row * D + 512 * jj + 8 * lane)); }
        if (need_h) {
            float ss = 0.f;
#pragma unroll
            for (int j = 0; j < 4; ++j) ss += (x[j][0] * x[j][0] + x[j][1] * x[j][1]) + (x[j][2] * x[j][2] + x[j][3] * x[j][3]);
            const float r = __builtin_amdgcn_rsqf(wave_sum_dpp(ss) * (1.0f / D) + 1e-6f);
            f32x4 hv[4];
#pragma unroll
            for (int j = 0; j < 4; ++j) hv[j] = (x[j] * r) * cb[j] + cs[j];
            float qinv = 0.f;
            {
                float am = 0.f;
#pragma unroll
                for (int j = 0; j < 4; ++j) am = __builtin_fmaxf(am, __builtin_fmaxf(__builtin_fmaxf(__builtin_fabsf(hv[j][0]), __builtin_fabsf(hv[j][1])), __builtin_fmaxf(__builtin_fabsf(hv[j][2]), __builtin_fabsf(hv[j][3]))));
                am = __builtin_fmaxf(wave_max_dpp(am), 1e-30f); qinv = 127.0f / am;
                if (lane == 0) { const float s = am * (1.0f / 127.0f); a.rs[row] = s; if (route) rsl[w * 8 + i] = s; } }
#pragma unroll
            for (int jj = 0; jj < 2; ++jj) {
                u32x2 o; o.x = pg8::pk4_i8(hv[2 * jj] * qinv); o.y = pg8::pk4_i8(hv[2 * jj + 1] * qinv); *(u32x2*)((unsigned char*)a.H + (size_t)row * D + 512 * jj + 8 * lane) = o; }
            if (route) {
                float pe[8];
#pragma unroll
                for (int e = 0; e < 8; ++e) { f32x4 s4 = {0.f, 0.f, 0.f, 0.f};
#pragma unroll
                    for (int j = 0; j < 4; ++j) { const f32x4 rv = *(const LAS f32x4*)(rt + e * 1024 + RC(j)); s4 += hv[j] * rv; }
                    pe[e] = (s4[0] + s4[1]) + (s4[2] + s4[3]); }
                float q4[4], q2[2], q1;
                { const bool up = (lane & 32) != 0;
#pragma unroll
                  for (int j = 0; j < 4; ++j) { const float keep = up ? pe[4 + j] : pe[j], give = up ? pe[j] : pe[4 + j]; q4[j] = keep + shx(give, lane, 32); } }
                { const bool up = (lane & 16) != 0;
#pragma unroll
                  for (int j = 0; j < 2; ++j) { const float keep = up ? q4[2 + j] : q4[j], give = up ? q4[j] : q4[2 + j]; q2[j] = keep + shx(give, lane, 16); } }
                { const bool up = (lane & 8) != 0; const float keep = up ? q2[1] : q2[0], give = up ? q2[0] : q2[1]; q1 = keep + shx(give, lane, 8); }
                q1 += shx(q1, lane, 4); q1 += shx(q1, lane, 2); q1 += shx(q1, lane, 1);
                float lg[8];
#pragma unroll
                for (int e = 0; e < 8; ++e) lg[e] = __builtin_bit_cast(float, __builtin_amdgcn_readlane(__builtin_bit_cast(int, q1), 8 * e));
                int e0 = 0; float v0 = lg[0];
#pragma unroll
                for (int e = 1; e < 8; ++e) if (lg[e] > v0) { v0 = lg[e]; e0 = e; }
                int e1 = -1; float v1 = -3.0e38f;
#pragma unroll
                for (int e = 0; e < 8; ++e) if (e != e0 && lg[e] > v1) { v1 = lg[e]; e1 = e; }
                const float g0 = frcp(1.0f + __expf(v1 - v0)), g1 = 1.0f - g0;
                if (lane == 0) { e01[w * 8 + i] = e0 | (e1 << 8); a.gatew_w[row * 2] = g0; a.gatew_w[row * 2 + 1] = g1; }
            }
        }
        if (MODE == 1 && lane == 0) { a.ssq_q[row] = 0ull; a.ssq_kv[row] = 0ull; }
    }
    if (route) {
        __syncthreads();
        if (w == 0) {
            const int pk = e01[lane], e0 = pk & 255, e1 = pk >> 8, token = vcu * 64 + lane; const u64 lt = (1ull << lane) - 1ull;
            int p0 = 0, p1 = 0, mycnt = 0;
#pragma unroll
            for (int e = 0; e < 8; ++e) {
                const u64 m0 = __ballot(e0 == e), m1 = __ballot(e1 == e); const int c0 = __popcll(m0), c1 = __popcll(m1);
                if (lane == e) mycnt = c0 + c1;
                if (e0 == e) p0 = __popcll(m0 & lt);
                if (e1 == e) p1 = c0 + __popcll(m1 & lt);
            }
            unsigned mybase = 0u; if (lane < 8 && mycnt > 0) mybase = atomicAdd(a.cursor + lane, (unsigned)mycnt);
#pragma unroll
            for (int e = 0; e < 8; ++e) { const int base = __builtin_amdgcn_readlane((int)mybase, e); if (e0 == e) p0 += base; if (e1 == e) p1 += base; }
            a.idx[e0 * ECAP + p0] = token; a.idx[e1 * ECAP + p1] = token;
            a.slot_w[token * 2] = e0 * ECAP + p0; a.slot_w[token * 2 + 1] = e1 * ECAP + p1;
            { const float s = rsl[lane]; a.rss[e0 * ECAP + p0] = s; a.rss[e1 * ECAP + p1] = s; }
        }
        __syncthreads();
    }
}

__device__ __forceinline__ int rperm(int jj) { return 8 * ((jj & 15) >> 2) + 4 * (jj >> 4) + (jj & 3); }
__device__ __forceinline__ int map_row(int kind, int n) {
    if (kind == 1) return 256 * (n >> 7) + (n & 127);
    if (kind == 2) return 256 * (n >> 7) + 128 + (n & 127);
    if (kind == 3) return n < 384 ? n : (n < 416 ? 384 + rperm(n - 384) : n + 96);
    if (kind == 4) { const int h = n / 96, j = n - 96 * h; return j < 64 ? n : h * 96 + 64 + rperm(j - 64); }
    return n;
}
template <bool F8 = false>
__device__ __forceinline__ void tr_item(const float* W, int ldn, void* WTv, int ldk, const float* gain, int kind, LAS float* scr, int kb, int nb, int lane) {
    const int k0 = 64 * kb, n0 = 32 * nb;
#pragma unroll
    for (int i = 0; i < 32; ++i) { const int kk = 2 * i + (lane >> 5); float v = __builtin_nontemporal_load(W + (size_t)(k0 + kk) * ldn + n0 + (lane & 31)); if (gain) v *= gain[k0 + kk]; scr[kk * 33 + (lane & 31)] = v; }
    LDS_WAIT(); asm volatile("" ::: "memory");
    const int c = lane & 7;
#pragma unroll
    for (int j = 0; j < 4; ++j) { const int n = (lane >> 3) + 8 * j; const LAS float* s = scr + (8 * c) * 33 + n;
        if constexpr (F8) { u32x2 o; o.x = pg8::pk4_fp8((f32x4){s[0 * 33], s[1 * 33], s[2 * 33], s[3 * 33]} * pg8::F8_WSC); o.y = pg8::pk4_fp8((f32x4){s[4 * 33], s[5 * 33], s[6 * 33], s[7 * 33]} * pg8::F8_WSC);
            *(u32x2*)((unsigned char*)WTv + (size_t)map_row(kind, n0 + n) * ldk + k0 + 8 * c) = o; }
        else { bf16* WT = (bf16*)WTv; u32x4 o; o.x = cvt_pk(s[0 * 33], s[1 * 33]); o.y = cvt_pk(s[2 * 33], s[3 * 33]); o.z = cvt_pk(s[4 * 33], s[5 * 33]); o.w = cvt_pk(s[6 * 33], s[7 * 33]);
            *(u32x4*)(WT + (size_t)map_row(kind, n0 + n) * ldk + k0 + 8 * c) = o; } }
    LDS_WAIT(); asm volatile("" ::: "memory");
}
__device__ __forceinline__ void colq_item(const float* W, int ldn, unsigned char* WT, float* CS, int kind, int nb, LAS float* red, int tid) {
    const int lane = tid & 63, w = tid >> 6, n = lane & 31, kh = lane >> 5, kb = 128 * w + 64 * kh;
    const float* src = W + (size_t)kb * ldn + nb * 32 + n;
    float v[64];
#pragma unroll
    for (int j = 0; j < 64; ++j) v[j] = __builtin_nontemporal_load(src + (size_t)j * ldn);
    float m = 0.f;
#pragma unroll
    for (int j = 0; j < 64; ++j) m = __builtin_fmaxf(m, __builtin_fabsf(v[j]));
    m = __builtin_fmaxf(m, shx(m, lane, 32));
    if (kh == 0) red[w * 32 + n] = m;
    __syncthreads();
    float cm = red[n];
#pragma unroll
    for (int ww = 1; ww < 8; ++ww) cm = __builtin_fmaxf(cm, red[ww * 32 + n]);
    cm = __builtin_fmaxf(cm, 1e-30f);
    const float inv = 127.0f / cm; const int row = map_row(kind, nb * 32 + n);
    if (w == 0 && kh == 0) CS[row] = cm * (1.0f / 127.0f);
    unsigned char* dst = WT + (size_t)row * 1024 + kb;
#pragma unroll
    for (int c = 0; c < 4; ++c) { u32x4 o;
        o.x = pg8::pk4_i8((f32x4){v[16 * c + 0], v[16 * c + 1], v[16 * c + 2], v[16 * c + 3]} * inv); o.y = pg8::pk4_i8((f32x4){v[16 * c + 4], v[16 * c + 5], v[16 * c + 6], v[16 * c + 7]} * inv);
        o.z = pg8::pk4_i8((f32x4){v[16 * c + 8], v[16 * c + 9], v[16 * c + 10], v[16 * c + 11]} * inv); o.w = pg8::pk4_i8((f32x4){v[16 * c + 12], v[16 * c + 13], v[16 * c + 14], v[16 * c + 15]} * inv);
        *(u32x4*)(dst + 16 * c) = o; }
    __syncthreads();
}
__device__ __forceinline__ void sincos_acc(float ang, float& s, float& c) {
    const double a = (double)ang; const double kq = __builtin_rint(a * 0.63661977236758134308); const double r = (a - kq * 1.57079632679489655800e+00) - kq * 6.12323399573676603587e-17;
    const float x = (float)r, x2 = x * x;
    const float sp = x + x * x2 * (-1.6666667163e-01f + x2 * (8.3333337680e-03f + x2 * (-1.9841270114e-04f + x2 * 2.7557314297e-06f)));
    const float cp = 1.0f + x2 * (-0.5f + x2 * (4.1666667908e-02f + x2 * (-1.3888889225e-03f + x2 * (2.4801587642e-05f + x2 * -2.7557314297e-07f))));
    const int q = ((int)kq) & 3;
    s = (q == 0) ? sp : (q == 1) ? cp : (q == 2) ? -sp : -cp;
    c = (q == 0) ? cp : (q == 1) ? -sp : (q == 2) ? -cp : sp;
}

struct Args { const float* in[32]; float* out; unsigned char* ws; };
enum { I_X = 0, I_C, I_WMOD, I_BMOD, I_PREMIX, I_POSTMIX, I_WIN, I_QNG, I_WUQ, I_KVNG, I_WUKV, I_SGLNG, I_SGLNB, I_SGW, I_SGB, I_CONVW, I_CONVB, I_LWA, I_LBA, I_LWX, I_LBX, I_LAM,
       I_WO, I_PREFFN, I_POSTFFN, I_FG, I_FU, I_FD, I_ROUTER, I_MG, I_MU, I_MD };

#define WSL GAS unsigned char* wslg_ = (GAS unsigned char*)args.ws; int zi_ = 0, bxo = bx_, vcuo = vcu_, Go = G_; asm volatile("" : "+s"(wslg_), "+s"(zi_), "+s"(bxo), "+s"(vcuo), "+s"(Go)); unsigned char* wsl = (unsigned char*)wslg_
#define AIN(i) ((const float*)(GAS const float*)args.in[(i) + zi_])
#define W_ctl ((unsigned*)(wsl + WS_CTL))
#define W_MOD ((float*)(wsl + WS_MOD))
#define W_cosT ((float*)(wsl + WS_COS))
#define W_sinT ((float*)(wsl + WS_SIN))
#define W_ssq_q ((u64*)(wsl + WS_SSQQ))
#define W_ssq_kv ((u64*)(wsl + WS_SSQK))
#define W_IDX ((int*)(wsl + WS_IDX))
#define W_SLOT ((int*)(wsl + WS_SLOT))
#define W_GATEW ((float*)(wsl + WS_GATEW))
#define W_WB ((bf16*)(wsl + WS_W))
#define W_H ((bf16*)(wsl + WS_H))
#define W_YO ((bf16*)(wsl + WS_YO))
#define W_ZQ ((bf16*)(wsl + WS_ZQ))
#define W_ZKV ((bf16*)(wsl + WS_ZKV))
#define W_KR ((bf16*)(wsl + WS_KR))
#define W_U ((bf16*)(wsl + WS_U))
#define W_GV ((bf16*)(wsl + WS_GV))
#define W_ZX ((bf16*)(wsl + WS_ZX))
#define W_GY ((bf16*)(wsl + WS_GY))
#define W_Q ((bf16*)(wsl + WS_Q))
#define W_KN ((bf16*)(wsl + WS_KN))
#define W_VT ((bf16*)(wsl + WS_VT))
#define W_Y ((bf16*)(wsl + WS_Y))
#define W_HL ((float*)(wsl + WS_HL))
#define W_PP ((float*)(wsl + WS_PP))
#define W_ACT ((bf16*)(wsl + WS_ACT))
#define W_YD ((bf16*)(wsl + WS_YD))
#define W_DW8(i) ((unsigned char*)(W_WB + WOFF_DENSE + (size_t)(i) * DW_SIZE))
#define W_MW8(i) ((unsigned char*)(W_WB + WOFF_MOE + (size_t)(i) * MW_SIZE))
#define W_ACT8 ((unsigned char*)(wsl + WS_ACT))
#define W_ACT8D ((unsigned char*)(wsl + WS_ACTD))
#define W_X ((float*)(GAS float*)args.out)
#define W_XB ((bf16*)(wsl + WS_YO + 32 * MiB))
__global__ void __launch_bounds__(512, 2) trunk_fwd(Args args) {
    extern __shared__ __attribute__((aligned(16))) unsigned char lds_raw[];
    LAS unsigned char* lds = (LAS unsigned char*)lds_raw;
    volatile LAS unsigned* MISC = (volatile LAS unsigned*)(lds + MISC_OFF);
    const volatile LAS int* tab = (const volatile LAS int*)(lds + MISC_OFF);
    const int wave = __builtin_amdgcn_readfirstlane(threadIdx.x >> 6);
    constexpr int G_ = 256;
    if (gridDim.x != G_) return;
    const int bx_ = blockIdx.x, vcu_ = (bx_ % 8) * (G_ / 8) + bx_ / 8;
    for (int u = threadIdx.x; u < (LDS_BYTES - MISC_OFF) / 4; u += 512) MISC[u] = 0u;
    __syncthreads();
    { WSL; (void)xcd_barrier_post(W_ctl, MISC); }
    { WSL; if (opaque_tid() == 0 && bx_ < 8) __hip_atomic_store(W_ctl + 6000 + bx_, xb_xcc_id() + 1u, __ATOMIC_RELAXED, __HIP_MEMORY_SCOPE_AGENT); }
#define GRID_BAR() do { WSL; XcdBarrier b_; b_.bar = W_ctl; b_.x = xb_xcc_id(); b_.st = MISC; xcd_barrier(b_); } while (0)
#define GRID_BAR_P() do { WSL; XcdBarrier b_; b_.bar = W_ctl; b_.x = xb_xcc_id(); b_.st = MISC; if (MISC[9]) xcd_pair_barrier(b_, (unsigned)((bx_ & 7) >> 1)); else xcd_barrier(b_); } while (0)
#define GRID_BAR_L() do { WSL; XcdBarrier b_; b_.bar = W_ctl; b_.x = xb_xcc_id(); b_.st = MISC; if (MISC[8]) xcd_local_barrier(b_); else xcd_barrier(b_); } while (0)

    {
        WSL; const int tid = opaque_tid(), lane = tid & 63;
        LAS float* scr = (LAS float*)(lds + wave * 8448);
        const int gw = vcuo * 8 + wave, NGW = Go * 8;
        constexpr int N0 = 4 * 720, N1 = 4 * 96, N2 = 4 * 64, N3 = 4 * 512, N4 = 2 * 1408, N7 = 16 * 704;
        constexpr int NITEMS = N1 + N2 + N3 + N4 + N7;
        { LAS float* red = (LAS float*)(lds + 102400);
          for (int it = vcuo; it < 352 + 1408 + 180; it += Go) {
              if (it >= 352 + 1408) { const int r = it - 1760, l = r / 45, nb = r % 45; unsigned char* wt = (unsigned char*)(W_WB + l * LW_SIZE + LW_WIN);
                  colq_item(AIN(I_WIN) + (size_t)l * D * DIN, DIN, wt, (float*)(wt + (size_t)DINP * D), 3, nb, red, tid); }
              else if (it < 352) { const int i = it / 176, r = it % 176, kind = 1 + r / 88, nb = r % 88;
                  colq_item(AIN(kind == 1 ? I_FG : I_FU) + (size_t)i * D * DFF, DFF, W_DW8(i) + DW8_GU, (float*)(W_DW8(i) + DW8_CS), kind, nb, red, tid); }
              else { const int r = it - 352, ie = r / 88, q = r % 88, kind = 1 + q / 44, nb = q % 44;
                  colq_item(AIN(kind == 1 ? I_MG : I_MU) + (size_t)ie * D * DFE, DFE, W_MW8(ie >> 3) + MW8_GU + (size_t)(ie & 7) * 2 * DFE * D, (float*)(W_MW8(ie >> 3) + MW8_CS) + (ie & 7) * 2 * DFE, kind, nb, red, tid); } } }
        for (int it = gw; it < NITEMS; it += NGW) {
            int r = it;
            if (r < N1) { const int l = r / 96, q = r % 96; tr_item(AIN(I_WUQ) + (size_t)l * 256 * 768, 768, W_WB + l * LW_SIZE + LW_WUQ, 256, AIN(I_QNG) + l * 256, 4, scr, q / 24, q % 24, lane); continue; } r -= N1;
            if (r < N2) { const int l = r / 64, q = r % 64, kb = q / 32, nb = q % 32;
                const bool isv = ((nb & 3) >= 2); bf16* dst = W_WB + l * LW_SIZE + (isv ? LW_WUV : LW_WUK) + (size_t)((nb >> 2) * 64 + (nb & 1) * 32) * 256;
                tr_item(AIN(I_WUKV) + (size_t)l * 128 * 1024 + nb * 32, 1024, dst, 256, AIN(I_KVNG) + l * 128, 0, scr, kb, 0, lane); continue; } r -= N2;
            if (r < N3) { const int l = r / 512, q = r % 512; tr_item(AIN(I_WO) + (size_t)l * D * D, D, W_WB + l * LW_SIZE + LW_WO, D, nullptr, 0, scr, q / 32, q % 32, lane); continue; } r -= N3;
            if (r < N4) { const int i = r / 1408, q = r % 1408; tr_item<true>(AIN(I_FD) + (size_t)i * DFF * D, D, W_DW8(i) + DW8_D, DFF, nullptr, 0, scr, q / 32, q % 32, lane); continue; } r -= N4;
            { const int ie = r / 704, q = r % 704, i = ie >> 3, e = ie & 7; tr_item<true>(AIN(I_MD) + (size_t)ie * DFE * D, D, W_MW8(i) + MW8_D + (size_t)e * D * DFEP, DFEP, nullptr, 0, scr, q / 32, q % 32, lane); }
        }
        const int gt = vcuo * 512 + tid, NGT = Go * 512;
        for (int i = gt; i < 4 * 96 * 64; i += NGT) {
            const int l = i / (96 * 64), q = i % (96 * 64); unsigned char* wt = (unsigned char*)(W_WB + l * LW_SIZE + LW_WIN);
            *(u32x4*)(wt + (size_t)(416 + q / 64) * D + (q % 64) * 16) = (u32x4){0u, 0u, 0u, 0u}; if ((q % 64) == 0) ((float*)(wt + (size_t)DINP * D))[416 + q / 64] = 0.f; }
        for (int i = gt; i < 4 * 2 * 512 * 16; i += NGT) {
            const int l = i / (2 * 512 * 16), q = i % (2 * 512 * 16), mtx = q / (512 * 16), rr = (q / 16) % 512, ch = q % 16;
            *(u32x4*)(W_WB + l * LW_SIZE + (mtx ? LW_WUV : LW_WUK) + (size_t)rr * 256 + 128 + ch * 8) = (u32x4){0u, 0u, 0u, 0u}; }
        for (int i = gt; i < 2 * NE * D * 8; i += NGT) {
            const int ie = i / (D * 8), q = i % (D * 8); *(u32x4*)(W_MW8(ie >> 3) + MW8_D + ((size_t)(ie & 7) * D + (q >> 3)) * DFEP + DFE + (q & 7) * 16) = (u32x4){0u, 0u, 0u, 0u}; }
        for (int i = gt; i < 4 * 4 * 128 * 128; i += NGT) {
            const int l = i / 65536, q = i % 65536, t = (q >> 7) & 127, s = q & 127; const float v = (s <= t) ? AIN(I_SGW)[i] : 0.f;
            W_WB[l * LW_SIZE + LW_SGW + q] = (bf16)(cvt_pk(v, 0.f) & 0xffffu); }
        for (int i = gt; i < 4 * 2 * 4 * 64 * 64; i += NGT) {
            const int l = i / 32768, q = i % 32768, mtx = q / 16384, hq = (q / 4096) & 3, j = (q >> 6) & 63, ii = q & 63;
            const float v = AIN(mtx ? I_LWX : I_LWA)[(size_t)l * 16384 + hq * 4096 + ii * 64 + j];
            W_WB[l * LW_SIZE + (mtx ? LW_LWX : LW_LWA) + hq * 4096 + j * 64 + ii] = (bf16)(cvt_pk(v, 0.f) & 0xffffu); }
        for (int i = gt; i < SEQ * 16; i += NGT) {
            const int pos = i >> 4, j = i & 15; const float inv = exp2f(-(float)j * (13.287712379549449f / 16.0f)); float s, c; sincos_acc((float)pos * inv, s, c); W_cosT[i] = c; W_sinT[i] = s; }
        __syncthreads();
        LAS float* cond = (LAS float*)(lds + 69632); LAS float* red = (LAS float*)(lds + 69632 + 16384);
        for (int i = tid; i < NB * D; i += 512) cond[i] = siluf_(AIN(I_C)[i]);
        __syncthreads();
        for (int item = vcuo; item < 4 * 96; item += Go) {
            const int l = item / 96, c0 = (item % 96) * 64; const float* Wm = AIN(I_WMOD) + (size_t)l * D * 6144 + c0 + lane;
            float a0 = 0.f, a1 = 0.f, a2 = 0.f, a3 = 0.f;
#pragma unroll 16
            for (int k = wave * 128; k < wave * 128 + 128; ++k) { const float wv = __builtin_nontemporal_load(Wm + (size_t)k * 6144); a0 += cond[k] * wv; a1 += cond[D + k] * wv; a2 += cond[2 * D + k] * wv; a3 += cond[3 * D + k] * wv; }
            red[(wave * 4 + 0) * 64 + lane] = a0; red[(wave * 4 + 1) * 64 + lane] = a1; red[(wave * 4 + 2) * 64 + lane] = a2; red[(wave * 4 + 3) * 64 + lane] = a3;
            __syncthreads();
            if (tid < 256) { const int b = tid >> 6, col = tid & 63; float s = AIN(I_BMOD)[l * 6144 + c0 + col];
#pragma unroll
                for (int ww = 0; ww < 8; ++ww) s += red[(ww * 4 + b) * 64 + col];
                W_MOD[(size_t)(l * 4 + b) * 6144 + c0 + col] = s; }
            __syncthreads();
        }
    }
    { WSL; if (opaque_tid() == 0) { unsigned gx; XB_SPIN((gx = xb_ld(W_ctl + 6000 + (bx_ & 7))) == 0u, W_ctl); if (gx != xb_xcc_id() + 1u) atomicOr(W_ctl + 6016, 1u); } }
    GRID_BAR();
    { WSL; if (opaque_tid() == 0) { const unsigned ok = (xb_ld(W_ctl + 6016) == 0u) ? 1u : 0u; unsigned pok = 1u;
#pragma unroll
        for (unsigned j = 0; j < 16; ++j) { const unsigned c = xb_ld(W_ctl + XB_XCNT(j)); if (c != 0u && c != 32u) pok = 0u; }
        MISC[8] = ok; MISC[9] = ok & pok; } } __syncthreads();
    {
        WSL; const int tid = opaque_tid();
        const int b = vcuo >> 6; const float* md = W_MOD + (size_t)(0 * 4 + b) * 6144;
        RowArgs ra{}; ra.xin = AIN(I_X); ra.X = nullptr; ra.Xb = W_XB; ra.preg = AIN(I_PREMIX); ra.sc = md + 1024; ra.sh = md; ra.H = W_H; ra.ssq_q = W_ssq_q; ra.ssq_kv = W_ssq_kv; ra.rs = (float*)(W_DW8(0) + DW8_RS);
        row_phase<0>(lds, tab, vcuo, ra, true, false);
        if (tid < 64) { W_ssq_q[vcuo * 64 + tid] = 0ull; W_ssq_kv[vcuo * 64 + tid] = 0ull; }
    }
    GRID_BAR_L();


    { constexpr int l = 0;

        const bool moe = (l & 1) != 0; const int fi = l >> 1;
#define LW (W_WB + (size_t)l * LW_SIZE)
#define md (W_MOD + (size_t)(l * 4 + (vcuo >> 6)) * 6144)
        { WSL; pg8::Gemm g{W_H, LW + LW_WIN, D}; pg8::StaticOrder S; S.init(M, DINP, Go, bxo); S.lim = (S.nwg / Go) * Go;
          pg8::EpiIn E{wsl, (const float*)(W_DW8(0) + DW8_RS), (const float*)((unsigned char*)(LW + LW_WIN) + (size_t)DINP * D)};
          pg8::gemm_phase<pg8::EpiIn, pg8::StaticOrder, true, 2, 2>(lds, g, S, E);
          pg8::TailOrder<pg8::StaticOrder> T{S};
          pg8::gemm_phase<pg8::EpiIn, pg8::TailOrder<pg8::StaticOrder>, false, 1, 2>(lds, g, T, E); }
        if (l == 2) GRID_BAR(); else GRID_BAR_L();
        { WSL; pg8::Gemm g{W_ZQ, LW + LW_WUQ, 256}; pg8::StaticOrder S; S.init(M, 768, Go, bxo); pg8::EpiQ E{wsl};
          pg8::gemm_phase<pg8::EpiQ, pg8::StaticOrder, true>(lds, g, S, E); }
        { WSL; pg8::Gemm g{W_ZKV, LW + LW_WUK, 128, 256};     pg8::StaticOrder S; S.init(M, 512, Go, (bxo + 64) % Go); pg8::EpiK E{wsl};
          pg8::gemm_phase<pg8::EpiK, pg8::StaticOrder, true>(lds, g, S, E); }
        { WSL; pg8::Gemm g{LW + LW_WUV, W_ZKV, 128, 256}; pg8::StaticOrder S; S.init(512, M, Go, (bxo + 192) % Go); pg8::EpiVT E{wsl};
          pg8::gemm_phase<pg8::EpiVT, pg8::StaticOrder, true>(lds, g, S, E); }
        { WSL; for (int uu = vcuo; uu < 256; uu += Go) {
            sgu::unit(lds, (uu >> 1) * 128, uu & 1, W_GV, W_U, LW + LW_SGW, AIN(I_SGLNG) + l * 256, AIN(I_SGLNB) + l * 256, AIN(I_SGB) + l * 512, W_Y); } }
        { WSL; for (int uu = vcuo; uu < 256; uu += Go) {
            lru::local_unit(lds, uu >> 6, uu & 63, W_ZX, AIN(I_CONVW) + l * 1024, AIN(I_CONVB) + l * 256, LW + LW_LWA, LW + LW_LWX,
                            AIN(I_LBA) + l * 256, AIN(I_LBX) + l * 256, AIN(I_LAM) + l * 256, W_HL, W_PP); } }
        GRID_BAR_P();
        { WSL; for (int uu = vcuo; uu < 256; uu += Go) { lru::fix_unit(lds, uu >> 6, uu & 63, W_HL, W_PP, W_GY, W_Y); } }
        { WSL; for (int uu = vcuo; uu < 256; uu += Go) { const int bh = uu >> 3, s = uu & 7;
            att::attn_unit(lds, bh >> 3, bh & 7, 15 - s, W_Q, W_KN, W_KR, W_VT, W_Y);
            att::attn_unit(lds, bh >> 3, bh & 7, s, W_Q, W_KN, W_KR, W_VT, W_Y); } }
        GRID_BAR_P();
        { WSL; pg8::Gemm g{W_Y, LW + LW_WO, D}; pg8::StaticOrder S; S.init(M, D, Go, bxo); pg8::EpiBf E{W_YO, D};
          pg8::gemm_phase<pg8::EpiBf, pg8::StaticOrder, false>(lds, g, S, E); }
        GRID_BAR_L();
        { WSL; RowArgs ra{}; ra.X = nullptr; ra.Xb = W_XB; ra.Ysrc = W_YO; ra.gate = md + 2048; ra.postg = AIN(I_POSTMIX) + l * D; ra.preg = AIN(I_PREFFN) + l * D; ra.sc = md + 4096; ra.sh = md + 3072; ra.H = W_H;
          ra.router = AIN(I_ROUTER) + (size_t)fi * D * NE; ra.cursor = W_ctl + CW_CURSOR + 64 * fi; ra.idx = W_IDX; ra.slot_w = W_SLOT; ra.gatew_w = W_GATEW; ra.ssq_q = W_ssq_q; ra.ssq_kv = W_ssq_kv; ra.rs = (float*)(W_DW8(0) + DW8_RS); ra.rss = (float*)(W_DW8(0) + DW8_RSS);
          row_phase<1>(lds, tab, vcuo, ra, true, moe); }
        if (moe) GRID_BAR(); else GRID_BAR_L();
        if (!moe) {
#define DW (W_WB + WOFF_DENSE + (size_t)fi * DW_SIZE)
            { WSL; pg8::Gemm g{W_H, W_DW8(fi) + DW8_GU, D}; pg8::StaticOrder S; S.init(M, 2 * DFF, Go, bxo); pg8::EpiSwigluI8<false> E{W_ACT8D, DFF, -1, (const float*)(W_DW8(0) + DW8_RS), (const float*)(W_DW8(fi) + DW8_CS)};
              pg8::gemm_phase<pg8::EpiSwigluI8<false>, pg8::StaticOrder, true, 2, 2>(lds, g, S, E); }
            GRID_BAR_L();
            { WSL; pg8::Gemm g{W_ACT8D, W_DW8(fi) + DW8_D, DFF}; pg8::StaticOrder S; S.init(M, D, Go, bxo); pg8::EpiBfS E{W_YO, D, 1.0f / (pg8::F8_ASC * pg8::F8_WSC)};
              pg8::gemm_phase<pg8::EpiBfS, pg8::StaticOrder, false, 2, 1>(lds, g, S, E); }
            GRID_BAR_L();
        } else {
#define MW (W_WB + WOFF_MOE + (size_t)fi * MW_SIZE)
            { const int ln = opaque_tid(); if (ln < 64) { WSL; volatile LAS int* tw = (volatile LAS int*)(lds + MISC_OFF);
                const int cnt = (ln < 8) ? (int)__hip_atomic_load(W_ctl + CW_CURSOR + 64 * fi + ln, __ATOMIC_RELAXED, __HIP_MEMORY_SCOPE_AGENT) : 0;
                const int nt = (cnt + 255) >> 8; int T = 0, tot = 0;
#pragma unroll
                for (int e = 0; e < 8; ++e) { const int v = __builtin_amdgcn_readlane(nt, e); if (e < ln) T += v; tot += v; }
                if (ln < 8) { tw[16 + ln] = T; tw[32 + ln] = cnt; }
                if (ln == 0) tw[24] = tot; } }
            __syncthreads();
            { WSL; pg8::Gemm g{W_H, W_MW8(fi) + MW8_GU, D}; MoeGatherOrder S{{tab, 11, Go, vcuo, 1 << 30}, W_IDX}; pg8::EpiSwigluI8<true> E{W_ACT8, DFEP, 10, (const float*)(W_DW8(0) + DW8_RSS), (const float*)(W_MW8(fi) + MW8_CS)};
              pg8::gemm_phase<pg8::EpiSwigluI8<true>, MoeGatherOrder, true, 2, 2>(lds, g, S, E); }
            GRID_BAR();
            { WSL; pg8::Gemm g{W_ACT8, W_MW8(fi) + MW8_D, DFEP}; MoeOrder S{tab, 4, Go, vcuo, 2 * Go}; pg8::EpiBfS E{W_YD, D, 1.0f / (pg8::F8_ASC * pg8::F8_WSC)};
              pg8::gemm_phase<pg8::EpiBfS, MoeOrder, true, 2, 1>(lds, g, S, E);
              pg8::TailOrder<MoeOrder> T{S};
              pg8::gemm_phase<pg8::EpiBfS, pg8::TailOrder<MoeOrder>, false, 1, 1>(lds, g, T, E); }
            GRID_BAR();
        }
        { WSL; const bool last = (l == DEPTH - 1); const float* mdn = W_MOD + (size_t)((last ? l : l + 1) * 4 + (vcuo >> 6)) * 6144;
          RowArgs ra{}; ra.X = last ? W_X : nullptr; ra.Xb = W_XB; ra.Ysrc = W_YO; ra.YD = W_YD; ra.slot = W_SLOT; ra.gatew = W_GATEW; ra.gate = md + 5120; ra.postg = AIN(I_POSTFFN) + l * D;
          ra.preg = AIN(I_PREMIX) + (last ? l : l + 1) * D; ra.sc = mdn + 1024; ra.sh = mdn; ra.H = W_H; ra.ssq_q = W_ssq_q; ra.ssq_kv = W_ssq_kv; ra.rs = (float*)(W_DW8(0) + DW8_RS);
          if (!moe) row_phase<2>(lds, tab, vcuo, ra, !last, false); else row_phase<3>(lds, tab, vcuo, ra, !last, false);
          if (!last) GRID_BAR_L(); }

    }
#undef LW
#undef md
#undef DW
#undef MW
    { constexpr int l = 1;

        const bool moe = (l & 1) != 0; const int fi = l >> 1;
#define LW (W_WB + (size_t)l * LW_SIZE)
#define md (W_MOD + (size_t)(l * 4 + (vcuo >> 6)) * 6144)
        { WSL; pg8::Gemm g{W_H, LW + LW_WIN, D}; pg8::StaticOrder S; S.init(M, DINP, Go, bxo); S.lim = (S.nwg / Go) * Go;
          pg8::EpiIn E{wsl, (const float*)(W_DW8(0) + DW8_RS), (const float*)((unsigned char*)(LW + LW_WIN) + (size_t)DINP * D)};
          pg8::gemm_phase<pg8::EpiIn, pg8::StaticOrder, true, 2, 2>(lds, g, S, E);
          pg8::TailOrder<pg8::StaticOrder> T{S};
          pg8::gemm_phase<pg8::EpiIn, pg8::TailOrder<pg8::StaticOrder>, false, 1, 2>(lds, g, T, E); }
        if (l == 2) GRID_BAR(); else GRID_BAR_L();
        { WSL; pg8::Gemm g{W_ZQ, LW + LW_WUQ, 256}; pg8::StaticOrder S; S.init(M, 768, Go, bxo); pg8::EpiQ E{wsl};
          pg8::gemm_phase<pg8::EpiQ, pg8::StaticOrder, true>(lds, g, S, E); }
        { WSL; pg8::Gemm g{W_ZKV, LW + LW_WUK, 128, 256};     pg8::StaticOrder S; S.init(M, 512, Go, (bxo + 64) % Go); pg8::EpiK E{wsl};
          pg8::gemm_phase<pg8::EpiK, pg8::StaticOrder, true>(lds, g, S, E); }
        { WSL; pg8::Gemm g{LW + LW_WUV, W_ZKV, 128, 256}; pg8::StaticOrder S; S.init(512, M, Go, (bxo + 192) % Go); pg8::EpiVT E{wsl};
          pg8::gemm_phase<pg8::EpiVT, pg8::StaticOrder, true>(lds, g, S, E); }
        { WSL; for (int uu = vcuo; uu < 256; uu += Go) {
            sgu::unit(lds, (uu >> 1) * 128, uu & 1, W_GV, W_U, LW + LW_SGW, AIN(I_SGLNG) + l * 256, AIN(I_SGLNB) + l * 256, AIN(I_SGB) + l * 512, W_Y); } }
        { WSL; for (int uu = vcuo; uu < 256; uu += Go) {
            lru::local_unit(lds, uu >> 6, uu & 63, W_ZX, AIN(I_CONVW) + l * 1024, AIN(I_CONVB) + l * 256, LW + LW_LWA, LW + LW_LWX,
                            AIN(I_LBA) + l * 256, AIN(I_LBX) + l * 256, AIN(I_LAM) + l * 256, W_HL, W_PP); } }
        GRID_BAR_P();
        { WSL; for (int uu = vcuo; uu < 256; uu += Go) { lru::fix_unit(lds, uu >> 6, uu & 63, W_HL, W_PP, W_GY, W_Y); } }
        { WSL; for (int uu = vcuo; uu < 256; uu += Go) { const int bh = uu >> 3, s = uu & 7;
            att::attn_unit(lds, bh >> 3, bh & 7, 15 - s, W_Q, W_KN, W_KR, W_VT, W_Y);
            att::attn_unit(lds, bh >> 3, bh & 7, s, W_Q, W_KN, W_KR, W_VT, W_Y); } }
        GRID_BAR_P();
        { WSL; pg8::Gemm g{W_Y, LW + LW_WO, D}; pg8::StaticOrder S; S.init(M, D, Go, bxo); pg8::EpiBf E{W_YO, D};
          pg8::gemm_phase<pg8::EpiBf, pg8::StaticOrder, false>(lds, g, S, E); }
        GRID_BAR_L();
        { WSL; RowArgs ra{}; ra.X = nullptr; ra.Xb = W_XB; ra.Ysrc = W_YO; ra.gate = md + 2048; ra.postg = AIN(I_POSTMIX) + l * D; ra.preg = AIN(I_PREFFN) + l * D; ra.sc = md + 4096; ra.sh = md + 3072; ra.H = W_H;
          ra.router = AIN(I_ROUTER) + (size_t)fi * D * NE; ra.cursor = W_ctl + CW_CURSOR + 64 * fi; ra.idx = W_IDX; ra.slot_w = W_SLOT; ra.gatew_w = W_GATEW; ra.ssq_q = W_ssq_q; ra.ssq_kv = W_ssq_kv; ra.rs = (float*)(W_DW8(0) + DW8_RS); ra.rss = (float*)(W_DW8(0) + DW8_RSS);
          row_phase<1>(lds, tab, vcuo, ra, true, moe); }
        if (moe) GRID_BAR(); else GRID_BAR_L();
        if (!moe) {
#define DW (W_WB + WOFF_DENSE + (size_t)fi * DW_SIZE)
            { WSL; pg8::Gemm g{W_H, W_DW8(fi) + DW8_GU, D}; pg8::StaticOrder S; S.init(M, 2 * DFF, Go, bxo); pg8::EpiSwigluI8<false> E{W_ACT8D, DFF, -1, (const float*)(W_DW8(0) + DW8_RS), (const float*)(W_DW8(fi) + DW8_CS)};
              pg8::gemm_phase<pg8::EpiSwigluI8<false>, pg8::StaticOrder, true, 2, 2>(lds, g, S, E); }
            GRID_BAR_L();
            { WSL; pg8::Gemm g{W_ACT8D, W_DW8(fi) + DW8_D, DFF}; pg8::StaticOrder S; S.init(M, D, Go, bxo); pg8::EpiBfS E{W_YO, D, 1.0f / (pg8::F8_ASC * pg8::F8_WSC)};
              pg8::gemm_phase<pg8::EpiBfS, pg8::StaticOrder, false, 2, 1>(lds, g, S, E); }
            GRID_BAR_L();
        } else {
#define MW (W_WB + WOFF_MOE + (size_t)fi * MW_SIZE)
            { const int ln = opaque_tid(); if (ln < 64) { WSL; volatile LAS int* tw = (volatile LAS int*)(lds + MISC_OFF);
                const int cnt = (ln < 8) ? (int)__hip_atomic_load(W_ctl + CW_CURSOR + 64 * fi + ln, __ATOMIC_RELAXED, __HIP_MEMORY_SCOPE_AGENT) : 0;
                const int nt = (cnt + 255) >> 8; int T = 0, tot = 0;
#pragma unroll
                for (int e = 0; e < 8; ++e) { const int v = __builtin_amdgcn_readlane(nt, e); if (e < ln) T += v; tot += v; }
                if (ln < 8) { tw[16 + ln] = T; tw[32 + ln] = cnt; }
                if (ln == 0) tw[24] = tot; } }
            __syncthreads();
            { WSL; pg8::Gemm g{W_H, W_MW8(fi) + MW8_GU, D}; MoeGatherOrder S{{tab, 11, Go, vcuo, 1 << 30}, W_IDX}; pg8::EpiSwigluI8<true> E{W_ACT8, DFEP, 10, (const float*)(W_DW8(0) + DW8_RSS), (const float*)(W_MW8(fi) + MW8_CS)};
              pg8::gemm_phase<pg8::EpiSwigluI8<true>, MoeGatherOrder, true, 2, 2>(lds, g, S, E); }
            GRID_BAR();
            { WSL; pg8::Gemm g{W_ACT8, W_MW8(fi) + MW8_D, DFEP}; MoeOrder S{tab, 4, Go, vcuo, 2 * Go}; pg8::EpiBfS E{W_YD, D, 1.0f / (pg8::F8_ASC * pg8::F8_WSC)};
              pg8::gemm_phase<pg8::EpiBfS, MoeOrder, true, 2, 1>(lds, g, S, E);
              pg8::TailOrder<MoeOrder> T{S};
              pg8::gemm_phase<pg8::EpiBfS, pg8::TailOrder<MoeOrder>, false, 1, 1>(lds, g, T, E); }
            GRID_BAR();
        }
        { WSL; const bool last = (l == DEPTH - 1); const float* mdn = W_MOD + (size_t)((last ? l : l + 1) * 4 + (vcuo >> 6)) * 6144;
          RowArgs ra{}; ra.X = last ? W_X : nullptr; ra.Xb = W_XB; ra.Ysrc = W_YO; ra.YD = W_YD; ra.slot = W_SLOT; ra.gatew = W_GATEW; ra.gate = md + 5120; ra.postg = AIN(I_POSTFFN) + l * D;
          ra.preg = AIN(I_PREMIX) + (last ? l : l + 1) * D; ra.sc = mdn + 1024; ra.sh = mdn; ra.H = W_H; ra.ssq_q = W_ssq_q; ra.ssq_kv = W_ssq_kv; ra.rs = (float*)(W_DW8(0) + DW8_RS);
          if (!moe) row_phase<2>(lds, tab, vcuo, ra, !last, false); else row_phase<3>(lds, tab, vcuo, ra, !last, false);
          if (!last) GRID_BAR_L(); }

    }
#undef LW
#undef md
#undef DW
#undef MW
    { constexpr int l = 2;

        const bool moe = (l & 1) != 0; const int fi = l >> 1;
#define LW (W_WB + (size_t)l * LW_SIZE)
#define md (W_MOD + (size_t)(l * 4 + (vcuo >> 6)) * 6144)
        { WSL; pg8::Gemm g{W_H, LW + LW_WIN, D}; pg8::StaticOrder S; S.init(M, DINP, Go, bxo); S.lim = (S.nwg / Go) * Go;
          pg8::EpiIn E{wsl, (const float*)(W_DW8(0) + DW8_RS), (const float*)((unsigned char*)(LW + LW_WIN) + (size_t)DINP * D)};
          pg8::gemm_phase<pg8::EpiIn, pg8::StaticOrder, true, 2, 2>(lds, g, S, E);
          pg8::TailOrder<pg8::StaticOrder> T{S};
          pg8::gemm_phase<pg8::EpiIn, pg8::TailOrder<pg8::StaticOrder>, false, 1, 2>(lds, g, T, E); }
        if (l == 2) GRID_BAR(); else GRID_BAR_L();
        { WSL; pg8::Gemm g{W_ZQ, LW + LW_WUQ, 256}; pg8::StaticOrder S; S.init(M, 768, Go, bxo); pg8::EpiQ E{wsl};
          pg8::gemm_phase<pg8::EpiQ, pg8::StaticOrder, true>(lds, g, S, E); }
        { WSL; pg8::Gemm g{W_ZKV, LW + LW_WUK, 128, 256};     pg8::StaticOrder S; S.init(M, 512, Go, (bxo + 64) % Go); pg8::EpiK E{wsl};
          pg8::gemm_phase<pg8::EpiK, pg8::StaticOrder, true>(lds, g, S, E); }
        { WSL; pg8::Gemm g{LW + LW_WUV, W_ZKV, 128, 256}; pg8::StaticOrder S; S.init(512, M, Go, (bxo + 192) % Go); pg8::EpiVT E{wsl};
          pg8::gemm_phase<pg8::EpiVT, pg8::StaticOrder, true>(lds, g, S, E); }
        { WSL; for (int uu = vcuo; uu < 256; uu += Go) {
            sgu::unit(lds, (uu >> 1) * 128, uu & 1, W_GV, W_U, LW + LW_SGW, AIN(I_SGLNG) + l * 256, AIN(I_SGLNB) + l * 256, AIN(I_SGB) + l * 512, W_Y); } }
        { WSL; for (int uu = vcuo; uu < 256; uu += Go) {
            lru::local_unit(lds, uu >> 6, uu & 63, W_ZX, AIN(I_CONVW) + l * 1024, AIN(I_CONVB) + l * 256, LW + LW_LWA, LW + LW_LWX,
                            AIN(I_LBA) + l * 256, AIN(I_LBX) + l * 256, AIN(I_LAM) + l * 256, W_HL, W_PP); } }
        GRID_BAR_P();
        { WSL; for (int uu = vcuo; uu < 256; uu += Go) { lru::fix_unit(lds, uu >> 6, uu & 63, W_HL, W_PP, W_GY, W_Y); } }
        { WSL; for (int uu = vcuo; uu < 256; uu += Go) { const int bh = uu >> 3, s = uu & 7;
            att::attn_unit(lds, bh >> 3, bh & 7, 15 - s, W_Q, W_KN, W_KR, W_VT, W_Y);
            att::attn_unit(lds, bh >> 3, bh & 7, s, W_Q, W_KN, W_KR, W_VT, W_Y); } }
        GRID_BAR_P();
        { WSL; pg8::Gemm g{W_Y, LW + LW_WO, D}; pg8::StaticOrder S; S.init(M, D, Go, bxo); pg8::EpiBf E{W_YO, D};
          pg8::gemm_phase<pg8::EpiBf, pg8::StaticOrder, false>(lds, g, S, E); }
        GRID_BAR_L();
        { WSL; RowArgs ra{}; ra.X = nullptr; ra.Xb = W_XB; ra.Ysrc = W_YO; ra.gate = md + 2048; ra.postg = AIN(I_POSTMIX) + l * D; ra.preg = AIN(I_PREFFN) + l * D; ra.sc = md + 4096; ra.sh = md + 3072; ra.H = W_H;
          ra.router = AIN(I_ROUTER) + (size_t)fi * D * NE; ra.cursor = W_ctl + CW_CURSOR + 64 * fi; ra.idx = W_IDX; ra.slot_w = W_SLOT; ra.gatew_w = W_GATEW; ra.ssq_q = W_ssq_q; ra.ssq_kv = W_ssq_kv; ra.rs = (float*)(W_DW8(0) + DW8_RS); ra.rss = (float*)(W_DW8(0) + DW8_RSS);
          row_phase<1>(lds, tab, vcuo, ra, true, moe); }
        if (moe) GRID_BAR(); else GRID_BAR_L();
        if (!moe) {
#define DW (W_WB + WOFF_DENSE + (size_t)fi * DW_SIZE)
            { WSL; pg8::Gemm g{W_H, W_DW8(fi) + DW8_GU, D}; pg8::StaticOrder S; S.init(M, 2 * DFF, Go, bxo); pg8::EpiSwigluI8<false> E{W_ACT8D, DFF, -1, (const float*)(W_DW8(0) + DW8_RS), (const float*)(W_DW8(fi) + DW8_CS)};
              pg8::gemm_phase<pg8::EpiSwigluI8<false>, pg8::StaticOrder, true, 2, 2>(lds, g, S, E); }
            GRID_BAR_L();
            { WSL; pg8::Gemm g{W_ACT8D, W_DW8(fi) + DW8_D, DFF}; pg8::StaticOrder S; S.init(M, D, Go, bxo); pg8::EpiBfS E{W_YO, D, 1.0f / (pg8::F8_ASC * pg8::F8_WSC)};
              pg8::gemm_phase<pg8::EpiBfS, pg8::StaticOrder, false, 2, 1>(lds, g, S, E); }
            GRID_BAR_L();
        } else {
#define MW (W_WB + WOFF_MOE + (size_t)fi * MW_SIZE)
            { const int ln = opaque_tid(); if (ln < 64) { WSL; volatile LAS int* tw = (volatile LAS int*)(lds + MISC_OFF);
                const int cnt = (ln < 8) ? (int)__hip_atomic_load(W_ctl + CW_CURSOR + 64 * fi + ln, __ATOMIC_RELAXED, __HIP_MEMORY_SCOPE_AGENT) : 0;
                const int nt = (cnt + 255) >> 8; int T = 0, tot = 0;
#pragma unroll
                for (int e = 0; e < 8; ++e) { const int v = __builtin_amdgcn_readlane(nt, e); if (e < ln) T += v; tot += v; }
                if (ln < 8) { tw[16 + ln] = T; tw[32 + ln] = cnt; }
                if (ln == 0) tw[24] = tot; } }
            __syncthreads();
            { WSL; pg8::Gemm g{W_H, W_MW8(fi) + MW8_GU, D}; MoeGatherOrder S{{tab, 11, Go, vcuo, 1 << 30}, W_IDX}; pg8::EpiSwigluI8<true> E{W_ACT8, DFEP, 10, (const float*)(W_DW8(0) + DW8_RSS), (const float*)(W_MW8(fi) + MW8_CS)};
              pg8::gemm_phase<pg8::EpiSwigluI8<true>, MoeGatherOrder, true, 2, 2>(lds, g, S, E); }
            GRID_BAR();
            { WSL; pg8::Gemm g{W_ACT8, W_MW8(fi) + MW8_D, DFEP}; MoeOrder S{tab, 4, Go, vcuo, 2 * Go}; pg8::EpiBfS E{W_YD, D, 1.0f / (pg8::F8_ASC * pg8::F8_WSC)};
              pg8::gemm_phase<pg8::EpiBfS, MoeOrder, true, 2, 1>(lds, g, S, E);
              pg8::TailOrder<MoeOrder> T{S};
              pg8::gemm_phase<pg8::EpiBfS, pg8::TailOrder<MoeOrder>, false, 1, 1>(lds, g, T, E); }
            GRID_BAR();
        }
        { WSL; const bool last = (l == DEPTH - 1); const float* mdn = W_MOD + (size_t)((last ? l : l + 1) * 4 + (vcuo >> 6)) * 6144;
          RowArgs ra{}; ra.X = last ? W_X : nullptr; ra.Xb = W_XB; ra.Ysrc = W_YO; ra.YD = W_YD; ra.slot = W_SLOT; ra.gatew = W_GATEW; ra.gate = md + 5120; ra.postg = AIN(I_POSTFFN) + l * D;
          ra.preg = AIN(I_PREMIX) + (last ? l : l + 1) * D; ra.sc = mdn + 1024; ra.sh = mdn; ra.H = W_H; ra.ssq_q = W_ssq_q; ra.ssq_kv = W_ssq_kv; ra.rs = (float*)(W_DW8(0) + DW8_RS);
          if (!moe) row_phase<2>(lds, tab, vcuo, ra, !last, false); else row_phase<3>(lds, tab, vcuo, ra, !last, false);
          if (!last) GRID_BAR_L(); }

    }
#undef LW
#undef md
#undef DW
#undef MW
    { constexpr int l = 3;

        const bool moe = (l & 1) != 0; const int fi = l >> 1;
#define LW (W_WB + (size_t)l * LW_SIZE)
#define md (W_MOD + (size_t)(l * 4 + (vcuo >> 6)) * 6144)
        { WSL; pg8::Gemm g{W_H, LW + LW_WIN, D}; pg8::StaticOrder S; S.init(M, DINP, Go, bxo); S.lim = (S.nwg / Go) * Go;
          pg8::EpiIn E{wsl, (const float*)(W_DW8(0) + DW8_RS), (const float*)((unsigned char*)(LW + LW_WIN) + (size_t)DINP * D)};
          pg8::gemm_phase<pg8::EpiIn, pg8::StaticOrder, true, 2, 2>(lds, g, S, E);
          pg8::TailOrder<pg8::StaticOrder> T{S};
          pg8::gemm_phase<pg8::EpiIn, pg8::TailOrder<pg8::StaticOrder>, false, 1, 2>(lds, g, T, E); }
        if (l == 2) GRID_BAR(); else GRID_BAR_L();
        { WSL; pg8::Gemm g{W_ZQ, LW + LW_WUQ, 256}; pg8::StaticOrder S; S.init(M, 768, Go, bxo); pg8::EpiQ E{wsl};
          pg8::gemm_phase<pg8::EpiQ, pg8::StaticOrder, true>(lds, g, S, E); }
        { WSL; pg8::Gemm g{W_ZKV, LW + LW_WUK, 128, 256};     pg8::StaticOrder S; S.init(M, 512, Go, (bxo + 64) % Go); pg8::EpiK E{wsl};
          pg8::gemm_phase<pg8::EpiK, pg8::StaticOrder, true>(lds, g, S, E); }
        { WSL; pg8::Gemm g{LW + LW_WUV, W_ZKV, 128, 256}; pg8::StaticOrder S; S.init(512, M, Go, (bxo + 192) % Go); pg8::EpiVT E{wsl};
          pg8::gemm_phase<pg8::EpiVT, pg8::StaticOrder, true>(lds, g, S, E); }
        { WSL; for (int uu = vcuo; uu < 256; uu += Go) {
            sgu::unit(lds, (uu >> 1) * 128, uu & 1, W_GV, W_U, LW + LW_SGW, AIN(I_SGLNG) + l * 256, AIN(I_SGLNB) + l * 256, AIN(I_SGB) + l * 512, W_Y); } }
        { WSL; for (int uu = vcuo; uu < 256; uu += Go) {
            lru::local_unit(lds, uu >> 6, uu & 63, W_ZX, AIN(I_CONVW) + l * 1024, AIN(I_CONVB) + l * 256, LW + LW_LWA, LW + LW_LWX,
                            AIN(I_LBA) + l * 256, AIN(I_LBX) + l * 256, AIN(I_LAM) + l * 256, W_HL, W_PP); } }
        GRID_BAR_P();
        { WSL; for (int uu = vcuo; uu < 256; uu += Go) { lru::fix_unit(lds, uu >> 6, uu & 63, W_HL, W_PP, W_GY, W_Y); } }
        { WSL; for (int uu = vcuo; uu < 256; uu += Go) { const int bh = uu >> 3, s = uu & 7;
            att::attn_unit(lds, bh >> 3, bh & 7, 15 - s, W_Q, W_KN, W_KR, W_VT, W_Y);
            att::attn_unit(lds, bh >> 3, bh & 7, s, W_Q, W_KN, W_KR, W_VT, W_Y); } }
        GRID_BAR_P();
        { WSL; pg8::Gemm g{W_Y, LW + LW_WO, D}; pg8::StaticOrder S; S.init(M, D, Go, bxo); pg8::EpiBf E{W_YO, D};
          pg8::gemm_phase<pg8::EpiBf, pg8::StaticOrder, false>(lds, g, S, E); }
        GRID_BAR_L();
        { WSL; RowArgs ra{}; ra.X = nullptr; ra.Xb = W_XB; ra.Ysrc = W_YO; ra.gate = md + 2048; ra.postg = AIN(I_POSTMIX) + l * D; ra.preg = AIN(I_PREFFN) + l * D; ra.sc = md + 4096; ra.sh = md + 3072; ra.H = W_H;
          ra.router = AIN(I_ROUTER) + (size_t)fi * D * NE; ra.cursor = W_ctl + CW_CURSOR + 64 * fi; ra.idx = W_IDX; ra.slot_w = W_SLOT; ra.gatew_w = W_GATEW; ra.ssq_q = W_ssq_q; ra.ssq_kv = W_ssq_kv; ra.rs = (float*)(W_DW8(0) + DW8_RS); ra.rss = (float*)(W_DW8(0) + DW8_RSS);
          row_phase<1>(lds, tab, vcuo, ra, true, moe); }
        if (moe) GRID_BAR(); else GRID_BAR_L();
        if (!moe) {
#define DW (W_WB + WOFF_DENSE + (size_t)fi * DW_SIZE)
            { WSL; pg8::Gemm g{W_H, W_DW8(fi) + DW8_GU, D}; pg8::StaticOrder S; S.init(M, 2 * DFF, Go, bxo); pg8::EpiSwigluI8<false> E{W_ACT8D, DFF, -1, (const float*)(W_DW8(0) + DW8_RS), (const float*)(W_DW8(fi) + DW8_CS)};
              pg8::gemm_phase<pg8::EpiSwigluI8<false>, pg8::StaticOrder, true, 2, 2>(lds, g, S, E); }
            GRID_BAR_L();
            { WSL; pg8::Gemm g{W_ACT8D, W_DW8(fi) + DW8_D, DFF}; pg8::StaticOrder S; S.init(M, D, Go, bxo); pg8::EpiBfS E{W_YO, D, 1.0f / (pg8::F8_ASC * pg8::F8_WSC)};
              pg8::gemm_phase<pg8::EpiBfS, pg8::StaticOrder, false, 2, 1>(lds, g, S, E); }
            GRID_BAR_L();
        } else {
#define MW (W_WB + WOFF_MOE + (size_t)fi * MW_SIZE)
            { const int ln = opaque_tid(); if (ln < 64) { WSL; volatile LAS int* tw = (volatile LAS int*)(lds + MISC_OFF);
                const int cnt = (ln < 8) ? (int)__hip_atomic_load(W_ctl + CW_CURSOR + 64 * fi + ln, __ATOMIC_RELAXED, __HIP_MEMORY_SCOPE_AGENT) : 0;
                const int nt = (cnt + 255) >> 8; int T = 0, tot = 0;
#pragma unroll
                for (int e = 0; e < 8; ++e) { const int v = __builtin_amdgcn_readlane(nt, e); if (e < ln) T += v; tot += v; }
                if (ln < 8) { tw[16 + ln] = T; tw[32 + ln] = cnt; }
                if (ln == 0) tw[24] = tot; } }
            __syncthreads();
            { WSL; pg8::Gemm g{W_H, W_MW8(fi) + MW8_GU, D}; MoeGatherOrder S{{tab, 11, Go, vcuo, 1 << 30}, W_IDX}; pg8::EpiSwigluI8<true> E{W_ACT8, DFEP, 10, (const float*)(W_DW8(0) + DW8_RSS), (const float*)(W_MW8(fi) + MW8_CS)};
              pg8::gemm_phase<pg8::EpiSwigluI8<true>, MoeGatherOrder, true, 2, 2>(lds, g, S, E); }
            GRID_BAR();
            { WSL; pg8::Gemm g{W_ACT8, W_MW8(fi) + MW8_D, DFEP}; MoeOrder S{tab, 4, Go, vcuo, 2 * Go}; pg8::EpiBfS E{W_YD, D, 1.0f / (pg8::F8_ASC * pg8::F8_WSC)};
              pg8::gemm_phase<pg8::EpiBfS, MoeOrder, true, 2, 1>(lds, g, S, E);
              pg8::TailOrder<MoeOrder> T{S};
              pg8::gemm_phase<pg8::EpiBfS, pg8::TailOrder<MoeOrder>, false, 1, 1>(lds, g, T, E); }
            GRID_BAR();
        }
        { WSL; const bool last = (l == DEPTH - 1); const float* mdn = W_MOD + (size_t)((last ? l : l + 1) * 4 + (vcuo >> 6)) * 6144;
          RowArgs ra{}; ra.X = last ? W_X : nullptr; ra.Xb = W_XB; ra.Ysrc = W_YO; ra.YD = W_YD; ra.slot = W_SLOT; ra.gatew = W_GATEW; ra.gate = md + 5120; ra.postg = AIN(I_POSTFFN) + l * D;
          ra.preg = AIN(I_PREMIX) + (last ? l : l + 1) * D; ra.sc = mdn + 1024; ra.sh = mdn; ra.H = W_H; ra.ssq_q = W_ssq_q; ra.ssq_kv = W_ssq_kv; ra.rs = (float*)(W_DW8(0) + DW8_RS);
          if (!moe) row_phase<2>(lds, tab, vcuo, ra, !last, false); else row_phase<3>(lds, tab, vcuo, ra, !last, false);
          if (!last) GRID_BAR_L(); }

    }
#undef LW
#undef md
#undef DW
#undef MW
#undef GRID_BAR
}

extern "C" void kernel_launch(void* const* d_in, const int* in_sizes, int n_in, void* d_out, int out_size, void* d_ws, size_t ws_size, hipStream_t stream) {
    static int grid = 0;
    if (grid == 0) {
        if (n_in != 32 || in_sizes[0] != M * D || out_size != M * D || ws_size < WS_END2) { fprintf(stderr, "kernel_launch: unexpected problem (n_in %d, in0 %d, out %d, ws %zu < %zu); nothing launched\n", n_in, n_in > 0 ? in_sizes[0] : -1, out_size, ws_size, (size_t)WS_END); grid = -1; return; }
        int dev = 0, cus = 0, per_cu = 0;
        if (hipGetDevice(&dev) != hipSuccess || hipDeviceGetAttribute(&cus, hipDeviceAttributeMultiprocessorCount, dev) != hipSuccess) { grid = -1; return; }
        if (hipFuncSetAttribute((const void*)trunk_fwd, hipFuncAttributeMaxDynamicSharedMemorySize, LDS_BYTES) != hipSuccess) { fprintf(stderr, "kernel_launch: hipFuncSetAttribute failed\n"); grid = -1; return; }
        if (hipOccupancyMaxActiveBlocksPerMultiprocessor(&per_cu, (const void*)trunk_fwd, 512, LDS_BYTES) != hipSuccess || per_cu < 1) fprintf(stderr, "kernel_launch: note: occupancy query reports %d workgroups per CU\n", per_cu);
        (void)hipGetLastError();
        if (cus < 256) { fprintf(stderr, "kernel_launch: this kernel is laid out for 256 CUs (one workgroup each, 64 token rows per workgroup in the row phases); device has %d; nothing launched\n", cus); grid = -1; return; }
        grid = 256;
    }
    if (grid < 0) return;
    if (hipMemsetAsync((char*)d_ws + WS_CTL, 0, CTL_ZERO_BYTES, stream) != hipSuccess) return;
    Args a{};
    for (int i = 0; i < 32; ++i) a.in[i] = (const float*)d_in[i];
    a.out = (float*)d_out; a.ws = (unsigned char*)d_ws;
    hipLaunchKernelGGL(trunk_fwd, dim3(grid), dim3(512), LDS_BYTES, stream, a);
}
```

```cpp
#include <hip/hip_runtime.h>
#include <cstdio>
#include <cstdint>

#define LAS __attribute__((address_space(3)))
#define GAS __attribute__((address_space(1)))
typedef unsigned short bf16;
typedef short bf16x8 __attribute__((ext_vector_type(8)));
typedef short s16x4 __attribute__((ext_vector_type(4)));
typedef float f32x4 __attribute__((ext_vector_type(4)));
typedef float f32x2 __attribute__((ext_vector_type(2)));
typedef float f32x16 __attribute__((ext_vector_type(16)));
typedef unsigned u32x4 __attribute__((ext_vector_type(4)));
typedef unsigned u32x2 __attribute__((ext_vector_type(2)));
typedef unsigned long long u64;

constexpr int D = 1024, NB = 4, SEQ = 4096, M = NB * SEQ, DEPTH = 4;
constexpr int NH = 8, QKD = 96, VD = 64, QL = 256, KVL = 128, ROPE = 32;
constexpr int SGW = 256, LRW = 256, DIN = 1440, DINP = 1536;
constexpr int DFF = 2816, NE = 8, DFE = 1408;
constexpr int ECAP = 16384;
constexpr int MAXT = 136;
constexpr float LOG2E = 1.4426950408889634f;
constexpr float QSCALE = 0.10206207261596577f * LOG2E;

typedef __bf16 bf16x2_t __attribute__((ext_vector_type(2)));
__device__ __forceinline__ unsigned cvt_pk(float lo, float hi) { f32x2 v = {lo, hi}; bf16x2_t b = __builtin_convertvector(v, bf16x2_t); return __builtin_bit_cast(unsigned, b); }
__device__ __forceinline__ float bf2f(unsigned short v) { return __uint_as_float((unsigned)v << 16); }
__device__ __forceinline__ float bflo(unsigned v) { return __uint_as_float(v << 16); }
__device__ __forceinline__ float bfhi(unsigned v) { return __uint_as_float(v & 0xffff0000u); }
__device__ __forceinline__ float fexp2(float x) { return __builtin_amdgcn_exp2f(x); }
__device__ __forceinline__ float frcp(float x) { return __builtin_amdgcn_rcpf(x); }
__device__ __forceinline__ float sigmoidf_(float x) { return frcp(1.0f + fexp2(-x * LOG2E)); }
__device__ __forceinline__ float siluf_(float x) { return x * sigmoidf_(x); }
__device__ __forceinline__ float gelu_tanh(float x) { const float u = 0.7978845608028654f * (x + 0.044715f * x * x * x); return x * frcp(1.0f + fexp2(-2.0f * LOG2E * u)); }
__device__ __forceinline__ float shx(float v, int lane, int o) { return __builtin_bit_cast(float, __builtin_amdgcn_ds_bpermute((lane ^ o) << 2, __builtin_bit_cast(int, v))); }
__device__ __forceinline__ float wave_sum_dpp(float v) {
    int x = __builtin_bit_cast(int, v);
#define DPP_ADD(ctrl, rmask) x = __builtin_bit_cast(int, __builtin_bit_cast(float, x) + __builtin_bit_cast(float, __builtin_amdgcn_update_dpp(0, x, (ctrl), (rmask), 0xf, false)))
    DPP_ADD(0x111, 0xf); DPP_ADD(0x112, 0xf); DPP_ADD(0x114, 0xf); DPP_ADD(0x118, 0xf);
    DPP_ADD(0x142, 0xa);
    DPP_ADD(0x143, 0xc);
#undef DPP_ADD
    return __builtin_bit_cast(float, __builtin_amdgcn_readlane(x, 63));
}
__device__ __forceinline__ float wave_max_dpp(float v) {
    int x = __builtin_bit_cast(int, v);
#define DPP_MAX(ctrl, rmask) x = __builtin_bit_cast(int, __builtin_fmaxf(__builtin_bit_cast(float, x), __builtin_bit_cast(float, __builtin_amdgcn_update_dpp(0, x, (ctrl), (rmask), 0xf, false))))
    DPP_MAX(0x111, 0xf); DPP_MAX(0x112, 0xf); DPP_MAX(0x114, 0xf); DPP_MAX(0x118, 0xf);
    DPP_MAX(0x142, 0xa);
    DPP_MAX(0x143, 0xc);
#undef DPP_MAX
    return __builtin_bit_cast(float, __builtin_amdgcn_readlane(x, 63));
}
__device__ __forceinline__ float wave_sum(float v, int lane) {
#pragma unroll
    for (int o = 1; o < 64; o <<= 1) v += shx(v, lane, o);
    return v;
}
__device__ __forceinline__ int opaque_tid() { int t = threadIdx.x; asm volatile("" : "+v"(t)); return t; }
#define LDS_WAIT() asm volatile("s_waitcnt lgkmcnt(0)" ::: "memory")
#define VM_WAIT() asm volatile("s_waitcnt vmcnt(0)" ::: "memory")

#define XB_TMO      128
#define XB_XCNT(j)  (256  + 64 * (j))
#define XB_XSUB(j)  (1280 + 64 * (j))
#define XB_XGEN(j)  (2304 + 64 * (j))
#define XB_TOP      3328
#define XB_TOPGEN   3392
#define XB_PTOP(p)  (3456 + 64 * (p))
#define XB_PGEN(p)  (3712 + 64 * (p))
#define XCD_BAR_WORDS 3456
#define XB_SPIN_CAP (1u << 18)

__device__ __forceinline__ unsigned xb_ld(unsigned* p)              { return __hip_atomic_load(p, __ATOMIC_RELAXED, __HIP_MEMORY_SCOPE_AGENT); }
__device__ __forceinline__ unsigned xb_add(unsigned* p, unsigned v) { return __hip_atomic_fetch_add(p, v, __ATOMIC_RELAXED, __HIP_MEMORY_SCOPE_AGENT); }
__device__ __forceinline__ unsigned xb_xcc_id() { return (unsigned)__builtin_amdgcn_s_getreg((3 << 11) | 20) & 0xFu; }
#define XB_SPIN(cond, bar) do { unsigned _sp = 0; while (cond) { __builtin_amdgcn_s_sleep(1); \
    if ((++_sp & 255u) == 0u) { if (xb_ld(&(bar)[XB_TMO])) break; if (_sp > XB_SPIN_CAP) { atomicAdd(&(bar)[XB_TMO], 1u); break; } } } } while (0)

struct XcdBarrier {
    unsigned* bar; unsigned x;
    volatile LAS unsigned* st;
};

__device__ __forceinline__ XcdBarrier xcd_barrier_post(unsigned* bar, volatile LAS unsigned* st) {
    XcdBarrier b; b.bar = bar; b.x = xb_xcc_id(); b.st = st;
    if (opaque_tid() == 0) (void)xb_add(&bar[XB_XCNT(b.x)], 1u);
    return b;
}
__device__ __forceinline__ void xcd_barrier_complete(unsigned* bar, unsigned x, unsigned& nloc, unsigned& nx) {
    const unsigned G = 256u;
    unsigned sum, cnt, mine, sp = 0u;
    for (;;) {
        sum = 0u; cnt = 0u; mine = 0u;
#pragma unroll
        for (unsigned j = 0; j < 16; ++j) { const unsigned c = xb_ld(&bar[XB_XCNT(j)]); sum += c; cnt += (c > 0u) ? 1u : 0u; mine = (j == x) ? c : mine; }
        if (sum == G) break;
        __builtin_amdgcn_s_sleep(1);
        if ((++sp & 255u) == 0u) { if (xb_ld(&bar[XB_TMO])) break; if (sp > XB_SPIN_CAP) { atomicAdd(&bar[XB_TMO], 1u); break; } }
    }
    nloc = mine > 0u ? mine : 1u; nx = cnt > 0u ? cnt : 1u;
}

__device__ __forceinline__ void xcd_barrier(const XcdBarrier& b) {
    asm volatile("s_waitcnt vmcnt(0)" ::: "memory");
    __syncthreads();
    if (opaque_tid() == 0) {
        unsigned* bar = b.bar;
        __builtin_amdgcn_s_waitcnt(0);
        unsigned nloc = b.st[0], nx = b.st[1];
        if (nloc == 0u) { xcd_barrier_complete(bar, b.x, nloc, nx); b.st[0] = nloc; b.st[1] = nx; }
        const unsigned old = xb_add(&bar[XB_XSUB(b.x)], 1u);
        const unsigned gen = old / nloc;
        if (old + 1u == (gen + 1u) * nloc) {
            __builtin_amdgcn_fence(__ATOMIC_RELEASE, "agent");
            asm volatile("s_waitcnt vmcnt(0)" ::: "memory");
            const unsigned og = xb_add(&bar[XB_TOP], 1u);
            const unsigned tg = og / nx;
            if (og + 1u == (tg + 1u) * nx) xb_add(&bar[XB_TOPGEN], 1u);
            else XB_SPIN(xb_ld(&bar[XB_TOPGEN]) == tg, bar);
            __builtin_amdgcn_fence(__ATOMIC_ACQUIRE, "agent");
            xb_add(&bar[XB_XGEN(b.x)], 1u);
            asm volatile("s_waitcnt vmcnt(0)" ::: "memory");
        } else {
            XB_SPIN(xb_ld(&bar[XB_XGEN(b.x)]) == gen, bar);
            __builtin_amdgcn_fence(__ATOMIC_ACQUIRE, "agent");
            asm volatile("s_waitcnt vmcnt(0)" ::: "memory");
        }
    }
    __syncthreads();
}

__device__ __forceinline__ void xcd_pair_barrier(const XcdBarrier& b, unsigned p) {
    asm volatile("s_waitcnt vmcnt(0)" ::: "memory");
    __syncthreads();
    if (opaque_tid() == 0) {
        unsigned* bar = b.bar;
        __builtin_amdgcn_s_waitcnt(0);
        const unsigned nloc = b.st[0];
        const unsigned old = xb_add(&bar[XB_XSUB(b.x)], 1u);
        const unsigned gen = old / nloc;
        if (old + 1u == (gen + 1u) * nloc) {
            __builtin_amdgcn_fence(__ATOMIC_RELEASE, "agent");
            asm volatile("s_waitcnt vmcnt(0)" ::: "memory");
            const unsigned og = xb_add(&bar[XB_PTOP(p)], 1u);
            const unsigned tg = og / 2u;
            if (og + 1u == (tg + 1u) * 2u) xb_add(&bar[XB_PGEN(p)], 1u);
            else XB_SPIN(xb_ld(&bar[XB_PGEN(p)]) == tg, bar);
            __builtin_amdgcn_fence(__ATOMIC_ACQUIRE, "agent");
            xb_add(&bar[XB_XGEN(b.x)], 1u);
            asm volatile("s_waitcnt vmcnt(0)" ::: "memory");
        } else {
            XB_SPIN(xb_ld(&bar[XB_XGEN(b.x)]) == gen, bar);
            __builtin_amdgcn_fence(__ATOMIC_ACQUIRE, "agent");
            asm volatile("s_waitcnt vmcnt(0)" ::: "memory");
        }
    }
    __syncthreads();
}
__device__ __forceinline__ void xcd_local_barrier(const XcdBarrier& b) {
    asm volatile("s_waitcnt vmcnt(0)" ::: "memory");
    __syncthreads();
    if (opaque_tid() == 0) {
        unsigned* bar = b.bar;
        __builtin_amdgcn_s_waitcnt(0);
        const unsigned nloc = b.st[0];
        const unsigned old = xb_add(&bar[XB_XSUB(b.x)], 1u);
        const unsigned gen = old / nloc;
        if (old + 1u == (gen + 1u) * nloc) xb_add(&bar[XB_XGEN(b.x)], 1u);
        else XB_SPIN(xb_ld(&bar[XB_XGEN(b.x)]) == gen, bar);
        __builtin_amdgcn_fence(__ATOMIC_ACQUIRE, "agent");
        asm volatile("s_waitcnt vmcnt(0)" ::: "memory");
    }
    __syncthreads();
}

constexpr size_t MiB = 1u << 20;
constexpr size_t WS_CTL = 0, CTL_ZERO_BYTES = 65536;
constexpr int CW_CURSOR = 4096;
constexpr size_t WS_MOD = 65536;
constexpr size_t WS_COS = WS_MOD + 393216, WS_SIN = WS_COS + 262144;
constexpr size_t WS_SSQQ = WS_SIN + 262144, WS_SSQK = WS_SSQQ + 131072;
constexpr size_t WS_IDX = WS_SSQK + 131072;
constexpr size_t WS_SLOT = WS_IDX + 524288, WS_GATEW = WS_SLOT + 131072;
static_assert(WS_GATEW + 131072 <= 2 * MiB, "small arrays");
constexpr size_t WS_W = 2 * MiB;
constexpr size_t LW_WIN = 0, LW_WUQ = LW_WIN + (size_t)DINP * D, LW_WUK = LW_WUQ + 768 * 256, LW_WUV = LW_WUK + 512 * 256, LW_WO = LW_WUV + 512 * 256,
                 LW_SGW = LW_WO + (size_t)D * D, LW_LWA = LW_SGW + 4 * 128 * 128, LW_LWX = LW_LWA + 4 * 64 * 64, LW_SIZE = ((LW_LWX + 4 * 64 * 64 + 65535) / 65536) * 65536;
static_assert(WS_W % 131072 == 0 && (LW_SIZE * 2) % 131072 == 0 && (LW_WUQ * 2) % 131072 == 0 && (LW_WUK * 2) % 131072 == 0 && (LW_WUV * 2) % 131072 == 0, "q/k/v tile alignment");
constexpr size_t DW_GU = 0, DW_D = DW_GU + (size_t)2 * DFF * D, DW_SIZE = DW_D + (size_t)D * DFF;
constexpr size_t MW_GU = 0, MW_D = MW_GU + (size_t)NE * 2 * DFE * D, MW_SIZE = MW_D + (size_t)NE * D * DFE;
constexpr int DFEP = 1536;
constexpr size_t DW8_GU = 0, DW8_D = DW8_GU + (size_t)2 * DFF * D;
constexpr size_t MW8_GU = 0, MW8_D = MW8_GU + (size_t)NE * 2 * DFE * D;
static_assert(MW8_D + (size_t)NE * D * DFEP <= ((size_t)NE * 2 * DFE * D + (size_t)NE * D * DFE) * 2, "fp8 MoE block fits");
constexpr size_t DW8_CS = 12 * MiB;
constexpr size_t DW8_RS = 13 * MiB, DW8_RSS = 14 * MiB;
constexpr size_t MW8_CS = 40 * MiB;
static_assert(DW8_D + (size_t)D * DFF <= DW8_CS && DW8_RSS + (size_t)8 * ECAP * 4 <= ((size_t)2 * DFF * D + (size_t)D * DFF) * 2, "dense block slack");
static_assert(MW8_D + (size_t)NE * D * DFEP <= MW8_CS && MW8_CS + (size_t)NE * 2 * DFE * 4 <= ((size_t)NE * 2 * DFE * D + (size_t)NE * D * DFE) * 2, "MoE block slack");
constexpr size_t WOFF_DENSE = 4 * LW_SIZE, WOFF_MOE = WOFF_DENSE + 2 * DW_SIZE, W_ELEMS = WOFF_MOE + 2 * MW_SIZE;
static_assert(WS_W + W_ELEMS * 2 <= 192 * MiB, "weight arena");
constexpr size_t WS_H = 192 * MiB, WS_YO = 224 * MiB, WS_RA = 288 * MiB;
constexpr size_t WS_ZQ = WS_RA, WS_ZKV = WS_ZQ + 8 * MiB, WS_KR = WS_ZKV + 8 * MiB, WS_U = WS_KR + 1 * MiB, WS_GV = WS_U + 8 * MiB, WS_ZX = WS_GV + 8 * MiB, WS_GY = WS_ZX + 8 * MiB,
                 WS_Q = WS_GY + 8 * MiB, WS_KN = WS_Q + 24 * MiB, WS_VT = WS_KN + 16 * MiB, WS_Y = WS_VT + 16 * MiB, WS_HL = WS_Y + 32 * MiB, WS_PP = WS_HL + 16 * MiB, WS_END = WS_PP + 16 * MiB;
constexpr size_t WS_ACT = WS_RA, WS_YD = WS_RA + 94 * MiB;
constexpr size_t WS_ACTD = WS_END, WS_END2 = WS_ACTD + 44 * MiB;
static_assert((size_t)M * DFF <= 44 * MiB, "dense activation buffer");
static_assert((size_t)MAXT * 256 * DFE * 2 <= 94 * MiB && (size_t)M * DFF * 2 <= 94 * MiB && WS_YD + (size_t)MAXT * 256 * D * 2 <= WS_END, "FFN overlay");

constexpr int RING_BYTES = 131072;
constexpr int MISC_OFF = RING_BYTES;
constexpr int LDS_BYTES = 147456;


namespace pg8 {
constexpr int BM = 256, BK = 64, HALF = 128, HTB = HALF * BK * 2  , STAGE_BYTES = 8 * HTB, NXCD = 8, WGM = 8;
__device__ __forceinline__ int lds_byte(int r, int c) { const int st = (r >> 4) * 2 + (c >> 5), rr = r & 15, cc = c & 31, ob = rr * 64 + cc * 2; return st * 1024 + (ob ^ (((ob >> 9) & 1) << 5)); }
__device__ __forceinline__ void stage_rc(int b, int& R, int& C) { const int st = b / 1024, sb = b % 1024, swz = sb ^ (((sb >> 9) & 1) << 5); R = (st >> 1) * 16 + swz / 64; C = (st & 1) * 32 + (swz % 64) / 2; }
__device__ __forceinline__ int perm32(int rho) { const int n = rho >> 4, i = rho & 15; return 8 * (i >> 2) + 4 * n + (i & 3); }

typedef int i32x8 __attribute__((ext_vector_type(8)));
typedef int i32x4v __attribute__((ext_vector_type(4)));
__device__ __forceinline__ i32x8 cat8(const bf16x8 a, const bf16x8 b) { const i32x4v x = __builtin_bit_cast(i32x4v, a), y = __builtin_bit_cast(i32x4v, b); return __builtin_shufflevector(x, y, 0, 1, 2, 3, 4, 5, 6, 7); }
__device__ __forceinline__ unsigned pk4_fp8(const f32x4 v) {
    float lim = 448.f; asm volatile("" : "+s"(lim));
    const float a = __builtin_fminf(__builtin_fmaxf(v[0], -lim), lim), b = __builtin_fminf(__builtin_fmaxf(v[1], -lim), lim), c = __builtin_fminf(__builtin_fmaxf(v[2], -lim), lim), d = __builtin_fminf(__builtin_fmaxf(v[3], -lim), lim);
    int w = __builtin_amdgcn_cvt_pk_fp8_f32(a, b, 0, false); w = __builtin_amdgcn_cvt_pk_fp8_f32(c, d, w, true); return (unsigned)w; }
__device__ __forceinline__ unsigned pk4_i8(const f32x4 v) {
    const unsigned b0 = __builtin_bit_cast(unsigned, v[0] + 12582912.0f), b1 = __builtin_bit_cast(unsigned, v[1] + 12582912.0f), b2 = __builtin_bit_cast(unsigned, v[2] + 12582912.0f), b3 = __builtin_bit_cast(unsigned, v[3] + 12582912.0f);
    const unsigned lo = __builtin_amdgcn_perm(b1, b0, 0x0c0c0400u), hi = __builtin_amdgcn_perm(b3, b2, 0x0c0c0400u);
    return __builtin_amdgcn_perm(hi, lo, 0x05040100u); }
__device__ __forceinline__ f32x4 i2f4(const f32x4 a) { const i32x4v q = __builtin_bit_cast(i32x4v, a); return (f32x4){(float)q[0], (float)q[1], (float)q[2], (float)q[3]}; }
constexpr float F8_WSC = 64.0f, F8_HSC = 4.0f, F8_ASC = 8.0f;
struct Unit { int pm, pn, x0, x1, x2, x3, co; };
struct Gemm { const void* A; const void* Bt; int K; int ld = 0; };

struct StaticOrder {
    static constexpr bool GATHER = false;
    int nM, nN, nwg, G, c, lim;
    __device__ void init(int Mr, int N, int G_, int c_) { nM = Mr / BM; nN = N / BM; nwg = nM * nN; G = G_; c = c_; lim = nwg; }
    __device__ bool next_tail(Unit& u) const { const int L = lim + 8 * ((c >> 3) >> 1) + (c & 7); if (L >= nwg) return false; map(L, u); u.co = ((c >> 3) & 1) * HALF; return true; }
    __device__ bool next(int i, Unit& u) const {
        const long L = (long)i * G + c; if (L >= lim) return false;
        map((int)L, u); return true; }
    __device__ void map(int Lq, Unit& u) const {
        int wgid = Lq; { const int q = nwg / NXCD, r = nwg % NXCD, xcd = wgid % NXCD, off = wgid / NXCD; wgid = (xcd < r ? xcd * (q + 1) : r * (q + 1) + (xcd - r) * q) + off; }
        const int nig = WGM * nN, gid = wgid / nig, fm = gid * WGM, gsz = (nM - fm) < WGM ? (nM - fm) : WGM;
        u.pm = fm + ((wgid % nig) % gsz); u.pn = (wgid % nig) / gsz; u.x0 = u.pm; u.x1 = u.pn; u.x2 = 0; u.x3 = 0; u.co = 0;
    }
    __device__ __forceinline__ int src_row(const Unit&, int) const { return 0; }
};

struct QkvOrder {
    static constexpr bool GATHER = false;
    int G, c, tq_a, tq_b, tk_a, tk_b, tv_a, tv_b;
    __device__ bool next(int i, Unit& u) const {
        const int L = i * G + c; if (L >= 448) return false;
        if (L < 192) { const int pm = L / 3, pn = L - 3 * pm; u.pm = tq_a + pm; u.pn = tq_b + pn; u.x0 = pm; u.x1 = pn; u.x2 = 0; }
        else if (L < 320) { const int j = L - 192, pm = j >> 1, pn = j & 1; u.pm = tk_a + pm; u.pn = tk_b + pn; u.x0 = pm; u.x1 = pn; u.x2 = 1; }
        else { const int j = L - 320, pn = j >> 1, pm = j & 1; u.pm = tv_a + pm; u.pn = tv_b + pn; u.x0 = pm; u.x1 = pn; u.x2 = 2; }
        u.x3 = 0; return true;
    }
    __device__ __forceinline__ int src_row(const Unit&, int) const { return 0; }
};
template <class S> struct TailOrder {
    static constexpr bool GATHER = false;
    const S& s;
    __device__ __forceinline__ bool next(int i, Unit& u) const { return i == 0 && s.next_tail(u); }
    __device__ __forceinline__ int src_row(const Unit&, int) const { return 0; }
};

template <class Epi, class Sched, bool ALIGN_EPI, int NBJ = 2, int QM = 0>
__device__ __forceinline__ void gemm_phase(LAS unsigned char* lds, const Gemm g, const Sched& S, const Epi& E) {
    const int tid = opaque_tid(), wid = __builtin_amdgcn_readfirstlane(tid >> 6), lane = tid & 63, wr = wid >> 2, wc = wid & 3, fr = lane & 15, fq = lane >> 4;
    constexpr bool F8 = (QM == 1); const int K = g.K, LD = g.ld ? g.ld : g.K, RB = QM ? LD : 2 * LD  , nt = (QM ? K : 2 * K) / 128;
    constexpr bool GA = Sched::GATHER;
    unsigned voffA, voffB;
    { int R, C; stage_rc(tid * 16, R, C); const int Rb = Epi::PERM ? ((R & ~31) + perm32(R & 31)) : R; voffA = (unsigned)(R * RB + 2 * C); voffB = (unsigned)(Rb * RB + 2 * C); }
    const size_t dstep = (size_t)64 * RB;
    u32x4 vG;
    LAS u32x4* gstash = (LAS u32x4*)(lds + STAGE_BYTES + 4096 + tid * 16);
    const size_t kstep = (size_t)(BK * 2);
    const size_t hstep = GA ? 0 : (size_t)HALF * RB;
    const size_t tstep = (size_t)BM * RB;
    const unsigned ldsw = (unsigned)wid * 1024u;
    const int aoff = lds_byte(wr * 64 + fr, fq * 8), boff = lds_byte(wc * 32 + fr, fq * 8);
#define PG8_SA(b, h) (((b) * 2 + (h)) * HTB)
#define PG8_SB(b, h) ((4 + (b) * 2 + (h)) * HTB)
#define PG8_STAGE(bufoff, gbase, voff) do { _Pragma("unroll") for (int _i = 0; _i < 2; ++_i) \
        __builtin_amdgcn_global_load_lds((const unsigned*)((const char*)(gbase) + _i * dstep + (voff)), (LAS unsigned*)(lds + (bufoff) + ldsw + _i * 8192), 16, 0, 0); } while (0)
#define PG8_STAGE_A(bufoff, gbase, h, NX) do { if constexpr (GA) { _Pragma("unroll") for (int _i = 0; _i < 2; ++_i) \
            __builtin_amdgcn_global_load_lds((const unsigned*)((const char*)(gbase) + vG[(h) * 2 + _i]), (LAS unsigned*)(lds + (bufoff) + ldsw + _i * 8192), 16, 0, 0); } \
        else { PG8_STAGE(bufoff, (const char*)(gbase) + (h) * hstep, voffA); } } while (0)
#define PG8_LDA(dst, b, h) do { _Pragma("unroll") for (int m = 0; m < 4; ++m) _Pragma("unroll") for (int k = 0; k < 2; ++k) dst[m][k] = *(const LAS bf16x8*)(lds + PG8_SA(b, h) + aoff + m * 2048 + k * 1024); } while (0)
#define PG8_LDB(dst, b, h) do { _Pragma("unroll") for (int n = 0; n < 2; ++n) _Pragma("unroll") for (int k = 0; k < 2; ++k) dst[n][k] = *(const LAS bf16x8*)(lds + PG8_SB(b, h) + boff + n * 2048 + k * 1024); } while (0)
#define PG8_MMA(ai, bj, At, Bt) do { __builtin_amdgcn_s_setprio(1); _Pragma("unroll") for (int m = 0; m < 4; ++m) _Pragma("unroll") for (int n = 0; n < 2; ++n) { \
        if constexpr (F8) acc[ai][bj][m][n] = __builtin_amdgcn_mfma_scale_f32_16x16x128_f8f6f4(cat8(Bt[n][0], Bt[n][1]), cat8(At[m][0], At[m][1]), acc[ai][bj][m][n], 0, 0, 0, 0, 0, 0);     \
        else if constexpr (QM == 2) { _Pragma("unroll") for (int k = 0; k < 2; ++k) acc[ai][bj][m][n] = __builtin_bit_cast(f32x4, __builtin_amdgcn_mfma_i32_16x16x64_i8(__builtin_bit_cast(i32x4v, Bt[n][k]), __builtin_bit_cast(i32x4v, At[m][k]), __builtin_bit_cast(i32x4v, acc[ai][bj][m][n]), 0, 0, 0)); } \
        else { _Pragma("unroll") for (int k = 0; k < 2; ++k) acc[ai][bj][m][n] = __builtin_amdgcn_mfma_f32_16x16x32_bf16(Bt[n][k], At[m][k], acc[ai][bj][m][n], 0, 0, 0); } } __builtin_amdgcn_s_setprio(0); } while (0)
#define PG8_WAIT_V(n) asm volatile("s_waitcnt vmcnt(" #n ")" ::: "memory")
#define PG8_WAIT_L(n) asm volatile("s_waitcnt lgkmcnt(" #n ")" ::: "memory")
#define PG8_WAIT_VN do { if constexpr (NBJ == 2) PG8_WAIT_V(8); else PG8_WAIT_V(6); } while (0)
#define PG8_BAR __builtin_amdgcn_s_barrier()
#define PG8_SCHED __builtin_amdgcn_sched_barrier(0)
#define PG8_GOFF(dst, u) do { if constexpr (GA) { int _t = tid, _R, _C; asm volatile("" : "+v"(_t)); stage_rc(_t * 16, _R, _C);     \
        _Pragma("unroll") for (int _h = 0; _h < 2; ++_h) _Pragma("unroll") for (int _i = 0; _i < 2; ++_i) \
        dst[_h * 2 + _i] = (unsigned)S.src_row(u, _h * HALF + _i * 64 + _R) * (unsigned)RB + 2u * (unsigned)_C; } } while (0)
    Unit cur, nxt; int ui = 0;
    if (!S.next(0, cur)) return;
    f32x4 acc[2][2][4][2];
#pragma unroll
    for (int a = 0; a < 2; ++a)
#pragma unroll
        for (int b = 0; b < 2; ++b)
#pragma unroll
            for (int m = 0; m < 4; ++m)
#pragma unroll
                for (int n = 0; n < 2; ++n) acc[a][b][m][n] = (f32x4){0.f, 0.f, 0.f, 0.f};
    bf16x8 At[4][2], B0[2][2], B1[2][2];
    const char* cA = (const char*)g.A + (GA ? (size_t)0 : (size_t)cur.pm * tstep); const char* cB = (const char*)g.Bt + (size_t)cur.pn * tstep + (size_t)(cur.co / HALF) * ((size_t)HALF * RB);
    PG8_GOFF(vG, cur);
    PG8_STAGE(PG8_SB(0, 0), cB, voffB); if constexpr (NBJ == 2) PG8_STAGE(PG8_SB(0, 1), cB + (size_t)HALF * RB, voffB); PG8_STAGE_A(PG8_SA(0, 0), cA, 0, false); PG8_STAGE_A(PG8_SA(0, 1), cA, 1, false);
    if (wr == 1) PG8_BAR;
    PG8_WAIT_V(2); PG8_BAR;
    PG8_STAGE(PG8_SB(1, 0), cB + kstep, voffB); PG8_STAGE_A(PG8_SA(1, 0), cA + kstep, 0, false); if constexpr (NBJ == 2) PG8_STAGE(PG8_SB(1, 1), cB + (size_t)HALF * RB + kstep, voffB);
    if constexpr (NBJ == 2) PG8_WAIT_V(6); else PG8_WAIT_V(4);
    PG8_BAR;
    const size_t bh = (size_t)HALF * RB;
    for (;;) {
        const bool has_next = S.next(ui + 1, nxt);
        if constexpr (GA) { u32x4 nx = vG; if (has_next) { PG8_GOFF(nx, nxt); } *gstash = nx; }
        const char* nA = has_next ? (const char*)g.A + (GA ? (size_t)0 : (size_t)nxt.pm * tstep) : cA; const char* nB = has_next ? (const char*)g.Bt + (size_t)nxt.pn * tstep + (size_t)(nxt.co / HALF) * ((size_t)HALF * RB) : cB;
#pragma nounroll
        for (int t = 0; t < nt; t += 2) {
            const bool last = (t == nt - 2);
            const bool tail = last && !has_next;
            if constexpr (GA) asm volatile("" : "+v"(voffB), "+v"(vG));
            else asm volatile("" : "+v"(voffA), "+v"(voffB));
            const char* a1 = cA + (size_t)(t + 1) * kstep;
            const char* a2 = last ? nA : cA + (size_t)(t + 2) * kstep; const char* b2 = last ? nB : cB + (size_t)(t + 2) * kstep;
            const char* a3 = a2 + kstep; const char* b3 = b2 + kstep;
            PG8_LDB(B0, 0, 0); if constexpr (NBJ == 2) PG8_LDB(B1, 0, 1); PG8_SCHED; PG8_LDA(At, 0, 0); PG8_STAGE_A(PG8_SA(1, 1), a1, 1, false);
            if constexpr (GA) { if (last) vG = *gstash; }
            PG8_WAIT_VN; PG8_WAIT_L(0); PG8_BAR; PG8_MMA(0, 0, At, B0); if constexpr (NBJ == 2) PG8_MMA(0, 1, At, B1); PG8_BAR; PG8_SCHED;
            PG8_LDA(At, 0, 1); if (!tail) { PG8_STAGE(PG8_SB(0, 0), b2, voffB); if constexpr (NBJ == 2) PG8_STAGE(PG8_SB(0, 1), b2 + bh, voffB); PG8_STAGE_A(PG8_SA(0, 0), a2, 0, last); }
            if (tail) PG8_WAIT_V(2); else PG8_WAIT_VN;
            PG8_WAIT_L(0); PG8_BAR; PG8_MMA(1, 0, At, B0); if constexpr (NBJ == 2) PG8_MMA(1, 1, At, B1); PG8_BAR; PG8_SCHED;
            PG8_LDB(B0, 1, 0); if constexpr (NBJ == 2) PG8_LDB(B1, 1, 1); PG8_SCHED; PG8_LDA(At, 1, 0); if (!tail) PG8_STAGE_A(PG8_SA(0, 1), a2, 1, last);
            if (tail) PG8_WAIT_V(0); else PG8_WAIT_VN;
            PG8_WAIT_L(0); PG8_BAR; PG8_MMA(0, 0, At, B0); if constexpr (NBJ == 2) PG8_MMA(0, 1, At, B1); PG8_BAR; PG8_SCHED;
            PG8_LDA(At, 1, 1); if (!tail) { PG8_STAGE(PG8_SB(1, 0), b3, voffB); if constexpr (NBJ == 2) PG8_STAGE(PG8_SB(1, 1), b3 + bh, voffB); PG8_STAGE_A(PG8_SA(1, 0), a3, 0, last); }
            if (tail) PG8_WAIT_V(0); else PG8_WAIT_VN;
            PG8_WAIT_L(0); PG8_BAR; PG8_MMA(1, 0, At, B0); if constexpr (NBJ == 2) PG8_MMA(1, 1, At, B1); PG8_BAR; PG8_SCHED;
        }
        if constexpr (ALIGN_EPI) { if (wr == 0) PG8_BAR; }
        { int l2 = lane; asm volatile("" : "+v"(l2)); E.template operator()<NBJ>(acc, cur, wr, wc, l2 & 15, l2 >> 4); }
        if (!has_next) break;
#pragma unroll
        for (int a = 0; a < 2; ++a)
#pragma unroll
            for (int b = 0; b < 2; ++b)
#pragma unroll
                for (int m = 0; m < 4; ++m)
#pragma unroll
                    for (int n = 0; n < 2; ++n) acc[a][b][m][n] = (f32x4){0.f, 0.f, 0.f, 0.f};
        cur = nxt; cA = nA; cB = nB; ++ui;
        if constexpr (ALIGN_EPI) { if (wr == 1) PG8_BAR; }
    }
    PG8_WAIT_V(0);
    if constexpr (!ALIGN_EPI) { if (wr == 0) PG8_BAR; }
    PG8_BAR;
#undef PG8_SA
#undef PG8_SB
#undef PG8_STAGE
#undef PG8_STAGE_A
#undef PG8_LDA
#undef PG8_LDB
#undef PG8_MMA
#undef PG8_WAIT_V
#undef PG8_WAIT_L
#undef PG8_WAIT_VN
#undef PG8_BAR
#undef PG8_SCHED
#undef PG8_GOFF
}

typedef f32x4 AccT[2][2][4][2];
__device__ __forceinline__ u32x4 pack8(const f32x4 v0, const f32x4 v1) { u32x4 w; w.x = cvt_pk(v0[0], v0[1]); w.y = cvt_pk(v0[2], v0[3]); w.z = cvt_pk(v1[0], v1[1]); w.w = cvt_pk(v1[2], v1[3]); return w; }
__device__ __forceinline__ float rstd_from(u64 ssq, float inv_n) { return __builtin_amdgcn_rsqf((float)ssq * (1.0f / 4294967296.0f) * inv_n + 1e-6f); }
__device__ __forceinline__ f32x4 gelu4(f32x4 v) {
    constexpr float K1 = -2.0f * LOG2E * 0.7978845608028654f, K2 = K1 * 0.044715f;
    typedef float f32x2_ __attribute__((ext_vector_type(2)));
    f32x2_ k1 = (f32x2_){K1, K1}, k2 = (f32x2_){K2, K2}; asm volatile("" : "+s"(k1), "+s"(k2));
    const f32x4 k1v = __builtin_shufflevector(k1, k1, 0, 1, 0, 1), k2v = __builtin_shufflevector(k2, k2, 0, 1, 0, 1);
    const f32x4 t = v * ((v * v) * k2v + k1v);
    f32x4 d = (f32x4){fexp2(t[0]), fexp2(t[1]), fexp2(t[2]), fexp2(t[3])}; d = d + 1.0f;
    const f32x4 s = (f32x4){frcp(d[0]), frcp(d[1]), frcp(d[2]), frcp(d[3])};
    return v * s; }

struct EpiF32 {
    static constexpr bool PERM = false;
    float* O; int ldc;
    template <int NBJ = 2> __device__ __forceinline__ void operator()(const AccT& acc, const Unit& u, int wr, int wc, int fr, int fq) const {
#pragma unroll
        for (int ai = 0; ai < 2; ++ai)
#pragma unroll
            for (int m = 0; m < 4; ++m) { float* rowp = O + (size_t)(u.x0 * BM + ai * HALF + wr * 64 + m * 16 + fr) * ldc + u.x1 * BM + wc * 32 + 4 * fq;
#pragma unroll
                for (int bj = 0; bj < 2; ++bj)
#pragma unroll
                    for (int n = 0; n < 2; ++n) *(f32x4*)(rowp + bj * HALF + n * 16) = acc[ai][bj][m][n]; }
    }
};
struct EpiBf {
    static constexpr bool PERM = true;
    bf16* O; int ldc;
    template <int NBJ = 2> __device__ __forceinline__ void operator()(const AccT& acc, const Unit& u, int wr, int wc, int fr, int fq) const {
#pragma unroll
        for (int ai = 0; ai < 2; ++ai)
#pragma unroll
            for (int m = 0; m < 4; ++m) { bf16* rowp = O + (size_t)(u.x0 * BM + ai * HALF + wr * 64 + m * 16 + fr) * ldc + u.x1 * BM + wc * 32 + 8 * fq;
#pragma unroll
                for (int bj = 0; bj < NBJ; ++bj) *(u32x4*)(rowp + u.co + bj * HALF) = pack8(acc[ai][bj][m][0], acc[ai][bj][m][1]); }
    }
};
struct EpiSwiglu {
    static constexpr bool PERM = true;
    bf16* O; int ldc;
    template <int NBJ = 2> __device__ __forceinline__ void operator()(const AccT& acc, const Unit& u, int wr, int wc, int fr, int fq) const {
#pragma unroll
        for (int ai = 0; ai < 2; ++ai)
#pragma unroll
            for (int m = 0; m < 4; ++m) { bf16* rowp = O + (size_t)(u.x0 * BM + ai * HALF + wr * 64 + m * 16 + fr) * ldc + u.x1 * HALF + wc * 32 + 8 * fq;
                f32x4 a0, a1;
#pragma unroll
                for (int e = 0; e < 4; ++e) { a0[e] = siluf_(acc[ai][0][m][0][e]) * acc[ai][1][m][0][e]; a1[e] = siluf_(acc[ai][0][m][1][e]) * acc[ai][1][m][1][e]; }
                *(u32x4*)rowp = pack8(a0, a1); }
    }
};
struct EpiBfS {
    static constexpr bool PERM = true;
    bf16* O; int ldc; float sc;
    template <int NBJ = 2> __device__ __forceinline__ void operator()(const AccT& acc, const Unit& u, int wr, int wc, int fr, int fq) const {
#pragma unroll
        for (int ai = 0; ai < 2; ++ai)
#pragma unroll
            for (int m = 0; m < 4; ++m) { bf16* rowp = O + (size_t)(u.x0 * BM + ai * HALF + wr * 64 + m * 16 + fr) * ldc + u.x1 * BM + wc * 32 + 8 * fq;
#pragma unroll
                for (int bj = 0; bj < NBJ; ++bj) *(u32x4*)(rowp + u.co + bj * HALF) = pack8(acc[ai][bj][m][0] * sc, acc[ai][bj][m][1] * sc); }
    }
};
struct EpiSwiglu8 {
    static constexpr bool PERM = true;
    unsigned char* O; int ldc, zt;
    template <int NBJ = 2> __device__ __forceinline__ void operator()(const AccT& acc, const Unit& u, int wr, int wc, int fr, int fq) const {
        constexpr float sg = 1.0f / (F8_HSC * F8_WSC), su = F8_ASC / (F8_HSC * F8_WSC);
#pragma unroll
        for (int ai = 0; ai < 2; ++ai)
#pragma unroll
            for (int m = 0; m < 4; ++m) { unsigned char* rowp = O + (size_t)(u.x0 * BM + ai * HALF + wr * 64 + m * 16 + fr) * ldc + u.x1 * HALF + wc * 32 + 8 * fq;
                f32x4 a0, a1;
#pragma unroll
                for (int e = 0; e < 4; ++e) { a0[e] = siluf_(acc[ai][0][m][0][e] * sg) * (acc[ai][1][m][0][e] * su); a1[e] = siluf_(acc[ai][0][m][1][e] * sg) * (acc[ai][1][m][1][e] * su); }
                u32x2 w; w.x = pk4_fp8(a0); w.y = pk4_fp8(a1); *(u32x2*)rowp = w;
                if (u.x1 == zt) *(u32x2*)(rowp + HALF) = (u32x2){0u, 0u}; }
    }
};
template <bool SLOT> struct EpiSwigluI8 {
    static constexpr bool PERM = true;
    unsigned char* O; int ldc, zt; const float* rs; const float* cs;
    template <int NBJ = 2> __device__ __forceinline__ void operator()(const AccT& acc, const Unit& u, int wr, int wc, int fr, int fq) const {
        const float* cp = cs + (size_t)u.pn * BM + wc * 32 + 8 * fq;
        const f32x4 cg0 = *(const f32x4*)cp, cg1 = *(const f32x4*)(cp + 4), cu0 = *(const f32x4*)(cp + HALF) * F8_ASC, cu1 = *(const f32x4*)(cp + HALF + 4) * F8_ASC;
        float rr[2][4];
#pragma unroll
        for (int ai = 0; ai < 2; ++ai)
#pragma unroll
            for (int m = 0; m < 4; ++m) { const int rl = ai * HALF + wr * 64 + m * 16 + fr; rr[ai][m] = SLOT ? ((rl < u.x3) ? rs[u.x2 + rl] : 0.f) : rs[u.x0 * BM + rl]; }
#pragma unroll
        for (int ai = 0; ai < 2; ++ai)
#pragma unroll
            for (int m = 0; m < 4; ++m) { const int rl = ai * HALF + wr * 64 + m * 16 + fr;
                unsigned char* rowp = O + (size_t)(u.x0 * BM + rl) * ldc + u.x1 * HALF + wc * 32 + 8 * fq;
                const float r = rr[ai][m];
                const f32x4 g0 = i2f4(acc[ai][0][m][0]) * (cg0 * r), g1 = i2f4(acc[ai][0][m][1]) * (cg1 * r), u0 = i2f4(acc[ai][1][m][0]) * (cu0 * r), u1 = i2f4(acc[ai][1][m][1]) * (cu1 * r);
                f32x4 nl2 = (f32x4){-LOG2E, -LOG2E, -LOG2E, -LOG2E}; asm volatile("" : "+v"(nl2));
                const f32x4 t0 = g0 * nl2, t1 = g1 * nl2;
                f32x4 d0, d1;
#pragma unroll
                for (int e = 0; e < 4; ++e) { d0[e] = fexp2(t0[e]); d1[e] = fexp2(t1[e]); }
                d0 = d0 + 1.0f; d1 = d1 + 1.0f;
                f32x4 s0, s1;
#pragma unroll
                for (int e = 0; e < 4; ++e) { s0[e] = frcp(d0[e]); s1[e] = frcp(d1[e]); }
                f32x4 a0 = (g0 * u0) * s0, a1 = (g1 * u1) * s1;
                float lim = 448.f; asm volatile("" : "+v"(lim));
#pragma unroll
                for (int e = 0; e < 4; ++e) { a0[e] = __builtin_amdgcn_fmed3f(a0[e], -lim, lim); a1[e] = __builtin_amdgcn_fmed3f(a1[e], -lim, lim); }
                u32x2 w;
                { int w0 = __builtin_amdgcn_cvt_pk_fp8_f32(a0[0], a0[1], 0, false); w0 = __builtin_amdgcn_cvt_pk_fp8_f32(a0[2], a0[3], w0, true);
                  int w1 = __builtin_amdgcn_cvt_pk_fp8_f32(a1[0], a1[1], 0, false); w1 = __builtin_amdgcn_cvt_pk_fp8_f32(a1[2], a1[3], w1, true); w.x = (unsigned)w0; w.y = (unsigned)w1; }
                *(u32x2*)rowp = w;
                if (u.x1 == zt) *(u32x2*)(rowp + HALF) = (u32x2){0u, 0u}; }
    }
};
struct EpiIn {
    static constexpr bool PERM = true;
    unsigned char* ws; const float* rs; const float* cs;
    template <int NBJ = 2> __device__ __forceinline__ void operator()(const AccT& acc, const Unit& u, int wr, int wc, int fr, int fq) const {
        const int pn = u.pn;
        f32x4 c0[NBJ], c1[NBJ];
        { const float* cp = cs + (size_t)pn * BM + u.co + wc * 32 + 8 * fq;
#pragma unroll
          for (int bj = 0; bj < NBJ; ++bj) { c0[bj] = *(const f32x4*)(cp + bj * HALF); c1[bj] = *(const f32x4*)(cp + bj * HALF + 4); } }
        float rr[2][4];
#pragma unroll
        for (int ai = 0; ai < 2; ++ai)
#pragma unroll
            for (int m = 0; m < 4; ++m) rr[ai][m] = rs[u.pm * BM + ai * HALF + wr * 64 + m * 16 + fr];
        bf16 *ZQ = (bf16*)(ws + WS_ZQ), *ZKV = (bf16*)(ws + WS_ZKV), *KR = (bf16*)(ws + WS_KR), *U = (bf16*)(ws + WS_U), *GV = (bf16*)(ws + WS_GV), *ZX = (bf16*)(ws + WS_ZX), *GY = (bf16*)(ws + WS_GY);
        u64 *ssq_q = (u64*)(ws + WS_SSQQ), *ssq_kv = (u64*)(ws + WS_SSQK); const float *cosT = (const float*)(ws + WS_COS), *sinT = (const float*)(ws + WS_SIN);
        const bool krope = (pn == 1 && wc == 0 && (NBJ == 2 || (u.co >> 7) == 1));
#pragma unroll
        for (int ai = 0; ai < 2; ++ai) {
            f32x4 cc[4], sn[4];
            if (krope) {
#pragma unroll
                for (int m = 0; m < 4; ++m) { const int pos = (u.pm * BM + ai * HALF + wr * 64 + m * 16 + fr) & (SEQ - 1); cc[m] = *(const f32x4*)(cosT + pos * 16 + 4 * fq); sn[m] = *(const f32x4*)(sinT + pos * 16 + 4 * fq); } }
#pragma unroll
            for (int m = 0; m < 4; ++m) {
                const int row = u.pm * BM + ai * HALF + wr * 64 + m * 16 + fr; const int cl = wc * 32 + 8 * fq; const float rsc = rr[ai][m];
                const int hb = u.co >> 7;
                if (pn == 0 || pn == 1) {
                    bf16* dst = (pn == 0 ? ZQ : ZKV) + (size_t)row * 256 + cl;
                    float ss = 0.f;
#pragma unroll
                    for (int bj = 0; bj < NBJ; ++bj) { const f32x4 v0 = i2f4(acc[ai][bj][m][0]) * (c0[bj] * rsc), v1 = i2f4(acc[ai][bj][m][1]) * (c1[bj] * rsc);
                        *(u32x4*)(dst + (bj + hb) * HALF) = pack8(v0, v1);
                        if (pn == 0 || bj + hb == 0) ss += (v0[0] * v0[0] + v0[1] * v0[1]) + (v0[2] * v0[2] + v0[3] * v0[3]) + (v1[0] * v1[0] + v1[1] * v1[1]) + (v1[2] * v1[2] + v1[3] * v1[3]); }
                    ss += shx(ss, fq * 16 + fr, 16); ss += shx(ss, fq * 16 + fr, 32);
                    if (fq == 0 && (pn == 0 || hb == 0)) atomicAdd((pn == 0 ? ssq_q : ssq_kv) + row, (u64)(ss * 4294967296.0f));
                    if (krope) {
                        const f32x4 x1 = i2f4(acc[ai][NBJ == 2 ? 1 : 0][m][0]) * (c0[NBJ == 2 ? 1 : 0] * rsc), x2 = i2f4(acc[ai][NBJ == 2 ? 1 : 0][m][1]) * (c1[NBJ == 2 ? 1 : 0] * rsc);
                        const f32x4 c = cc[m], s = sn[m];
                        const f32x4 o1 = x1 * c - x2 * s, o2 = x2 * c + x1 * s;
                        u32x2 w1, w2; w1.x = cvt_pk(o1[0], o1[1]); w1.y = cvt_pk(o1[2], o1[3]); w2.x = cvt_pk(o2[0], o2[1]); w2.y = cvt_pk(o2[2], o2[3]);
                        *(u32x2*)(KR + (size_t)row * 32 + 4 * fq) = w1; *(u32x2*)(KR + (size_t)row * 32 + 16 + 4 * fq) = w2; }
                } else {
                    bf16* dst = (pn == 2 ? U : pn == 3 ? GV : pn == 4 ? ZX : GY) + (size_t)row * 256 + cl;
#pragma unroll
                    for (int bj = 0; bj < NBJ; ++bj) { f32x4 v0 = i2f4(acc[ai][bj][m][0]) * (c0[bj] * rsc), v1 = i2f4(acc[ai][bj][m][1]) * (c1[bj] * rsc);
                        if (pn != 4) { v0 = gelu4(v0); v1 = gelu4(v1); }
                        *(u32x4*)(dst + (bj + hb) * HALF) = pack8(v0, v1); }
                }
            }
        }
    }
};
struct EpiQ {
    static constexpr bool PERM = true;
    unsigned char* ws;
    template <int NBJ = 2> __device__ __forceinline__ void operator()(const AccT& acc, const Unit& u, int wr, int wc, int fr, int fq) const {
        bf16* Q = (bf16*)(ws + WS_Q); const u64* ssq = (const u64*)(ws + WS_SSQQ); const float *cosT = (const float*)(ws + WS_COS), *sinT = (const float*)(ws + WS_SIN);
        u64 sq[2][4];
#pragma unroll
        for (int ai = 0; ai < 2; ++ai)
#pragma unroll
            for (int m = 0; m < 4; ++m) sq[ai][m] = ssq[u.x0 * BM + ai * HALF + wr * 64 + m * 16 + fr];
        const bool rope = ((u.x1 * 8 + wc) % 3 == 2) || ((u.x1 * 8 + 4 + wc) % 3 == 2);
#pragma unroll
        for (int ai = 0; ai < 2; ++ai) {
            f32x4 cc[4], sn[4];
            if (rope) {
#pragma unroll
                for (int m = 0; m < 4; ++m) { const int pos = (u.x0 * BM + ai * HALF + wr * 64 + m * 16 + fr) & (SEQ - 1); cc[m] = *(const f32x4*)(cosT + pos * 16 + 4 * fq); sn[m] = *(const f32x4*)(sinT + pos * 16 + 4 * fq); } }
#pragma unroll
            for (int m = 0; m < 4; ++m) {
                const int row = u.x0 * BM + ai * HALF + wr * 64 + m * 16 + fr; const float sc = rstd_from(sq[ai][m], 1.0f / 256.0f) * QSCALE;
#pragma unroll
                for (int bj = 0; bj < 2; ++bj) {
                    const int c32 = u.x1 * 8 + bj * 4 + wc, head = c32 / 3, part = c32 - 3 * head;
                    const f32x4 v0 = acc[ai][bj][m][0] * sc, v1 = acc[ai][bj][m][1] * sc; bf16* dst = Q + (size_t)row * 768 + head * 96;
                    if (part < 2) *(u32x4*)(dst + part * 32 + 8 * fq) = pack8(v0, v1);
                    else { const f32x4 c = cc[m], s = sn[m];
                        const f32x4 o1 = v0 * c - v1 * s, o2 = v1 * c + v0 * s;
                        u32x2 w1, w2; w1.x = cvt_pk(o1[0], o1[1]); w1.y = cvt_pk(o1[2], o1[3]); w2.x = cvt_pk(o2[0], o2[1]); w2.y = cvt_pk(o2[2], o2[3]);
                        *(u32x2*)(dst + 64 + 4 * fq) = w1; *(u32x2*)(dst + 80 + 4 * fq) = w2; }
                }
            }
            asm volatile("" ::: "memory");
        }
    }
};
struct EpiK {
    static constexpr bool PERM = true;
    unsigned char* ws;
    template <int NBJ = 2> __device__ __forceinline__ void operator()(const AccT& acc, const Unit& u, int wr, int wc, int fr, int fq) const {
        bf16* KN = (bf16*)(ws + WS_KN); const u64* ssq = (const u64*)(ws + WS_SSQK);
        u64 sq[2][4];
#pragma unroll
        for (int ai = 0; ai < 2; ++ai)
#pragma unroll
            for (int m = 0; m < 4; ++m) sq[ai][m] = ssq[u.x0 * BM + ai * HALF + wr * 64 + m * 16 + fr];
#pragma unroll
        for (int ai = 0; ai < 2; ++ai)
#pragma unroll
            for (int m = 0; m < 4; ++m) {
                const int row = u.x0 * BM + ai * HALF + wr * 64 + m * 16 + fr; const float sc = rstd_from(sq[ai][m], 1.0f / 128.0f);
                bf16* dst = KN + (size_t)row * 512 + u.x1 * BM + wc * 32 + 8 * fq;
#pragma unroll
                for (int bj = 0; bj < 2; ++bj) *(u32x4*)(dst + bj * HALF) = pack8(acc[ai][bj][m][0] * sc, acc[ai][bj][m][1] * sc);
            }
    }
};
struct EpiVT {
    static constexpr bool PERM = true;
    unsigned char* ws;
    template <int NBJ = 2> __device__ __forceinline__ void operator()(const AccT& acc, const Unit& u, int wr, int wc, int fr, int fq) const {
        bf16* VT = (bf16*)(ws + WS_VT); const u64* ssq = (const u64*)(ws + WS_SSQK);
#pragma unroll
        for (int bj = 0; bj < 2; ++bj) {
            const int tk = u.x1 * BM + bj * HALF + wc * 32 + 8 * fq; f32x4 s0, s1;
#pragma unroll
            for (int e = 0; e < 4; ++e) { s0[e] = rstd_from(ssq[tk + e], 1.0f / 128.0f); s1[e] = rstd_from(ssq[tk + 4 + e], 1.0f / 128.0f); }
#pragma unroll
            for (int ai = 0; ai < 2; ++ai)
#pragma unroll
                for (int m = 0; m < 4; ++m) { const int vr = u.x0 * BM + ai * HALF + wr * 64 + m * 16 + fr;
                    *(u32x4*)(VT + (size_t)vr * M + tk) = pack8(acc[ai][bj][m][0] * s0, acc[ai][bj][m][1] * s1); }
        }
    }
};
struct EpiQKV {
    static constexpr bool PERM = true;
    unsigned char* ws;
    template <int NBJ = 2> __device__ __forceinline__ void operator()(const AccT& acc, const Unit& u, int wr, int wc, int fr, int fq) const {
        if (u.x2 == 0) { EpiQ e{ws}; e(acc, u, wr, wc, fr, fq); }
        else if (u.x2 == 1) { EpiK e{ws}; e(acc, u, wr, wc, fr, fq); }
        else { EpiVT e{ws}; e(acc, u, wr, wc, fr, fq); }
    }
};
}

namespace att {
constexpr int KP = 208, VP = 144;
constexpr int KT = 64 * KP, VTB = 64 * VP;
constexpr int LDS_NEED = 2 * KT + 2 * VTB;
constexpr float THR = 8.0f;
__device__ __forceinline__ float max3(float a, float b, float c) { return __builtin_fmaxf(__builtin_fmaxf(a, b), c); }
__device__ __forceinline__ float rowmax32(const f32x16& p0, const f32x16& p1) {
    float a = max3(p0[0], p0[1], p1[0]), b = max3(p0[2], p0[3], p1[1]); a = max3(a, p1[2], p1[3]);
#pragma unroll
    for (int r = 4; r < 16; r += 4) { a = max3(a, p0[r], p0[r + 1]); b = max3(b, p0[r + 2], p0[r + 3]); a = max3(a, p1[r], p1[r + 1]); b = max3(b, p1[r + 2], p1[r + 3]); }
    const float m = __builtin_fmaxf(a, b);
    auto rr = __builtin_amdgcn_permlane32_swap(__float_as_uint(m), __float_as_uint(m), false, false);
    return __builtin_fmaxf(__uint_as_float(rr[0]), __uint_as_float(rr[1]));
}
__device__ __forceinline__ void attn_unit(LAS unsigned char* lds, int b, int h, int qb, const bf16* __restrict__ Q, const bf16* __restrict__ KN, const bf16* __restrict__ KR, const bf16* __restrict__ VT, bf16* __restrict__ Y) {
    const int tid = opaque_tid(), lane = tid & 63, r32 = lane & 31, hi = lane >> 5, w = __builtin_amdgcn_readfirstlane(tid >> 6);
    const int mrow = b * SEQ + qb * 256 + w * 32 + r32;
    const int nt_wg = 4 * qb + 4, nt_w = 4 * qb + (w >> 1) + 1;
    bf16x8 qf[6];
#pragma unroll
    for (int s = 0; s < 6; ++s) qf[s] = *(const bf16x8*)(Q + (size_t)mrow * 768 + h * 96 + 16 * s + 8 * hi);
    f32x16 o0 = {}, o1 = {}; float mref = 0.f, lsum = 0.f;
    const int kr0 = tid / 12, kc0 = tid % 12, kr1 = (tid + 512) / 12, kc1 = (tid + 512) % 12; const bool k2 = tid < 256;
    const int vd = tid >> 3, vc = tid & 7;
    const bf16* kp0 = (kc0 < 8) ? KN + ((size_t)b * SEQ + kr0) * 512 + h * 64 + kc0 * 8 : KR + ((size_t)b * SEQ + kr0) * 32 + (kc0 - 8) * 8; const size_t ks0 = (kc0 < 8) ? 64 * 512 : 64 * 32;
    const bf16* kp1 = (kc1 < 8) ? KN + ((size_t)b * SEQ + kr1) * 512 + h * 64 + kc1 * 8 : KR + ((size_t)b * SEQ + kr1) * 32 + (kc1 - 8) * 8; const size_t ks1 = (kc1 < 8) ? 64 * 512 : 64 * 32;
    const bf16* vp = VT + (size_t)(h * 64 + vd) * M + (size_t)b * SEQ + vc * 8;
    const int kw0 = kr0 * KP + kc0 * 16, kw1 = kr1 * KP + kc1 * 16, vw = 2 * KT + vd * VP + (vc >> 1) * 32 + (vc & 1) * 8;
    u32x4 kgA0, kgA1, vgA, kgB0, kgB1, vgB;
#define AT_GLOADK(S, t) do { kg##S##0 = *(const u32x4*)(kp0 + (size_t)(t) * ks0); if (k2) kg##S##1 = *(const u32x4*)(kp1 + (size_t)(t) * ks1); } while (0)
#define AT_GLOADV(S, t) do { vg##S = *(const u32x4*)(vp + (size_t)(t) * 64); } while (0)
#define AT_WRITEK(S, buf) do { *(LAS u32x4*)(lds + (buf) * KT + kw0) = kg##S##0; if (k2) *(LAS u32x4*)(lds + (buf) * KT + kw1) = kg##S##1; } while (0)
#define AT_WRITEV(S, buf) do { *(LAS u32x2*)(lds + (buf) * VTB + vw) = (u32x2){vg##S.x, vg##S.y}; *(LAS u32x2*)(lds + (buf) * VTB + vw + 16) = (u32x2){vg##S.z, vg##S.w}; } while (0)
    const int kro = r32 * KP + 16 * hi, vro = 2 * KT + r32 * VP + 16 * hi;
#define AT_QK(P0, P1, kb_, CIN) do { const LAS unsigned char* kb__ = lds + (kb_) * KT + kro; \
        _Pragma("unroll") for (int s = 0; s < 6; ++s) { const bf16x8 ka0 = *(const LAS bf16x8*)(kb__ + 32 * s), ka1 = *(const LAS bf16x8*)(kb__ + 32 * KP + 32 * s); \
            if (s == 0) { P0 = __builtin_amdgcn_mfma_f32_32x32x16_bf16(ka0, qf[0], CIN, 0, 0, 0); P1 = __builtin_amdgcn_mfma_f32_32x32x16_bf16(ka1, qf[0], CIN, 0, 0, 0); } \
            else { P0 = __builtin_amdgcn_mfma_f32_32x32x16_bf16(ka0, qf[s], P0, 0, 0, 0); P1 = __builtin_amdgcn_mfma_f32_32x32x16_bf16(ka1, qf[s], P1, 0, 0, 0); } } } while (0)
    AT_GLOADK(A, 0); AT_GLOADV(A, 0); AT_WRITEK(A, 0); AT_WRITEV(A, 0); AT_GLOADK(A, 1); AT_WRITEK(A, 1);
    AT_GLOADK(B, 2); AT_GLOADV(B, 1);
    __syncthreads();
    f32x16 pA, pB, negm = {};
    AT_QK(pA, pB, 0, negm);
    float rm = rowmax32(pA, pB);
    mref = rm;
    f32x16 pA1 = pB;
    f32x16 pB1 = {};
#pragma unroll
    for (int r = 0; r < 16; ++r) { pA[r] -= rm; pA1[r] -= rm; negm[r] = -rm; }
    rm = 0.f;
    __syncthreads();
#define AT_STEP(C0, C1, N0, N1, t, LS, WS) do { \
        if ((t) + 3 < nt_wg) AT_GLOADK(LS, (t) + 3); \
        if ((t) + 2 < nt_wg) AT_GLOADV(LS, (t) + 2); \
        if ((t) < nt_w) { \
            if ((t) > 0 && __builtin_amdgcn_ballot_w64(rm > THR) != 0ull) {     \
                const float dl = __builtin_fmaxf(rm, 0.f), f = fexp2(-dl); mref += dl; lsum *= f; \
                _Pragma("unroll") for (int r = 0; r < 16; ++r) { C0[r] -= dl; C1[r] -= dl; o0[r] *= f; o1[r] *= f; negm[r] = -mref; } } \
            AT_QK(N0, N1, ((t) + 1) & 1, negm);                   \
            _Pragma("unroll") for (int r = 0; r < 16; ++r) { C0[r] = fexp2(C0[r]); C1[r] = fexp2(C1[r]); } \
            bf16x8 pb[4]; \
            _Pragma("unroll") for (int ks = 0; ks < 2; ++ks) { u32x4 wv, wx; \
                wv.x = cvt_pk(C0[8 * ks + 0], C0[8 * ks + 1]); wv.y = cvt_pk(C0[8 * ks + 2], C0[8 * ks + 3]); wv.z = cvt_pk(C0[8 * ks + 4], C0[8 * ks + 5]); wv.w = cvt_pk(C0[8 * ks + 6], C0[8 * ks + 7]); \
                wx.x = cvt_pk(C1[8 * ks + 0], C1[8 * ks + 1]); wx.y = cvt_pk(C1[8 * ks + 2], C1[8 * ks + 3]); wx.z = cvt_pk(C1[8 * ks + 4], C1[8 * ks + 5]); wx.w = cvt_pk(C1[8 * ks + 6], C1[8 * ks + 7]); \
                pb[ks] = __builtin_bit_cast(bf16x8, wv); pb[2 + ks] = __builtin_bit_cast(bf16x8, wx); } \
            { const LAS unsigned char* vb__ = lds + ((t) & 1) * VTB + vro; \
              _Pragma("unroll") for (int ks = 0; ks < 4; ++ks) { \
                const bf16x8 va0 = *(const LAS bf16x8*)(vb__ + 32 * ks), va1 = *(const LAS bf16x8*)(vb__ + 32 * VP + 32 * ks); \
                o0 = __builtin_amdgcn_mfma_f32_32x32x16_bf16(va0, pb[ks], o0, 0, 0, 0); o1 = __builtin_amdgcn_mfma_f32_32x32x16_bf16(va1, pb[ks], o1, 0, 0, 0); } } \
            { float sa = 0.f, sb = 0.f; \
              _Pragma("unroll") for (int r = 0; r < 16; r += 2) { sa += C0[r] + C1[r]; sb += C0[r + 1] + C1[r + 1]; } \
              lsum += sa + sb; } \
            rm = rowmax32(N0, N1); \
              \
            __builtin_amdgcn_sched_group_barrier(0x100, 5, 0);     \
            _Pragma("unroll") for (int g_ = 0; g_ < 12; ++g_) { __builtin_amdgcn_sched_group_barrier(0x008, 1, 0); __builtin_amdgcn_sched_group_barrier(0x100, 1, 0); __builtin_amdgcn_sched_group_barrier(0x402, 4, 0); } \
            _Pragma("unroll") for (int g_ = 0; g_ < 8; ++g_) { __builtin_amdgcn_sched_group_barrier(0x008, 1, 0); __builtin_amdgcn_sched_group_barrier(0x100, 1, 0); __builtin_amdgcn_sched_group_barrier(0x402, 6, 0); } \
        } \
        if ((t) + 2 < nt_wg) AT_WRITEK(WS, (t) & 1); \
        if ((t) + 1 < nt_wg) AT_WRITEV(WS, ((t) + 1) & 1); \
        __syncthreads(); \
    } while (0)
    for (int t = 0; t < nt_wg; t += 2) {
        AT_STEP(pA, pA1, pB, pB1, t, A, B);
        AT_STEP(pB, pB1, pA, pA1, t + 1, B, A);
    }
#undef AT_STEP
#undef AT_QK
#undef AT_GLOADK
#undef AT_GLOADV
#undef AT_WRITEK
#undef AT_WRITEV
    float ltot = lsum; { auto rr = __builtin_amdgcn_permlane32_swap(__float_as_uint(lsum), __float_as_uint(lsum), false, false); ltot = __uint_as_float(rr[0]) + __uint_as_float(rr[1]); }
    const float inv = 1.0f / ltot;
    bf16* yrow = Y + (size_t)mrow * D + h * 64 + 4 * hi;
#pragma unroll
    for (int i = 0; i < 4; ++i) {
        u32x2 w0, w1; w0.x = cvt_pk(o0[4 * i] * inv, o0[4 * i + 1] * inv); w0.y = cvt_pk(o0[4 * i + 2] * inv, o0[4 * i + 3] * inv);
        w1.x = cvt_pk(o1[4 * i] * inv, o1[4 * i + 1] * inv); w1.y = cvt_pk(o1[4 * i + 2] * inv, o1[4 * i + 3] * inv);
        *(u32x2*)(yrow + 8 * i) = w0; *(u32x2*)(yrow + 32 + 8 * i) = w1;
    }
}
}

namespace sgu {
constexpr int VTP = 272;
constexpr int LDS_NEED = 128 * VTP;
__device__ __forceinline__ void unit(LAS unsigned char* lds, int m0, int gh, const bf16* __restrict__ GV, const bf16* __restrict__ U, const bf16* __restrict__ WS, const float* __restrict__ ln_g, const float* __restrict__ ln_b, const float* __restrict__ sb, bf16* __restrict__ Y) {
    const int tid = opaque_tid(), lane = tid & 63, r32 = lane & 31, hi = lane >> 5, w = __builtin_amdgcn_readfirstlane(tid >> 6);
    {
        const int cg = lane & 15, rsub = lane >> 4; const bool mine = (cg >> 3) == gh; const int cl = 16 * (cg & 7);
        f32x4 gq[4], bq[4];
#pragma unroll
        for (int q = 0; q < 4; ++q) { gq[q] = *(const f32x4*)(ln_g + 16 * cg + 4 * q); bq[q] = *(const f32x4*)(ln_b + 16 * cg + 4 * q); }
#pragma unroll
        for (int it = 0; it < 4; ++it) {
            const int s = w * 16 + it * 4 + rsub; const u32x4 r0 = *(const u32x4*)(GV + (size_t)(m0 + s) * 256 + 16 * cg), r1 = *(const u32x4*)(GV + (size_t)(m0 + s) * 256 + 16 * cg + 8);
            f32x4 x[4] = {{bflo(r0.x), bfhi(r0.x), bflo(r0.y), bfhi(r0.y)}, {bflo(r0.z), bfhi(r0.z), bflo(r0.w), bfhi(r0.w)}, {bflo(r1.x), bfhi(r1.x), bflo(r1.y), bfhi(r1.y)}, {bflo(r1.z), bfhi(r1.z), bflo(r1.w), bfhi(r1.w)}};
            float sm = 0.f;
#pragma unroll
            for (int q = 0; q < 4; ++q) sm += (x[q][0] + x[q][1]) + (x[q][2] + x[q][3]);
#pragma unroll
            for (int o = 1; o < 16; o <<= 1) sm += shx(sm, lane, o);
            const float mean = sm * (1.0f / 256.0f); float sq = 0.f;
#pragma unroll
            for (int q = 0; q < 4; ++q) { x[q] = x[q] - mean; sq += (x[q][0] * x[q][0] + x[q][1] * x[q][1]) + (x[q][2] * x[q][2] + x[q][3] * x[q][3]); }
#pragma unroll
            for (int o = 1; o < 16; o <<= 1) sq += shx(sq, lane, o);
            const float rstd = __builtin_amdgcn_rsqf(sq * (1.0f / 256.0f) + 1e-5f);
            if (mine) {
#pragma unroll
                for (int q = 0; q < 4; ++q) { const f32x4 y = x[q] * rstd * gq[q] + bq[q];
#pragma unroll
                    for (int e = 0; e < 4; ++e) *(LAS bf16*)(lds + (cl + 4 * q + e) * VTP + s * 2) = (bf16)(cvt_pk(y[e], 0.f) & 0xffffu); } }
        }
    }
    __syncthreads();
    const int gl = w >> 2, g = 2 * gh + gl, T = w & 3, nks = 2 * (T + 1);
    const bf16* wrow = WS + ((size_t)g * 128 + 32 * T + r32) * 128 + 8 * hi;
    bf16x8 af[8];
#pragma unroll
    for (int ks = 0; ks < 8; ++ks) af[ks] = (ks < nks) ? *(const bf16x8*)(wrow + 16 * ks) : (bf16x8){0, 0, 0, 0, 0, 0, 0, 0};
    f32x16 acc[2] = {};
#pragma unroll
    for (int ks = 0; ks < 8; ++ks) if (ks < nks) {
#pragma unroll
        for (int cb = 0; cb < 2; ++cb) { const bf16x8 bv = *(const LAS bf16x8*)(lds + (gl * 64 + 32 * cb + r32) * VTP + (16 * ks + 8 * hi) * 2);
            acc[cb] = __builtin_amdgcn_mfma_f32_32x32x16_bf16(af[ks], bv, acc[cb], 0, 0, 0); } }
    {
        constexpr int SP = 144;
        LAS unsigned char* sc = lds + 40960 + w * (32 * SP);
        const bf16* urow = U + (size_t)(m0 + 32 * T) * 256 + g * 64; bf16* yrow = Y + (size_t)(m0 + 32 * T) * D + 512 + g * 64;
#pragma unroll
        for (int i = 0; i < 4; ++i) { const int t = i * 8 + (lane >> 3), ch = lane & 7; *(LAS u32x4*)(sc + t * SP + ch * 16) = *(const u32x4*)(urow + (size_t)t * 256 + ch * 8); }
        float bv[16];
#pragma unroll
        for (int r = 0; r < 16; ++r) bv[r] = sb[g * 128 + 32 * T + (r & 3) + 8 * (r >> 2) + 4 * hi];
        asm volatile("" ::: "memory");
#pragma unroll
        for (int cb = 0; cb < 2; ++cb)
#pragma unroll
            for (int r = 0; r < 16; ++r) { const int t = (r & 3) + 8 * (r >> 2) + 4 * hi; LAS bf16* p = (LAS bf16*)(sc + t * SP + (32 * cb + r32) * 2);
                const float y = bf2f(*p) * (acc[cb][r] + bv[r]); *p = (bf16)(cvt_pk(y, 0.f) & 0xffffu); }
        asm volatile("" ::: "memory");
#pragma unroll
        for (int i = 0; i < 4; ++i) { const int t = i * 8 + (lane >> 3), ch = lane & 7; *(u32x4*)(yrow + (size_t)t * D + ch * 8) = *(const LAS u32x4*)(sc + t * SP + ch * 16); }
    }
    __syncthreads();
}
}

namespace lru {
constexpr int XP = 528;
constexpr int AP = 132;
constexpr int OFF_A = 64 * XP, OFF_B = OFF_A + 64 * AP * 4, LDS_NEED = OFF_B + 64 * AP * 4;
__device__ __forceinline__ void local_unit(LAS unsigned char* lds, int b, int c, const bf16* ZX, const float* conv_w, const float* conv_b, const bf16* WA, const bf16* WX,
                                           const float* ba, const float* bx, const float* lam, float* HL, float* PP) {
    const int tid = opaque_tid(), lane = tid & 63, r32 = lane & 31, hi = lane >> 5, w = __builtin_amdgcn_readfirstlane(tid >> 6);
    const int m0 = b * SEQ + c * 64;
    {
        const int cp = tid & 127, tq = tid >> 7, ch = 2 * cp;
        float w0[4], w1[4];
#pragma unroll
        for (int k = 0; k < 4; ++k) { w0[k] = conv_w[k * 256 + ch]; w1[k] = conv_w[k * 256 + ch + 1]; }
        const float cb0 = conv_b[ch], cb1 = conv_b[ch + 1];
        float z0[3], z1[3];
#pragma unroll
        for (int k = 0; k < 3; ++k) { const int tt = c * 64 + tq * 16 - 3 + k; unsigned raw = 0u; if (tt >= 0) raw = *(const unsigned*)(ZX + (size_t)(b * SEQ + tt) * 256 + ch); z0[k] = bflo(raw); z1[k] = bfhi(raw); }
#pragma unroll
        for (int i = 0; i < 16; ++i) { const int t = tq * 16 + i; const unsigned raw = *(const unsigned*)(ZX + (size_t)(m0 + t) * 256 + ch); const float a0 = bflo(raw), a1 = bfhi(raw);
            const float x0 = cb0 + z0[0] * w0[0] + z0[1] * w0[1] + z0[2] * w0[2] + a0 * w0[3], x1 = cb1 + z1[0] * w1[0] + z1[1] * w1[1] + z1[2] * w1[2] + a1 * w1[3];
            *(LAS unsigned*)(lds + t * XP + ch * 2) = cvt_pk(x0, x1);
            z0[0] = z0[1]; z0[1] = z0[2]; z0[2] = a0; z1[0] = z1[1]; z1[1] = z1[2]; z1[2] = a1; }
    }
    __syncthreads();
    LAS float* A32 = (LAS float*)(lds + OFF_A); LAS float* B32 = (LAS float*)(lds + OFF_B);
    for (int half = 0; half < 2; ++half) {
        {
            const int head = 2 * half + (w >> 2), tb = (w >> 1) & 1, jb = w & 1;
            f32x16 ar = {}, ai = {};
            bf16x8 wa[4], wx[4];
#pragma unroll
            for (int ks = 0; ks < 4; ++ks) { wa[ks] = *(const bf16x8*)(WA + ((size_t)head * 64 + 32 * jb + r32) * 64 + 16 * ks + 8 * hi); wx[ks] = *(const bf16x8*)(WX + ((size_t)head * 64 + 32 * jb + r32) * 64 + 16 * ks + 8 * hi); }
#pragma unroll
            for (int ks = 0; ks < 4; ++ks) {
                const bf16x8 xa = *(const LAS bf16x8*)(lds + (32 * tb + r32) * XP + (head * 64 + 16 * ks + 8 * hi) * 2);
                ar = __builtin_amdgcn_mfma_f32_32x32x16_bf16(xa, wa[ks], ar, 0, 0, 0); ai = __builtin_amdgcn_mfma_f32_32x32x16_bf16(xa, wx[ks], ai, 0, 0, 0);
            }
            const int ch = head * 64 + 32 * jb + r32, chl = ch - 128 * half;
            const float bav = ba[ch], bxv = bx[ch], lm = lam[ch];
            const float nsp = -8.0f * (fmaxf(-lm, 0.f) + log1pf(__expf(-fabsf(lm))));
#pragma unroll
            for (int r = 0; r < 16; ++r) { const int t = 32 * tb + (r & 3) + 8 * (r >> 2) + 4 * hi;
                const float rg = sigmoidf_(ar[r] + bav), ig = sigmoidf_(ai[r] + bxv), la = rg * nsp;
                const float x2 = 2.0f * la;
                const float a = __expf(la);
                const float om = (x2 > -0.25f) ? -x2 * (1.0f + x2 * (0.5f + x2 * (0.16666667f + x2 * (0.041666668f + x2 * (0.0083333338f + x2 * 0.0013888889f))))) : 1.0f - a * a;
                const float s = sqrtf(fmaxf(om, 0.f));
                const float xc = bf2f(*(const LAS bf16*)(lds + t * XP + ch * 2));
                A32[t * AP + chl] = a; B32[t * AP + chl] = s * (ig * xc); }
        }
        __syncthreads();
        {
            const int chs = tid & 127, seg = tid >> 7; LAS float* sum = (LAS float*)(lds + LDS_NEED);
            float av[16], bv[16];
#pragma unroll
            for (int i = 0; i < 16; ++i) { av[i] = A32[(16 * seg + i) * AP + chs]; bv[i] = B32[(16 * seg + i) * AP + chs]; }
            float hh = 0.f, pp = 1.f;
#pragma unroll
            for (int i = 0; i < 16; ++i) { hh = av[i] * hh + bv[i]; pp *= av[i]; bv[i] = hh; av[i] = pp; }
            sum[(seg * 2) * 128 + chs] = hh; sum[(seg * 2 + 1) * 128 + chs] = pp;
            __syncthreads();
            float Hin = 0.f, Pin = 1.f;
#pragma unroll
            for (int s = 0; s < 3; ++s) if (s < seg) { const float hs = sum[(s * 2) * 128 + chs], ps = sum[(s * 2 + 1) * 128 + chs]; Hin = ps * Hin + hs; Pin *= ps; }
            float* hl = HL + (size_t)(m0 + 16 * seg) * 256 + 128 * half + chs; float* pq = PP + (size_t)(m0 + 16 * seg) * 256 + 128 * half + chs;
#pragma unroll
            for (int i = 0; i < 16; ++i) { hl[(size_t)i * 256] = bv[i] + av[i] * Hin; pq[(size_t)i * 256] = av[i] * Pin; }
        }
        __syncthreads();
    }
}
__device__ __forceinline__ void fix_unit(LAS unsigned char* lds, int b, int c, const float* __restrict__ HL, const float* __restrict__ PP, const bf16* __restrict__ GY, bf16* __restrict__ Y) {
    const int tid = opaque_tid(); const int m0 = b * SEQ + c * 64; LAS float* hin = (LAS float*)lds;
    {
        const int ch = tid & 255, half = tid >> 8, c0 = half ? (c >> 1) : 0, c1 = half ? c : (c >> 1);
        float h = 0.f, pa = 1.f; const float* pq = PP + (size_t)(b * SEQ + 63) * 256 + ch; const float* hq = HL + (size_t)(b * SEQ + 63) * 256 + ch;
        int cc = c0;
        for (; cc + 8 <= c1; cc += 8) { float pv[8], hv[8];
#pragma unroll
            for (int j = 0; j < 8; ++j) { pv[j] = pq[(size_t)(cc + j) * 64 * 256]; hv[j] = hq[(size_t)(cc + j) * 64 * 256]; }
#pragma unroll
            for (int j = 0; j < 8; ++j) { h = pv[j] * h + hv[j]; pa *= pv[j]; } }
        for (; cc < c1; ++cc) { const float pv = pq[(size_t)cc * 64 * 256]; h = pv * h + hq[(size_t)cc * 64 * 256]; pa *= pv; }
        if (half) { hin[256 + ch] = h; hin[512 + ch] = pa; }
        __syncthreads();
        if (!half) hin[ch] = hin[512 + ch] * h + hin[256 + ch];
    }
    __syncthreads();
#pragma unroll
    for (int k = 0; k < 8; ++k) { const int item = tid + 512 * k, t = item >> 6, cg = item & 63; const size_t mo = (size_t)(m0 + t) * 256 + 4 * cg;
        const f32x4 hl = *(const f32x4*)(HL + mo), pp = *(const f32x4*)(PP + mo), hi4 = *(const LAS f32x4*)(hin + 4 * cg); const u32x2 gy = *(const u32x2*)(GY + mo);
        const f32x4 hv = hl + pp * hi4; u32x2 o; o.x = cvt_pk(hv[0] * bflo(gy.x), hv[1] * bfhi(gy.x)); o.y = cvt_pk(hv[2] * bflo(gy.y), hv[3] * bfhi(gy.y));
        *(u32x2*)(Y + (size_t)(m0 + t) * D + 768 + 4 * cg) = o; }
    __syncthreads();
}
}

struct MoeOrder {
    static constexpr bool GATHER = false;
    const volatile LAS int* tab; int npn, G, c, lim;
    __device__ __forceinline__ bool next_tail(pg8::Unit& u) const { const int L = lim + (c >> 1); if (L >= __builtin_amdgcn_readfirstlane(tab[24]) * npn) return false; map(L, u); u.co = (c & 1) * pg8::HALF; return true; }
    __device__ __forceinline__ bool next(int i, pg8::Unit& u) const {
        const int L = i * G + c, TT = __builtin_amdgcn_readfirstlane(tab[24]); if (L >= TT * npn || L >= lim) return false;
        map(L, u); return true; }
    __device__ __forceinline__ void map(int L, pg8::Unit& u) const {
        const int ti = L / npn, pnl = L - ti * npn; int e = 0;
#pragma unroll
        for (int j = 1; j < 8; ++j) e += (ti >= tab[16 + j]) ? 1 : 0;
        e = __builtin_amdgcn_readfirstlane(e);
        const int lt = ti - __builtin_amdgcn_readfirstlane(tab[16 + e]);
        u.pm = ti; u.pn = e * npn + pnl; u.x0 = ti; u.x1 = pnl; u.x2 = e * ECAP + lt * 256; u.x3 = __builtin_amdgcn_readfirstlane(tab[32 + e]) - lt * 256; u.co = 0;
    }
    __device__ __forceinline__ int src_row(const pg8::Unit&, int) const { return 0; }
};
struct MoeGatherOrder : MoeOrder {
    static constexpr bool GATHER = true;
    const int* idx;
    __device__ __forceinline__ int src_row(const pg8::Unit& u, int r) const { return (r < u.x3) ? idx[u.x2 + r] : 0; }
};

struct RowArgs {
    const float* xin; float* X; bf16* Xb; const bf16* Ysrc; const bf16* YD;     const int* slot; const float* gatew;
    const float* gate; const float* postg;
    const float* preg; const float* sc; const float* sh;
    bf16* H; const float* router; unsigned* cursor; int* idx; int* slot_w; float* gatew_w; u64* ssq_q; u64* ssq_kv; float* rs; float* rss;
};
template <int MODE>
__device__ __forceinline__ void row_phase(LAS unsigned char* lds, const volatile LAS int* tab, int vcu, const RowArgs& a, bool need_h, bool route) {
    const int tid = opaque_tid(), lane = tid & 63, w = __builtin_amdgcn_readfirstlane(tid >> 6);
    LAS float* rt = (LAS float*)lds; LAS int* e01 = (LAS int*)(lds + 32768); LAS float* rsl = (LAS float*)(lds + 32768 + 256);
    if (route) { for (int i = tid; i < 8192; i += 512) rt[(i & 7) * 1024 + (i >> 3)] = a.router[i]; __syncthreads(); }
    f32x4 cg[4], cb[4], cs[4];
#pragma unroll
#define RC(j) (512 * ((j) >> 1) + 8 * lane + 4 * ((j) & 1))
    for (int j = 0; j < 4; ++j) { const int col = RC(j);
        if (MODE != 0) cg[j] = *(const f32x4*)(a.gate + col) * *(const f32x4*)(a.postg + col);
        if (need_h) { cb[j] = *(const f32x4*)(a.preg + col) * (*(const f32x4*)(a.sc + col) + 1.0f); cs[j] = *(const f32x4*)(a.sh + col); } }
    const int row0 = vcu * 64 + w * 8;
    int slotv0 = 0, slotv1 = 0; float gv0 = 0.f, gv1 = 0.f;
    if (MODE == 3) { const int rr = row0 + (lane & 7); slotv0 = a.slot[rr * 2]; slotv1 = a.slot[rr * 2 + 1]; gv0 = a.gatew[rr * 2]; gv1 = a.gatew[rr * 2 + 1]; }
    f32x4 nx0[2][4]; u32x4 nxb[2][2], nyp[2][2], nyq[2][2];
#define ROW_LOAD(S, rw, ii) do { \
        if (MODE == 0) { _Pragma("unroll") for (int j = 0; j < 4; ++j) nx0[S][j] = __builtin_nontemporal_load((const f32x4*)(a.xin + (size_t)(rw) * D + RC(j))); } \
        else { _Pragma("unroll") for (int jj = 0; jj < 2; ++jj) nxb[S][jj] = __builtin_nontemporal_load((const u32x4*)(a.Xb + (size_t)(rw) * D + 512 * jj + 8 * lane)); } \
        if (MODE == 3) { const int s0_ = __builtin_amdgcn_readlane(slotv0, (ii)), s1_ = __builtin_amdgcn_readlane(slotv1, (ii)); \
            const size_t r0_ = (size_t)tab[16 + (s0_ >> 14)] * 256 + (s0_ & (ECAP - 1)), r1_ = (size_t)tab[16 + (s1_ >> 14)] * 256 + (s1_ & (ECAP - 1)); \
            _Pragma("unroll") for (int jj = 0; jj < 2; ++jj) { nyp[S][jj] = __builtin_nontemporal_load((const u32x4*)(a.YD + r0_ * D + 512 * jj + 8 * lane)); nyq[S][jj] = __builtin_nontemporal_load((const u32x4*)(a.YD + r1_ * D + 512 * jj + 8 * lane)); } } \
        else if (MODE != 0) { _Pragma("unroll") for (int jj = 0; jj < 2; ++jj) nyp[S][jj] = __builtin_nontemporal_load((const u32x4*)(a.Ysrc + (size_t)(rw) * D + 512 * jj + 8 * lane)); } } while (0)
    ROW_LOAD(0, row0, 0); ROW_LOAD(1, row0 + 1, 1);
#pragma unroll
    for (int i = 0; i < 8; ++i) {
        const int row = row0 + i; constexpr int dummy_ = 0; (void)dummy_;
        f32x4 x[4]; u32x2 yp[4], yq[4];
#pragma unroll
        for (int jj = 0; jj < 2; ++jj) {
            if (MODE == 0) { x[2 * jj] = nx0[i & 1][2 * jj]; x[2 * jj + 1] = nx0[i & 1][2 * jj + 1]; }
            else { const u32x4 q_ = nxb[i & 1][jj]; x[2 * jj] = (f32x4){bflo(q_.x), bfhi(q_.x), bflo(q_.y), bfhi(q_.y)}; x[2 * jj + 1] = (f32x4){bflo(q_.z), bfhi(q_.z), bflo(q_.w), bfhi(q_.w)}; }
            yp[2 * jj] = (u32x2){nyp[i & 1][jj].x, nyp[i & 1][jj].y}; yp[2 * jj + 1] = (u32x2){nyp[i & 1][jj].z, nyp[i & 1][jj].w}; yq[2 * jj] = (u32x2){nyq[i & 1][jj].x, nyq[i & 1][jj].y}; yq[2 * jj + 1] = (u32x2){nyq[i & 1][jj].z, nyq[i & 1][jj].w}; }
        if (i + 2 < 8) { if (i & 1) ROW_LOAD(1, row + 2, i + 2); else ROW_LOAD(0, row + 2, i + 2); }
        if (MODE != 0) {
            f32x4 y[4];
            if (MODE == 3) {
                const float g0 = __builtin_bit_cast(float, __builtin_amdgcn_readlane(__builtin_bit_cast(int, gv0), i)), g1 = __builtin_bit_cast(float, __builtin_amdgcn_readlane(__builtin_bit_cast(int, gv1), i));
#pragma unroll
                for (int j = 0; j < 4; ++j) y[j] = (f32x4){bflo(yp[j].x), bfhi(yp[j].x), bflo(yp[j].y), bfhi(yp[j].y)} * g0 + (f32x4){bflo(yq[j].x), bfhi(yq[j].x), bflo(yq[j].y), bfhi(yq[j].y)} * g1;
            } else {
#pragma unroll
                for (int j = 0; j < 4; ++j) y[j] = (f32x4){bflo(yp[j].x), bfhi(yp[j].x), bflo(yp[j].y), bfhi(yp[j].y)};
            }
            float ss = 0.f;
#pragma unroll
            for (int j = 0; j < 4; ++j) ss += (y[j][0] * y[j][0] + y[j][1] * y[j][1]) + (y[j][2] * y[j][2] + y[j][3] * y[j][3]);
            const float r = __builtin_amdgcn_rsqf(wave_sum_dpp(ss) * (1.0f / D) + 1e-6f);
#pragma unroll
            for (int j = 0; j < 4; ++j) x[j] = x[j] + cg[j] * (y[j] * r);
        }
        if (a.X) {
#pragma unroll
            for (int j = 0; j < 4; ++j) *(f32x4*)(a.X + (size_t)row * D + RC(j)) = x[j];
        } else {
#pragma unroll
            for (int jj = 0; jj < 2; ++jj) __builtin_nontemporal_store(pg8::pack8(x[2 * jj], x[2 * jj + 1]), (u32x4*)(a.Xb + (size_t)row * D + 512 * jj + 8 * lane)); }
        if (need_h) {
            float ss = 0.f;
#pragma unroll
            for (int j = 0; j < 4; ++j) ss += (x[j][0] * x[j][0] + x[j][1] * x[j][1]) + (x[j][2] * x[j][2] + x[j][3] * x[j][3]);
            const float r = __builtin_amdgcn_rsqf(wave_sum_dpp(ss) * (1.0f / D) + 1e-6f);
            f32x4 hv[4];
#pragma unroll
            for (int j = 0; j < 4; ++j) hv[j] = (x[j] * r) * cb[j] + cs[j];
            float qinv = 0.f;
            {
                float am = 0.f;
#pragma unroll
                for (int j = 0; j < 4; ++j) am = __builtin_fmaxf(am, __builtin_fmaxf(__builtin_fmaxf(__builtin_fabsf(hv[j][0]), __builtin_fabsf(hv[j][1])), __builtin_fmaxf(__builtin_fabsf(hv[j][2]), __builtin_fabsf(hv[j][3]))));
                am = __builtin_fmaxf(wave_max_dpp(am), 1e-30f); qinv = 127.0f / am;
                if (lane == 0) { const float s = am * (1.0f / 127.0f); a.rs[row] = s; if (route) rsl[w * 8 + i] = s; } }
#pragma unroll
            for (int jj = 0; jj < 2; ++jj) {
                u32x2 o; o.x = pg8::pk4_i8(hv[2 * jj] * qinv); o.y = pg8::pk4_i8(hv[2 * jj + 1] * qinv); *(u32x2*)((unsigned char*)a.H + (size_t)row * D + 512 * jj + 8 * lane) = o; }
            if (route) {
                float pe[8];
#pragma unroll
                for (int e = 0; e < 8; ++e) { float p = 0.f;
#pragma unroll
                    for (int j = 0; j < 4; ++j) { const f32x4 rv = *(const LAS f32x4*)(rt + e * 1024 + RC(j)); p += (hv[j][0] * rv[0] + hv[j][1] * rv[1]) + (hv[j][2] * rv[2] + hv[j][3] * rv[3]); }
                    pe[e] = p; }
                float q4[4], q2[2], q1;
                { const bool up = (lane & 32) != 0;
#pragma unroll
                  for (int j = 0; j < 4; ++j) { const float keep = up ? pe[4 + j] : pe[j], give = up ? pe[j] : pe[4 + j]; q4[j] = keep + shx(give, lane, 32); } }
                { const bool up = (lane & 16) != 0;
#pragma unroll
                  for (int j = 0; j < 2; ++j) { const float keep = up ? q4[2 + j] : q4[j], give = up ? q4[j] : q4[2 + j]; q2[j] = keep + shx(give, lane, 16); } }
                { const bool up = (lane & 8) != 0; const float keep = up ? q2[1] : q2[0], give = up ? q2[0] : q2[1]; q1 = keep + shx(give, lane, 8); }
                q1 += shx(q1, lane, 4); q1 += shx(q1, lane, 2); q1 += shx(q1, lane, 1);
                float lg[8];
#pragma unroll
                for (int e = 0; e < 8; ++e) lg[e] = __builtin_bit_cast(float, __builtin_amdgcn_readlane(__builtin_bit_cast(int, q1), 8 * e));
                int e0 = 0; float v0 = lg[0];
#pragma unroll
                for (int e = 1; e < 8; ++e) if (lg[e] > v0) { v0 = lg[e]; e0 = e; }
                int e1 = -1; float v1 = -3.0e38f;
#pragma unroll
                for (int e = 0; e < 8; ++e) if (e != e0 && lg[e] > v1) { v1 = lg[e]; e1 = e; }
                const float g0 = 1.0f / (1.0f + __expf(v1 - v0)), g1 = 1.0f - g0;
                if (lane == 0) { e01[w * 8 + i] = e0 | (e1 << 8); a.gatew_w[row * 2] = g0; a.gatew_w[row * 2 + 1] = g1; }
            }
        }
        if (MODE == 1 && lane == 0) { a.ssq_q[row] = 0ull; a.ssq_kv[row] = 0ull; }
    }
    if (route) {
        __syncthreads();
        if (w == 0) {
            const int pk = e01[lane], e0 = pk & 255, e1 = pk >> 8, token = vcu * 64 + lane; const u64 lt = (1ull << lane) - 1ull;
            int p0 = 0, p1 = 0, mycnt = 0;
#pragma unroll
            for (int e = 0; e < 8; ++e) {
                const u64 m0 = __ballot(e0 == e), m1 = __ballot(e1 == e); const int c0 = __popcll(m0), c1 = __popcll(m1);
                if (lane == e) mycnt = c0 + c1;
                if (e0 == e) p0 = __popcll(m0 & lt);
                if (e1 == e) p1 = c0 + __popcll(m1 & lt);
            }
            unsigned mybase = 0u; if (lane < 8 && mycnt > 0) mybase = atomicAdd(a.cursor + lane, (unsigned)mycnt);
#pragma unroll
            for (int e = 0; e < 8; ++e) { const int base = __builtin_amdgcn_readlane((int)mybase, e); if (e0 == e) p0 += base; if (e1 == e) p1 += base; }
            a.idx[e0 * ECAP + p0] = token; a.idx[e1 * ECAP + p1] = token;
            a.slot_w[token * 2] = e0 * ECAP + p0; a.slot_w[token * 2 + 1] = e1 * ECAP + p1;
            { const float s = rsl[lane]; a.rss[e0 * ECAP + p0] = s; a.rss[e1 * ECAP + p1] = s; }
        }
        __syncthreads();
    }
}

__device__ __forceinline__ int rperm(int jj) { return 8 * ((jj & 15) >> 2) + 4 * (jj >> 4) + (jj & 3); }
__device__ __forceinline__ int map_row(int kind, int n) {
    if (kind == 1) return 256 * (n >> 7) + (n & 127);
    if (kind == 2) return 256 * (n >> 7) + 128 + (n & 127);
    if (kind == 3) return n < 384 ? n : (n < 416 ? 384 + rperm(n - 384) : n + 96);
    if (kind == 4) { const int h = n / 96, j = n - 96 * h; return j < 64 ? n : h * 96 + 64 + rperm(j - 64); }
    return n;
}
template <bool F8 = false>
__device__ __forceinline__ void tr_item(const float* W, int ldn, void* WTv, int ldk, const float* gain, int kind, LAS float* scr, int kb, int nb, int lane) {
    const int k0 = 64 * kb, n0 = 32 * nb;
#pragma unroll
    for (int i = 0; i < 32; ++i) { const int kk = 2 * i + (lane >> 5); float v = __builtin_nontemporal_load(W + (size_t)(k0 + kk) * ldn + n0 + (lane & 31)); if (gain) v *= gain[k0 + kk]; scr[kk * 33 + (lane & 31)] = v; }
    LDS_WAIT(); asm volatile("" ::: "memory");
    const int c = lane & 7;
#pragma unroll
    for (int j = 0; j < 4; ++j) { const int n = (lane >> 3) + 8 * j; const LAS float* s = scr + (8 * c) * 33 + n;
        if constexpr (F8) { u32x2 o; o.x = pg8::pk4_fp8((f32x4){s[0 * 33], s[1 * 33], s[2 * 33], s[3 * 33]} * pg8::F8_WSC); o.y = pg8::pk4_fp8((f32x4){s[4 * 33], s[5 * 33], s[6 * 33], s[7 * 33]} * pg8::F8_WSC);
            *(u32x2*)((unsigned char*)WTv + (size_t)map_row(kind, n0 + n) * ldk + k0 + 8 * c) = o; }
        else { bf16* WT = (bf16*)WTv; u32x4 o; o.x = cvt_pk(s[0 * 33], s[1 * 33]); o.y = cvt_pk(s[2 * 33], s[3 * 33]); o.z = cvt_pk(s[4 * 33], s[5 * 33]); o.w = cvt_pk(s[6 * 33], s[7 * 33]);
            *(u32x4*)(WT + (size_t)map_row(kind, n0 + n) * ldk + k0 + 8 * c) = o; } }
    LDS_WAIT(); asm volatile("" ::: "memory");
}
__device__ __forceinline__ void colq_item(const float* W, int ldn, unsigned char* WT, float* CS, int kind, int nb, LAS float* red, int tid) {
    const int lane = tid & 63, w = tid >> 6, n = lane & 31, kh = lane >> 5, kb = 128 * w + 64 * kh;
    const float* src = W + (size_t)kb * ldn + nb * 32 + n;
    float v[64];
#pragma unroll
    for (int j = 0; j < 64; ++j) v[j] = __builtin_nontemporal_load(src + (size_t)j * ldn);
    float m = 0.f;
#pragma unroll
    for (int j = 0; j < 64; ++j) m = __builtin_fmaxf(m, __builtin_fabsf(v[j]));
    m = __builtin_fmaxf(m, shx(m, lane, 32));
    if (kh == 0) red[w * 32 + n] = m;
    __syncthreads();
    float cm = red[n];
#pragma unroll
    for (int ww = 1; ww < 8; ++ww) cm = __builtin_fmaxf(cm, red[ww * 32 + n]);
    cm = __builtin_fmaxf(cm, 1e-30f);
    const float inv = 127.0f / cm; const int row = map_row(kind, nb * 32 + n);
    if (w == 0 && kh == 0) CS[row] = cm * (1.0f / 127.0f);
    unsigned char* dst = WT + (size_t)row * 1024 + kb;
#pragma unroll
    for (int c = 0; c < 4; ++c) { u32x4 o;
        o.x = pg8::pk4_i8((f32x4){v[16 * c + 0], v[16 * c + 1], v[16 * c + 2], v[16 * c + 3]} * inv); o.y = pg8::pk4_i8((f32x4){v[16 * c + 4], v[16 * c + 5], v[16 * c + 6], v[16 * c + 7]} * inv);
        o.z = pg8::pk4_i8((f32x4){v[16 * c + 8], v[16 * c + 9], v[16 * c + 10], v[16 * c + 11]} * inv); o.w = pg8::pk4_i8((f32x4){v[16 * c + 12], v[16 * c + 13], v[16 * c + 14], v[16 * c + 15]} * inv);
        *(u32x4*)(dst + 16 * c) = o; }
    __syncthreads();
}
__device__ __forceinline__ void sincos_acc(float ang, float& s, float& c) {
    const double a = (double)ang; const double kq = __builtin_rint(a * 0.63661977236758134308); const double r = (a - kq * 1.57079632679489655800e+00) - kq * 6.12323399573676603587e-17;
    const float x = (float)r, x2 = x * x;
    const float sp = x + x * x2 * (-1.6666667163e-01f + x2 * (8.3333337680e-03f + x2 * (-1.9841270114e-04f + x2 * 2.7557314297e-06f)));
    const float cp = 1.0f + x2 * (-0.5f + x2 * (4.1666667908e-02f + x2 * (-1.3888889225e-03f + x2 * (2.4801587642e-05f + x2 * -2.7557314297e-07f))));
    const int q = ((int)kq) & 3;
    s = (q == 0) ? sp : (q == 1) ? cp : (q == 2) ? -sp : -cp;
    c = (q == 0) ? cp : (q == 1) ? -sp : (q == 2) ? -cp : sp;
}

struct Args { const float* in[32]; float* out; unsigned char* ws; };
enum { I_X = 0, I_C, I_WMOD, I_BMOD, I_PREMIX, I_POSTMIX, I_WIN, I_QNG, I_WUQ, I_KVNG, I_WUKV, I_SGLNG, I_SGLNB, I_SGW, I_SGB, I_CONVW, I_CONVB, I_LWA, I_LBA, I_LWX, I_LBX, I_LAM,
       I_WO, I_PREFFN, I_POSTFFN, I_FG, I_FU, I_FD, I_ROUTER, I_MG, I_MU, I_MD };

#define WSL GAS unsigned char* wslg_ = (GAS unsigned char*)args.ws; int zi_ = 0, bxo = bx_, vcuo = vcu_, Go = G_; asm volatile("" : "+s"(wslg_), "+s"(zi_), "+s"(bxo), "+s"(vcuo), "+s"(Go)); unsigned char* wsl = (unsigned char*)wslg_
#define AIN(i) ((const float*)(GAS const float*)args.in[(i) + zi_])
#define W_ctl ((unsigned*)(wsl + WS_CTL))
#define W_MOD ((float*)(wsl + WS_MOD))
#define W_cosT ((float*)(wsl + WS_COS))
#define W_sinT ((float*)(wsl + WS_SIN))
#define W_ssq_q ((u64*)(wsl + WS_SSQQ))
#define W_ssq_kv ((u64*)(wsl + WS_SSQK))
#define W_IDX ((int*)(wsl + WS_IDX))
#define W_SLOT ((int*)(wsl + WS_SLOT))
#define W_GATEW ((float*)(wsl + WS_GATEW))
#define W_WB ((bf16*)(wsl + WS_W))
#define W_H ((bf16*)(wsl + WS_H))
#define W_YO ((bf16*)(wsl + WS_YO))
#define W_ZQ ((bf16*)(wsl + WS_ZQ))
#define W_ZKV ((bf16*)(wsl + WS_ZKV))
#define W_KR ((bf16*)(wsl + WS_KR))
#define W_U ((bf16*)(wsl + WS_U))
#define W_GV ((bf16*)(wsl + WS_GV))
#define W_ZX ((bf16*)(wsl + WS_ZX))
#define W_GY ((bf16*)(wsl + WS_GY))
#define W_Q ((bf16*)(wsl + WS_Q))
#define W_KN ((bf16*)(wsl + WS_KN))
#define W_VT ((bf16*)(wsl + WS_VT))
#define W_Y ((bf16*)(wsl + WS_Y))
#define W_HL ((float*)(wsl + WS_HL))
#define W_PP ((float*)(wsl + WS_PP))
#define W_ACT ((bf16*)(wsl + WS_ACT))
#define W_YD ((bf16*)(wsl + WS_YD))
#define W_DW8(i) ((unsigned char*)(W_WB + WOFF_DENSE + (size_t)(i) * DW_SIZE))
#define W_MW8(i) ((unsigned char*)(W_WB + WOFF_MOE + (size_t)(i) * MW_SIZE))
#define W_ACT8 ((unsigned char*)(wsl + WS_ACT))
#define W_ACT8D ((unsigned char*)(wsl + WS_ACTD))
#define W_X ((float*)(GAS float*)args.out)
#define W_XB ((bf16*)(wsl + WS_YO + 32 * MiB))
__global__ void __launch_bounds__(512, 2) trunk_fwd(Args args) {
    extern __shared__ __attribute__((aligned(16))) unsigned char lds_raw[];
    LAS unsigned char* lds = (LAS unsigned char*)lds_raw;
    volatile LAS unsigned* MISC = (volatile LAS unsigned*)(lds + MISC_OFF);
    const volatile LAS int* tab = (const volatile LAS int*)(lds + MISC_OFF);
    const int wave = __builtin_amdgcn_readfirstlane(threadIdx.x >> 6);
    constexpr int G_ = 256;
    if (gridDim.x != G_) return;
    const int bx_ = blockIdx.x, vcu_ = (bx_ % 8) * (G_ / 8) + bx_ / 8;
    for (int u = threadIdx.x; u < (LDS_BYTES - MISC_OFF) / 4; u += 512) MISC[u] = 0u;
    __syncthreads();
    { WSL; (void)xcd_barrier_post(W_ctl, MISC); }
    { WSL; if (opaque_tid() == 0 && bx_ < 8) __hip_atomic_store(W_ctl + 6000 + bx_, xb_xcc_id() + 1u, __ATOMIC_RELAXED, __HIP_MEMORY_SCOPE_AGENT); }
#define GRID_BAR() do { WSL; XcdBarrier b_; b_.bar = W_ctl; b_.x = xb_xcc_id(); b_.st = MISC; xcd_barrier(b_); } while (0)
#define GRID_BAR_P() do { WSL; XcdBarrier b_; b_.bar = W_ctl; b_.x = xb_xcc_id(); b_.st = MISC; if (MISC[9]) xcd_pair_barrier(b_, (unsigned)((bx_ & 7) >> 1)); else xcd_barrier(b_); } while (0)
#define GRID_BAR_L() do { WSL; XcdBarrier b_; b_.bar = W_ctl; b_.x = xb_xcc_id(); b_.st = MISC; if (MISC[8]) xcd_local_barrier(b_); else xcd_barrier(b_); } while (0)

    {
        WSL; const int tid = opaque_tid(), lane = tid & 63;
        LAS float* scr = (LAS float*)(lds + wave * 8448);
        const int gw = vcuo * 8 + wave, NGW = Go * 8;
        constexpr int N0 = 4 * 720, N1 = 4 * 96, N2 = 4 * 64, N3 = 4 * 512, N4 = 2 * 1408, N7 = 16 * 704;
        constexpr int NITEMS = N1 + N2 + N3 + N4 + N7;
        { LAS float* red = (LAS float*)(lds + 102400);
          for (int it = vcuo; it < 352 + 1408 + 180; it += Go) {
              if (it >= 352 + 1408) { const int r = it - 1760, l = r / 45, nb = r % 45; unsigned char* wt = (unsigned char*)(W_WB + l * LW_SIZE + LW_WIN);
                  colq_item(AIN(I_WIN) + (size_t)l * D * DIN, DIN, wt, (float*)(wt + (size_t)DINP * D), 3, nb, red, tid); }
              else if (it < 352) { const int i = it / 176, r = it % 176, kind = 1 + r / 88, nb = r % 88;
                  colq_item(AIN(kind == 1 ? I_FG : I_FU) + (size_t)i * D * DFF, DFF, W_DW8(i) + DW8_GU, (float*)(W_DW8(i) + DW8_CS), kind, nb, red, tid); }
              else { const int r = it - 352, ie = r / 88, q = r % 88, kind = 1 + q / 44, nb = q % 44;
                  colq_item(AIN(kind == 1 ? I_MG : I_MU) + (size_t)ie * D * DFE, DFE, W_MW8(ie >> 3) + MW8_GU + (size_t)(ie & 7) * 2 * DFE * D, (float*)(W_MW8(ie >> 3) + MW8_CS) + (ie & 7) * 2 * DFE, kind, nb, red, tid); } } }
        for (int it = gw; it < NITEMS; it += NGW) {
            int r = it;
            if (r < N1) { const int l = r / 96, q = r % 96; tr_item(AIN(I_WUQ) + (size_t)l * 256 * 768, 768, W_WB + l * LW_SIZE + LW_WUQ, 256, AIN(I_QNG) + l * 256, 4, scr, q / 24, q % 24, lane); continue; } r -= N1;
            if (r < N2) { const int l = r / 64, q = r % 64, kb = q / 32, nb = q % 32;
                const bool isv = ((nb & 3) >= 2); bf16* dst = W_WB + l * LW_SIZE + (isv ? LW_WUV : LW_WUK) + (size_t)((nb >> 2) * 64 + (nb & 1) * 32) * 256;
                tr_item(AIN(I_WUKV) + (size_t)l * 128 * 1024 + nb * 32, 1024, dst, 256, AIN(I_KVNG) + l * 128, 0, scr, kb, 0, lane); continue; } r -= N2;
            if (r < N3) { const int l = r / 512, q = r % 512; tr_item(AIN(I_WO) + (size_t)l * D * D, D, W_WB + l * LW_SIZE + LW_WO, D, nullptr, 0, scr, q / 32, q % 32, lane); continue; } r -= N3;
            if (r < N4) { const int i = r / 1408, q = r % 1408; tr_item<true>(AIN(I_FD) + (size_t)i * DFF * D, D, W_DW8(i) + DW8_D, DFF, nullptr, 0, scr, q / 32, q % 32, lane); continue; } r -= N4;
            { const int ie = r / 704, q = r % 704, i = ie >> 3, e = ie & 7; tr_item<true>(AIN(I_MD) + (size_t)ie * DFE * D, D, W_MW8(i) + MW8_D + (size_t)e * D * DFEP, DFEP, nullptr, 0, scr, q / 32, q % 32, lane); }
        }
        const int gt = vcuo * 512 + tid, NGT = Go * 512;
        for (int i = gt; i < 4 * 96 * 64; i += NGT) {
            const int l = i / (96 * 64), q = i % (96 * 64); unsigned char* wt = (unsigned char*)(W_WB + l * LW_SIZE + LW_WIN);
            *(u32x4*)(wt + (size_t)(416 + q / 64) * D + (q % 64) * 16) = (u32x4){0u, 0u, 0u, 0u}; if ((q % 64) == 0) ((float*)(wt + (size_t)DINP * D))[416 + q / 64] = 0.f; }
        for (int i = gt; i < 4 * 2 * 512 * 16; i += NGT) {
            const int l = i / (2 * 512 * 16), q = i % (2 * 512 * 16), mtx = q / (512 * 16), rr = (q / 16) % 512, ch = q % 16;
            *(u32x4*)(W_WB + l * LW_SIZE + (mtx ? LW_WUV : LW_WUK) + (size_t)rr * 256 + 128 + ch * 8) = (u32x4){0u, 0u, 0u, 0u}; }
        for (int i = gt; i < 2 * NE * D * 8; i += NGT) {
            const int ie = i / (D * 8), q = i % (D * 8); *(u32x4*)(W_MW8(ie >> 3) + MW8_D + ((size_t)(ie & 7) * D + (q >> 3)) * DFEP + DFE + (q & 7) * 16) = (u32x4){0u, 0u, 0u, 0u}; }
        for (int i = gt; i < 4 * 4 * 128 * 128; i += NGT) {
            const int l = i / 65536, q = i % 65536, t = (q >> 7) & 127, s = q & 127; const float v = (s <= t) ? AIN(I_SGW)[i] : 0.f;
            W_WB[l * LW_SIZE + LW_SGW + q] = (bf16)(cvt_pk(v, 0.f) & 0xffffu); }
        for (int i = gt; i < 4 * 2 * 4 * 64 * 64; i += NGT) {
            const int l = i / 32768, q = i % 32768, mtx = q / 16384, hq = (q / 4096) & 3, j = (q >> 6) & 63, ii = q & 63;
            const float v = AIN(mtx ? I_LWX : I_LWA)[(size_t)l * 16384 + hq * 4096 + ii * 64 + j];
            W_WB[l * LW_SIZE + (mtx ? LW_LWX : LW_LWA) + hq * 4096 + j * 64 + ii] = (bf16)(cvt_pk(v, 0.f) & 0xffffu); }
        for (int i = gt; i < SEQ * 16; i += NGT) {
            const int pos = i >> 4, j = i & 15; const float inv = exp2f(-(float)j * (13.287712379549449f / 16.0f)); float s, c; sincos_acc((float)pos * inv, s, c); W_cosT[i] = c; W_sinT[i] = s; }
        __syncthreads();
        LAS float* cond = (LAS float*)(lds + 69632); LAS float* red = (LAS float*)(lds + 69632 + 16384);
        for (int i = tid; i < NB * D; i += 512) cond[i] = siluf_(AIN(I_C)[i]);
        __syncthreads();
        for (int item = vcuo; item < 4 * 96; item += Go) {
            const int l = item / 96, c0 = (item % 96) * 64; const float* Wm = AIN(I_WMOD) + (size_t)l * D * 6144 + c0 + lane;
            float a0 = 0.f, a1 = 0.f, a2 = 0.f, a3 = 0.f;
#pragma unroll 16
            for (int k = wave * 128; k < wave * 128 + 128; ++k) { const float wv = __builtin_nontemporal_load(Wm + (size_t)k * 6144); a0 += cond[k] * wv; a1 += cond[D + k] * wv; a2 += cond[2 * D + k] * wv; a3 += cond[3 * D + k] * wv; }
            red[(wave * 4 + 0) * 64 + lane] = a0; red[(wave * 4 + 1) * 64 + lane] = a1; red[(wave * 4 + 2) * 64 + lane] = a2; red[(wave * 4 + 3) * 64 + lane] = a3;
            __syncthreads();
            if (tid < 256) { const int b = tid >> 6, col = tid & 63; float s = AIN(I_BMOD)[l * 6144 + c0 + col];
#pragma unroll
                for (int ww = 0; ww < 8; ++ww) s += red[(ww * 4 + b) * 64 + col];
                W_MOD[(size_t)(l * 4 + b) * 6144 + c0 + col] = s; }
            __syncthreads();
        }
    }
    { WSL; if (opaque_tid() == 0) { unsigned gx; XB_SPIN((gx = xb_ld(W_ctl + 6000 + (bx_ & 7))) == 0u, W_ctl); if (gx != xb_xcc_id() + 1u) atomicOr(W_ctl + 6016, 1u); } }
    GRID_BAR();
    { WSL; if (opaque_tid() == 0) { const unsigned ok = (xb_ld(W_ctl + 6016) == 0u) ? 1u : 0u; unsigned pok = 1u;
#pragma unroll
        for (unsigned j = 0; j < 16; ++j) { const unsigned c = xb_ld(W_ctl + XB_XCNT(j)); if (c != 0u && c != 32u) pok = 0u; }
        MISC[8] = ok; MISC[9] = ok & pok; } } __syncthreads();
    {
        WSL; const int tid = opaque_tid();
        const int b = vcuo >> 6; const float* md = W_MOD + (size_t)(0 * 4 + b) * 6144;
        RowArgs ra{}; ra.xin = AIN(I_X); ra.X = nullptr; ra.Xb = W_XB; ra.preg = AIN(I_PREMIX); ra.sc = md + 1024; ra.sh = md; ra.H = W_H; ra.ssq_q = W_ssq_q; ra.ssq_kv = W_ssq_kv; ra.rs = (float*)(W_DW8(0) + DW8_RS);
        row_phase<0>(lds, tab, vcuo, ra, true, false);
        if (tid < 64) { W_ssq_q[vcuo * 64 + tid] = 0ull; W_ssq_kv[vcuo * 64 + tid] = 0ull; }
    }
    GRID_BAR_L();


    { constexpr int l = 0;

        const bool moe = (l & 1) != 0; const int fi = l >> 1;
#define LW (W_WB + (size_t)l * LW_SIZE)
#define md (W_MOD + (size_t)(l * 4 + (vcuo >> 6)) * 6144)
        { WSL; pg8::Gemm g{W_H, LW + LW_WIN, D}; pg8::StaticOrder S; S.init(M, DINP, Go, bxo); S.lim = (S.nwg / Go) * Go;
          pg8::EpiIn E{wsl, (const float*)(W_DW8(0) + DW8_RS), (const float*)((unsigned char*)(LW + LW_WIN) + (size_t)DINP * D)};
          pg8::gemm_phase<pg8::EpiIn, pg8::StaticOrder, true, 2, 2>(lds, g, S, E);
          pg8::TailOrder<pg8::StaticOrder> T{S};
          pg8::gemm_phase<pg8::EpiIn, pg8::TailOrder<pg8::StaticOrder>, false, 1, 2>(lds, g, T, E); }
        if (l == 2) GRID_BAR(); else GRID_BAR_L();
        { WSL; pg8::Gemm g{W_ZQ, LW + LW_WUQ, 256}; pg8::StaticOrder S; S.init(M, 768, Go, bxo); pg8::EpiQ E{wsl};
          pg8::gemm_phase<pg8::EpiQ, pg8::StaticOrder, true>(lds, g, S, E); }
        { WSL; pg8::Gemm g{W_ZKV, LW + LW_WUK, 128, 256};     pg8::StaticOrder S; S.init(M, 512, Go, (bxo + 64) % Go); pg8::EpiK E{wsl};
          pg8::gemm_phase<pg8::EpiK, pg8::StaticOrder, true>(lds, g, S, E); }
        { WSL; pg8::Gemm g{LW + LW_WUV, W_ZKV, 128, 256}; pg8::StaticOrder S; S.init(512, M, Go, (bxo + 192) % Go); pg8::EpiVT E{wsl};
          pg8::gemm_phase<pg8::EpiVT, pg8::StaticOrder, true>(lds, g, S, E); }
        { WSL; for (int uu = vcuo; uu < 256; uu += Go) {
            sgu::unit(lds, (uu >> 1) * 128, uu & 1, W_GV, W_U, LW + LW_SGW, AIN(I_SGLNG) + l * 256, AIN(I_SGLNB) + l * 256, AIN(I_SGB) + l * 512, W_Y); } }
        { WSL; for (int uu = vcuo; uu < 256; uu += Go) {
            lru::local_unit(lds, uu >> 6, uu & 63, W_ZX, AIN(I_CONVW) + l * 1024, AIN(I_CONVB) + l * 256, LW + LW_LWA, LW + LW_LWX,
                            AIN(I_LBA) + l * 256, AIN(I_LBX) + l * 256, AIN(I_LAM) + l * 256, W_HL, W_PP); } }
        GRID_BAR_P();
        { WSL; for (int uu = vcuo; uu < 256; uu += Go) { lru::fix_unit(lds, uu >> 6, uu & 63, W_HL, W_PP, W_GY, W_Y); } }
        { WSL; for (int uu = vcuo; uu < 256; uu += Go) { const int bh = uu >> 3, s = uu & 7;
            att::attn_unit(lds, bh >> 3, bh & 7, 15 - s, W_Q, W_KN, W_KR, W_VT, W_Y);
            att::attn_unit(lds, bh >> 3, bh & 7, s, W_Q, W_KN, W_KR, W_VT, W_Y); } }
        GRID_BAR_P();
        { WSL; pg8::Gemm g{W_Y, LW + LW_WO, D}; pg8::StaticOrder S; S.init(M, D, Go, bxo); pg8::EpiBf E{W_YO, D};
          pg8::gemm_phase<pg8::EpiBf, pg8::StaticOrder, false>(lds, g, S, E); }
        GRID_BAR_L();
        { WSL; RowArgs ra{}; ra.X = nullptr; ra.Xb = W_XB; ra.Ysrc = W_YO; ra.gate = md + 2048; ra.postg = AIN(I_POSTMIX) + l * D; ra.preg = AIN(I_PREFFN) + l * D; ra.sc = md + 4096; ra.sh = md + 3072; ra.H = W_H;
          ra.router = AIN(I_ROUTER) + (size_t)fi * D * NE; ra.cursor = W_ctl + CW_CURSOR + 64 * fi; ra.idx = W_IDX; ra.slot_w = W_SLOT; ra.gatew_w = W_GATEW; ra.ssq_q = W_ssq_q; ra.ssq_kv = W_ssq_kv; ra.rs = (float*)(W_DW8(0) + DW8_RS); ra.rss = (float*)(W_DW8(0) + DW8_RSS);
          row_phase<1>(lds, tab, vcuo, ra, true, moe); }
        if (moe) GRID_BAR(); else GRID_BAR_L();
        if (!moe) {
#define DW (W_WB + WOFF_DENSE + (size_t)fi * DW_SIZE)
            { WSL; pg8::Gemm g{W_H, W_DW8(fi) + DW8_GU, D}; pg8::StaticOrder S; S.init(M, 2 * DFF, Go, bxo); pg8::EpiSwigluI8<false> E{W_ACT8D, DFF, -1, (const float*)(W_DW8(0) + DW8_RS), (const float*)(W_DW8(fi) + DW8_CS)};
              pg8::gemm_phase<pg8::EpiSwigluI8<false>, pg8::StaticOrder, true, 2, 2>(lds, g, S, E); }
            GRID_BAR_L();
            { WSL; pg8::Gemm g{W_ACT8D, W_DW8(fi) + DW8_D, DFF}; pg8::StaticOrder S; S.init(M, D, Go, bxo); pg8::EpiBfS E{W_YO, D, 1.0f / (pg8::F8_ASC * pg8::F8_WSC)};
              pg8::gemm_phase<pg8::EpiBfS, pg8::StaticOrder, false, 2, 1>(lds, g, S, E); }
            GRID_BAR_L();
        } else {
#define MW (W_WB + WOFF_MOE + (size_t)fi * MW_SIZE)
            { const int ln = opaque_tid(); if (ln < 64) { WSL; volatile LAS int* tw = (volatile LAS int*)(lds + MISC_OFF);
                const int cnt = (ln < 8) ? (int)__hip_atomic_load(W_ctl + CW_CURSOR + 64 * fi + ln, __ATOMIC_RELAXED, __HIP_MEMORY_SCOPE_AGENT) : 0;
                const int nt = (cnt + 255) >> 8; int T = 0, tot = 0;
#pragma unroll
                for (int e = 0; e < 8; ++e) { const int v = __builtin_amdgcn_readlane(nt, e); if (e < ln) T += v; tot += v; }
                if (ln < 8) { tw[16 + ln] = T; tw[32 + ln] = cnt; }
                if (ln == 0) tw[24] = tot; } }
            __syncthreads();
            { WSL; pg8::Gemm g{W_H, W_MW8(fi) + MW8_GU, D}; MoeGatherOrder S{{tab, 11, Go, vcuo, 1 << 30}, W_IDX}; pg8::EpiSwigluI8<true> E{W_ACT8, DFEP, 10, (const float*)(W_DW8(0) + DW8_RSS), (const float*)(W_MW8(fi) + MW8_CS)};
              pg8::gemm_phase<pg8::EpiSwigluI8<true>, MoeGatherOrder, true, 2, 2>(lds, g, S, E); }
            GRID_BAR();
            { WSL; pg8::Gemm g{W_ACT8, W_MW8(fi) + MW8_D, DFEP}; MoeOrder S{tab, 4, Go, vcuo, 2 * Go}; pg8::EpiBfS E{W_YD, D, 1.0f / (pg8::F8_ASC * pg8::F8_WSC)};
              pg8::gemm_phase<pg8::EpiBfS, MoeOrder, true, 2, 1>(lds, g, S, E);
              pg8::TailOrder<MoeOrder> T{S};
              pg8::gemm_phase<pg8::EpiBfS, pg8::TailOrder<MoeOrder>, false, 1, 1>(lds, g, T, E); }
            GRID_BAR();
        }
        { WSL; const bool last = (l == DEPTH - 1); const float* mdn = W_MOD + (size_t)((last ? l : l + 1) * 4 + (vcuo >> 6)) * 6144;
          RowArgs ra{}; ra.X = last ? W_X : nullptr; ra.Xb = W_XB; ra.Ysrc = W_YO; ra.YD = W_YD; ra.slot = W_SLOT; ra.gatew = W_GATEW; ra.gate = md + 5120; ra.postg = AIN(I_POSTFFN) + l * D;
          ra.preg = AIN(I_PREMIX) + (last ? l : l + 1) * D; ra.sc = mdn + 1024; ra.sh = mdn; ra.H = W_H; ra.ssq_q = W_ssq_q; ra.ssq_kv = W_ssq_kv; ra.rs = (float*)(W_DW8(0) + DW8_RS);
          if (!moe) row_phase<2>(lds, tab, vcuo, ra, !last, false); else row_phase<3>(lds, tab, vcuo, ra, !last, false);
          if (!last) GRID_BAR_L(); }

    }
#undef LW
#undef md
#undef DW
#undef MW
    { constexpr int l = 1;

        const bool moe = (l & 1) != 0; const int fi = l >> 1;
#define LW (W_WB + (size_t)l * LW_SIZE)
#define md (W_MOD + (size_t)(l * 4 + (vcuo >> 6)) * 6144)
        { WSL; pg8::Gemm g{W_H, LW + LW_WIN, D}; pg8::StaticOrder S; S.init(M, DINP, Go, bxo); S.lim = (S.nwg / Go) * Go;
          pg8::EpiIn E{wsl, (const float*)(W_DW8(0) + DW8_RS), (const float*)((unsigned char*)(LW + LW_WIN) + (size_t)DINP * D)};
          pg8::gemm_phase<pg8::EpiIn, pg8::StaticOrder, true, 2, 2>(lds, g, S, E);
          pg8::TailOrder<pg8::StaticOrder> T{S};
          pg8::gemm_phase<pg8::EpiIn, pg8::TailOrder<pg8::StaticOrder>, false, 1, 2>(lds, g, T, E); }
        if (l == 2) GRID_BAR(); else GRID_BAR_L();
        { WSL; pg8::Gemm g{W_ZQ, LW + LW_WUQ, 256}; pg8::StaticOrder S; S.init(M, 768, Go, bxo); pg8::EpiQ E{wsl};
          pg8::gemm_phase<pg8::EpiQ, pg8::StaticOrder, true>(lds, g, S, E); }
        { WSL; pg8::Gemm g{W_ZKV, LW + LW_WUK, 128, 256};     pg8::StaticOrder S; S.init(M, 512, Go, (bxo + 64) % Go); pg8::EpiK E{wsl};
          pg8::gemm_phase<pg8::EpiK, pg8::StaticOrder, true>(lds, g, S, E); }
        { WSL; pg8::Gemm g{LW + LW_WUV, W_ZKV, 128, 256}; pg8::StaticOrder S; S.init(512, M, Go, (bxo + 192) % Go); pg8::EpiVT E{wsl};
          pg8::gemm_phase<pg8::EpiVT, pg8::StaticOrder, true>(lds, g, S, E); }
        { WSL; for (int uu = vcuo; uu < 256; uu += Go) {
            sgu::unit(lds, (uu >> 1) * 128, uu & 1, W_GV, W_U, LW + LW_SGW, AIN(I_SGLNG) + l * 256, AIN(I_SGLNB) + l * 256, AIN(I_SGB) + l * 512, W_Y); } }
        { WSL; for (int uu = vcuo; uu < 256; uu += Go) {
            lru::local_unit(lds, uu >> 6, uu & 63, W_ZX, AIN(I_CONVW) + l * 1024, AIN(I_CONVB) + l * 256, LW + LW_LWA, LW + LW_LWX,
                            AIN(I_LBA) + l * 256, AIN(I_LBX) + l * 256, AIN(I_LAM) + l * 256, W_HL, W_PP); } }
        GRID_BAR_P();
        { WSL; for (int uu = vcuo; uu < 256; uu += Go) { lru::fix_unit(lds, uu >> 6, uu & 63, W_HL, W_PP, W_GY, W_Y); } }
        { WSL; for (int uu = vcuo; uu < 256; uu += Go) { const int bh = uu >> 3, s = uu & 7;
            att::attn_unit(lds, bh >> 3, bh & 7, 15 - s, W_Q, W_KN, W_KR, W_VT, W_Y);
            att::attn_unit(lds, bh >> 3, bh & 7, s, W_Q, W_KN, W_KR, W_VT, W_Y); } }
        GRID_BAR_P();
        { WSL; pg8::Gemm g{W_Y, LW + LW_WO, D}; pg8::StaticOrder S; S.init(M, D, Go, bxo); pg8::EpiBf E{W_YO, D};
          pg8::gemm_phase<pg8::EpiBf, pg8::StaticOrder, false>(lds, g, S, E); }
        GRID_BAR_L();
        { WSL; RowArgs ra{}; ra.X = nullptr; ra.Xb = W_XB; ra.Ysrc = W_YO; ra.gate = md + 2048; ra.postg = AIN(I_POSTMIX) + l * D; ra.preg = AIN(I_PREFFN) + l * D; ra.sc = md + 4096; ra.sh = md + 3072; ra.H = W_H;
          ra.router = AIN(I_ROUTER) + (size_t)fi * D * NE; ra.cursor = W_ctl + CW_CURSOR + 64 * fi; ra.idx = W_IDX; ra.slot_w = W_SLOT; ra.gatew_w = W_GATEW; ra.ssq_q = W_ssq_q; ra.ssq_kv = W_ssq_kv; ra.rs = (float*)(W_DW8(0) + DW8_RS); ra.rss = (float*)(W_DW8(0) + DW8_RSS);
          row_phase<1>(lds, tab, vcuo, ra, true, moe); }
        if (moe) GRID_BAR(); else GRID_BAR_L();
        if (!moe) {
#define DW (W_WB + WOFF_DENSE + (size_t)fi * DW_SIZE)
            { WSL; pg8::Gemm g{W_H, W_DW8(fi) + DW8_GU, D}; pg8::StaticOrder S; S.init(M, 2 * DFF, Go, bxo); pg8::EpiSwigluI8<false> E{W_ACT8D, DFF, -1, (const float*)(W_DW8(0) + DW8_RS), (const float*)(W_DW8(fi) + DW8_CS)};
              pg8::gemm_phase<pg8::EpiSwigluI8<false>, pg8::StaticOrder, true, 2, 2>(lds, g, S, E); }
            GRID_BAR_L();
            { WSL; pg8::Gemm g{W_ACT8D, W_DW8(fi) + DW8_D, DFF}; pg8::StaticOrder S; S.init(M, D, Go, bxo); pg8::EpiBfS E{W_YO, D, 1.0f / (pg8::F8_ASC * pg8::F8_WSC)};
              pg8::gemm_phase<pg8::EpiBfS, pg8::StaticOrder, false, 2, 1>(lds, g, S, E); }
            GRID_BAR_L();
        } else {
#define MW (W_WB + WOFF_MOE + (size_t)fi * MW_SIZE)
            { const int ln = opaque_tid(); if (ln < 64) { WSL; volatile LAS int* tw = (volatile LAS int*)(lds + MISC_OFF);
                const int cnt = (ln < 8) ? (int)__hip_atomic_load(W_ctl + CW_CURSOR + 64 * fi + ln, __ATOMIC_RELAXED, __HIP_MEMORY_SCOPE_AGENT) : 0;
                const int nt = (cnt + 255) >> 8; int T = 0, tot = 0;
#pragma unroll
                for (int e = 0; e < 8; ++e) { const int v = __builtin_amdgcn_readlane(nt, e); if (e < ln) T += v; tot += v; }
                if (ln < 8) { tw[16 + ln] = T; tw[32 + ln] = cnt; }
                if (ln == 0) tw[24] = tot; } }
            __syncthreads();
            { WSL; pg8::Gemm g{W_H, W_MW8(fi) + MW8_GU, D}; MoeGatherOrder S{{tab, 11, Go, vcuo, 1 << 30}, W_IDX}; pg8::EpiSwigluI8<true> E{W_ACT8, DFEP, 10, (const float*)(W_DW8(0) + DW8_RSS), (const float*)(W_MW8(fi) + MW8_CS)};
              pg8::gemm_phase<pg8::EpiSwigluI8<true>, MoeGatherOrder, true, 2, 2>(lds, g, S, E); }
            GRID_BAR();
            { WSL; pg8::Gemm g{W_ACT8, W_MW8(fi) + MW8_D, DFEP}; MoeOrder S{tab, 4, Go, vcuo, 2 * Go}; pg8::EpiBfS E{W_YD, D, 1.0f / (pg8::F8_ASC * pg8::F8_WSC)};
              pg8::gemm_phase<pg8::EpiBfS, MoeOrder, true, 2, 1>(lds, g, S, E);
              pg8::TailOrder<MoeOrder> T{S};
              pg8::gemm_phase<pg8::EpiBfS, pg8::TailOrder<MoeOrder>, false, 1, 1>(lds, g, T, E); }
            GRID_BAR();
        }
        { WSL; const bool last = (l == DEPTH - 1); const float* mdn = W_MOD + (size_t)((last ? l : l + 1) * 4 + (vcuo >> 6)) * 6144;
          RowArgs ra{}; ra.X = last ? W_X : nullptr; ra.Xb = W_XB; ra.Ysrc = W_YO; ra.YD = W_YD; ra.slot = W_SLOT; ra.gatew = W_GATEW; ra.gate = md + 5120; ra.postg = AIN(I_POSTFFN) + l * D;
          ra.preg = AIN(I_PREMIX) + (last ? l : l + 1) * D; ra.sc = mdn + 1024; ra.sh = mdn; ra.H = W_H; ra.ssq_q = W_ssq_q; ra.ssq_kv = W_ssq_kv; ra.rs = (float*)(W_DW8(0) + DW8_RS);
          if (!moe) row_phase<2>(lds, tab, vcuo, ra, !last, false); else row_phase<3>(lds, tab, vcuo, ra, !last, false);
          if (!last) GRID_BAR_L(); }

    }
#undef LW
#undef md
#undef DW
#undef MW
    { constexpr int l = 2;

        const bool moe = (l & 1) != 0; const int fi = l >> 1;
#define LW (W_WB + (size_t)l * LW_SIZE)
#define md (W_MOD + (size_t)(l * 4 + (vcuo >> 6)) * 6144)
        { WSL; pg8::Gemm g{W_H, LW + LW_WIN, D}; pg8::StaticOrder S; S.init(M, DINP, Go, bxo); S.lim = (S.nwg / Go) * Go;
          pg8::EpiIn E{wsl, (const float*)(W_DW8(0) + DW8_RS), (const float*)((unsigned char*)(LW + LW_WIN) + (size_t)DINP * D)};
          pg8::gemm_phase<pg8::EpiIn, pg8::StaticOrder, true, 2, 2>(lds, g, S, E);
          pg8::TailOrder<pg8::StaticOrder> T{S};
          pg8::gemm_phase<pg8::EpiIn, pg8::TailOrder<pg8::StaticOrder>, false, 1, 2>(lds, g, T, E); }
        if (l == 2) GRID_BAR(); else GRID_BAR_L();
        { WSL; pg8::Gemm g{W_ZQ, LW + LW_WUQ, 256}; pg8::StaticOrder S; S.init(M, 768, Go, bxo); pg8::EpiQ E{wsl};
          pg8::gemm_phase<pg8::EpiQ, pg8::StaticOrder, true>(lds, g, S, E); }
        { WSL; pg8::Gemm g{W_ZKV, LW + LW_WUK, 128, 256};     pg8::StaticOrder S; S.init(M, 512, Go, (bxo + 64) % Go); pg8::EpiK E{wsl};
          pg8::gemm_phase<pg8::EpiK, pg8::StaticOrder, true>(lds, g, S, E); }
        { WSL; pg8::Gemm g{LW + LW_WUV, W_ZKV, 128, 256}; pg8::StaticOrder S; S.init(512, M, Go, (bxo + 192) % Go); pg8::EpiVT E{wsl};
          pg8::gemm_phase<pg8::EpiVT, pg8::StaticOrder, true>(lds, g, S, E); }
        { WSL; for (int uu = vcuo; uu < 256; uu += Go) {
            sgu::unit(lds, (uu >> 1) * 128, uu & 1, W_GV, W_U, LW + LW_SGW, AIN(I_SGLNG) + l * 256, AIN(I_SGLNB) + l * 256, AIN(I_SGB) + l * 512, W_Y); } }
        { WSL; for (int uu = vcuo; uu < 256; uu += Go) {
            lru::local_unit(lds, uu >> 6, uu & 63, W_ZX, AIN(I_CONVW) + l * 1024, AIN(I_CONVB) + l * 256, LW + LW_LWA, LW + LW_LWX,
                            AIN(I_LBA) + l * 256, AIN(I_LBX) + l * 256, AIN(I_LAM) + l * 256, W_HL, W_PP); } }
        GRID_BAR_P();
        { WSL; for (int uu = vcuo; uu < 256; uu += Go) { lru::fix_unit(lds, uu >> 6, uu & 63, W_HL, W_PP, W_GY, W_Y); } }
        { WSL; for (int uu = vcuo; uu < 256; uu += Go) { const int bh = uu >> 3, s = uu & 7;
            att::attn_unit(lds, bh >> 3, bh & 7, 15 - s, W_Q, W_KN, W_KR, W_VT, W_Y);
            att::attn_unit(lds, bh >> 3, bh & 7, s, W_Q, W_KN, W_KR, W_VT, W_Y); } }
        GRID_BAR_P();
        { WSL; pg8::Gemm g{W_Y, LW + LW_WO, D}; pg8::StaticOrder S; S.init(M, D, Go, bxo); pg8::EpiBf E{W_YO, D};
          pg8::gemm_phase<pg8::EpiBf, pg8::StaticOrder, false>(lds, g, S, E); }
        GRID_BAR_L();
        { WSL; RowArgs ra{}; ra.X = nullptr; ra.Xb = W_XB; ra.Ysrc = W_YO; ra.gate = md + 2048; ra.postg = AIN(I_POSTMIX) + l * D; ra.preg = AIN(I_PREFFN) + l * D; ra.sc = md + 4096; ra.sh = md + 3072; ra.H = W_H;
          ra.router = AIN(I_ROUTER) + (size_t)fi * D * NE; ra.cursor = W_ctl + CW_CURSOR + 64 * fi; ra.idx = W_IDX; ra.slot_w = W_SLOT; ra.gatew_w = W_GATEW; ra.ssq_q = W_ssq_q; ra.ssq_kv = W_ssq_kv; ra.rs = (float*)(W_DW8(0) + DW8_RS); ra.rss = (float*)(W_DW8(0) + DW8_RSS);
          row_phase<1>(lds, tab, vcuo, ra, true, moe); }
        if (moe) GRID_BAR(); else GRID_BAR_L();
        if (!moe) {
#define DW (W_WB + WOFF_DENSE + (size_t)fi * DW_SIZE)
            { WSL; pg8::Gemm g{W_H, W_DW8(fi) + DW8_GU, D}; pg8::StaticOrder S; S.init(M, 2 * DFF, Go, bxo); pg8::EpiSwigluI8<false> E{W_ACT8D, DFF, -1, (const float*)(W_DW8(0) + DW8_RS), (const float*)(W_DW8(fi) + DW8_CS)};
              pg8::gemm_phase<pg8::EpiSwigluI8<false>, pg8::StaticOrder, true, 2, 2>(lds, g, S, E); }
            GRID_BAR_L();
            { WSL; pg8::Gemm g{W_ACT8D, W_DW8(fi) + DW8_D, DFF}; pg8::StaticOrder S; S.init(M, D, Go, bxo); pg8::EpiBfS E{W_YO, D, 1.0f / (pg8::F8_ASC * pg8::F8_WSC)};
              pg8::gemm_phase<pg8::EpiBfS, pg8::StaticOrder, false, 2, 1>(lds, g, S, E); }
            GRID_BAR_L();
        } else {
#define MW (W_WB + WOFF_MOE + (size_t)fi * MW_SIZE)
            { const int ln = opaque_tid(); if (ln < 64) { WSL; volatile LAS int* tw = (volatile LAS int*)(lds + MISC_OFF);
                const int cnt = (ln < 8) ? (int)__hip_atomic_load(W_ctl + CW_CURSOR + 64 * fi + ln, __ATOMIC_RELAXED, __HIP_MEMORY_SCOPE_AGENT) : 0;
                const int nt = (cnt + 255) >> 8; int T = 0, tot = 0;
#pragma unroll
                for (int e = 0; e < 8; ++e) { const int v = __builtin_amdgcn_readlane(nt, e); if (e < ln) T += v; tot += v; }
                if (ln < 8) { tw[16 + ln] = T; tw[32 + ln] = cnt; }
                if (ln == 0) tw[24] = tot; } }
            __syncthreads();
            { WSL; pg8::Gemm g{W_H, W_MW8(fi) + MW8_GU, D}; MoeGatherOrder S{{tab, 11, Go, vcuo, 1 << 30}, W_IDX}; pg8::EpiSwigluI8<true> E{W_ACT8, DFEP, 10, (const float*)(W_DW8(0) + DW8_RSS), (const float*)(W_MW8(fi) + MW8_CS)};
              pg8::gemm_phase<pg8::EpiSwigluI8<true>, MoeGatherOrder, true, 2, 2>(lds, g, S, E); }
            GRID_BAR();
            { WSL; pg8::Gemm g{W_ACT8, W_MW8(fi) + MW8_D, DFEP}; MoeOrder S{tab, 4, Go, vcuo, 2 * Go}; pg8::EpiBfS E{W_YD, D, 1.0f / (pg8::F8_ASC * pg8::F8_WSC)};
              pg8::gemm_phase<pg8::EpiBfS, MoeOrder, true, 2, 1>(lds, g, S, E);
              pg8::TailOrder<MoeOrder> T{S};
              pg8::gemm_phase<pg8::EpiBfS, pg8::TailOrder<MoeOrder>, false, 1, 1>(lds, g, T, E); }
            GRID_BAR();
        }
        { WSL; const bool last = (l == DEPTH - 1); const float* mdn = W_MOD + (size_t)((last ? l : l + 1) * 4 + (vcuo >> 6)) * 6144;
          RowArgs ra{}; ra.X = last ? W_X : nullptr; ra.Xb = W_XB; ra.Ysrc = W_YO; ra.YD = W_YD; ra.slot = W_SLOT; ra.gatew = W_GATEW; ra.gate = md + 5120; ra.postg = AIN(I_POSTFFN) + l * D;
          ra.preg = AIN(I_PREMIX) + (last ? l : l + 1) * D; ra.sc = mdn + 1024; ra.sh = mdn; ra.H = W_H; ra.ssq_q = W_ssq_q; ra.ssq_kv = W_ssq_kv; ra.rs = (float*)(W_DW8(0) + DW8_RS);
          if (!moe) row_phase<2>(lds, tab, vcuo, ra, !last, false); else row_phase<3>(lds, tab, vcuo, ra, !last, false);
          if (!last) GRID_BAR_L(); }

    }
#undef LW
#undef md
#undef DW
#undef MW
    { constexpr int l = 3;

        const bool moe = (l & 1) != 0; const int fi = l >> 1;
#define LW (W_WB + (size_t)l * LW_SIZE)
#define md (W_MOD + (size_t)(l * 4 + (vcuo >> 6)) * 6144)
        { WSL; pg8::Gemm g{W_H, LW + LW_WIN, D}; pg8::StaticOrder S; S.init(M, DINP, Go, bxo); S.lim = (S.nwg / Go) * Go;
          pg8::EpiIn E{wsl, (const float*)(W_DW8(0) + DW8_RS), (const float*)((unsigned char*)(LW + LW_WIN) + (size_t)DINP * D)};
          pg8::gemm_phase<pg8::EpiIn, pg8::StaticOrder, true, 2, 2>(lds, g, S, E);
          pg8::TailOrder<pg8::StaticOrder> T{S};
          pg8::gemm_phase<pg8::EpiIn, pg8::TailOrder<pg8::StaticOrder>, false, 1, 2>(lds, g, T, E); }
        if (l == 2) GRID_BAR(); else GRID_BAR_L();
        { WSL; pg8::Gemm g{W_ZQ, LW + LW_WUQ, 256}; pg8::StaticOrder S; S.init(M, 768, Go, bxo); pg8::EpiQ E{wsl};
          pg8::gemm_phase<pg8::EpiQ, pg8::StaticOrder, true>(lds, g, S, E); }
        { WSL; pg8::Gemm g{W_ZKV, LW + LW_WUK, 128, 256};     pg8::StaticOrder S; S.init(M, 512, Go, (bxo + 64) % Go); pg8::EpiK E{wsl};
          pg8::gemm_phase<pg8::EpiK, pg8::StaticOrder, true>(lds, g, S, E); }
        { WSL; pg8::Gemm g{LW + LW_WUV, W_ZKV, 128, 256}; pg8::StaticOrder S; S.init(512, M, Go, (bxo + 192) % Go); pg8::EpiVT E{wsl};
          pg8::gemm_phase<pg8::EpiVT, pg8::StaticOrder, true>(lds, g, S, E); }
        { WSL; for (int uu = vcuo; uu < 256; uu += Go) {
            sgu::unit(lds, (uu >> 1) * 128, uu & 1, W_GV, W_U, LW + LW_SGW, AIN(I_SGLNG) + l * 256, AIN(I_SGLNB) + l * 256, AIN(I_SGB) + l * 512, W_Y); } }
        { WSL; for (int uu = vcuo; uu < 256; uu += Go) {
            lru::local_unit(lds, uu >> 6, uu & 63, W_ZX, AIN(I_CONVW) + l * 1024, AIN(I_CONVB) + l * 256, LW + LW_LWA, LW + LW_LWX,
                            AIN(I_LBA) + l * 256, AIN(I_LBX) + l * 256, AIN(I_LAM) + l * 256, W_HL, W_PP); } }
        GRID_BAR_P();
        { WSL; for (int uu = vcuo; uu < 256; uu += Go) { lru::fix_unit(lds, uu >> 6, uu & 63, W_HL, W_PP, W_GY, W_Y); } }
        { WSL; for (int uu = vcuo; uu < 256; uu += Go) { const int bh = uu >> 3, s = uu & 7;
            att::attn_unit(lds, bh >> 3, bh & 7, 15 - s, W_Q, W_KN, W_KR, W_VT, W_Y);
            att::attn_unit(lds, bh >> 3, bh & 7, s, W_Q, W_KN, W_KR, W_VT, W_Y); } }
        GRID_BAR_P();
        { WSL; pg8::Gemm g{W_Y, LW + LW_WO, D}; pg8::StaticOrder S; S.init(M, D, Go, bxo); pg8::EpiBf E{W_YO, D};
          pg8::gemm_phase<pg8::EpiBf, pg8::StaticOrder, false>(lds, g, S, E); }
        GRID_BAR_L();
        { WSL; RowArgs ra{}; ra.X = nullptr; ra.Xb = W_XB; ra.Ysrc = W_YO; ra.gate = md + 2048; ra.postg = AIN(I_POSTMIX) + l * D; ra.preg = AIN(I_PREFFN) + l * D; ra.sc = md + 4096; ra.sh = md + 3072; ra.H = W_H;
          ra.router = AIN(I_ROUTER) + (size_t)fi * D * NE; ra.cursor = W_ctl + CW_CURSOR + 64 * fi; ra.idx = W_IDX; ra.slot_w = W_SLOT; ra.gatew_w = W_GATEW; ra.ssq_q = W_ssq_q; ra.ssq_kv = W_ssq_kv; ra.rs = (float*)(W_DW8(0) + DW8_RS); ra.rss = (float*)(W_DW8(0) + DW8_RSS);
          row_phase<1>(lds, tab, vcuo, ra, true, moe); }
        if (moe) GRID_BAR(); else GRID_BAR_L();
        if (!moe) {
#define DW (W_WB + WOFF_DENSE + (size_t)fi * DW_SIZE)
            { WSL; pg8::Gemm g{W_H, W_DW8(fi) + DW8_GU, D}; pg8::StaticOrder S; S.init(M, 2 * DFF, Go, bxo); pg8::EpiSwigluI8<false> E{W_ACT8D, DFF, -1, (const float*)(W_DW8(0) + DW8_RS), (const float*)(W_DW8(fi) + DW8_CS)};
              pg8::gemm_phase<pg8::EpiSwigluI8<false>, pg8::StaticOrder, true, 2, 2>(lds, g, S, E); }
            GRID_BAR_L();
            { WSL; pg8::Gemm g{W_ACT8D, W_DW8(fi) + DW8_D, DFF}; pg8::StaticOrder S; S.init(M, D, Go, bxo); pg8::EpiBfS E{W_YO, D, 1.0f / (pg8::F8_ASC * pg8::F8_WSC)};
              pg8::gemm_phase<pg8::EpiBfS, pg8::StaticOrder, false, 2, 1>(lds, g, S, E); }
            GRID_BAR_L();
        } else {
#define MW (W_WB + WOFF_MOE + (size_t)fi * MW_SIZE)
            { const int ln = opaque_tid(); if (ln < 64) { WSL; volatile LAS int* tw = (volatile LAS int*)(lds + MISC_OFF);
                const int cnt = (ln < 8) ? (int)__hip_atomic_load(W_ctl + CW_CURSOR + 64 * fi + ln, __ATOMIC_RELAXED, __HIP_MEMORY_SCOPE_AGENT) : 0;
                const int nt = (cnt + 255) >> 8; int T = 0, tot = 0;
#pragma unroll
                for (int e = 0; e < 8; ++e) { const int v = __builtin_amdgcn_readlane(nt, e); if (e < ln) T += v; tot += v; }
                if (ln < 8) { tw[16 + ln] = T; tw[32 + ln] = cnt; }
                if (ln == 0) tw[24] = tot; } }
            __syncthreads();
            { WSL; pg8::Gemm g{W_H, W_MW8(fi) + MW8_GU, D}; MoeGatherOrder S{{tab, 11, Go, vcuo, 1 << 30}, W_IDX}; pg8::EpiSwigluI8<true> E{W_ACT8, DFEP, 10, (const float*)(W_DW8(0) + DW8_RSS), (const float*)(W_MW8(fi) + MW8_CS)};
              pg8::gemm_phase<pg8::EpiSwigluI8<true>, MoeGatherOrder, true, 2, 2>(lds, g, S, E); }
            GRID_BAR();
            { WSL; pg8::Gemm g{W_ACT8, W_MW8(fi) + MW8_D, DFEP}; MoeOrder S{tab, 4, Go, vcuo, 2 * Go}; pg8::EpiBfS E{W_YD, D, 1.0f / (pg8::F8_ASC * pg8::F8_WSC)};
              pg8::gemm_phase<pg8::EpiBfS, MoeOrder, true, 2, 1>(lds, g, S, E);
              pg8::TailOrder<MoeOrder> T{S};
              pg8::gemm_phase<pg8::EpiBfS, pg8::TailOrder<MoeOrder>, false, 1, 1>(lds, g, T, E); }
            GRID_BAR();
        }
        { WSL; const bool last = (l == DEPTH - 1); const float* mdn = W_MOD + (size_t)((last ? l : l + 1) * 4 + (vcuo >> 6)) * 6144;
          RowArgs ra{}; ra.X = last ? W_X : nullptr; ra.Xb = W_XB; ra.Ysrc = W_YO; ra.YD = W_YD; ra.slot = W_SLOT; ra.gatew = W_GATEW; ra.gate = md + 5120; ra.postg = AIN(I_POSTFFN) + l * D;
          ra.preg = AIN(I_PREMIX) + (last ? l : l + 1) * D; ra.sc = mdn + 1024; ra.sh = mdn; ra.H = W_H; ra.ssq_q = W_ssq_q; ra.ssq_kv = W_ssq_kv; ra.rs = (float*)(W_DW8(0) + DW8_RS);
          if (!moe) row_phase<2>(lds, tab, vcuo, ra, !last, false); else row_phase<3>(lds, tab, vcuo, ra, !last, false);
          if (!last) GRID_BAR_L(); }

    }
#undef LW
#undef md
#undef DW
#undef MW
#undef GRID_BAR
}

extern "C" void kernel_launch(void* const* d_in, const int* in_sizes, int n_in, void* d_out, int out_size, void* d_ws, size_t ws_size, hipStream_t stream) {
    static int grid = 0;
    if (grid == 0) {
        if (n_in != 32 || in_sizes[0] != M * D || out_size != M * D || ws_size < WS_END2) { fprintf(stderr, "kernel_launch: unexpected problem (n_in %d, in0 %d, out %d, ws %zu < %zu); nothing launched\n", n_in, n_in > 0 ? in_sizes[0] : -1, out_size, ws_size, (size_t)WS_END); grid = -1; return; }
        int dev = 0, cus = 0, per_cu = 0;
        if (hipGetDevice(&dev) != hipSuccess || hipDeviceGetAttribute(&cus, hipDeviceAttributeMultiprocessorCount, dev) != hipSuccess) { grid = -1; return; }
        if (hipFuncSetAttribute((const void*)trunk_fwd, hipFuncAttributeMaxDynamicSharedMemorySize, LDS_BYTES) != hipSuccess) { fprintf(stderr, "kernel_launch: hipFuncSetAttribute failed\n"); grid = -1; return; }
        if (hipOccupancyMaxActiveBlocksPerMultiprocessor(&per_cu, (const void*)trunk_fwd, 512, LDS_BYTES) != hipSuccess || per_cu < 1) fprintf(stderr, "kernel_launch: note: occupancy query reports %d workgroups per CU\n", per_cu);
        (void)hipGetLastError();
        if (cus < 256) { fprintf(stderr, "kernel_launch: this kernel is laid out for 256 CUs (one workgroup each, 64 token rows per workgroup in the row phases); device has %d; nothing launched\n", cus); grid = -1; return; }
        grid = 256;
    }
    if (grid < 0) return;
    if (hipMemsetAsync((char*)d_ws + WS_CTL, 0, CTL_ZERO_BYTES, stream) != hipSuccess) return;
    Args a{};
    for (int i = 0; i < 32; ++i) a.in[i] = (const float*)d_in[i];
    a.out = (float*)d_out; a.ws = (unsigned char*)d_ws;
    hipLaunchKernelGGL(trunk_fwd, dim3(grid), dim3(512), LDS_BYTES, stream, a);
}
```

```cpp
#include <hip/hip_runtime.h>
#include <cstdio>
#include <cstdint>

#define LAS __attribute__((address_space(3)))
#define GAS __attribute__((address_space(1)))
typedef unsigned short bf16;
typedef short bf16x8 __attribute__((ext_vector_type(8)));
typedef short s16x4 __attribute__((ext_vector_type(4)));
typedef float f32x4 __attribute__((ext_vector_type(4)));
typedef float f32x2 __attribute__((ext_vector_type(2)));
typedef float f32x16 __attribute__((ext_vector_type(16)));
typedef unsigned u32x4 __attribute__((ext_vector_type(4)));
typedef unsigned u32x2 __attribute__((ext_vector_type(2)));
typedef unsigned long long u64;

constexpr int D = 1024, NB = 4, SEQ = 4096, M = NB * SEQ, DEPTH = 4;
constexpr int NH = 8, QKD = 96, VD = 64, QL = 256, KVL = 128, ROPE = 32;
constexpr int SGW = 256, LRW = 256, DIN = 1440, DINP = 1536;
constexpr int DFF = 2816, NE = 8, DFE = 1408;
constexpr int ECAP = 16384;
constexpr int MAXT = 136;
constexpr float LOG2E = 1.4426950408889634f;
constexpr float QSCALE = 0.10206207261596577f * LOG2E;

typedef __bf16 bf16x2_t __attribute__((ext_vector_type(2)));
__device__ __forceinline__ unsigned cvt_pk(float lo, float hi) { f32x2 v = {lo, hi}; bf16x2_t b = __builtin_convertvector(v, bf16x2_t); return __builtin_bit_cast(unsigned, b); }
__device__ __forceinline__ float bf2f(unsigned short v) { return __uint_as_float((unsigned)v << 16); }
__device__ __forceinline__ float bflo(unsigned v) { return __uint_as_float(v << 16); }
__device__ __forceinline__ float bfhi(unsigned v) { return __uint_as_float(v & 0xffff0000u); }
__device__ __forceinline__ float fexp2(float x) { return __builtin_amdgcn_exp2f(x); }
__device__ __forceinline__ float frcp(float x) { return __builtin_amdgcn_rcpf(x); }
__device__ __forceinline__ float sigmoidf_(float x) { return frcp(1.0f + fexp2(-x * LOG2E)); }
__device__ __forceinline__ float siluf_(float x) { return x * sigmoidf_(x); }
__device__ __forceinline__ float gelu_tanh(float x) { const float u = 0.7978845608028654f * (x + 0.044715f * x * x * x); return x * frcp(1.0f + fexp2(-2.0f * LOG2E * u)); }
__device__ __forceinline__ float shx(float v, int lane, int o) { return __builtin_bit_cast(float, __builtin_amdgcn_ds_bpermute((lane ^ o) << 2, __builtin_bit_cast(int, v))); }
__device__ __forceinline__ float wave_sum_dpp(float v) {
    int x = __builtin_bit_cast(int, v);
#define DPP_ADD(ctrl, rmask) x = __builtin_bit_cast(int, __builtin_bit_cast(float, x) + __builtin_bit_cast(float, __builtin_amdgcn_update_dpp(0, x, (ctrl), (rmask), 0xf, false)))
    DPP_ADD(0x111, 0xf); DPP_ADD(0x112, 0xf); DPP_ADD(0x114, 0xf); DPP_ADD(0x118, 0xf);
    DPP_ADD(0x142, 0xa);
    DPP_ADD(0x143, 0xc);
#undef DPP_ADD
    return __builtin_bit_cast(float, __builtin_amdgcn_readlane(x, 63));
}
__device__ __forceinline__ float wave_max_dpp(float v) {
    int x = __builtin_bit_cast(int, v);
#define DPP_MAX(ctrl, rmask) x = __builtin_bit_cast(int, __builtin_fmaxf(__builtin_bit_cast(float, x), __builtin_bit_cast(float, __builtin_amdgcn_update_dpp(0, x, (ctrl), (rmask), 0xf, false))))
    DPP_MAX(0x111, 0xf); DPP_MAX(0x112, 0xf); DPP_MAX(0x114, 0xf); DPP_MAX(0x118, 0xf);
    DPP_MAX(0x142, 0xa);
    DPP_MAX(0x143, 0xc);
#undef DPP_MAX
    return __builtin_bit_cast(float, __builtin_amdgcn_readlane(x, 63));
}
__device__ __forceinline__ float wave_sum(float v, int lane) {
#pragma unroll
    for (int o = 1; o < 64; o <<= 1) v += shx(v, lane, o);
    return v;
}
__device__ __forceinline__ int opaque_tid() { int t = threadIdx.x; asm volatile("" : "+v"(t)); return t; }
#define LDS_WAIT() asm volatile("s_waitcnt lgkmcnt(0)" ::: "memory")
#define VM_WAIT() asm volatile("s_waitcnt vmcnt(0)" ::: "memory")

#define XB_TMO      128
#define XB_XCNT(j)  (256  + 64 * (j))
#define XB_XSUB(j)  (1280 + 64 * (j))
#define XB_XGEN(j)  (2304 + 64 * (j))
#define XB_TOP      3328
#define XB_TOPGEN   3392
#define XB_PTOP(p)  (3456 + 64 * (p))
#define XB_PGEN(p)  (3712 + 64 * (p))
#define XCD_BAR_WORDS 3456
#define XB_SPIN_CAP (1u << 18)

__device__ __forceinline__ unsigned xb_ld(unsigned* p)              { return __hip_atomic_load(p, __ATOMIC_RELAXED, __HIP_MEMORY_SCOPE_AGENT); }
__device__ __forceinline__ unsigned xb_add(unsigned* p, unsigned v) { return __hip_atomic_fetch_add(p, v, __ATOMIC_RELAXED, __HIP_MEMORY_SCOPE_AGENT); }
__device__ __forceinline__ unsigned xb_xcc_id() { return (unsigned)__builtin_amdgcn_s_getreg((3 << 11) | 20) & 0xFu; }
#define XB_SPIN(cond, bar) do { unsigned _sp = 0; while (cond) { __builtin_amdgcn_s_sleep(1); \
    if ((++_sp & 255u) == 0u) { if (xb_ld(&(bar)[XB_TMO])) break; if (_sp > XB_SPIN_CAP) { atomicAdd(&(bar)[XB_TMO], 1u); break; } } } } while (0)

struct XcdBarrier {
    unsigned* bar; unsigned x;
    volatile LAS unsigned* st;
};

__device__ __forceinline__ XcdBarrier xcd_barrier_post(unsigned* bar, volatile LAS unsigned* st) {
    XcdBarrier b; b.bar = bar; b.x = xb_xcc_id(); b.st = st;
    if (opaque_tid() == 0) (void)xb_add(&bar[XB_XCNT(b.x)], 1u);
    return b;
}
__device__ __forceinline__ void xcd_barrier_complete(unsigned* bar, unsigned x, unsigned& nloc, unsigned& nx) {
    const unsigned G = 256u;
    unsigned sum, cnt, mine, sp = 0u;
    for (;;) {
        sum = 0u; cnt = 0u; mine = 0u;
#pragma unroll
        for (unsigned j = 0; j < 16; ++j) { const unsigned c = xb_ld(&bar[XB_XCNT(j)]); sum += c; cnt += (c > 0u) ? 1u : 0u; mine = (j == x) ? c : mine; }
        if (sum == G) break;
        __builtin_amdgcn_s_sleep(1);
        if ((++sp & 255u) == 0u) { if (xb_ld(&bar[XB_TMO])) break; if (sp > XB_SPIN_CAP) { atomicAdd(&bar[XB_TMO], 1u); break; } }
    }
    nloc = mine > 0u ? mine : 1u; nx = cnt > 0u ? cnt : 1u;
}

__device__ __forceinline__ void xcd_barrier(const XcdBarrier& b) {
    asm volatile("s_waitcnt vmcnt(0)" ::: "memory");
    __syncthreads();
    if (opaque_tid() == 0) {
        unsigned* bar = b.bar;
        __builtin_amdgcn_s_waitcnt(0);
        unsigned nloc = b.st[0], nx = b.st[1];
        if (nloc == 0u) { xcd_barrier_complete(bar, b.x, nloc, nx); b.st[0] = nloc; b.st[1] = nx; }
        const unsigned old = xb_add(&bar[XB_XSUB(b.x)], 1u);
        const unsigned gen = old / nloc;
        if (old + 1u == (gen + 1u) * nloc) {
            __builtin_amdgcn_fence(__ATOMIC_RELEASE, "agent");
            asm volatile("s_waitcnt vmcnt(0)" ::: "memory");
            const unsigned og = xb_add(&bar[XB_TOP], 1u);
            const unsigned tg = og / nx;
            if (og + 1u == (tg + 1u) * nx) xb_add(&bar[XB_TOPGEN], 1u);
            else XB_SPIN(xb_ld(&bar[XB_TOPGEN]) == tg, bar);
            __builtin_amdgcn_fence(__ATOMIC_ACQUIRE, "agent");
            xb_add(&bar[XB_XGEN(b.x)], 1u);
            asm volatile("s_waitcnt vmcnt(0)" ::: "memory");
        } else {
            XB_SPIN(xb_ld(&bar[XB_XGEN(b.x)]) == gen, bar);
            __builtin_amdgcn_fence(__ATOMIC_ACQUIRE, "agent");
            asm volatile("s_waitcnt vmcnt(0)" ::: "memory");
        }
    }
    __syncthreads();
}

__device__ __forceinline__ void xcd_pair_barrier(const XcdBarrier& b, unsigned p) {
    asm volatile("s_waitcnt vmcnt(0)" ::: "memory");
    __syncthreads();
    if (opaque_tid() == 0) {
        unsigned* bar = b.bar;
        __builtin_amdgcn_s_waitcnt(0);
        const unsigned nloc = b.st[0];
        const unsigned old = xb_add(&bar[XB_XSUB(b.x)], 1u);
        const unsigned gen = old / nloc;
        if (old + 1u == (gen + 1u) * nloc) {
            __builtin_amdgcn_fence(__ATOMIC_RELEASE, "agent");
            asm volatile("s_waitcnt vmcnt(0)" ::: "memory");
            const unsigned og = xb_add(&bar[XB_PTOP(p)], 1u);
            const unsigned tg = og / 2u;
            if (og + 1u == (tg + 1u) * 2u) xb_add(&bar[XB_PGEN(p)], 1u);
            else XB_SPIN(xb_ld(&bar[XB_PGEN(p)]) == tg, bar);
            __builtin_amdgcn_fence(__ATOMIC_ACQUIRE, "agent");
            xb_add(&bar[XB_XGEN(b.x)], 1u);
            asm volatile("s_waitcnt vmcnt(0)" ::: "memory");
        } else {
            XB_SPIN(xb_ld(&bar[XB_XGEN(b.x)]) == gen, bar);
            __builtin_amdgcn_fence(__ATOMIC_ACQUIRE, "agent");
            asm volatile("s_waitcnt vmcnt(0)" ::: "memory");
        }
    }
    __syncthreads();
}
__device__ __forceinline__ void xcd_local_barrier(const XcdBarrier& b) {
    asm volatile("s_waitcnt vmcnt(0)" ::: "memory");
    __syncthreads();
    if (opaque_tid() == 0) {
        unsigned* bar = b.bar;
        __builtin_amdgcn_s_waitcnt(0);
        const unsigned nloc = b.st[0];
        const unsigned old = xb_add(&bar[XB_XSUB(b.x)], 1u);
        const unsigned gen = old / nloc;
        if (old + 1u == (gen + 1u) * nloc) xb_add(&bar[XB_XGEN(b.x)], 1u);
        else XB_SPIN(xb_ld(&bar[XB_XGEN(b.x)]) == gen, bar);
        __builtin_amdgcn_fence(__ATOMIC_ACQUIRE, "agent");
        asm volatile("s_waitcnt vmcnt(0)" ::: "memory");
    }
    __syncthreads();
}

constexpr size_t MiB = 1u << 20;
constexpr size_t WS_CTL = 0, CTL_ZERO_BYTES = 65536;
constexpr int CW_CURSOR = 4096;
constexpr size_t WS_MOD = 65536;
constexpr size_t WS_COS = WS_MOD + 393216, WS_SIN = WS_COS + 262144;
constexpr size_t WS_SSQQ = WS_SIN + 262144, WS_SSQK = WS_SSQQ + 131072;
constexpr size_t WS_IDX = WS_SSQK + 131072;
constexpr size_t WS_SLOT = WS_IDX + 524288, WS_GATEW = WS_SLOT + 131072;
static_assert(WS_GATEW + 131072 <= 2 * MiB, "small arrays");
constexpr size_t WS_W = 2 * MiB;
constexpr size_t LW_WIN = 0, LW_WUQ = LW_WIN + (size_t)DINP * D, LW_WUK = LW_WUQ + 768 * 256, LW_WUV = LW_WUK + 512 * 256, LW_WO = LW_WUV + 512 * 256,
                 LW_SGW = LW_WO + (size_t)D * D, LW_LWA = LW_SGW + 4 * 128 * 128, LW_LWX = LW_LWA + 4 * 64 * 64, LW_SIZE = ((LW_LWX + 4 * 64 * 64 + 65535) / 65536) * 65536;
static_assert(WS_W % 131072 == 0 && (LW_SIZE * 2) % 131072 == 0 && (LW_WUQ * 2) % 131072 == 0 && (LW_WUK * 2) % 131072 == 0 && (LW_WUV * 2) % 131072 == 0, "q/k/v tile alignment");
constexpr size_t DW_GU = 0, DW_D = DW_GU + (size_t)2 * DFF * D, DW_SIZE = DW_D + (size_t)D * DFF;
constexpr size_t MW_GU = 0, MW_D = MW_GU + (size_t)NE * 2 * DFE * D, MW_SIZE = MW_D + (size_t)NE * D * DFE;
constexpr int DFEP = 1536;
constexpr size_t DW8_GU = 0, DW8_D = DW8_GU + (size_t)2 * DFF * D;
constexpr size_t MW8_GU = 0, MW8_D = MW8_GU + (size_t)NE * 2 * DFE * D;
static_assert(MW8_D + (size_t)NE * D * DFEP <= ((size_t)NE * 2 * DFE * D + (size_t)NE * D * DFE) * 2, "fp8 MoE block fits");
constexpr size_t DW8_CS = 12 * MiB;
constexpr size_t DW8_RS = 13 * MiB, DW8_RSS = 14 * MiB;
constexpr size_t MW8_CS = 40 * MiB;
static_assert(DW8_D + (size_t)D * DFF <= DW8_CS && DW8_RSS + (size_t)8 * ECAP * 4 <= ((size_t)2 * DFF * D + (size_t)D * DFF) * 2, "dense block slack");
static_assert(MW8_D + (size_t)NE * D * DFEP <= MW8_CS && MW8_CS + (size_t)NE * 2 * DFE * 4 <= ((size_t)NE * 2 * DFE * D + (size_t)NE * D * DFE) * 2, "MoE block slack");
constexpr size_t WOFF_DENSE = 4 * LW_SIZE, WOFF_MOE = WOFF_DENSE + 2 * DW_SIZE, W_ELEMS = WOFF_MOE + 2 * MW_SIZE;
static_assert(WS_W + W_ELEMS * 2 <= 192 * MiB, "weight arena");
constexpr size_t WS_H = 192 * MiB, WS_YO = 224 * MiB, WS_RA = 288 * MiB;
constexpr size_t WS_ZQ = WS_RA, WS_ZKV = WS_ZQ + 8 * MiB, WS_KR = WS_ZKV + 8 * MiB, WS_U = WS_KR + 1 * MiB, WS_GV = WS_U + 8 * MiB, WS_ZX = WS_GV + 8 * MiB, WS_GY = WS_ZX + 8 * MiB,
                 WS_Q = WS_GY + 8 * MiB, WS_KN = WS_Q + 24 * MiB, WS_VT = WS_KN + 16 * MiB, WS_Y = WS_VT + 16 * MiB, WS_HL = WS_Y + 32 * MiB, WS_PP = WS_HL + 16 * MiB, WS_END = WS_PP + 16 * MiB;
constexpr size_t WS_ACT = WS_RA, WS_YD = WS_RA + 94 * MiB;
constexpr size_t WS_ACTD = WS_END, WS_END2 = WS_ACTD + 44 * MiB;
static_assert((size_t)M * DFF <= 44 * MiB, "dense activation buffer");
static_assert((size_t)MAXT * 256 * DFE * 2 <= 94 * MiB && (size_t)M * DFF * 2 <= 94 * MiB && WS_YD + (size_t)MAXT * 256 * D * 2 <= WS_END, "FFN overlay");

constexpr int RING_BYTES = 131072;
constexpr int MISC_OFF = RING_BYTES;
constexpr int LDS_BYTES = 147456;


namespace pg8 {
constexpr int BM = 256, BK = 64, HALF = 128, HTB = HALF * BK * 2  , STAGE_BYTES = 8 * HTB, NXCD = 8, WGM = 8;
__device__ __forceinline__ int lds_byte(int r, int c) { const int st = (r >> 4) * 2 + (c >> 5), rr = r & 15, cc = c & 31, ob = rr * 64 + cc * 2; return st * 1024 + (ob ^ (((ob >> 9) & 1) << 5)); }
__device__ __forceinline__ void stage_rc(int b, int& R, int& C) { const int st = b / 1024, sb = b % 1024, swz = sb ^ (((sb >> 9) & 1) << 5); R = (st >> 1) * 16 + swz / 64; C = (st & 1) * 32 + (swz % 64) / 2; }
__device__ __forceinline__ int perm32(int rho) { const int n = rho >> 4, i = rho & 15; return 8 * (i >> 2) + 4 * n + (i & 3); }

typedef int i32x8 __attribute__((ext_vector_type(8)));
typedef int i32x4v __attribute__((ext_vector_type(4)));
__device__ __forceinline__ i32x8 cat8(const bf16x8 a, const bf16x8 b) { const i32x4v x = __builtin_bit_cast(i32x4v, a), y = __builtin_bit_cast(i32x4v, b); return __builtin_shufflevector(x, y, 0, 1, 2, 3, 4, 5, 6, 7); }
__device__ __forceinline__ unsigned pk4_fp8(const f32x4 v) {
    float lim = 448.f; asm volatile("" : "+s"(lim));
    const float a = __builtin_fminf(__builtin_fmaxf(v[0], -lim), lim), b = __builtin_fminf(__builtin_fmaxf(v[1], -lim), lim), c = __builtin_fminf(__builtin_fmaxf(v[2], -lim), lim), d = __builtin_fminf(__builtin_fmaxf(v[3], -lim), lim);
    int w = __builtin_amdgcn_cvt_pk_fp8_f32(a, b, 0, false); w = __builtin_amdgcn_cvt_pk_fp8_f32(c, d, w, true); return (unsigned)w; }
__device__ __forceinline__ unsigned pk4_i8(const f32x4 v) {
    const unsigned b0 = __builtin_bit_cast(unsigned, v[0] + 12582912.0f), b1 = __builtin_bit_cast(unsigned, v[1] + 12582912.0f), b2 = __builtin_bit_cast(unsigned, v[2] + 12582912.0f), b3 = __builtin_bit_cast(unsigned, v[3] + 12582912.0f);
    const unsigned lo = __builtin_amdgcn_perm(b1, b0, 0x0c0c0400u), hi = __builtin_amdgcn_perm(b3, b2, 0x0c0c0400u);
    return __builtin_amdgcn_perm(hi, lo, 0x05040100u); }
__device__ __forceinline__ f32x4 i2f4(const f32x4 a) { const i32x4v q = __builtin_bit_cast(i32x4v, a); return (f32x4){(float)q[0], (float)q[1], (float)q[2], (float)q[3]}; }
constexpr float F8_WSC = 64.0f, F8_HSC = 4.0f, F8_ASC = 8.0f;
struct Unit { int pm, pn, x0, x1, x2, x3, co; };
struct Gemm { const void* A; const void* Bt; int K; int ld = 0; };

struct StaticOrder {
    static constexpr bool GATHER = false;
    int nM, nN, nwg, G, c, lim;
    __device__ void init(int Mr, int N, int G_, int c_) { nM = Mr / BM; nN = N / BM; nwg = nM * nN; G = G_; c = c_; lim = nwg; }
    __device__ bool next_tail(Unit& u) const { const int L = lim + 8 * ((c >> 3) >> 1) + (c & 7); if (L >= nwg) return false; map(L, u); u.co = ((c >> 3) & 1) * HALF; return true; }
    __device__ bool next(int i, Unit& u) const {
        const long L = (long)i * G + c; if (L >= lim) return false;
        map((int)L, u); return true; }
    __device__ void map(int Lq, Unit& u) const {
        int wgid = Lq; { const int q = nwg / NXCD, r = nwg % NXCD, xcd = wgid % NXCD, off = wgid / NXCD; wgid = (xcd < r ? xcd * (q + 1) : r * (q + 1) + (xcd - r) * q) + off; }
        const int nig = WGM * nN, gid = wgid / nig, fm = gid * WGM, gsz = (nM - fm) < WGM ? (nM - fm) : WGM;
        u.pm = fm + ((wgid % nig) % gsz); u.pn = (wgid % nig) / gsz; u.x0 = u.pm; u.x1 = u.pn; u.x2 = 0; u.x3 = 0; u.co = 0;
    }
    __device__ __forceinline__ int src_row(const Unit&, int) const { return 0; }
};

struct QkvOrder {
    static constexpr bool GATHER = false;
    int G, c, tq_a, tq_b, tk_a, tk_b, tv_a, tv_b;
    __device__ bool next(int i, Unit& u) const {
        const int L = i * G + c; if (L >= 448) return false;
        if (L < 192) { const int pm = L / 3, pn = L - 3 * pm; u.pm = tq_a + pm; u.pn = tq_b + pn; u.x0 = pm; u.x1 = pn; u.x2 = 0; }
        else if (L < 320) { const int j = L - 192, pm = j >> 1, pn = j & 1; u.pm = tk_a + pm; u.pn = tk_b + pn; u.x0 = pm; u.x1 = pn; u.x2 = 1; }
        else { const int j = L - 320, pn = j >> 1, pm = j & 1; u.pm = tv_a + pm; u.pn = tv_b + pn; u.x0 = pm; u.x1 = pn; u.x2 = 2; }
        u.x3 = 0; return true;
    }
    __device__ __forceinline__ int src_row(const Unit&, int) const { return 0; }
};
template <class S> struct TailOrder {
    static constexpr bool GATHER = false;
    const S& s;
    __device__ __forceinline__ bool next(int i, Unit& u) const { return i == 0 && s.next_tail(u); }
    __device__ __forceinline__ int src_row(const Unit&, int) const { return 0; }
};

template <class Epi, class Sched, bool ALIGN_EPI, int NBJ = 2, int QM = 0>
__device__ __forceinline__ void gemm_phase(LAS unsigned char* lds, const Gemm g, const Sched& S, const Epi& E) {
    const int tid = opaque_tid(), wid = __builtin_amdgcn_readfirstlane(tid >> 6), lane = tid & 63, wr = wid >> 2, wc = wid & 3, fr = lane & 15, fq = lane >> 4;
    constexpr bool F8 = (QM == 1); const int K = g.K, LD = g.ld ? g.ld : g.K, RB = QM ? LD : 2 * LD  , nt = (QM ? K : 2 * K) / 128;
    constexpr bool GA = Sched::GATHER;
    unsigned voffA, voffB;
    { int R, C; stage_rc(tid * 16, R, C); const int Rb = Epi::PERM ? ((R & ~31) + perm32(R & 31)) : R; voffA = (unsigned)(R * RB + 2 * C); voffB = (unsigned)(Rb * RB + 2 * C); }
    const size_t dstep = (size_t)64 * RB;
    u32x4 vG;
    LAS u32x4* gstash = (LAS u32x4*)(lds + STAGE_BYTES + 4096 + tid * 16);
    const size_t kstep = (size_t)(BK * 2);
    const size_t hstep = GA ? 0 : (size_t)HALF * RB;
    const size_t tstep = (size_t)BM * RB;
    const unsigned ldsw = (unsigned)wid * 1024u;
    const int aoff = lds_byte(wr * 64 + fr, fq * 8), boff = lds_byte(wc * 32 + fr, fq * 8);
#define PG8_SA(b, h) (((b) * 2 + (h)) * HTB)
#define PG8_SB(b, h) ((4 + (b) * 2 + (h)) * HTB)
#define PG8_STAGE(bufoff, gbase, voff) do { _Pragma("unroll") for (int _i = 0; _i < 2; ++_i) \
        __builtin_amdgcn_global_load_lds((const unsigned*)((const char*)(gbase) + _i * dstep + (voff)), (LAS unsigned*)(lds + (bufoff) + ldsw + _i * 8192), 16, 0, 0); } while (0)
#define PG8_STAGE_A(bufoff, gbase, h, NX) do { if constexpr (GA) { _Pragma("unroll") for (int _i = 0; _i < 2; ++_i) \
            __builtin_amdgcn_global_load_lds((const unsigned*)((const char*)(gbase) + vG[(h) * 2 + _i]), (LAS unsigned*)(lds + (bufoff) + ldsw + _i * 8192), 16, 0, 0); } \
        else { PG8_STAGE(bufoff, (const char*)(gbase) + (h) * hstep, voffA); } } while (0)
#define PG8_LDA(dst, b, h) do { _Pragma("unroll") for (int m = 0; m < 4; ++m) _Pragma("unroll") for (int k = 0; k < 2; ++k) dst[m][k] = *(const LAS bf16x8*)(lds + PG8_SA(b, h) + aoff + m * 2048 + k * 1024); } while (0)
#define PG8_LDB(dst, b, h) do { _Pragma("unroll") for (int n = 0; n < 2; ++n) _Pragma("unroll") for (int k = 0; k < 2; ++k) dst[n][k] = *(const LAS bf16x8*)(lds + PG8_SB(b, h) + boff + n * 2048 + k * 1024); } while (0)
#define PG8_MMA(ai, bj, At, Bt) do { __builtin_amdgcn_s_setprio(1); _Pragma("unroll") for (int m = 0; m < 4; ++m) _Pragma("unroll") for (int n = 0; n < 2; ++n) { \
        if constexpr (F8) acc[ai][bj][m][n] = __builtin_amdgcn_mfma_scale_f32_16x16x128_f8f6f4(cat8(Bt[n][0], Bt[n][1]), cat8(At[m][0], At[m][1]), acc[ai][bj][m][n], 0, 0, 0, 0, 0, 0);     \
        else if constexpr (QM == 2) { _Pragma("unroll") for (int k = 0; k < 2; ++k) acc[ai][bj][m][n] = __builtin_bit_cast(f32x4, __builtin_amdgcn_mfma_i32_16x16x64_i8(__builtin_bit_cast(i32x4v, Bt[n][k]), __builtin_bit_cast(i32x4v, At[m][k]), __builtin_bit_cast(i32x4v, acc[ai][bj][m][n]), 0, 0, 0)); } \
        else { _Pragma("unroll") for (int k = 0; k < 2; ++k) acc[ai][bj][m][n] = __builtin_amdgcn_mfma_f32_16x16x32_bf16(Bt[n][k], At[m][k], acc[ai][bj][m][n], 0, 0, 0); } } __builtin_amdgcn_s_setprio(0); } while (0)
#define PG8_WAIT_V(n) asm volatile("s_waitcnt vmcnt(" #n ")" ::: "memory")
#define PG8_WAIT_L(n) asm volatile("s_waitcnt lgkmcnt(" #n ")" ::: "memory")
#define PG8_WAIT_VN do { if constexpr (NBJ == 2) PG8_WAIT_V(8); else PG8_WAIT_V(6); } while (0)
#define PG8_BAR __builtin_amdgcn_s_barrier()
#define PG8_SCHED __builtin_amdgcn_sched_barrier(0)
#define PG8_GOFF(dst, u) do { if constexpr (GA) { int _t = tid, _R, _C; asm volatile("" : "+v"(_t)); stage_rc(_t * 16, _R, _C);     \
        _Pragma("unroll") for (int _h = 0; _h < 2; ++_h) _Pragma("unroll") for (int _i = 0; _i < 2; ++_i) \
        dst[_h * 2 + _i] = (unsigned)S.src_row(u, _h * HALF + _i * 64 + _R) * (unsigned)RB + 2u * (unsigned)_C; } } while (0)
    Unit cur, nxt; int ui = 0;
    if (!S.next(0, cur)) return;
    f32x4 acc[2][2][4][2];
#pragma unroll
    for (int a = 0; a < 2; ++a)
#pragma unroll
        for (int b = 0; b < 2; ++b)
#pragma unroll
            for (int m = 0; m < 4; ++m)
#pragma unroll
                for (int n = 0; n < 2; ++n) acc[a][b][m][n] = (f32x4){0.f, 0.f, 0.f, 0.f};
    bf16x8 At[4][2], B0[2][2], B1[2][2];
    const char* cA = (const char*)g.A + (GA ? (size_t)0 : (size_t)cur.pm * tstep); const char* cB = (const char*)g.Bt + (size_t)cur.pn * tstep + (size_t)(cur.co / HALF) * ((size_t)HALF * RB);
    PG8_GOFF(vG, cur);
    PG8_STAGE(PG8_SB(0, 0), cB, voffB); if constexpr (NBJ == 2) PG8_STAGE(PG8_SB(0, 1), cB + (size_t)HALF * RB, voffB); PG8_STAGE_A(PG8_SA(0, 0), cA, 0, false); PG8_STAGE_A(PG8_SA(0, 1), cA, 1, false);
    if (wr == 1) PG8_BAR;
    PG8_WAIT_V(2); PG8_BAR;
    PG8_STAGE(PG8_SB(1, 0), cB + kstep, voffB); PG8_STAGE_A(PG8_SA(1, 0), cA + kstep, 0, false); if constexpr (NBJ == 2) PG8_STAGE(PG8_SB(1, 1), cB + (size_t)HALF * RB + kstep, voffB);
    if constexpr (NBJ == 2) PG8_WAIT_V(6); else PG8_WAIT_V(4);
    PG8_BAR;
    const size_t bh = (size_t)HALF * RB;
    for (;;) {
        const bool has_next = S.next(ui + 1, nxt);
        if constexpr (GA) { u32x4 nx = vG; if (has_next) { PG8_GOFF(nx, nxt); } *gstash = nx; }
        const char* nA = has_next ? (const char*)g.A + (GA ? (size_t)0 : (size_t)nxt.pm * tstep) : cA; const char* nB = has_next ? (const char*)g.Bt + (size_t)nxt.pn * tstep + (size_t)(nxt.co / HALF) * ((size_t)HALF * RB) : cB;
#pragma nounroll
        for (int t = 0; t < nt; t += 2) {
            const bool last = (t == nt - 2);
            const bool tail = last && !has_next;
            if constexpr (GA) asm volatile("" : "+v"(voffB), "+v"(vG));
            else asm volatile("" : "+v"(voffA), "+v"(voffB));
            const char* a1 = cA + (size_t)(t + 1) * kstep;
            const char* a2 = last ? nA : cA + (size_t)(t + 2) * kstep; const char* b2 = last ? nB : cB + (size_t)(t + 2) * kstep;
            const char* a3 = a2 + kstep; const char* b3 = b2 + kstep;
            PG8_LDB(B0, 0, 0); if constexpr (NBJ == 2) PG8_LDB(B1, 0, 1); PG8_SCHED; PG8_LDA(At, 0, 0); PG8_STAGE_A(PG8_SA(1, 1), a1, 1, false);
            if constexpr (GA) { if (last) vG = *gstash; }
            PG8_WAIT_VN; PG8_WAIT_L(0); PG8_BAR; PG8_MMA(0, 0, At, B0); if constexpr (NBJ == 2) PG8_MMA(0, 1, At, B1); PG8_BAR; PG8_SCHED;
            PG8_LDA(At, 0, 1); if (!tail) { PG8_STAGE(PG8_SB(0, 0), b2, voffB); if constexpr (NBJ == 2) PG8_STAGE(PG8_SB(0, 1), b2 + bh, voffB); PG8_STAGE_A(PG8_SA(0, 0), a2, 0, last); }
            if (tail) PG8_WAIT_V(2); else PG8_WAIT_VN;
            PG8_WAIT_L(0); PG8_BAR; PG8_MMA(1, 0, At, B0); if constexpr (NBJ == 2) PG8_MMA(1, 1, At, B1); PG8_BAR; PG8_SCHED;
            PG8_LDB(B0, 1, 0); if constexpr (NBJ == 2) PG8_LDB(B1, 1, 1); PG8_SCHED; PG8_LDA(At, 1, 0); if (!tail) PG8_STAGE_A(PG8_SA(0, 1), a2, 1, last);
            if (tail) PG8_WAIT_V(0); else PG8_WAIT_VN;
            PG8_WAIT_L(0); PG8_BAR; PG8_MMA(0, 0, At, B0); if constexpr (NBJ == 2) PG8_MMA(0, 1, At, B1); PG8_BAR; PG8_SCHED;
            PG8_LDA(At, 1, 1); if (!tail) { PG8_STAGE(PG8_SB(1, 0), b3, voffB); if constexpr (NBJ == 2) PG8_STAGE(PG8_SB(1, 1), b3 + bh, voffB); PG8_STAGE_A(PG8_SA(1, 0), a3, 0, last); }
            if (tail) PG8_WAIT_V(0); else PG8_WAIT_VN;
            PG8_WAIT_L(0); PG8_BAR; PG8_MMA(1, 0, At, B0); if constexpr (NBJ == 2) PG8_MMA(1, 1, At, B1); PG8_BAR; PG8_SCHED;
        }
        if constexpr (ALIGN_EPI) { if (wr == 0) PG8_BAR; }
        { int l2 = lane; asm volatile("" : "+v"(l2)); E.template operator()<NBJ>(acc, cur, wr, wc, l2 & 15, l2 >> 4); }
        if (!has_next) break;
#pragma unroll
        for (int a = 0; a < 2; ++a)
#pragma unroll
            for (int b = 0; b < 2; ++b)
#pragma unroll
                for (int m = 0; m < 4; ++m)
#pragma unroll
                    for (int n = 0; n < 2; ++n) acc[a][b][m][n] = (f32x4){0.f, 0.f, 0.f, 0.f};
        cur = nxt; cA = nA; cB = nB; ++ui;
        if constexpr (ALIGN_EPI) { if (wr == 1) PG8_BAR; }
    }
    PG8_WAIT_V(0);
    if constexpr (!ALIGN_EPI) { if (wr == 0) PG8_BAR; }
    PG8_BAR;
#undef PG8_SA
#undef PG8_SB
#undef PG8_STAGE
#undef PG8_STAGE_A
#undef PG8_LDA
#undef PG8_LDB
#undef PG8_MMA
#undef PG8_WAIT_V
#undef PG8_WAIT_L
#undef PG8_WAIT_VN
#undef PG8_BAR
#undef PG8_SCHED
#undef PG8_GOFF
}

typedef f32x4 AccT[2][2][4][2];
__device__ __forceinline__ u32x4 pack8(const f32x4 v0, const f32x4 v1) { u32x4 w; w.x = cvt_pk(v0[0], v0[1]); w.y = cvt_pk(v0[2], v0[3]); w.z = cvt_pk(v1[0], v1[1]); w.w = cvt_pk(v1[2], v1[3]); return w; }
__device__ __forceinline__ float rstd_from(u64 ssq, float inv_n) { return __builtin_amdgcn_rsqf((float)ssq * (1.0f / 4294967296.0f) * inv_n + 1e-6f); }
__device__ __forceinline__ f32x4 gelu4(f32x4 v) {
    constexpr float K1 = -2.0f * LOG2E * 0.7978845608028654f, K2 = K1 * 0.044715f;
    typedef float f32x2_ __attribute__((ext_vector_type(2)));
    f32x2_ k1 = (f32x2_){K1, K1}, k2 = (f32x2_){K2, K2}; asm volatile("" : "+s"(k1), "+s"(k2));
    const f32x4 k1v = __builtin_shufflevector(k1, k1, 0, 1, 0, 1), k2v = __builtin_shufflevector(k2, k2, 0, 1, 0, 1);
    const f32x4 t = v * ((v * v) * k2v + k1v);
    f32x4 d = (f32x4){fexp2(t[0]), fexp2(t[1]), fexp2(t[2]), fexp2(t[3])}; d = d + 1.0f;
    const f32x4 s = (f32x4){frcp(d[0]), frcp(d[1]), frcp(d[2]), frcp(d[3])};
    return v * s; }

struct EpiF32 {
    static constexpr bool PERM = false;
    float* O; int ldc;
    template <int NBJ = 2> __device__ __forceinline__ void operator()(const AccT& acc, const Unit& u, int wr, int wc, int fr, int fq) const {
#pragma unroll
        for (int ai = 0; ai < 2; ++ai)
#pragma unroll
            for (int m = 0; m < 4; ++m) { float* rowp = O + (size_t)(u.x0 * BM + ai * HALF + wr * 64 + m * 16 + fr) * ldc + u.x1 * BM + wc * 32 + 4 * fq;
#pragma unroll
                for (int bj = 0; bj < 2; ++bj)
#pragma unroll
                    for (int n = 0; n < 2; ++n) *(f32x4*)(rowp + bj * HALF + n * 16) = acc[ai][bj][m][n]; }
    }
};
struct EpiBf {
    static constexpr bool PERM = true;
    bf16* O; int ldc;
    template <int NBJ = 2> __device__ __forceinline__ void operator()(const AccT& acc, const Unit& u, int wr, int wc, int fr, int fq) const {
#pragma unroll
        for (int ai = 0; ai < 2; ++ai)
#pragma unroll
            for (int m = 0; m < 4; ++m) { bf16* rowp = O + (size_t)(u.x0 * BM + ai * HALF + wr * 64 + m * 16 + fr) * ldc + u.x1 * BM + wc * 32 + 8 * fq;
#pragma unroll
                for (int bj = 0; bj < NBJ; ++bj) *(u32x4*)(rowp + u.co + bj * HALF) = pack8(acc[ai][bj][m][0], acc[ai][bj][m][1]); }
    }
};
struct EpiSwiglu {
    static constexpr bool PERM = true;
    bf16* O; int ldc;
    template <int NBJ = 2> __device__ __forceinline__ void operator()(const AccT& acc, const Unit& u, int wr, int wc, int fr, int fq) const {
#pragma unroll
        for (int ai = 0; ai < 2; ++ai)
#pragma unroll
            for (int m = 0; m < 4; ++m) { bf16* rowp = O + (size_t)(u.x0 * BM + ai * HALF + wr * 64 + m * 16 + fr) * ldc + u.x1 * HALF + wc * 32 + 8 * fq;
                f32x4 a0, a1;
#pragma unroll
                for (int e = 0; e < 4; ++e) { a0[e] = siluf_(acc[ai][0][m][0][e]) * acc[ai][1][m][0][e]; a1[e] = siluf_(acc[ai][0][m][1][e]) * acc[ai][1][m][1][e]; }
                *(u32x4*)rowp = pack8(a0, a1); }
    }
};
struct EpiBfS {
    static constexpr bool PERM = true;
    bf16* O; int ldc; float sc;
    template <int NBJ = 2> __device__ __forceinline__ void operator()(const AccT& acc, const Unit& u, int wr, int wc, int fr, int fq) const {
#pragma unroll
        for (int ai = 0; ai < 2; ++ai)
#pragma unroll
            for (int m = 0; m < 4; ++m) { bf16* rowp = O + (size_t)(u.x0 * BM + ai * HALF + wr * 64 + m * 16 + fr) * ldc + u.x1 * BM + wc * 32 + 8 * fq;
#pragma unroll
                for (int bj = 0; bj < NBJ; ++bj) *(u32x4*)(rowp + u.co + bj * HALF) = pack8(acc[ai][bj][m][0] * sc, acc[ai][bj][m][1] * sc); }
    }
};
struct EpiSwiglu8 {
    static constexpr bool PERM = true;
    unsigned char* O; int ldc, zt;
    template <int NBJ = 2> __device__ __forceinline__ void operator()(const AccT& acc, const Unit& u, int wr, int wc, int fr, int fq) const {
        constexpr float sg = 1.0f / (F8_HSC * F8_WSC), su = F8_ASC / (F8_HSC * F8_WSC);
#pragma unroll
        for (int ai = 0; ai < 2; ++ai)
#pragma unroll
            for (int m = 0; m < 4; ++m) { unsigned char* rowp = O + (size_t)(u.x0 * BM + ai * HALF + wr * 64 + m * 16 + fr) * ldc + u.x1 * HALF + wc * 32 + 8 * fq;
                f32x4 a0, a1;
#pragma unroll
                for (int e = 0; e < 4; ++e) { a0[e] = siluf_(acc[ai][0][m][0][e] * sg) * (acc[ai][1][m][0][e] * su); a1[e] = siluf_(acc[ai][0][m][1][e] * sg) * (acc[ai][1][m][1][e] * su); }
                u32x2 w; w.x = pk4_fp8(a0); w.y = pk4_fp8(a1); *(u32x2*)rowp = w;
                if (u.x1 == zt) *(u32x2*)(rowp + HALF) = (u32x2){0u, 0u}; }
    }
};
template <bool SLOT> struct EpiSwigluI8 {
    static constexpr bool PERM = true;
    unsigned char* O; int ldc, zt; const float* rs; const float* cs;
    template <int NBJ = 2> __device__ __forceinline__ void operator()(const AccT& acc, const Unit& u, int wr, int wc, int fr, int fq) const {
        const float* cp = cs + (size_t)u.pn * BM + wc * 32 + 8 * fq;
        const f32x4 cg0 = *(const f32x4*)cp, cg1 = *(const f32x4*)(cp + 4), cu0 = *(const f32x4*)(cp + HALF) * F8_ASC, cu1 = *(const f32x4*)(cp + HALF + 4) * F8_ASC;
        float rr[2][4];
#pragma unroll
        for (int ai = 0; ai < 2; ++ai)
#pragma unroll
            for (int m = 0; m < 4; ++m) { const int rl = ai * HALF + wr * 64 + m * 16 + fr; rr[ai][m] = SLOT ? ((rl < u.x3) ? rs[u.x2 + rl] : 0.f) : rs[u.x0 * BM + rl]; }
#pragma unroll
        for (int ai = 0; ai < 2; ++ai)
#pragma unroll
            for (int m = 0; m < 4; ++m) { const int rl = ai * HALF + wr * 64 + m * 16 + fr;
                unsigned char* rowp = O + (size_t)(u.x0 * BM + rl) * ldc + u.x1 * HALF + wc * 32 + 8 * fq;
                const float r = rr[ai][m];
                const f32x4 g0 = i2f4(acc[ai][0][m][0]) * (cg0 * r), g1 = i2f4(acc[ai][0][m][1]) * (cg1 * r), u0 = i2f4(acc[ai][1][m][0]) * (cu0 * r), u1 = i2f4(acc[ai][1][m][1]) * (cu1 * r);
                f32x4 nl2 = (f32x4){-LOG2E, -LOG2E, -LOG2E, -LOG2E}; asm volatile("" : "+v"(nl2));
                const f32x4 t0 = g0 * nl2, t1 = g1 * nl2;
                f32x4 d0, d1;
#pragma unroll
                for (int e = 0; e < 4; ++e) { d0[e] = fexp2(t0[e]); d1[e] = fexp2(t1[e]); }
                d0 = d0 + 1.0f; d1 = d1 + 1.0f;
                f32x4 s0, s1;
#pragma unroll
                for (int e = 0; e < 4; ++e) { s0[e] = frcp(d0[e]); s1[e] = frcp(d1[e]); }
                f32x4 a0 = (g0 * u0) * s0, a1 = (g1 * u1) * s1;
                float lim = 448.f; asm volatile("" : "+v"(lim));
#pragma unroll
                for (int e = 0; e < 4; ++e) { a0[e] = __builtin_amdgcn_fmed3f(a0[e], -lim, lim); a1[e] = __builtin_amdgcn_fmed3f(a1[e], -lim, lim); }
                u32x2 w;
                { int w0 = __builtin_amdgcn_cvt_pk_fp8_f32(a0[0], a0[1], 0, false); w0 = __builtin_amdgcn_cvt_pk_fp8_f32(a0[2], a0[3], w0, true);
                  int w1 = __builtin_amdgcn_cvt_pk_fp8_f32(a1[0], a1[1], 0, false); w1 = __builtin_amdgcn_cvt_pk_fp8_f32(a1[2], a1[3], w1, true); w.x = (unsigned)w0; w.y = (unsigned)w1; }
                *(u32x2*)rowp = w;
                if (u.x1 == zt) *(u32x2*)(rowp + HALF) = (u32x2){0u, 0u}; }
    }
};
struct EpiIn {
    static constexpr bool PERM = true;
    unsigned char* ws; const float* rs; const float* cs;
    template <int NBJ = 2> __device__ __forceinline__ void operator()(const AccT& acc, const Unit& u, int wr, int wc, int fr, int fq) const {
        const int pn = u.pn;
        f32x4 c0[NBJ], c1[NBJ];
        { const float* cp = cs + (size_t)pn * BM + u.co + wc * 32 + 8 * fq;
#pragma unroll
          for (int bj = 0; bj < NBJ; ++bj) { c0[bj] = *(const f32x4*)(cp + bj * HALF); c1[bj] = *(const f32x4*)(cp + bj * HALF + 4); } }
        float rr[2][4];
#pragma unroll
        for (int ai = 0; ai < 2; ++ai)
#pragma unroll
            for (int m = 0; m < 4; ++m) rr[ai][m] = rs[u.pm * BM + ai * HALF + wr * 64 + m * 16 + fr];
        bf16 *ZQ = (bf16*)(ws + WS_ZQ), *ZKV = (bf16*)(ws + WS_ZKV), *KR = (bf16*)(ws + WS_KR), *U = (bf16*)(ws + WS_U), *GV = (bf16*)(ws + WS_GV), *ZX = (bf16*)(ws + WS_ZX), *GY = (bf16*)(ws + WS_GY);
        u64 *ssq_q = (u64*)(ws + WS_SSQQ), *ssq_kv = (u64*)(ws + WS_SSQK); const float *cosT = (const float*)(ws + WS_COS), *sinT = (const float*)(ws + WS_SIN);
        const bool krope = (pn == 1 && wc == 0 && (NBJ == 2 || (u.co >> 7) == 1));
#pragma unroll
        for (int ai = 0; ai < 2; ++ai) {
            f32x4 cc[4], sn[4];
            if (krope) {
#pragma unroll
                for (int m = 0; m < 4; ++m) { const int pos = (u.pm * BM + ai * HALF + wr * 64 + m * 16 + fr) & (SEQ - 1); cc[m] = *(const f32x4*)(cosT + pos * 16 + 4 * fq); sn[m] = *(const f32x4*)(sinT + pos * 16 + 4 * fq); } }
#pragma unroll
            for (int m = 0; m < 4; ++m) {
                const int row = u.pm * BM + ai * HALF + wr * 64 + m * 16 + fr; const int cl = wc * 32 + 8 * fq; const float rsc = rr[ai][m];
                const int hb = u.co >> 7;
                if (pn == 0 || pn == 1) {
                    bf16* dst = (pn == 0 ? ZQ : ZKV) + (size_t)row * 256 + cl;
                    float ss = 0.f;
#pragma unroll
                    for (int bj = 0; bj < NBJ; ++bj) { const f32x4 v0 = i2f4(acc[ai][bj][m][0]) * (c0[bj] * rsc), v1 = i2f4(acc[ai][bj][m][1]) * (c1[bj] * rsc);
                        *(u32x4*)(dst + (bj + hb) * HALF) = pack8(v0, v1);
                        if (pn == 0 || bj + hb == 0) ss += (v0[0] * v0[0] + v0[1] * v0[1]) + (v0[2] * v0[2] + v0[3] * v0[3]) + (v1[0] * v1[0] + v1[1] * v1[1]) + (v1[2] * v1[2] + v1[3] * v1[3]); }
                    ss += shx(ss, fq * 16 + fr, 16); ss += shx(ss, fq * 16 + fr, 32);
                    if (fq == 0 && (pn == 0 || hb == 0)) atomicAdd((pn == 0 ? ssq_q : ssq_kv) + row, (u64)(ss * 4294967296.0f));
                    if (krope) {
                        const f32x4 x1 = i2f4(acc[ai][NBJ == 2 ? 1 : 0][m][0]) * (c0[NBJ == 2 ? 1 : 0] * rsc), x2 = i2f4(acc[ai][NBJ == 2 ? 1 : 0][m][1]) * (c1[NBJ == 2 ? 1 : 0] * rsc);
                        const f32x4 c = cc[m], s = sn[m];
                        const f32x4 o1 = x1 * c - x2 * s, o2 = x2 * c + x1 * s;
                        u32x2 w1, w2; w1.x = cvt_pk(o1[0], o1[1]); w1.y = cvt_pk(o1[2], o1[3]); w2.x = cvt_pk(o2[0], o2[1]); w2.y = cvt_pk(o2[2], o2[3]);
                        *(u32x2*)(KR + (size_t)row * 32 + 4 * fq) = w1; *(u32x2*)(KR + (size_t)row * 32 + 16 + 4 * fq) = w2; }
                } else {
                    bf16* dst = (pn == 2 ? U : pn == 3 ? GV : pn == 4 ? ZX : GY) + (size_t)row * 256 + cl;
#pragma unroll
                    for (int bj = 0; bj < NBJ; ++bj) { f32x4 v0 = i2f4(acc[ai][bj][m][0]) * (c0[bj] * rsc), v1 = i2f4(acc[ai][bj][m][1]) * (c1[bj] * rsc);
                        if (pn != 4) { v0 = gelu4(v0); v1 = gelu4(v1); }
                        *(u32x4*)(dst + (bj + hb) * HALF) = pack8(v0, v1); }
                }
            }
        }
    }
};
struct EpiQ {
    static constexpr bool PERM = true;
    unsigned char* ws;
    template <int NBJ = 2> __device__ __forceinline__ void operator()(const AccT& acc, const Unit& u, int wr, int wc, int fr, int fq) const {
        bf16* Q = (bf16*)(ws + WS_Q); const u64* ssq = (const u64*)(ws + WS_SSQQ); const float *cosT = (const float*)(ws + WS_COS), *sinT = (const float*)(ws + WS_SIN);
        u64 sq[2][4];
#pragma unroll
        for (int ai = 0; ai < 2; ++ai)
#pragma unroll
            for (int m = 0; m < 4; ++m) sq[ai][m] = ssq[u.x0 * BM + ai * HALF + wr * 64 + m * 16 + fr];
        const bool rope = ((u.x1 * 8 + wc) % 3 == 2) || ((u.x1 * 8 + 4 + wc) % 3 == 2);
#pragma unroll
        for (int ai = 0; ai < 2; ++ai) {
            f32x4 cc[4], sn[4];
            if (rope) {
#pragma unroll
                for (int m = 0; m < 4; ++m) { const int pos = (u.x0 * BM + ai * HALF + wr * 64 + m * 16 + fr) & (SEQ - 1); cc[m] = *(const f32x4*)(cosT + pos * 16 + 4 * fq); sn[m] = *(const f32x4*)(sinT + pos * 16 + 4 * fq); } }
#pragma unroll
            for (int m = 0; m < 4; ++m) {
                const int row = u.x0 * BM + ai * HALF + wr * 64 + m * 16 + fr; const float sc = rstd_from(sq[ai][m], 1.0f / 256.0f) * QSCALE;
#pragma unroll
                for (int bj = 0; bj < 2; ++bj) {
                    const int c32 = u.x1 * 8 + bj * 4 + wc, head = c32 / 3, part = c32 - 3 * head;
                    const f32x4 v0 = acc[ai][bj][m][0] * sc, v1 = acc[ai][bj][m][1] * sc; bf16* dst = Q + (size_t)row * 768 + head * 96;
                    if (part < 2) *(u32x4*)(dst + part * 32 + 8 * fq) = pack8(v0, v1);
                    else { const f32x4 c = cc[m], s = sn[m];
                        const f32x4 o1 = v0 * c - v1 * s, o2 = v1 * c + v0 * s;
                        u32x2 w1, w2; w1.x = cvt_pk(o1[0], o1[1]); w1.y = cvt_pk(o1[2], o1[3]); w2.x = cvt_pk(o2[0], o2[1]); w2.y = cvt_pk(o2[2], o2[3]);
                        *(u32x2*)(dst + 64 + 4 * fq) = w1; *(u32x2*)(dst + 80 + 4 * fq) = w2; }
                }
            }
            asm volatile("" ::: "memory");
        }
    }
};
struct EpiK {
    static constexpr bool PERM = true;
    unsigned char* ws;
    template <int NBJ = 2> __device__ __forceinline__ void operator()(const AccT& acc, const Unit& u, int wr, int wc, int fr, int fq) const {
        bf16* KN = (bf16*)(ws + WS_KN); const u64* ssq = (const u64*)(ws + WS_SSQK);
        u64 sq[2][4];
#pragma unroll
        for (int ai = 0; ai < 2; ++ai)
#pragma unroll
            for (int m = 0; m < 4; ++m) sq[ai][m] = ssq[u.x0 * BM + ai * HALF + wr * 64 + m * 16 + fr];
#pragma unroll
        for (int ai = 0; ai < 2; ++ai)
#pragma unroll
            for (int m = 0; m < 4; ++m) {
                const int row = u.x0 * BM + ai * HALF + wr * 64 + m * 16 + fr; const float sc = rstd_from(sq[ai][m], 1.0f / 128.0f);
                bf16* dst = KN + (size_t)row * 512 + u.x1 * BM + wc * 32 + 8 * fq;
#pragma unroll
                for (int bj = 0; bj < 2; ++bj) *(u32x4*)(dst + bj * HALF) = pack8(acc[ai][bj][m][0] * sc, acc[ai][bj][m][1] * sc);
            }
    }
};
struct EpiVT {
    static constexpr bool PERM = true;
    unsigned char* ws;
    template <int NBJ = 2> __device__ __forceinline__ void operator()(const AccT& acc, const Unit& u, int wr, int wc, int fr, int fq) const {
        bf16* VT = (bf16*)(ws + WS_VT); const u64* ssq = (const u64*)(ws + WS_SSQK);
#pragma unroll
        for (int bj = 0; bj < 2; ++bj) {
            const int tk = u.x1 * BM + bj * HALF + wc * 32 + 8 * fq; f32x4 s0, s1;
#pragma unroll
            for (int e = 0; e < 4; ++e) { s0[e] = rstd_from(ssq[tk + e], 1.0f / 128.0f); s1[e] = rstd_from(ssq[tk + 4 + e], 1.0f / 128.0f); }
#pragma unroll
            for (int ai = 0; ai < 2; ++ai)
#pragma unroll
                for (int m = 0; m < 4; ++m) { const int vr = u.x0 * BM + ai * HALF + wr * 64 + m * 16 + fr;
                    *(u32x4*)(VT + (size_t)vr * M + tk) = pack8(acc[ai][bj][m][0] * s0, acc[ai][bj][m][1] * s1); }
        }
    }
};
struct EpiQKV {
    static constexpr bool PERM = true;
    unsigned char* ws;
    template <int NBJ = 2> __device__ __forceinline__ void operator()(const AccT& acc, const Unit& u, int wr, int wc, int fr, int fq) const {
        if (u.x2 == 0) { EpiQ e{ws}; e(acc, u, wr, wc, fr, fq); }
        else if (u.x2 == 1) { EpiK e{ws}; e(acc, u, wr, wc, fr, fq); }
        else { EpiVT e{ws}; e(acc, u, wr, wc, fr, fq); }
    }
};
}

namespace att {
constexpr int KP = 208, VP = 144;
constexpr int KT = 64 * KP, VTB = 64 * VP;
constexpr int LDS_NEED = 2 * KT + 2 * VTB;
constexpr float THR = 8.0f;
__device__ __forceinline__ float max3(float a, float b, float c) { return __builtin_fmaxf(__builtin_fmaxf(a, b), c); }
__device__ __forceinline__ float rowmax32(const f32x16& p0, const f32x16& p1) {
    float a = max3(p0[0], p0[1], p1[0]), b = max3(p0[2], p0[3], p1[1]); a = max3(a, p1[2], p1[3]);
#pragma unroll
    for (int r = 4; r < 16; r += 4) { a = max3(a, p0[r], p0[r + 1]); b = max3(b, p0[r + 2], p0[r + 3]); a = max3(a, p1[r], p1[r + 1]); b = max3(b, p1[r + 2], p1[r + 3]); }
    const float m = __builtin_fmaxf(a, b);
    auto rr = __builtin_amdgcn_permlane32_swap(__float_as_uint(m), __float_as_uint(m), false, false);
    return __builtin_fmaxf(__uint_as_float(rr[0]), __uint_as_float(rr[1]));
}
__device__ __forceinline__ void attn_unit(LAS unsigned char* lds, int b, int h, int qb, const bf16* __restrict__ Q, const bf16* __restrict__ KN, const bf16* __restrict__ KR, const bf16* __restrict__ VT, bf16* __restrict__ Y) {
    const int tid = opaque_tid(), lane = tid & 63, r32 = lane & 31, hi = lane >> 5, w = __builtin_amdgcn_readfirstlane(tid >> 6);
    const int mrow = b * SEQ + qb * 256 + w * 32 + r32;
    const int nt_wg = 4 * qb + 4, nt_w = 4 * qb + (w >> 1) + 1;
    bf16x8 qf[6];
#pragma unroll
    for (int s = 0; s < 6; ++s) qf[s] = *(const bf16x8*)(Q + (size_t)mrow * 768 + h * 96 + 16 * s + 8 * hi);
    f32x16 o0 = {}, o1 = {}; float mref = 0.f, lsum = 0.f;
    const int kr0 = tid / 12, kc0 = tid % 12, kr1 = (tid + 512) / 12, kc1 = (tid + 512) % 12; const bool k2 = tid < 256;
    const int vd = tid >> 3, vc = tid & 7;
    const bf16* kp0 = (kc0 < 8) ? KN + ((size_t)b * SEQ + kr0) * 512 + h * 64 + kc0 * 8 : KR + ((size_t)b * SEQ + kr0) * 32 + (kc0 - 8) * 8; const size_t ks0 = (kc0 < 8) ? 64 * 512 : 64 * 32;
    const bf16* kp1 = (kc1 < 8) ? KN + ((size_t)b * SEQ + kr1) * 512 + h * 64 + kc1 * 8 : KR + ((size_t)b * SEQ + kr1) * 32 + (kc1 - 8) * 8; const size_t ks1 = (kc1 < 8) ? 64 * 512 : 64 * 32;
    const bf16* vp = VT + (size_t)(h * 64 + vd) * M + (size_t)b * SEQ + vc * 8;
    const int kw0 = kr0 * KP + kc0 * 16, kw1 = kr1 * KP + kc1 * 16, vw = 2 * KT + vd * VP + (vc >> 1) * 32 + (vc & 1) * 8;
    u32x4 kgA0, kgA1, vgA, kgB0, kgB1, vgB;
#define AT_GLOADK(S, t) do { kg##S##0 = *(const u32x4*)(kp0 + (size_t)(t) * ks0); if (k2) kg##S##1 = *(const u32x4*)(kp1 + (size_t)(t) * ks1); } while (0)
#define AT_GLOADV(S, t) do { vg##S = *(const u32x4*)(vp + (size_t)(t) * 64); } while (0)
#define AT_WRITEK(S, buf) do { *(LAS u32x4*)(lds + (buf) * KT + kw0) = kg##S##0; if (k2) *(LAS u32x4*)(lds + (buf) * KT + kw1) = kg##S##1; } while (0)
#define AT_WRITEV(S, buf) do { *(LAS u32x2*)(lds + (buf) * VTB + vw) = (u32x2){vg##S.x, vg##S.y}; *(LAS u32x2*)(lds + (buf) * VTB + vw + 16) = (u32x2){vg##S.z, vg##S.w}; } while (0)
    const int kro = r32 * KP + 16 * hi, vro = 2 * KT + r32 * VP + 16 * hi;
#define AT_QK(P0, P1, kb_, CIN) do { const LAS unsigned char* kb__ = lds + (kb_) * KT + kro; \
        _Pragma("unroll") for (int s = 0; s < 6; ++s) { const bf16x8 ka0 = *(const LAS bf16x8*)(kb__ + 32 * s), ka1 = *(const LAS bf16x8*)(kb__ + 32 * KP + 32 * s); \
            if (s == 0) { P0 = __builtin_amdgcn_mfma_f32_32x32x16_bf16(ka0, qf[0], CIN, 0, 0, 0); P1 = __builtin_amdgcn_mfma_f32_32x32x16_bf16(ka1, qf[0], CIN, 0, 0, 0); } \
            else { P0 = __builtin_amdgcn_mfma_f32_32x32x16_bf16(ka0, qf[s], P0, 0, 0, 0); P1 = __builtin_amdgcn_mfma_f32_32x32x16_bf16(ka1, qf[s], P1, 0, 0, 0); } } } while (0)
    AT_GLOADK(A, 0); AT_GLOADV(A, 0); AT_WRITEK(A, 0); AT_WRITEV(A, 0); AT_GLOADK(A, 1); AT_WRITEK(A, 1);
    AT_GLOADK(B, 2); AT_GLOADV(B, 1);
    __syncthreads();
    f32x16 pA, pB, negm = {};
    AT_QK(pA, pB, 0, negm);
    float rm = rowmax32(pA, pB);
    mref = rm;
    f32x16 pA1 = pB;
    f32x16 pB1 = {};
#pragma unroll
    for (int r = 0; r < 16; ++r) { pA[r] -= rm; pA1[r] -= rm; negm[r] = -rm; }
    rm = 0.f;
    __syncthreads();
#define AT_STEP(C0, C1, N0, N1, t, LS, WS) do { \
        if ((t) + 3 < nt_wg) AT_GLOADK(LS, (t) + 3); \
        if ((t) + 2 < nt_wg) AT_GLOADV(LS, (t) + 2); \
        if ((t) < nt_w) { \
            if ((t) > 0 && __builtin_amdgcn_ballot_w64(rm > THR) != 0ull) {     \
                const float dl = __builtin_fmaxf(rm, 0.f), f = fexp2(-dl); mref += dl; lsum *= f; \
                _Pragma("unroll") for (int r = 0; r < 16; ++r) { C0[r] -= dl; C1[r] -= dl; o0[r] *= f; o1[r] *= f; negm[r] = -mref; } } \
            AT_QK(N0, N1, ((t) + 1) & 1, negm);                   \
            _Pragma("unroll") for (int r = 0; r < 16; ++r) { C0[r] = fexp2(C0[r]); C1[r] = fexp2(C1[r]); } \
            bf16x8 pb[4]; \
            _Pragma("unroll") for (int ks = 0; ks < 2; ++ks) { u32x4 wv, wx; \
                wv.x = cvt_pk(C0[8 * ks + 0], C0[8 * ks + 1]); wv.y = cvt_pk(C0[8 * ks + 2], C0[8 * ks + 3]); wv.z = cvt_pk(C0[8 * ks + 4], C0[8 * ks + 5]); wv.w = cvt_pk(C0[8 * ks + 6], C0[8 * ks + 7]); \
                wx.x = cvt_pk(C1[8 * ks + 0], C1[8 * ks + 1]); wx.y = cvt_pk(C1[8 * ks + 2], C1[8 * ks + 3]); wx.z = cvt_pk(C1[8 * ks + 4], C1[8 * ks + 5]); wx.w = cvt_pk(C1[8 * ks + 6], C1[8 * ks + 7]); \
                pb[ks] = __builtin_bit_cast(bf16x8, wv); pb[2 + ks] = __builtin_bit_cast(bf16x8, wx); } \
            { const LAS unsigned char* vb__ = lds + ((t) & 1) * VTB + vro; \
              _Pragma("unroll") for (int ks = 0; ks < 4; ++ks) { \
                const bf16x8 va0 = *(const LAS bf16x8*)(vb__ + 32 * ks), va1 = *(const LAS bf16x8*)(vb__ + 32 * VP + 32 * ks); \
                o0 = __builtin_amdgcn_mfma_f32_32x32x16_bf16(va0, pb[ks], o0, 0, 0, 0); o1 = __builtin_amdgcn_mfma_f32_32x32x16_bf16(va1, pb[ks], o1, 0, 0, 0); } } \
            { float sa = 0.f, sb = 0.f; \
              _Pragma("unroll") for (int r = 0; r < 16; r += 2) { sa += C0[r] + C1[r]; sb += C0[r + 1] + C1[r + 1]; } \
              lsum += sa + sb; } \
            rm = rowmax32(N0, N1); \
              \
            __builtin_amdgcn_sched_group_barrier(0x100, 5, 0);     \
            _Pragma("unroll") for (int g_ = 0; g_ < 12; ++g_) { __builtin_amdgcn_sched_group_barrier(0x008, 1, 0); __builtin_amdgcn_sched_group_barrier(0x100, 1, 0); __builtin_amdgcn_sched_group_barrier(0x402, 4, 0); } \
            _Pragma("unroll") for (int g_ = 0; g_ < 8; ++g_) { __builtin_amdgcn_sched_group_barrier(0x008, 1, 0); __builtin_amdgcn_sched_group_barrier(0x100, 1, 0); __builtin_amdgcn_sched_group_barrier(0x402, 6, 0); } \
        } \
        if ((t) + 2 < nt_wg) AT_WRITEK(WS, (t) & 1); \
        if ((t) + 1 < nt_wg) AT_WRITEV(WS, ((t) + 1) & 1); \
        __syncthreads(); \
    } while (0)
    for (int t = 0; t < nt_wg; t += 2) {
        AT_STEP(pA, pA1, pB, pB1, t, A, B);
        AT_STEP(pB, pB1, pA, pA1, t + 1, B, A);
    }
#undef AT_STEP
#undef AT_QK
#undef AT_GLOADK
#undef AT_GLOADV
#undef AT_WRITEK
#undef AT_WRITEV
    float ltot = lsum; { auto rr = __builtin_amdgcn_permlane32_swap(__float_as_uint(lsum), __float_as_uint(lsum), false, false); ltot = __uint_as_float(rr[0]) + __uint_as_float(rr[1]); }
    const float inv = 1.0f / ltot;
    bf16* yrow = Y + (size_t)mrow * D + h * 64 + 4 * hi;
#pragma unroll
    for (int i = 0; i < 4; ++i) {
        u32x2 w0, w1; w0.x = cvt_pk(o0[4 * i] * inv, o0[4 * i + 1] * inv); w0.y = cvt_pk(o0[4 * i + 2] * inv, o0[4 * i + 3] * inv);
        w1.x = cvt_pk(o1[4 * i] * inv, o1[4 * i + 1] * inv); w1.y = cvt_pk(o1[4 * i + 2] * inv, o1[4 * i + 3] * inv);
        *(u32x2*)(yrow + 8 * i) = w0; *(u32x2*)(yrow + 32 + 8 * i) = w1;
    }
}
}

namespace sgu {
constexpr int VTP = 272;
constexpr int LDS_NEED = 128 * VTP;
__device__ __forceinline__ void unit(LAS unsigned char* lds, int m0, int gh, const bf16* __restrict__ GV, const bf16* __restrict__ U, const bf16* __restrict__ WS, const float* __restrict__ ln_g, const float* __restrict__ ln_b, const float* __restrict__ sb, bf16* __restrict__ Y) {
    const int tid = opaque_tid(), lane = tid & 63, r32 = lane & 31, hi = lane >> 5, w = __builtin_amdgcn_readfirstlane(tid >> 6);
    {
        const int cg = lane & 15, rsub = lane >> 4; const bool mine = (cg >> 3) == gh; const int cl = 16 * (cg & 7);
        f32x4 gq[4], bq[4];
#pragma unroll
        for (int q = 0; q < 4; ++q) { gq[q] = *(const f32x4*)(ln_g + 16 * cg + 4 * q); bq[q] = *(const f32x4*)(ln_b + 16 * cg + 4 * q); }
#pragma unroll
        for (int it = 0; it < 4; ++it) {
            const int s = w * 16 + it * 4 + rsub; const u32x4 r0 = *(const u32x4*)(GV + (size_t)(m0 + s) * 256 + 16 * cg), r1 = *(const u32x4*)(GV + (size_t)(m0 + s) * 256 + 16 * cg + 8);
            f32x4 x[4] = {{bflo(r0.x), bfhi(r0.x), bflo(r0.y), bfhi(r0.y)}, {bflo(r0.z), bfhi(r0.z), bflo(r0.w), bfhi(r0.w)}, {bflo(r1.x), bfhi(r1.x), bflo(r1.y), bfhi(r1.y)}, {bflo(r1.z), bfhi(r1.z), bflo(r1.w), bfhi(r1.w)}};
            float sm = 0.f;
#pragma unroll
            for (int q = 0; q < 4; ++q) sm += (x[q][0] + x[q][1]) + (x[q][2] + x[q][3]);
#pragma unroll
            for (int o = 1; o < 16; o <<= 1) sm += shx(sm, lane, o);
            const float mean = sm * (1.0f / 256.0f); float sq = 0.f;
#pragma unroll
            for (int q = 0; q < 4; ++q) { x[q] = x[q] - mean; sq += (x[q][0] * x[q][0] + x[q][1] * x[q][1]) + (x[q][2] * x[q][2] + x[q][3] * x[q][3]); }
#pragma unroll
            for (int o = 1; o < 16; o <<= 1) sq += shx(sq, lane, o);
            const float rstd = __builtin_amdgcn_rsqf(sq * (1.0f / 256.0f) + 1e-5f);
            if (mine) {
#pragma unroll
                for (int q = 0; q < 4; ++q) { const f32x4 y = x[q] * rstd * gq[q] + bq[q];
#pragma unroll
                    for (int e = 0; e < 4; ++e) *(LAS bf16*)(lds + (cl + 4 * q + e) * VTP + s * 2) = (bf16)(cvt_pk(y[e], 0.f) & 0xffffu); } }
        }
    }
    __syncthreads();
    const int gl = w >> 2, g = 2 * gh + gl, T = w & 3, nks = 2 * (T + 1);
    const bf16* wrow = WS + ((size_t)g * 128 + 32 * T + r32) * 128 + 8 * hi;
    bf16x8 af[8];
#pragma unroll
    for (int ks = 0; ks < 8; ++ks) af[ks] = (ks < nks) ? *(const bf16x8*)(wrow + 16 * ks) : (bf16x8){0, 0, 0, 0, 0, 0, 0, 0};
    f32x16 acc[2] = {};
#pragma unroll
    for (int ks = 0; ks < 8; ++ks) if (ks < nks) {
#pragma unroll
        for (int cb = 0; cb < 2; ++cb) { const bf16x8 bv = *(const LAS bf16x8*)(lds + (gl * 64 + 32 * cb + r32) * VTP + (16 * ks + 8 * hi) * 2);
            acc[cb] = __builtin_amdgcn_mfma_f32_32x32x16_bf16(af[ks], bv, acc[cb], 0, 0, 0); } }
    {
        constexpr int SP = 144;
        LAS unsigned char* sc = lds + 40960 + w * (32 * SP);
        const bf16* urow = U + (size_t)(m0 + 32 * T) * 256 + g * 64; bf16* yrow = Y + (size_t)(m0 + 32 * T) * D + 512 + g * 64;
#pragma unroll
        for (int i = 0; i < 4; ++i) { const int t = i * 8 + (lane >> 3), ch = lane & 7; *(LAS u32x4*)(sc + t * SP + ch * 16) = *(const u32x4*)(urow + (size_t)t * 256 + ch * 8); }
        float bv[16];
#pragma unroll
        for (int r = 0; r < 16; ++r) bv[r] = sb[g * 128 + 32 * T + (r & 3) + 8 * (r >> 2) + 4 * hi];
        asm volatile("" ::: "memory");
#pragma unroll
        for (int cb = 0; cb < 2; ++cb)
#pragma unroll
            for (int r = 0; r < 16; ++r) { const int t = (r & 3) + 8 * (r >> 2) + 4 * hi; LAS bf16* p = (LAS bf16*)(sc + t * SP + (32 * cb + r32) * 2);
                const float y = bf2f(*p) * (acc[cb][r] + bv[r]); *p = (bf16)(cvt_pk(y, 0.f) & 0xffffu); }
        asm volatile("" ::: "memory");
#pragma unroll
        for (int i = 0; i < 4; ++i) { const int t = i * 8 + (lane >> 3), ch = lane & 7; *(u32x4*)(yrow + (size_t)t * D + ch * 8) = *(const LAS u32x4*)(sc + t * SP + ch * 16); }
    }
    __syncthreads();
}
}

namespace lru {
constexpr int XP = 528;
constexpr int AP = 132;
constexpr int OFF_A = 64 * XP, OFF_B = OFF_A + 64 * AP * 4, LDS_NEED = OFF_B + 64 * AP * 4;
__device__ __forceinline__ void local_unit(LAS unsigned char* lds, int b, int c, const bf16* ZX, const float* conv_w, const float* conv_b, const bf16* WA, const bf16* WX,
                                           const float* ba, const float* bx, const float* lam, float* HL, float* PP) {
    const int tid = opaque_tid(), lane = tid & 63, r32 = lane & 31, hi = lane >> 5, w = __builtin_amdgcn_readfirstlane(tid >> 6);
    const int m0 = b * SEQ + c * 64;
    {
        const int cp = tid & 127, tq = tid >> 7, ch = 2 * cp;
        float w0[4], w1[4];
#pragma unroll
        for (int k = 0; k < 4; ++k) { w0[k] = conv_w[k * 256 + ch]; w1[k] = conv_w[k * 256 + ch + 1]; }
        const float cb0 = conv_b[ch], cb1 = conv_b[ch + 1];
        float z0[3], z1[3];
#pragma unroll
        for (int k = 0; k < 3; ++k) { const int tt = c * 64 + tq * 16 - 3 + k; unsigned raw = 0u; if (tt >= 0) raw = *(const unsigned*)(ZX + (size_t)(b * SEQ + tt) * 256 + ch); z0[k] = bflo(raw); z1[k] = bfhi(raw); }
#pragma unroll
        for (int i = 0; i < 16; ++i) { const int t = tq * 16 + i; const unsigned raw = *(const unsigned*)(ZX + (size_t)(m0 + t) * 256 + ch); const float a0 = bflo(raw), a1 = bfhi(raw);
            const float x0 = cb0 + z0[0] * w0[0] + z0[1] * w0[1] + z0[2] * w0[2] + a0 * w0[3], x1 = cb1 + z1[0] * w1[0] + z1[1] * w1[1] + z1[2] * w1[2] + a1 * w1[3];
            *(LAS unsigned*)(lds + t * XP + ch * 2) = cvt_pk(x0, x1);
            z0[0] = z0[1]; z0[1] = z0[2]; z0[2] = a0; z1[0] = z1[1]; z1[1] = z1[2]; z1[2] = a1; }
    }
    __syncthreads();
    LAS float* A32 = (LAS float*)(lds + OFF_A); LAS float* B32 = (LAS float*)(lds + OFF_B);
    for (int half = 0; half < 2; ++half) {
        {
            const int head = 2 * half + (w >> 2), tb = (w >> 1) & 1, jb = w & 1;
            f32x16 ar = {}, ai = {};
            bf16x8 wa[4], wx[4];
#pragma unroll
            for (int ks = 0; ks < 4; ++ks) { wa[ks] = *(const bf16x8*)(WA + ((size_t)head * 64 + 32 * jb + r32) * 64 + 16 * ks + 8 * hi); wx[ks] = *(const bf16x8*)(WX + ((size_t)head * 64 + 32 * jb + r32) * 64 + 16 * ks + 8 * hi); }
#pragma unroll
            for (int ks = 0; ks < 4; ++ks) {
                const bf16x8 xa = *(const LAS bf16x8*)(lds + (32 * tb + r32) * XP + (head * 64 + 16 * ks + 8 * hi) * 2);
                ar = __builtin_amdgcn_mfma_f32_32x32x16_bf16(xa, wa[ks], ar, 0, 0, 0); ai = __builtin_amdgcn_mfma_f32_32x32x16_bf16(xa, wx[ks], ai, 0, 0, 0);
            }
            const int ch = head * 64 + 32 * jb + r32, chl = ch - 128 * half;
            const float bav = ba[ch], bxv = bx[ch], lm = lam[ch];
            const float nsp = -8.0f * (fmaxf(-lm, 0.f) + log1pf(__expf(-fabsf(lm))));
#pragma unroll
            for (int r = 0; r < 16; ++r) { const int t = 32 * tb + (r & 3) + 8 * (r >> 2) + 4 * hi;
                const float rg = sigmoidf_(ar[r] + bav), ig = sigmoidf_(ai[r] + bxv), la = rg * nsp;
                const float x2 = 2.0f * la;
                const float a = __expf(la);
                const float om = (x2 > -0.25f) ? -x2 * (1.0f + x2 * (0.5f + x2 * (0.16666667f + x2 * (0.041666668f + x2 * (0.0083333338f + x2 * 0.0013888889f))))) : 1.0f - a * a;
                const float s = sqrtf(fmaxf(om, 0.f));
                const float xc = bf2f(*(const LAS bf16*)(lds + t * XP + ch * 2));
                A32[t * AP + chl] = a; B32[t * AP + chl] = s * (ig * xc); }
        }
        __syncthreads();
        {
            const int chs = tid & 127, seg = tid >> 7; LAS float* sum = (LAS float*)(lds + LDS_NEED);
            float av[16], bv[16];
#pragma unroll
            for (int i = 0; i < 16; ++i) { av[i] = A32[(16 * seg + i) * AP + chs]; bv[i] = B32[(16 * seg + i) * AP + chs]; }
            float hh = 0.f, pp = 1.f;
#pragma unroll
            for (int i = 0; i < 16; ++i) { hh = av[i] * hh + bv[i]; pp *= av[i]; bv[i] = hh; av[i] = pp; }
            sum[(seg * 2) * 128 + chs] = hh; sum[(seg * 2 + 1) * 128 + chs] = pp;
            __syncthreads();
            float Hin = 0.f, Pin = 1.f;
#pragma unroll
            for (int s = 0; s < 3; ++s) if (s < seg) { const float hs = sum[(s * 2) * 128 + chs], ps = sum[(s * 2 + 1) * 128 + chs]; Hin = ps * Hin + hs; Pin *= ps; }
            float* hl = HL + (size_t)(m0 + 16 * seg) * 256 + 128 * half + chs; float* pq = PP + (size_t)(m0 + 16 * seg) * 256 + 128 * half + chs;
#pragma unroll
            for (int i = 0; i < 16; ++i) { hl[(size_t)i * 256] = bv[i] + av[i] * Hin; pq[(size_t)i * 256] = av[i] * Pin; }
        }
        __syncthreads();
    }
}
__device__ __forceinline__ void fix_unit(LAS unsigned char* lds, int b, int c, const float* __restrict__ HL, const float* __restrict__ PP, const bf16* __restrict__ GY, bf16* __restrict__ Y) {
    const int tid = opaque_tid(); const int m0 = b * SEQ + c * 64; LAS float* hin = (LAS float*)lds;
    {
        const int ch = tid & 255, half = tid >> 8, c0 = half ? (c >> 1) : 0, c1 = half ? c : (c >> 1);
        float h = 0.f, pa = 1.f; const float* pq = PP + (size_t)(b * SEQ + 63) * 256 + ch; const float* hq = HL + (size_t)(b * SEQ + 63) * 256 + ch;
        int cc = c0;
        for (; cc + 8 <= c1; cc += 8) { float pv[8], hv[8];
#pragma unroll
            for (int j = 0; j < 8; ++j) { pv[j] = pq[(size_t)(cc + j) * 64 * 256]; hv[j] = hq[(size_t)(cc + j) * 64 * 256]; }
#pragma unroll
            for (int j = 0; j < 8; ++j) { h = pv[j] * h + hv[j]; pa *= pv[j]; } }
        for (; cc < c1; ++cc) { const float pv = pq[(size_t)cc * 64 * 256]; h = pv * h + hq[(size_t)cc * 64 * 256]; pa *= pv; }
        if (half) { hin[256 + ch] = h; hin[512 + ch] = pa; }
        __syncthreads();
        if (!half) hin[ch] = hin[512 + ch] * h + hin[256 + ch];
    }
    __syncthreads();
#pragma unroll
    for (int k = 0; k < 8; ++k) { const int item = tid + 512 * k, t = item >> 6, cg = item & 63; const size_t mo = (size_t)(m0 + t) * 256 + 4 * cg;
        const f32x4 hl = *(const f32x4*)(HL + mo), pp = *(const f32x4*)(PP + mo), hi4 = *(const LAS f32x4*)(hin + 4 * cg); const u32x2 gy = *(const u32x2*)(GY + mo);
        const f32x4 hv = hl + pp * hi4; u32x2 o; o.x = cvt_pk(hv[0] * bflo(gy.x), hv[1] * bfhi(gy.x)); o.y = cvt_pk(hv[2] * bflo(gy.y), hv[3] * bfhi(gy.y));
        *(u32x2*)(Y + (size_t)(m0 + t) * D + 768 + 4 * cg) = o; }
    __syncthreads();
}
}

struct MoeOrder {
    static constexpr bool GATHER = false;
    const volatile LAS int* tab; int npn, G, c, lim;
    __device__ __forceinline__ bool next_tail(pg8::Unit& u) const { const int L = lim + (c >> 1); if (L >= __builtin_amdgcn_readfirstlane(tab[24]) * npn) return false; map(L, u); u.co = (c & 1) * pg8::HALF; return true; }
    __device__ __forceinline__ bool next(int i, pg8::Unit& u) const {
        const int L = i * G + c, TT = __builtin_amdgcn_readfirstlane(tab[24]); if (L >= TT * npn || L >= lim) return false;
        map(L, u); return true; }
    __device__ __forceinline__ void map(int L, pg8::Unit& u) const {
        const int ti = L / npn, pnl = L - ti * npn; int e = 0;
#pragma unroll
        for (int j = 1; j < 8; ++j) e += (ti >= tab[16 + j]) ? 1 : 0;
        e = __builtin_amdgcn_readfirstlane(e);
        const int lt = ti - __builtin_amdgcn_readfirstlane(tab[16 + e]);
        u.pm = ti; u.pn = e * npn + pnl; u.x0 = ti; u.x1 = pnl; u.x2 = e * ECAP + lt * 256; u.x3 = __builtin_amdgcn_readfirstlane(tab[32 + e]) - lt * 256; u.co = 0;
    }
    __device__ __forceinline__ int src_row(const pg8::Unit&, int) const { return 0; }
};
struct MoeGatherOrder : MoeOrder {
    static constexpr bool GATHER = true;
    const int* idx;
    __device__ __forceinline__ int src_row(const pg8::Unit& u, int r) const { return (r < u.x3) ? idx[u.x2 + r] : 0; }
};

struct RowArgs {
    const float* xin; float* X; bf16* Xb; const bf16* Ysrc; const bf16* YD;     const int* slot; const float* gatew;
    const float* gate; const float* postg;
    const float* preg; const float* sc; const float* sh;
    bf16* H; const float* router; unsigned* cursor; int* idx; int* slot_w; float* gatew_w; u64* ssq_q; u64* ssq_kv; float* rs; float* rss;
};
template <int MODE>
__device__ __forceinline__ void row_phase(LAS unsigned char* lds, const volatile LAS int* tab, int vcu, const RowArgs& a, bool need_h, bool route) {
    const int tid = opaque_tid(), lane = tid & 63, w = __builtin_amdgcn_readfirstlane(tid >> 6);
    LAS float* rt = (LAS float*)lds; LAS int* e01 = (LAS int*)(lds + 32768); LAS float* rsl = (LAS float*)(lds + 32768 + 256);
    if (route) { for (int i = tid; i < 8192; i += 512) rt[(i & 7) * 1024 + (i >> 3)] = a.router[i]; __syncthreads(); }
    f32x4 cg[4], cb[4], cs[4];
#pragma unroll
#define RC(j) (512 * ((j) >> 1) + 8 * lane + 4 * ((j) & 1))
    for (int j = 0; j < 4; ++j) { const int col = RC(j);
        if (MODE != 0) cg[j] = *(const f32x4*)(a.gate + col) * *(const f32x4*)(a.postg + col);
        if (need_h) { cb[j] = *(const f32x4*)(a.preg + col) * (*(const f32x4*)(a.sc + col) + 1.0f); cs[j] = *(const f32x4*)(a.sh + col); } }
    const int row0 = vcu * 64 + w * 8;
    int slotv0 = 0, slotv1 = 0; float gv0 = 0.f, gv1 = 0.f;
    if (MODE == 3) { const int rr = row0 + (lane & 7); slotv0 = a.slot[rr * 2]; slotv1 = a.slot[rr * 2 + 1]; gv0 = a.gatew[rr * 2]; gv1 = a.gatew[rr * 2 + 1]; }
    f32x4 nx0[2][4]; u32x4 nxb[2][2], nyp[2][2], nyq[2][2];
#define ROW_LOAD(S, rw, ii) do { \
        if (MODE == 0) { _Pragma("unroll") for (int j = 0; j < 4; ++j) nx0[S][j] = __builtin_nontemporal_load((const f32x4*)(a.xin + (size_t)(rw) * D + RC(j))); } \
        else { _Pragma("unroll") for (int jj = 0; jj < 2; ++jj) nxb[S][jj] = __builtin_nontemporal_load((const u32x4*)(a.Xb + (size_t)(rw) * D + 512 * jj + 8 * lane)); } \
        if (MODE == 3) { const int s0_ = __builtin_amdgcn_readlane(slotv0, (ii)), s1_ = __builtin_amdgcn_readlane(slotv1, (ii)); \
            const size_t r0_ = (size_t)tab[16 + (s0_ >> 14)] * 256 + (s0_ & (ECAP - 1)), r1_ = (size_t)tab[16 + (s1_ >> 14)] * 256 + (s1_ & (ECAP - 1)); \
            _Pragma("unroll") for (int jj = 0; jj < 2; ++jj) { nyp[S][jj] = __builtin_nontemporal_load((const u32x4*)(a.YD + r0_ * D + 512 * jj + 8 * lane)); nyq[S][jj] = __builtin_nontemporal_load((const u32x4*)(a.YD + r1_ * D + 512 * jj + 8 * lane)); } } \
        else if (MODE != 0) { _Pragma("unroll") for (int jj = 0; jj < 2; ++jj) nyp[S][jj] = __builtin_nontemporal_load((const u32x4*)(a.Ysrc + (size_t)(rw) * D + 512 * jj + 8 * lane)); } } while (0)
    float my_rs = 0.f, my_g0 = 0.f, my_g1 = 0.f; int my_pk = 0;
    ROW_LOAD(0, row0, 0); ROW_LOAD(1, row0 + 1, 1);
#pragma unroll
    for (int i = 0; i < 8; ++i) {
        const int row = row0 + i; constexpr int dummy_ = 0; (void)dummy_;
        f32x4 x[4]; u32x2 yp[4], yq[4];
#pragma unroll
        for (int jj = 0; jj < 2; ++jj) {
            if (MODE == 0) { x[2 * jj] = nx0[i & 1][2 * jj]; x[2 * jj + 1] = nx0[i & 1][2 * jj + 1]; }
            else { const u32x4 q_ = nxb[i & 1][jj]; x[2 * jj] = (f32x4){bflo(q_.x), bfhi(q_.x), bflo(q_.y), bfhi(q_.y)}; x[2 * jj + 1] = (f32x4){bflo(q_.z), bfhi(q_.z), bflo(q_.w), bfhi(q_.w)}; }
            yp[2 * jj] = (u32x2){nyp[i & 1][jj].x, nyp[i & 1][jj].y}; yp[2 * jj + 1] = (u32x2){nyp[i & 1][jj].z, nyp[i & 1][jj].w}; yq[2 * jj] = (u32x2){nyq[i & 1][jj].x, nyq[i & 1][jj].y}; yq[2 * jj + 1] = (u32x2){nyq[i & 1][jj].z, nyq[i & 1][jj].w}; }
        if (i + 2 < 8) { if (i & 1) ROW_LOAD(1, row + 2, i + 2); else ROW_LOAD(0, row + 2, i + 2); }
        if (MODE != 0) {
            f32x4 y[4];
            if (MODE == 3) {
                const float g0 = __builtin_bit_cast(float, __builtin_amdgcn_readlane(__builtin_bit_cast(int, gv0), i)), g1 = __builtin_bit_cast(float, __builtin_amdgcn_readlane(__builtin_bit_cast(int, gv1), i));
#pragma unroll
                for (int j = 0; j < 4; ++j) y[j] = (f32x4){bflo(yp[j].x), bfhi(yp[j].x), bflo(yp[j].y), bfhi(yp[j].y)} * g0 + (f32x4){bflo(yq[j].x), bfhi(yq[j].x), bflo(yq[j].y), bfhi(yq[j].y)} * g1;
            } else {
#pragma unroll
                for (int j = 0; j < 4; ++j) y[j] = (f32x4){bflo(yp[j].x), bfhi(yp[j].x), bflo(yp[j].y), bfhi(yp[j].y)};
            }
            float ss = 0.f;
#pragma unroll
            for (int j = 0; j < 4; ++j) ss += (y[j][0] * y[j][0] + y[j][1] * y[j][1]) + (y[j][2] * y[j][2] + y[j][3] * y[j][3]);
            const float r = __builtin_amdgcn_rsqf(wave_sum_dpp(ss) * (1.0f / D) + 1e-6f);
#pragma unroll
            for (int j = 0; j < 4; ++j) x[j] = x[j] + cg[j] * (y[j] * r);
        }
        if (a.X) {
#pragma unroll
            for (int j = 0; j < 4; ++j) *(f32x4*)(a.X + (size_t)row * D + RC(j)) = x[j];
        } else {
#pragma unroll
            for (int jj = 0; jj < 2; ++jj) __builtin_nontemporal_store(pg8::pack8(x[2 * jj], x[2 * jj + 1]), (u32x4*)(a.Xb + (size_t)row * D + 512 * jj + 8 * lane)); }
        if (need_h) {
            float ss = 0.f;
#pragma unroll
            for (int j = 0; j < 4; ++j) ss += (x[j][0] * x[j][0] + x[j][1] * x[j][1]) + (x[j][2] * x[j][2] + x[j][3] * x[j][3]);
            const float r = __builtin_amdgcn_rsqf(wave_sum_dpp(ss) * (1.0f / D) + 1e-6f);
            f32x4 hv[4];
#pragma unroll
            for (int j = 0; j < 4; ++j) hv[j] = (x[j] * r) * cb[j] + cs[j];
            float qinv = 0.f;
            {
                float am = 0.f;
#pragma unroll
                for (int j = 0; j < 4; ++j) am = __builtin_fmaxf(am, __builtin_fmaxf(__builtin_fmaxf(__builtin_fabsf(hv[j][0]), __builtin_fabsf(hv[j][1])), __builtin_fmaxf(__builtin_fabsf(hv[j][2]), __builtin_fabsf(hv[j][3]))));
                am = __builtin_fmaxf(wave_max_dpp(am), 1e-30f); qinv = 127.0f / am;
                { const float s = am * (1.0f / 127.0f); if (lane == i) my_rs = s; } }
#pragma unroll
            for (int jj = 0; jj < 2; ++jj) {
                u32x2 o; o.x = pg8::pk4_i8(hv[2 * jj] * qinv); o.y = pg8::pk4_i8(hv[2 * jj + 1] * qinv); *(u32x2*)((unsigned char*)a.H + (size_t)row * D + 512 * jj + 8 * lane) = o; }
            if (route) {
                float pe[8];
#pragma unroll
                for (int e = 0; e < 8; ++e) { float p = 0.f;
#pragma unroll
                    for (int j = 0; j < 4; ++j) { const f32x4 rv = *(const LAS f32x4*)(rt + e * 1024 + RC(j)); p += (hv[j][0] * rv[0] + hv[j][1] * rv[1]) + (hv[j][2] * rv[2] + hv[j][3] * rv[3]); }
                    pe[e] = p; }
                float q4[4], q2[2], q1;
                { const bool up = (lane & 32) != 0;
#pragma unroll
                  for (int j = 0; j < 4; ++j) { const float keep = up ? pe[4 + j] : pe[j], give = up ? pe[j] : pe[4 + j]; q4[j] = keep + shx(give, lane, 32); } }
                { const bool up = (lane & 16) != 0;
#pragma unroll
                  for (int j = 0; j < 2; ++j) { const float keep = up ? q4[2 + j] : q4[j], give = up ? q4[j] : q4[2 + j]; q2[j] = keep + shx(give, lane, 16); } }
                { const bool up = (lane & 8) != 0; const float keep = up ? q2[1] : q2[0], give = up ? q2[0] : q2[1]; q1 = keep + shx(give, lane, 8); }
                q1 += shx(q1, lane, 4); q1 += shx(q1, lane, 2); q1 += shx(q1, lane, 1);
                float lg[8];
#pragma unroll
                for (int e = 0; e < 8; ++e) lg[e] = __builtin_bit_cast(float, __builtin_amdgcn_readlane(__builtin_bit_cast(int, q1), 8 * e));
                int e0 = 0; float v0 = lg[0];
#pragma unroll
                for (int e = 1; e < 8; ++e) if (lg[e] > v0) { v0 = lg[e]; e0 = e; }
                int e1 = -1; float v1 = -3.0e38f;
#pragma unroll
                for (int e = 0; e < 8; ++e) if (e != e0 && lg[e] > v1) { v1 = lg[e]; e1 = e; }
                const float g0 = 1.0f / (1.0f + __expf(v1 - v0)), g1 = 1.0f - g0;
                if (lane == i) { my_pk = e0 | (e1 << 8); my_g0 = g0; my_g1 = g1; }
            }
        }
        asm volatile("" ::: "memory");
    }
    if (lane < 8) {
        if (need_h) a.rs[row0 + lane] = my_rs;
        if (MODE == 1) { a.ssq_q[row0 + lane] = 0ull; a.ssq_kv[row0 + lane] = 0ull; }
        if (route) { rsl[w * 8 + lane] = my_rs; e01[w * 8 + lane] = my_pk; a.gatew_w[(row0 + lane) * 2] = my_g0; a.gatew_w[(row0 + lane) * 2 + 1] = my_g1; } }
    if (route) {
        __syncthreads();
        if (w == 0) {
            const int pk = e01[lane], e0 = pk & 255, e1 = pk >> 8, token = vcu * 64 + lane; const u64 lt = (1ull << lane) - 1ull;
            int p0 = 0, p1 = 0, mycnt = 0;
#pragma unroll
            for (int e = 0; e < 8; ++e) {
                const u64 m0 = __ballot(e0 == e), m1 = __ballot(e1 == e); const int c0 = __popcll(m0), c1 = __popcll(m1);
                if (lane == e) mycnt = c0 + c1;
                if (e0 == e) p0 = __popcll(m0 & lt);
                if (e1 == e) p1 = c0 + __popcll(m1 & lt);
            }
            unsigned mybase = 0u; if (lane < 8 && mycnt > 0) mybase = atomicAdd(a.cursor + lane, (unsigned)mycnt);
#pragma unroll
            for (int e = 0; e < 8; ++e) { const int base = __builtin_amdgcn_readlane((int)mybase, e); if (e0 == e) p0 += base; if (e1 == e) p1 += base; }
            a.idx[e0 * ECAP + p0] = token; a.idx[e1 * ECAP + p1] = token;
            a.slot_w[token * 2] = e0 * ECAP + p0; a.slot_w[token * 2 + 1] = e1 * ECAP + p1;
            { const float s = rsl[lane]; a.rss[e0 * ECAP + p0] = s; a.rss[e1 * ECAP + p1] = s; }
        }
        __syncthreads();
    }
}

__device__ __forceinline__ int rperm(int jj) { return 8 * ((jj & 15) >> 2) + 4 * (jj >> 4) + (jj & 3); }
__device__ __forceinline__ int map_row(int kind, int n) {
    if (kind == 1) return 256 * (n >> 7) + (n & 127);
    if (kind == 2) return 256 * (n >> 7) + 128 + (n & 127);
    if (kind == 3) return n < 384 ? n : (n < 416 ? 384 + rperm(n - 384) : n + 96);
    if (kind == 4) { const int h = n / 96, j = n - 96 * h; return j < 64 ? n : h * 96 + 64 + rperm(j - 64); }
    return n;
}
template <bool F8 = false>
__device__ __forceinline__ void tr_item(const float* W, int ldn, void* WTv, int ldk, const float* gain, int kind, LAS float* scr, int kb, int nb, int lane) {
    const int k0 = 64 * kb, n0 = 32 * nb;
#pragma unroll
    for (int i = 0; i < 32; ++i) { const int kk = 2 * i + (lane >> 5); float v = __builtin_nontemporal_load(W + (size_t)(k0 + kk) * ldn + n0 + (lane & 31)); if (gain) v *= gain[k0 + kk]; scr[kk * 33 + (lane & 31)] = v; }
    LDS_WAIT(); asm volatile("" ::: "memory");
    const int c = lane & 7;
#pragma unroll
    for (int j = 0; j < 4; ++j) { const int n = (lane >> 3) + 8 * j; const LAS float* s = scr + (8 * c) * 33 + n;
        if constexpr (F8) { u32x2 o; o.x = pg8::pk4_fp8((f32x4){s[0 * 33], s[1 * 33], s[2 * 33], s[3 * 33]} * pg8::F8_WSC); o.y = pg8::pk4_fp8((f32x4){s[4 * 33], s[5 * 33], s[6 * 33], s[7 * 33]} * pg8::F8_WSC);
            *(u32x2*)((unsigned char*)WTv + (size_t)map_row(kind, n0 + n) * ldk + k0 + 8 * c) = o; }
        else { bf16* WT = (bf16*)WTv; u32x4 o; o.x = cvt_pk(s[0 * 33], s[1 * 33]); o.y = cvt_pk(s[2 * 33], s[3 * 33]); o.z = cvt_pk(s[4 * 33], s[5 * 33]); o.w = cvt_pk(s[6 * 33], s[7 * 33]);
            *(u32x4*)(WT + (size_t)map_row(kind, n0 + n) * ldk + k0 + 8 * c) = o; } }
    LDS_WAIT(); asm volatile("" ::: "memory");
}
__device__ __forceinline__ void colq_item(const float* W, int ldn, unsigned char* WT, float* CS, int kind, int nb, LAS float* red, int tid) {
    const int lane = tid & 63, w = tid >> 6, n = lane & 31, kh = lane >> 5, kb = 128 * w + 64 * kh;
    const float* src = W + (size_t)kb * ldn + nb * 32 + n;
    float v[64];
#pragma unroll
    for (int j = 0; j < 64; ++j) v[j] = __builtin_nontemporal_load(src + (size_t)j * ldn);
    float m = 0.f;
#pragma unroll
    for (int j = 0; j < 64; ++j) m = __builtin_fmaxf(m, __builtin_fabsf(v[j]));
    m = __builtin_fmaxf(m, shx(m, lane, 32));
    if (kh == 0) red[w * 32 + n] = m;
    __syncthreads();
    float cm = red[n];
#pragma unroll
    for (int ww = 1; ww < 8; ++ww) cm = __builtin_fmaxf(cm, red[ww * 32 + n]);
    cm = __builtin_fmaxf(cm, 1e-30f);
    const float inv = 127.0f / cm; const int row = map_row(kind, nb * 32 + n);
    if (w == 0 && kh == 0) CS[row] = cm * (1.0f / 127.0f);
    unsigned char* dst = WT + (size_t)row * 1024 + kb;
#pragma unroll
    for (int c = 0; c < 4; ++c) { u32x4 o;
        o.x = pg8::pk4_i8((f32x4){v[16 * c + 0], v[16 * c + 1], v[16 * c + 2], v[16 * c + 3]} * inv); o.y = pg8::pk4_i8((f32x4){v[16 * c + 4], v[16 * c + 5], v[16 * c + 6], v[16 * c + 7]} * inv);
        o.z = pg8::pk4_i8((f32x4){v[16 * c + 8], v[16 * c + 9], v[16 * c + 10], v[16 * c + 11]} * inv); o.w = pg8::pk4_i8((f32x4){v[16 * c + 12], v[16 * c + 13], v[16 * c + 14], v[16 * c + 15]} * inv);
        *(u32x4*)(dst + 16 * c) = o; }
    __syncthreads();
}
__device__ __forceinline__ void sincos_acc(float ang, float& s, float& c) {
    const double a = (double)ang; const double kq = __builtin_rint(a * 0.63661977236758134308); const double r = (a - kq * 1.57079632679489655800e+00) - kq * 6.12323399573676603587e-17;
    const float x = (float)r, x2 = x * x;
    const float sp = x + x * x2 * (-1.6666667163e-01f + x2 * (8.3333337680e-03f + x2 * (-1.9841270114e-04f + x2 * 2.7557314297e-06f)));
    const float cp = 1.0f + x2 * (-0.5f + x2 * (4.1666667908e-02f + x2 * (-1.3888889225e-03f + x2 * (2.4801587642e-05f + x2 * -2.7557314297e-07f))));
    const int q = ((int)kq) & 3;
    s = (q == 0) ? sp : (q == 1) ? cp : (q == 2) ? -sp : -cp;
    c = (q == 0) ? cp : (q == 1) ? -sp : (q == 2) ? -cp : sp;
}

struct Args { const float* in[32]; float* out; unsigned char* ws; };
enum { I_X = 0, I_C, I_WMOD, I_BMOD, I_PREMIX, I_POSTMIX, I_WIN, I_QNG, I_WUQ, I_KVNG, I_WUKV, I_SGLNG, I_SGLNB, I_SGW, I_SGB, I_CONVW, I_CONVB, I_LWA, I_LBA, I_LWX, I_LBX, I_LAM,
       I_WO, I_PREFFN, I_POSTFFN, I_FG, I_FU, I_FD, I_ROUTER, I_MG, I_MU, I_MD };

#define WSL GAS unsigned char* wslg_ = (GAS unsigned char*)args.ws; int zi_ = 0, bxo = bx_, vcuo = vcu_, Go = G_; asm volatile("" : "+s"(wslg_), "+s"(zi_), "+s"(bxo), "+s"(vcuo), "+s"(Go)); unsigned char* wsl = (unsigned char*)wslg_
#define AIN(i) ((const float*)(GAS const float*)args.in[(i) + zi_])
#define W_ctl ((unsigned*)(wsl + WS_CTL))
#define W_MOD ((float*)(wsl + WS_MOD))
#define W_cosT ((float*)(wsl + WS_COS))
#define W_sinT ((float*)(wsl + WS_SIN))
#define W_ssq_q ((u64*)(wsl + WS_SSQQ))
#define W_ssq_kv ((u64*)(wsl + WS_SSQK))
#define W_IDX ((int*)(wsl + WS_IDX))
#define W_SLOT ((int*)(wsl + WS_SLOT))
#define W_GATEW ((float*)(wsl + WS_GATEW))
#define W_WB ((bf16*)(wsl + WS_W))
#define W_H ((bf16*)(wsl + WS_H))
#define W_YO ((bf16*)(wsl + WS_YO))
#define W_ZQ ((bf16*)(wsl + WS_ZQ))
#define W_ZKV ((bf16*)(wsl + WS_ZKV))
#define W_KR ((bf16*)(wsl + WS_KR))
#define W_U ((bf16*)(wsl + WS_U))
#define W_GV ((bf16*)(wsl + WS_GV))
#define W_ZX ((bf16*)(wsl + WS_ZX))
#define W_GY ((bf16*)(wsl + WS_GY))
#define W_Q ((bf16*)(wsl + WS_Q))
#define W_KN ((bf16*)(wsl + WS_KN))
#define W_VT ((bf16*)(wsl + WS_VT))
#define W_Y ((bf16*)(wsl + WS_Y))
#define W_HL ((float*)(wsl + WS_HL))
#define W_PP ((float*)(wsl + WS_PP))
#define W_ACT ((bf16*)(wsl + WS_ACT))
#define W_YD ((bf16*)(wsl + WS_YD))
#define W_DW8(i) ((unsigned char*)(W_WB + WOFF_DENSE + (size_t)(i) * DW_SIZE))
#define W_MW8(i) ((unsigned char*)(W_WB + WOFF_MOE + (size_t)(i) * MW_SIZE))
#define W_ACT8 ((unsigned char*)(wsl + WS_ACT))
#define W_ACT8D ((unsigned char*)(wsl + WS_ACTD))
#define W_X ((float*)(GAS float*)args.out)
#define W_XB ((bf16*)(wsl + WS_YO + 32 * MiB))
__global__ void __launch_bounds__(512, 2) trunk_fwd(Args args) {
    extern __shared__ __attribute__((aligned(16))) unsigned char lds_raw[];
    LAS unsigned char* lds = (LAS unsigned char*)lds_raw;
    volatile LAS unsigned* MISC = (volatile LAS unsigned*)(lds + MISC_OFF);
    const volatile LAS int* tab = (const volatile LAS int*)(lds + MISC_OFF);
    const int wave = __builtin_amdgcn_readfirstlane(threadIdx.x >> 6);
    constexpr int G_ = 256;
    if (gridDim.x != G_) return;
    const int bx_ = blockIdx.x, vcu_ = (bx_ % 8) * (G_ / 8) + bx_ / 8;
    for (int u = threadIdx.x; u < (LDS_BYTES - MISC_OFF) / 4; u += 512) MISC[u] = 0u;
    __syncthreads();
    { WSL; (void)xcd_barrier_post(W_ctl, MISC); }
    { WSL; if (opaque_tid() == 0 && bx_ < 8) __hip_atomic_store(W_ctl + 6000 + bx_, xb_xcc_id() + 1u, __ATOMIC_RELAXED, __HIP_MEMORY_SCOPE_AGENT); }
#define GRID_BAR() do { WSL; XcdBarrier b_; b_.bar = W_ctl; b_.x = xb_xcc_id(); b_.st = MISC; xcd_barrier(b_); } while (0)
#define GRID_BAR_P() do { WSL; XcdBarrier b_; b_.bar = W_ctl; b_.x = xb_xcc_id(); b_.st = MISC; if (MISC[9]) xcd_pair_barrier(b_, (unsigned)((bx_ & 7) >> 1)); else xcd_barrier(b_); } while (0)
#define GRID_BAR_L() do { WSL; XcdBarrier b_; b_.bar = W_ctl; b_.x = xb_xcc_id(); b_.st = MISC; if (MISC[8]) xcd_local_barrier(b_); else xcd_barrier(b_); } while (0)

    {
        WSL; const int tid = opaque_tid(), lane = tid & 63;
        LAS float* scr = (LAS float*)(lds + wave * 8448);
        const int gw = vcuo * 8 + wave, NGW = Go * 8;
        constexpr int N0 = 4 * 720, N1 = 4 * 96, N2 = 4 * 64, N3 = 4 * 512, N4 = 2 * 1408, N7 = 16 * 704;
        constexpr int NITEMS = N1 + N2 + N3 + N4 + N7;
        { LAS float* red = (LAS float*)(lds + 102400);
          for (int it = vcuo; it < 352 + 1408 + 180; it += Go) {
              if (it >= 352 + 1408) { const int r = it - 1760, l = r / 45, nb = r % 45; unsigned char* wt = (unsigned char*)(W_WB + l * LW_SIZE + LW_WIN);
                  colq_item(AIN(I_WIN) + (size_t)l * D * DIN, DIN, wt, (float*)(wt + (size_t)DINP * D), 3, nb, red, tid); }
              else if (it < 352) { const int i = it / 176, r = it % 176, kind = 1 + r / 88, nb = r % 88;
                  colq_item(AIN(kind == 1 ? I_FG : I_FU) + (size_t)i * D * DFF, DFF, W_DW8(i) + DW8_GU, (float*)(W_DW8(i) + DW8_CS), kind, nb, red, tid); }
              else { const int r = it - 352, ie = r / 88, q = r % 88, kind = 1 + q / 44, nb = q % 44;
                  colq_item(AIN(kind == 1 ? I_MG : I_MU) + (size_t)ie * D * DFE, DFE, W_MW8(ie >> 3) + MW8_GU + (size_t)(ie & 7) * 2 * DFE * D, (float*)(W_MW8(ie >> 3) + MW8_CS) + (ie & 7) * 2 * DFE, kind, nb, red, tid); } } }
        for (int it = gw; it < NITEMS; it += NGW) {
            int r = it;
            if (r < N1) { const int l = r / 96, q = r % 96; tr_item(AIN(I_WUQ) + (size_t)l * 256 * 768, 768, W_WB + l * LW_SIZE + LW_WUQ, 256, AIN(I_QNG) + l * 256, 4, scr, q / 24, q % 24, lane); continue; } r -= N1;
            if (r < N2) { const int l = r / 64, q = r % 64, kb = q / 32, nb = q % 32;
                const bool isv = ((nb & 3) >= 2); bf16* dst = W_WB + l * LW_SIZE + (isv ? LW_WUV : LW_WUK) + (size_t)((nb >> 2) * 64 + (nb & 1) * 32) * 256;
                tr_item(AIN(I_WUKV) + (size_t)l * 128 * 1024 + nb * 32, 1024, dst, 256, AIN(I_KVNG) + l * 128, 0, scr, kb, 0, lane); continue; } r -= N2;
            if (r < N3) { const int l = r / 512, q = r % 512; tr_item(AIN(I_WO) + (size_t)l * D * D, D, W_WB + l * LW_SIZE + LW_WO, D, nullptr, 0, scr, q / 32, q % 32, lane); continue; } r -= N3;
            if (r < N4) { const int i = r / 1408, q = r % 1408; tr_item<true>(AIN(I_FD) + (size_t)i * DFF * D, D, W_DW8(i) + DW8_D, DFF, nullptr, 0, scr, q / 32, q % 32, lane); continue; } r -= N4;
            { const int ie = r / 704, q = r % 704, i = ie >> 3, e = ie & 7; tr_item<true>(AIN(I_MD) + (size_t)ie * DFE * D, D, W_MW8(i) + MW8_D + (size_t)e * D * DFEP, DFEP, nullptr, 0, scr, q / 32, q % 32, lane); }
        }
        const int gt = vcuo * 512 + tid, NGT = Go * 512;
        for (int i = gt; i < 4 * 96 * 64; i += NGT) {
            const int l = i / (96 * 64), q = i % (96 * 64); unsigned char* wt = (unsigned char*)(W_WB + l * LW_SIZE + LW_WIN);
            *(u32x4*)(wt + (size_t)(416 + q / 64) * D + (q % 64) * 16) = (u32x4){0u, 0u, 0u, 0u}; if ((q % 64) == 0) ((float*)(wt + (size_t)DINP * D))[416 + q / 64] = 0.f; }
        for (int i = gt; i < 4 * 2 * 512 * 16; i += NGT) {
            const int l = i / (2 * 512 * 16), q = i % (2 * 512 * 16), mtx = q / (512 * 16), rr = (q / 16) % 512, ch = q % 16;
            *(u32x4*)(W_WB + l * LW_SIZE + (mtx ? LW_WUV : LW_WUK) + (size_t)rr * 256 + 128 + ch * 8) = (u32x4){0u, 0u, 0u, 0u}; }
        for (int i = gt; i < 2 * NE * D * 8; i += NGT) {
            const int ie = i / (D * 8), q = i % (D * 8); *(u32x4*)(W_MW8(ie >> 3) + MW8_D + ((size_t)(ie & 7) * D + (q >> 3)) * DFEP + DFE + (q & 7) * 16) = (u32x4){0u, 0u, 0u, 0u}; }
        for (int i = gt; i < 4 * 4 * 128 * 128; i += NGT) {
            const int l = i / 65536, q = i % 65536, t = (q >> 7) & 127, s = q & 127; const float v = (s <= t) ? AIN(I_SGW)[i] : 0.f;
            W_WB[l * LW_SIZE + LW_SGW + q] = (bf16)(cvt_pk(v, 0.f) & 0xffffu); }
        for (int i = gt; i < 4 * 2 * 4 * 64 * 64; i += NGT) {
            const int l = i / 32768, q = i % 32768, mtx = q / 16384, hq = (q / 4096) & 3, j = (q >> 6) & 63, ii = q & 63;
            const float v = AIN(mtx ? I_LWX : I_LWA)[(size_t)l * 16384 + hq * 4096 + ii * 64 + j];
            W_WB[l * LW_SIZE + (mtx ? LW_LWX : LW_LWA) + hq * 4096 + j * 64 + ii] = (bf16)(cvt_pk(v, 0.f) & 0xffffu); }
        for (int i = gt; i < SEQ * 16; i += NGT) {
            const int pos = i >> 4, j = i & 15; const float inv = exp2f(-(float)j * (13.287712379549449f / 16.0f)); float s, c; sincos_acc((float)pos * inv, s, c); W_cosT[i] = c; W_sinT[i] = s; }
        __syncthreads();
        LAS float* cond = (LAS float*)(lds + 69632); LAS float* red = (LAS float*)(lds + 69632 + 16384);
        for (int i = tid; i < NB * D; i += 512) cond[i] = siluf_(AIN(I_C)[i]);
        __syncthreads();
        for (int item = vcuo; item < 4 * 96; item += Go) {
            const int l = item / 96, c0 = (item % 96) * 64; const float* Wm = AIN(I_WMOD) + (size_t)l * D * 6144 + c0 + lane;
            float a0 = 0.f, a1 = 0.f, a2 = 0.f, a3 = 0.f;
#pragma unroll 16
            for (int k = wave * 128; k < wave * 128 + 128; ++k) { const float wv = __builtin_nontemporal_load(Wm + (size_t)k * 6144); a0 += cond[k] * wv; a1 += cond[D + k] * wv; a2 += cond[2 * D + k] * wv; a3 += cond[3 * D + k] * wv; }
            red[(wave * 4 + 0) * 64 + lane] = a0; red[(wave * 4 + 1) * 64 + lane] = a1; red[(wave * 4 + 2) * 64 + lane] = a2; red[(wave * 4 + 3) * 64 + lane] = a3;
            __syncthreads();
            if (tid < 256) { const int b = tid >> 6, col = tid & 63; float s = AIN(I_BMOD)[l * 6144 + c0 + col];
#pragma unroll
                for (int ww = 0; ww < 8; ++ww) s += red[(ww * 4 + b) * 64 + col];
                W_MOD[(size_t)(l * 4 + b) * 6144 + c0 + col] = s; }
            __syncthreads();
        }
    }
    { WSL; if (opaque_tid() == 0) { unsigned gx; XB_SPIN((gx = xb_ld(W_ctl + 6000 + (bx_ & 7))) == 0u, W_ctl); if (gx != xb_xcc_id() + 1u) atomicOr(W_ctl + 6016, 1u); } }
    GRID_BAR();
    { WSL; if (opaque_tid() == 0) { const unsigned ok = (xb_ld(W_ctl + 6016) == 0u) ? 1u : 0u; unsigned pok = 1u;
#pragma unroll
        for (unsigned j = 0; j < 16; ++j) { const unsigned c = xb_ld(W_ctl + XB_XCNT(j)); if (c != 0u && c != 32u) pok = 0u; }
        MISC[8] = ok; MISC[9] = ok & pok; } } __syncthreads();
    {
        WSL; const int tid = opaque_tid();
        const int b = vcuo >> 6; const float* md = W_MOD + (size_t)(0 * 4 + b) * 6144;
        RowArgs ra{}; ra.xin = AIN(I_X); ra.X = nullptr; ra.Xb = W_XB; ra.preg = AIN(I_PREMIX); ra.sc = md + 1024; ra.sh = md; ra.H = W_H; ra.ssq_q = W_ssq_q; ra.ssq_kv = W_ssq_kv; ra.rs = (float*)(W_DW8(0) + DW8_RS);
        row_phase<0>(lds, tab, vcuo, ra, true, false);
        if (tid < 64) { W_ssq_q[vcuo * 64 + tid] = 0ull; W_ssq_kv[vcuo * 64 + tid] = 0ull; }
    }
    GRID_BAR_L();


    { constexpr int l = 0;

        const bool moe = (l & 1) != 0; const int fi = l >> 1;
#define LW (W_WB + (size_t)l * LW_SIZE)
#define md (W_MOD + (size_t)(l * 4 + (vcuo >> 6)) * 6144)
        { WSL; pg8::Gemm g{W_H, LW + LW_WIN, D}; pg8::StaticOrder S; S.init(M, DINP, Go, bxo); S.lim = (S.nwg / Go) * Go;
          pg8::EpiIn E{wsl, (const float*)(W_DW8(0) + DW8_RS), (const float*)((unsigned char*)(LW + LW_WIN) + (size_t)DINP * D)};
          pg8::gemm_phase<pg8::EpiIn, pg8::StaticOrder, true, 2, 2>(lds, g, S, E);
          pg8::TailOrder<pg8::StaticOrder> T{S};
          pg8::gemm_phase<pg8::EpiIn, pg8::TailOrder<pg8::StaticOrder>, false, 1, 2>(lds, g, T, E); }
        if (l == 2) GRID_BAR(); else GRID_BAR_L();
        { WSL; pg8::Gemm g{W_ZQ, LW + LW_WUQ, 256}; pg8::StaticOrder S; S.init(M, 768, Go, bxo); pg8::EpiQ E{wsl};
          pg8::gemm_phase<pg8::EpiQ, pg8::StaticOrder, true>(lds, g, S, E); }
        { WSL; pg8::Gemm g{W_ZKV, LW + LW_WUK, 128, 256};     pg8::StaticOrder S; S.init(M, 512, Go, (bxo + 64) % Go); pg8::EpiK E{wsl};
          pg8::gemm_phase<pg8::EpiK, pg8::StaticOrder, true>(lds, g, S, E); }
        { WSL; pg8::Gemm g{LW + LW_WUV, W_ZKV, 128, 256}; pg8::StaticOrder S; S.init(512, M, Go, (bxo + 192) % Go); pg8::EpiVT E{wsl};
          pg8::gemm_phase<pg8::EpiVT, pg8::StaticOrder, true>(lds, g, S, E); }
        { WSL; for (int uu = vcuo; uu < 256; uu += Go) {
            sgu::unit(lds, (uu >> 1) * 128, uu & 1, W_GV, W_U, LW + LW_SGW, AIN(I_SGLNG) + l * 256, AIN(I_SGLNB) + l * 256, AIN(I_SGB) + l * 512, W_Y); } }
        { WSL; for (int uu = vcuo; uu < 256; uu += Go) {
            lru::local_unit(lds, uu >> 6, uu & 63, W_ZX, AIN(I_CONVW) + l * 1024, AIN(I_CONVB) + l * 256, LW + LW_LWA, LW + LW_LWX,
                            AIN(I_LBA) + l * 256, AIN(I_LBX) + l * 256, AIN(I_LAM) + l * 256, W_HL, W_PP); } }
        GRID_BAR_P();
        { WSL; for (int uu = vcuo; uu < 256; uu += Go) { lru::fix_unit(lds, uu >> 6, uu & 63, W_HL, W_PP, W_GY, W_Y); } }
        { WSL; for (int uu = vcuo; uu < 256; uu += Go) { const int bh = uu >> 3, s = uu & 7;
            att::attn_unit(lds, bh >> 3, bh & 7, 15 - s, W_Q, W_KN, W_KR, W_VT, W_Y);
            att::attn_unit(lds, bh >> 3, bh & 7, s, W_Q, W_KN, W_KR, W_VT, W_Y); } }
        GRID_BAR_P();
        { WSL; pg8::Gemm g{W_Y, LW + LW_WO, D}; pg8::StaticOrder S; S.init(M, D, Go, bxo); pg8::EpiBf E{W_YO, D};
          pg8::gemm_phase<pg8::EpiBf, pg8::StaticOrder, false>(lds, g, S, E); }
        GRID_BAR_L();
        { WSL; RowArgs ra{}; ra.X = nullptr; ra.Xb = W_XB; ra.Ysrc = W_YO; ra.gate = md + 2048; ra.postg = AIN(I_POSTMIX) + l * D; ra.preg = AIN(I_PREFFN) + l * D; ra.sc = md + 4096; ra.sh = md + 3072; ra.H = W_H;
          ra.router = AIN(I_ROUTER) + (size_t)fi * D * NE; ra.cursor = W_ctl + CW_CURSOR + 64 * fi; ra.idx = W_IDX; ra.slot_w = W_SLOT; ra.gatew_w = W_GATEW; ra.ssq_q = W_ssq_q; ra.ssq_kv = W_ssq_kv; ra.rs = (float*)(W_DW8(0) + DW8_RS); ra.rss = (float*)(W_DW8(0) + DW8_RSS);
          row_phase<1>(lds, tab, vcuo, ra, true, moe); }
        if (moe) GRID_BAR(); else GRID_BAR_L();
        if (!moe) {
#define DW (W_WB + WOFF_DENSE + (size_t)fi * DW_SIZE)
            { WSL; pg8::Gemm g{W_H, W_DW8(fi) + DW8_GU, D}; pg8::StaticOrder S; S.init(M, 2 * DFF, Go, bxo); pg8::EpiSwigluI8<false> E{W_ACT8D, DFF, -1, (const float*)(W_DW8(0) + DW8_RS), (const float*)(W_DW8(fi) + DW8_CS)};
              pg8::gemm_phase<pg8::EpiSwigluI8<false>, pg8::StaticOrder, true, 2, 2>(lds, g, S, E); }
            GRID_BAR_L();
            { WSL; pg8::Gemm g{W_ACT8D, W_DW8(fi) + DW8_D, DFF}; pg8::StaticOrder S; S.init(M, D, Go, bxo); pg8::EpiBfS E{W_YO, D, 1.0f / (pg8::F8_ASC * pg8::F8_WSC)};
              pg8::gemm_phase<pg8::EpiBfS, pg8::StaticOrder, false, 2, 1>(lds, g, S, E); }
            GRID_BAR_L();
        } else {
#define MW (W_WB + WOFF_MOE + (size_t)fi * MW_SIZE)
            { const int ln = opaque_tid(); if (ln < 64) { WSL; volatile LAS int* tw = (volatile LAS int*)(lds + MISC_OFF);
                const int cnt = (ln < 8) ? (int)__hip_atomic_load(W_ctl + CW_CURSOR + 64 * fi + ln, __ATOMIC_RELAXED, __HIP_MEMORY_SCOPE_AGENT) : 0;
                const int nt = (cnt + 255) >> 8; int T = 0, tot = 0;
#pragma unroll
                for (int e = 0; e < 8; ++e) { const int v = __builtin_amdgcn_readlane(nt, e); if (e < ln) T += v; tot += v; }
                if (ln < 8) { tw[16 + ln] = T; tw[32 + ln] = cnt; }
                if (ln == 0) tw[24] = tot; } }
            __syncthreads();
            { WSL; pg8::Gemm g{W_H, W_MW8(fi) + MW8_GU, D}; MoeGatherOrder S{{tab, 11, Go, vcuo, 1 << 30}, W_IDX}; pg8::EpiSwigluI8<true> E{W_ACT8, DFEP, 10, (const float*)(W_DW8(0) + DW8_RSS), (const float*)(W_MW8(fi) + MW8_CS)};
              pg8::gemm_phase<pg8::EpiSwigluI8<true>, MoeGatherOrder, true, 2, 2>(lds, g, S, E); }
            GRID_BAR();
            { WSL; pg8::Gemm g{W_ACT8, W_MW8(fi) + MW8_D, DFEP}; MoeOrder S{tab, 4, Go, vcuo, 2 * Go}; pg8::EpiBfS E{W_YD, D, 1.0f / (pg8::F8_ASC * pg8::F8_WSC)};
              pg8::gemm_phase<pg8::EpiBfS, MoeOrder, true, 2, 1>(lds, g, S, E);
              pg8::TailOrder<MoeOrder> T{S};
              pg8::gemm_phase<pg8::EpiBfS, pg8::TailOrder<MoeOrder>, false, 1, 1>(lds, g, T, E); }
            GRID_BAR();
        }
        { WSL; const bool last = (l == DEPTH - 1); const float* mdn = W_MOD + (size_t)((last ? l : l + 1) * 4 + (vcuo >> 6)) * 6144;
          RowArgs ra{}; ra.X = last ? W_X : nullptr; ra.Xb = W_XB; ra.Ysrc = W_YO; ra.YD = W_YD; ra.slot = W_SLOT; ra.gatew = W_GATEW; ra.gate = md + 5120; ra.postg = AIN(I_POSTFFN) + l * D;
          ra.preg = AIN(I_PREMIX) + (last ? l : l + 1) * D; ra.sc = mdn + 1024; ra.sh = mdn; ra.H = W_H; ra.ssq_q = W_ssq_q; ra.ssq_kv = W_ssq_kv; ra.rs = (float*)(W_DW8(0) + DW8_RS);
          if (!moe) row_phase<2>(lds, tab, vcuo, ra, !last, false); else row_phase<3>(lds, tab, vcuo, ra, !last, false);
          if (!last) GRID_BAR_L(); }

    }
#undef LW
#undef md
#undef DW
#undef MW
    { constexpr int l = 1;

        const bool moe = (l & 1) != 0; const int fi = l >> 1;
#define LW (W_WB + (size_t)l * LW_SIZE)
#define md (W_MOD + (size_t)(l * 4 + (vcuo >> 6)) * 6144)
        { WSL; pg8::Gemm g{W_H, LW + LW_WIN, D}; pg8::StaticOrder S; S.init(M, DINP, Go, bxo); S.lim = (S.nwg / Go) * Go;
          pg8::EpiIn E{wsl, (const float*)(W_DW8(0) + DW8_RS), (const float*)((unsigned char*)(LW + LW_WIN) + (size_t)DINP * D)};
          pg8::gemm_phase<pg8::EpiIn, pg8::StaticOrder, true, 2, 2>(lds, g, S, E);
          pg8::TailOrder<pg8::StaticOrder> T{S};
          pg8::gemm_phase<pg8::EpiIn, pg8::TailOrder<pg8::StaticOrder>, false, 1, 2>(lds, g, T, E); }
        if (l == 2) GRID_BAR(); else GRID_BAR_L();
        { WSL; pg8::Gemm g{W_ZQ, LW + LW_WUQ, 256}; pg8::StaticOrder S; S.init(M, 768, Go, bxo); pg8::EpiQ E{wsl};
          pg8::gemm_phase<pg8::EpiQ, pg8::StaticOrder, true>(lds, g, S, E); }
        { WSL; pg8::Gemm g{W_ZKV, LW + LW_WUK, 128, 256};     pg8::StaticOrder S; S.init(M, 512, Go, (bxo + 64) % Go); pg8::EpiK E{wsl};
          pg8::gemm_phase<pg8::EpiK, pg8::StaticOrder, true>(lds, g, S, E); }
        { WSL; pg8::Gemm g{LW + LW_WUV, W_ZKV, 128, 256}; pg8::StaticOrder S; S.init(512, M, Go, (bxo + 192) % Go); pg8::EpiVT E{wsl};
          pg8::gemm_phase<pg8::EpiVT, pg8::StaticOrder, true>(lds, g, S, E); }
        { WSL; for (int uu = vcuo; uu < 256; uu += Go) {
            sgu::unit(lds, (uu >> 1) * 128, uu & 1, W_GV, W_U, LW + LW_SGW, AIN(I_SGLNG) + l * 256, AIN(I_SGLNB) + l * 256, AIN(I_SGB) + l * 512, W_Y); } }
        { WSL; for (int uu = vcuo; uu < 256; uu += Go) {
            lru::local_unit(lds, uu >> 6, uu & 63, W_ZX, AIN(I_CONVW) + l * 1024, AIN(I_CONVB) + l * 256, LW + LW_LWA, LW + LW_LWX,
                            AIN(I_LBA) + l * 256, AIN(I_LBX) + l * 256, AIN(I_LAM) + l * 256, W_HL, W_PP); } }
        GRID_BAR_P();
        { WSL; for (int uu = vcuo; uu < 256; uu += Go) { lru::fix_unit(lds, uu >> 6, uu & 63, W_HL, W_PP, W_GY, W_Y); } }
        { WSL; for (int uu = vcuo; uu < 256; uu += Go) { const int bh = uu >> 3, s = uu & 7;
            att::attn_unit(lds, bh >> 3, bh & 7, 15 - s, W_Q, W_KN, W_KR, W_VT, W_Y);
            att::attn_unit(lds, bh >> 3, bh & 7, s, W_Q, W_KN, W_KR, W_VT, W_Y); } }
        GRID_BAR_P();
        { WSL; pg8::Gemm g{W_Y, LW + LW_WO, D}; pg8::StaticOrder S; S.init(M, D, Go, bxo); pg8::EpiBf E{W_YO, D};
          pg8::gemm_phase<pg8::EpiBf, pg8::StaticOrder, false>(lds, g, S, E); }
        GRID_BAR_L();
        { WSL; RowArgs ra{}; ra.X = nullptr; ra.Xb = W_XB; ra.Ysrc = W_YO; ra.gate = md + 2048; ra.postg = AIN(I_POSTMIX) + l * D; ra.preg = AIN(I_PREFFN) + l * D; ra.sc = md + 4096; ra.sh = md + 3072; ra.H = W_H;
          ra.router = AIN(I_ROUTER) + (size_t)fi * D * NE; ra.cursor = W_ctl + CW_CURSOR + 64 * fi; ra.idx = W_IDX; ra.slot_w = W_SLOT; ra.gatew_w = W_GATEW; ra.ssq_q = W_ssq_q; ra.ssq_kv = W_ssq_kv; ra.rs = (float*)(W_DW8(0) + DW8_RS); ra.rss = (float*)(W_DW8(0) + DW8_RSS);
          row_phase<1>(lds, tab, vcuo, ra, true, moe); }
        if (moe) GRID_BAR(); else GRID_BAR_L();
        if (!moe) {
#define DW (W_WB + WOFF_DENSE + (size_t)fi * DW_SIZE)
            { WSL; pg8::Gemm g{W_H, W_DW8(fi) + DW8_GU, D}; pg8::StaticOrder S; S.init(M, 2 * DFF, Go, bxo); pg8::EpiSwigluI8<false> E{W_ACT8D, DFF, -1, (const float*)(W_DW8(0) + DW8_RS), (const float*)(W_DW8(fi) + DW8_CS)};
              pg8::gemm_phase<pg8::EpiSwigluI8<false>, pg8::StaticOrder, true, 2, 2>(lds, g, S, E); }
            GRID_BAR_L();
            { WSL; pg8::Gemm g{W_ACT8D, W_DW8(fi) + DW8_D, DFF}; pg8::StaticOrder S; S.init(M, D, Go, bxo); pg8::EpiBfS E{W_YO, D, 1.0f / (pg8::F8_ASC * pg8::F8_WSC)};
              pg8::gemm_phase<pg8::EpiBfS, pg8::StaticOrder, false, 2, 1>(lds, g, S, E); }
            GRID_BAR_L();
        } else {
#define MW (W_WB + WOFF_MOE + (size_t)fi * MW_SIZE)
            { const int ln = opaque_tid(); if (ln < 64) { WSL; volatile LAS int* tw = (volatile LAS int*)(lds + MISC_OFF);
                const int cnt = (ln < 8) ? (int)__hip_atomic_load(W_ctl + CW_CURSOR + 64 * fi + ln, __ATOMIC_RELAXED, __HIP_MEMORY_SCOPE_AGENT) : 0;
                const int nt = (cnt + 255) >> 8; int T = 0, tot = 0;
#pragma unroll
                for (int e = 0; e < 8; ++e) { const int v = __builtin_amdgcn_readlane(nt, e); if (e < ln) T += v; tot += v; }
                if (ln < 8) { tw[16 + ln] = T; tw[32 + ln] = cnt; }
                if (ln == 0) tw[24] = tot; } }
            __syncthreads();
            { WSL; pg8::Gemm g{W_H, W_MW8(fi) + MW8_GU, D}; MoeGatherOrder S{{tab, 11, Go, vcuo, 1 << 30}, W_IDX}; pg8::EpiSwigluI8<true> E{W_ACT8, DFEP, 10, (const float*)(W_DW8(0) + DW8_RSS), (const float*)(W_MW8(fi) + MW8_CS)};
              pg8::gemm_phase<pg8::EpiSwigluI8<true>, MoeGatherOrder, true, 2, 2>(lds, g, S, E); }
            GRID_BAR();
            { WSL; pg8::Gemm g{W_ACT8, W_MW8(fi) + MW8_D, DFEP}; MoeOrder S{tab, 4, Go, vcuo, 2 * Go}; pg8::EpiBfS E{W_YD, D, 1.0f / (pg8::F8_ASC * pg8::F8_WSC)};
              pg8::gemm_phase<pg8::EpiBfS, MoeOrder, true, 2, 1>(lds, g, S, E);
              pg8::TailOrder<MoeOrder> T{S};
              pg8::gemm_phase<pg8::EpiBfS, pg8::TailOrder<MoeOrder>, false, 1, 1>(lds, g, T, E); }
            GRID_BAR();
        }
        { WSL; const bool last = (l == DEPTH - 1); const float* mdn = W_MOD + (size_t)((last ? l : l + 1) * 4 + (vcuo >> 6)) * 6144;
          RowArgs ra{}; ra.X = last ? W_X : nullptr; ra.Xb = W_XB; ra.Ysrc = W_YO; ra.YD = W_YD; ra.slot = W_SLOT; ra.gatew = W_GATEW; ra.gate = md + 5120; ra.postg = AIN(I_POSTFFN) + l * D;
          ra.preg = AIN(I_PREMIX) + (last ? l : l + 1) * D; ra.sc = mdn + 1024; ra.sh = mdn; ra.H = W_H; ra.ssq_q = W_ssq_q; ra.ssq_kv = W_ssq_kv; ra.rs = (float*)(W_DW8(0) + DW8_RS);
          if (!moe) row_phase<2>(lds, tab, vcuo, ra, !last, false); else row_phase<3>(lds, tab, vcuo, ra, !last, false);
          if (!last) GRID_BAR_L(); }

    }
#undef LW
#undef md
#undef DW
#undef MW
    { constexpr int l = 2;

        const bool moe = (l & 1) != 0; const int fi = l >> 1;
#define LW (W_WB + (size_t)l * LW_SIZE)
#define md (W_MOD + (size_t)(l * 4 + (vcuo >> 6)) * 6144)
        { WSL; pg8::Gemm g{W_H, LW + LW_WIN, D}; pg8::StaticOrder S; S.init(M, DINP, Go, bxo); S.lim = (S.nwg / Go) * Go;
          pg8::EpiIn E{wsl, (const float*)(W_DW8(0) + DW8_RS), (const float*)((unsigned char*)(LW + LW_WIN) + (size_t)DINP * D)};
          pg8::gemm_phase<pg8::EpiIn, pg8::StaticOrder, true, 2, 2>(lds, g, S, E);
          pg8::TailOrder<pg8::StaticOrder> T{S};
          pg8::gemm_phase<pg8::EpiIn, pg8::TailOrder<pg8::StaticOrder>, false, 1, 2>(lds, g, T, E); }
        if (l == 2) GRID_BAR(); else GRID_BAR_L();
        { WSL; pg8::Gemm g{W_ZQ, LW + LW_WUQ, 256}; pg8::StaticOrder S; S.init(M, 768, Go, bxo); pg8::EpiQ E{wsl};
          pg8::gemm_phase<pg8::EpiQ, pg8::StaticOrder, true>(lds, g, S, E); }
        { WSL; pg8::Gemm g{W_ZKV, LW + LW_WUK, 128, 256};     pg8::StaticOrder S; S.init(M, 512, Go, (bxo + 64) % Go); pg8::EpiK E{wsl};
          pg8::gemm_phase<pg8::EpiK, pg8::StaticOrder, true>(lds, g, S, E); }
        { WSL; pg8::Gemm g{LW + LW_WUV, W_ZKV, 128, 256}; pg8::StaticOrder S; S.init(512, M, Go, (bxo + 192) % Go); pg8::EpiVT E{wsl};
          pg8::gemm_phase<pg8::EpiVT, pg8::StaticOrder, true>(lds, g, S, E); }
        { WSL; for (int uu = vcuo; uu < 256; uu += Go) {
            sgu::unit(lds, (uu >> 1) * 128, uu & 1, W_GV, W_U, LW + LW_SGW, AIN(I_SGLNG) + l * 256, AIN(I_SGLNB) + l * 256, AIN(I_SGB) + l * 512, W_Y); } }
        { WSL; for (int uu = vcuo; uu < 256; uu += Go) {
            lru::local_unit(lds, uu >> 6, uu & 63, W_ZX, AIN(I_CONVW) + l * 1024, AIN(I_CONVB) + l * 256, LW + LW_LWA, LW + LW_LWX,
                            AIN(I_LBA) + l * 256, AIN(I_LBX) + l * 256, AIN(I_LAM) + l * 256, W_HL, W_PP); } }
        GRID_BAR_P();
        { WSL; for (int uu = vcuo; uu < 256; uu += Go) { lru::fix_unit(lds, uu >> 6, uu & 63, W_HL, W_PP, W_GY, W_Y); } }
        { WSL; for (int uu = vcuo; uu < 256; uu += Go) { const int bh = uu >> 3, s = uu & 7;
            att::attn_unit(lds, bh >> 3, bh & 7, 15 - s, W_Q, W_KN, W_KR, W_VT, W_Y);
            att::attn_unit(lds, bh >> 3, bh & 7, s, W_Q, W_KN, W_KR, W_VT, W_Y); } }
        GRID_BAR_P();
        { WSL; pg8::Gemm g{W_Y, LW + LW_WO, D}; pg8::StaticOrder S; S.init(M, D, Go, bxo); pg8::EpiBf E{W_YO, D};
          pg8::gemm_phase<pg8::EpiBf, pg8::StaticOrder, false>(lds, g, S, E); }
        GRID_BAR_L();
        { WSL; RowArgs ra{}; ra.X = nullptr; ra.Xb = W_XB; ra.Ysrc = W_YO; ra.gate = md + 2048; ra.postg = AIN(I_POSTMIX) + l * D; ra.preg = AIN(I_PREFFN) + l * D; ra.sc = md + 4096; ra.sh = md + 3072; ra.H = W_H;
          ra.router = AIN(I_ROUTER) + (size_t)fi * D * NE; ra.cursor = W_ctl + CW_CURSOR + 64 * fi; ra.idx = W_IDX; ra.slot_w = W_SLOT; ra.gatew_w = W_GATEW; ra.ssq_q = W_ssq_q; ra.ssq_kv = W_ssq_kv; ra.rs = (float*)(W_DW8(0) + DW8_RS); ra.rss = (float*)(W_DW8(0) + DW8_RSS);
          row_phase<1>(lds, tab, vcuo, ra, true, moe); }
        if (moe) GRID_BAR(); else GRID_BAR_L();
        if (!moe) {
#define DW (W_WB + WOFF_DENSE + (size_t)fi * DW_SIZE)
            { WSL; pg8::Gemm g{W_H, W_DW8(fi) + DW8_GU, D}; pg8::StaticOrder S; S.init(M, 2 * DFF, Go, bxo); pg8::EpiSwigluI8<false> E{W_ACT8D, DFF, -1, (const float*)(W_DW8(0) + DW8_RS), (const float*)(W_DW8(fi) + DW8_CS)};
              pg8::gemm_phase<pg8::EpiSwigluI8<false>, pg8::StaticOrder, true, 2, 2>(lds, g, S, E); }
            GRID_BAR_L();
            { WSL; pg8::Gemm g{W_ACT8D, W_DW8(fi) + DW8_D, DFF}; pg8::StaticOrder S; S.init(M, D, Go, bxo); pg8::EpiBfS E{W_YO, D, 1.0f / (pg8::F8_ASC * pg8::F8_WSC)};
              pg8::gemm_phase<pg8::EpiBfS, pg8::StaticOrder, false, 2, 1>(lds, g, S, E); }
            GRID_BAR_L();
        } else {
#define MW (W_WB + WOFF_MOE + (size_t)fi * MW_SIZE)
            { const int ln = opaque_tid(); if (ln < 64) { WSL; volatile LAS int* tw = (volatile LAS int*)(lds + MISC_OFF);
                const int cnt = (ln < 8) ? (int)__hip_atomic_load(W_ctl + CW_CURSOR + 64 * fi + ln, __ATOMIC_RELAXED, __HIP_MEMORY_SCOPE_AGENT) : 0;
                const int nt = (cnt + 255) >> 8; int T = 0, tot = 0;
#pragma unroll
                for (int e = 0; e < 8; ++e) { const int v = __builtin_amdgcn_readlane(nt, e); if (e < ln) T += v; tot += v; }
                if (ln < 8) { tw[16 + ln] = T; tw[32 + ln] = cnt; }
                if (ln == 0) tw[24] = tot; } }
            __syncthreads();
            { WSL; pg8::Gemm g{W_H, W_MW8(fi) + MW8_GU, D}; MoeGatherOrder S{{tab, 11, Go, vcuo, 1 << 30}, W_IDX}; pg8::EpiSwigluI8<true> E{W_ACT8, DFEP, 10, (const float*)(W_DW8(0) + DW8_RSS), (const float*)(W_MW8(fi) + MW8_CS)};
              pg8::gemm_phase<pg8::EpiSwigluI8<true>, MoeGatherOrder, true, 2, 2>(lds, g, S, E); }
            GRID_BAR();
            { WSL; pg8::Gemm g{W_ACT8, W_MW8(fi) + MW8_D, DFEP}; MoeOrder S{tab, 4, Go, vcuo, 2 * Go}; pg8::EpiBfS E{W_YD, D, 1.0f / (pg8::F8_ASC * pg8::F8_WSC)};
              pg8::gemm_phase<pg8::EpiBfS, MoeOrder, true, 2, 1>(lds, g, S, E);
              pg8::TailOrder<MoeOrder> T{S};
              pg8::gemm_phase<pg8::EpiBfS, pg8::TailOrder<MoeOrder>, false, 1, 1>(lds, g, T, E); }
            GRID_BAR();
        }
        { WSL; const bool last = (l == DEPTH - 1); const float* mdn = W_MOD + (size_t)((last ? l : l + 1) * 4 + (vcuo >> 6)) * 6144;
          RowArgs ra{}; ra.X = last ? W_X : nullptr; ra.Xb = W_XB; ra.Ysrc = W_YO; ra.YD = W_YD; ra.slot = W_SLOT; ra.gatew = W_GATEW; ra.gate = md + 5120; ra.postg = AIN(I_POSTFFN) + l * D;
          ra.preg = AIN(I_PREMIX) + (last ? l : l + 1) * D; ra.sc = mdn + 1024; ra.sh = mdn; ra.H = W_H; ra.ssq_q = W_ssq_q; ra.ssq_kv = W_ssq_kv; ra.rs = (float*)(W_DW8(0) + DW8_RS);
          if (!moe) row_phase<2>(lds, tab, vcuo, ra, !last, false); else row_phase<3>(lds, tab, vcuo, ra, !last, false);
          if (!last) GRID_BAR_L(); }

    }
#undef LW
#undef md
#undef DW
#undef MW
    { constexpr int l = 3;

        const bool moe = (l & 1) != 0; const int fi = l >> 1;
#define LW (W_WB + (size_t)l * LW_SIZE)
#define md (W_MOD + (size_t)(l * 4 + (vcuo >> 6)) * 6144)
        { WSL; pg8::Gemm g{W_H, LW + LW_WIN, D}; pg8::StaticOrder S; S.init(M, DINP, Go, bxo); S.lim = (S.nwg / Go) * Go;
          pg8::EpiIn E{wsl, (const float*)(W_DW8(0) + DW8_RS), (const float*)((unsigned char*)(LW + LW_WIN) + (size_t)DINP * D)};
          pg8::gemm_phase<pg8::EpiIn, pg8::StaticOrder, true, 2, 2>(lds, g, S, E);
          pg8::TailOrder<pg8::StaticOrder> T{S};
          pg8::gemm_phase<pg8::EpiIn, pg8::TailOrder<pg8::StaticOrder>, false, 1, 2>(lds, g, T, E); }
        if (l == 2) GRID_BAR(); else GRID_BAR_L();
        { WSL; pg8::Gemm g{W_ZQ, LW + LW_WUQ, 256}; pg8::StaticOrder S; S.init(M, 768, Go, bxo); pg8::EpiQ E{wsl};
          pg8::gemm_phase<pg8::EpiQ, pg8::StaticOrder, true>(lds, g, S, E); }
        { WSL; pg8::Gemm g{W_ZKV, LW + LW_WUK, 128, 256};     pg8::StaticOrder S; S.init(M, 512, Go, (bxo + 64) % Go); pg8::EpiK E{wsl};
          pg8::gemm_phase<pg8::EpiK, pg8::StaticOrder, true>(lds, g, S, E); }
        { WSL; pg8::Gemm g{LW + LW_WUV, W_ZKV, 128, 256}; pg8::StaticOrder S; S.init(512, M, Go, (bxo + 192) % Go); pg8::EpiVT E{wsl};
          pg8::gemm_phase<pg8::EpiVT, pg8::StaticOrder, true>(lds, g, S, E); }
        { WSL; for (int uu = vcuo; uu < 256; uu += Go) {
            sgu::unit(lds, (uu >> 1) * 128, uu & 1, W_GV, W_U, LW + LW_SGW, AIN(I_SGLNG) + l * 256, AIN(I_SGLNB) + l * 256, AIN(I_SGB) + l * 512, W_Y); } }
        { WSL; for (int uu = vcuo; uu < 256; uu += Go) {
            lru::local_unit(lds, uu >> 6, uu & 63, W_ZX, AIN(I_CONVW) + l * 1024, AIN(I_CONVB) + l * 256, LW + LW_LWA, LW + LW_LWX,
                            AIN(I_LBA) + l * 256, AIN(I_LBX) + l * 256, AIN(I_LAM) + l * 256, W_HL, W_PP); } }
        GRID_BAR_P();
        { WSL; for (int uu = vcuo; uu < 256; uu += Go) { lru::fix_unit(lds, uu >> 6, uu & 63, W_HL, W_PP, W_GY, W_Y); } }
        { WSL; for (int uu = vcuo; uu < 256; uu += Go) { const int bh = uu >> 3, s = uu & 7;
            att::attn_unit(lds, bh >> 3, bh & 7, 15 - s, W_Q, W_KN, W_KR, W_VT, W_Y);
            att::attn_unit(lds, bh >> 3, bh & 7, s, W_Q, W_KN, W_KR, W_VT, W_Y); } }
        GRID_BAR_P();
        { WSL; pg8::Gemm g{W_Y, LW + LW_WO, D}; pg8::StaticOrder S; S.init(M, D, Go, bxo); pg8::EpiBf E{W_YO, D};
          pg8::gemm_phase<pg8::EpiBf, pg8::StaticOrder, false>(lds, g, S, E); }
        GRID_BAR_L();
        { WSL; RowArgs ra{}; ra.X = nullptr; ra.Xb = W_XB; ra.Ysrc = W_YO; ra.gate = md + 2048; ra.postg = AIN(I_POSTMIX) + l * D; ra.preg = AIN(I_PREFFN) + l * D; ra.sc = md + 4096; ra.sh = md + 3072; ra.H = W_H;
          ra.router = AIN(I_ROUTER) + (size_t)fi * D * NE; ra.cursor = W_ctl + CW_CURSOR + 64 * fi; ra.idx = W_IDX; ra.slot_w = W_SLOT; ra.gatew_w = W_GATEW; ra.ssq_q = W_ssq_q; ra.ssq_kv = W_ssq_kv; ra.rs = (float*)(W_DW8(0) + DW8_RS); ra.rss = (float*)(W_DW8(0) + DW8_RSS);
          row_phase<1>(lds, tab, vcuo, ra, true, moe); }
        if (moe) GRID_BAR(); else GRID_BAR_L();
        if (!moe) {
#define DW (W_WB + WOFF_DENSE + (size_t)fi * DW_SIZE)
            { WSL; pg8::Gemm g{W_H, W_DW8(fi) + DW8_GU, D}; pg8::StaticOrder S; S.init(M, 2 * DFF, Go, bxo); pg8::EpiSwigluI8<false> E{W_ACT8D, DFF, -1, (const float*)(W_DW8(0) + DW8_RS), (const float*)(W_DW8(fi) + DW8_CS)};
              pg8::gemm_phase<pg8::EpiSwigluI8<false>, pg8::StaticOrder, true, 2, 2>(lds, g, S, E); }
            GRID_BAR_L();
            { WSL; pg8::Gemm g{W_ACT8D, W_DW8(fi) + DW8_D, DFF}; pg8::StaticOrder S; S.init(M, D, Go, bxo); pg8::EpiBfS E{W_YO, D, 1.0f / (pg8::F8_ASC * pg8::F8_WSC)};
              pg8::gemm_phase<pg8::EpiBfS, pg8::StaticOrder, false, 2, 1>(lds, g, S, E); }
            GRID_BAR_L();
        } else {
#define MW (W_WB + WOFF_MOE + (size_t)fi * MW_SIZE)
            { const int ln = opaque_tid(); if (ln < 64) { WSL; volatile LAS int* tw = (volatile LAS int*)(lds + MISC_OFF);
                const int cnt = (ln < 8) ? (int)__hip_atomic_load(W_ctl + CW_CURSOR + 64 * fi + ln, __ATOMIC_RELAXED, __HIP_MEMORY_SCOPE_AGENT) : 0;
                const int nt = (cnt + 255) >> 8; int T = 0, tot = 0;
#pragma unroll
                for (int e = 0; e < 8; ++e) { const int v = __builtin_amdgcn_readlane(nt, e); if (e < ln) T += v; tot += v; }
                if (ln < 8) { tw[16 + ln] = T; tw[32 + ln] = cnt; }
                if (ln == 0) tw[24] = tot; } }
            __syncthreads();
            { WSL; pg8::Gemm g{W_H, W_MW8(fi) + MW8_GU, D}; MoeGatherOrder S{{tab, 11, Go, vcuo, 1 << 30}, W_IDX}; pg8::EpiSwigluI8<true> E{W_ACT8, DFEP, 10, (const float*)(W_DW8(0) + DW8_RSS), (const float*)(W_MW8(fi) + MW8_CS)};
              pg8::gemm_phase<pg8::EpiSwigluI8<true>, MoeGatherOrder, true, 2, 2>(lds, g, S, E); }
            GRID_BAR();
            { WSL; pg8::Gemm g{W_ACT8, W_MW8(fi) + MW8_D, DFEP}; MoeOrder S{tab, 4, Go, vcuo, 2 * Go}; pg8::EpiBfS E{W_YD, D, 1.0f / (pg8::F8_ASC * pg8::F8_WSC)};
              pg8::gemm_phase<pg8::EpiBfS, MoeOrder, true, 2, 1>(lds, g, S, E);
              pg8::TailOrder<MoeOrder> T{S};
              pg8::gemm_phase<pg8::EpiBfS, pg8::TailOrder<MoeOrder>, false, 1, 1>(lds, g, T, E); }
            GRID_BAR();
        }
        { WSL; const bool last = (l == DEPTH - 1); const float* mdn = W_MOD + (size_t)((last ? l : l + 1) * 4 + (vcuo >> 6)) * 6144;
          RowArgs ra{}; ra.X = last ? W_X : nullptr; ra.Xb = W_XB; ra.Ysrc = W_YO; ra.YD = W_YD; ra.slot = W_SLOT; ra.gatew = W_GATEW; ra.gate = md + 5120; ra.postg = AIN(I_POSTFFN) + l * D;
          ra.preg = AIN(I_PREMIX) + (last ? l : l + 1) * D; ra.sc = mdn + 1024; ra.sh = mdn; ra.H = W_H; ra.ssq_q = W_ssq_q; ra.ssq_kv = W_ssq_kv; ra.rs = (float*)(W_DW8(0) + DW8_RS);
          if (!moe) row_phase<2>(lds, tab, vcuo, ra, !last, false); else row_phase<3>(lds, tab, vcuo, ra, !last, false);
          if (!last) GRID_BAR_L(); }

    }
#undef LW
#undef md
#undef DW
#undef MW
#undef GRID_BAR
}

extern "C" void kernel_launch(void* const* d_in, const int* in_sizes, int n_in, void* d_out, int out_size, void* d_ws, size_t ws_size, hipStream_t stream) {
    static int grid = 0;
    if (grid == 0) {
        if (n_in != 32 || in_sizes[0] != M * D || out_size != M * D || ws_size < WS_END2) { fprintf(stderr, "kernel_launch: unexpected problem (n_in %d, in0 %d, out %d, ws %zu < %zu); nothing launched\n", n_in, n_in > 0 ? in_sizes[0] : -1, out_size, ws_size, (size_t)WS_END); grid = -1; return; }
        int dev = 0, cus = 0, per_cu = 0;
        if (hipGetDevice(&dev) != hipSuccess || hipDeviceGetAttribute(&cus, hipDeviceAttributeMultiprocessorCount, dev) != hipSuccess) { grid = -1; return; }
        if (hipFuncSetAttribute((const void*)trunk_fwd, hipFuncAttributeMaxDynamicSharedMemorySize, LDS_BYTES) != hipSuccess) { fprintf(stderr, "kernel_launch: hipFuncSetAttribute failed\n"); grid = -1; return; }
        if (hipOccupancyMaxActiveBlocksPerMultiprocessor(&per_cu, (const void*)trunk_fwd, 512, LDS_BYTES) != hipSuccess || per_cu < 1) fprintf(stderr, "kernel_launch: note: occupancy query reports %d workgroups per CU\n", per_cu);
        (void)hipGetLastError();
        if (cus < 256) { fprintf(stderr, "kernel_launch: this kernel is laid out for 256 CUs (one workgroup each, 64 token rows per workgroup in the row phases); device has %d; nothing launched\n", cus); grid = -1; return; }
        grid = 256;
    }
    if (grid < 0) return;
    if (hipMemsetAsync((char*)d_ws + WS_CTL, 0, CTL_ZERO_BYTES, stream) != hipSuccess) return;
    Args a{};
    for (int i = 0; i < 32; ++i) a.in[i] = (const float*)d_in[i];
    a.out = (float*)d_out; a.ws = (unsigned char*)d_ws;
    hipLaunchKernelGGL(trunk_fwd, dim3(grid), dim3(512), LDS_BYTES, stream, a);
}
```

```cpp
#include <hip/hip_runtime.h>
#include <cstdio>
#include <cstdint>

#define LAS __attribute__((address_space(3)))
#define GAS __attribute__((address_space(1)))
typedef unsigned short bf16;
typedef short bf16x8 __attribute__((ext_vector_type(8)));
typedef short s16x4 __attribute__((ext_vector_type(4)));
typedef float f32x4 __attribute__((ext_vector_type(4)));
typedef float f32x2 __attribute__((ext_vector_type(2)));
typedef float f32x16 __attribute__((ext_vector_type(16)));
typedef unsigned u32x4 __attribute__((ext_vector_type(4)));
typedef unsigned u32x2 __attribute__((ext_vector_type(2)));
typedef unsigned long long u64;

constexpr int D = 1024, NB = 4, SEQ = 4096, M = NB * SEQ, DEPTH = 4;
constexpr int NH = 8, QKD = 96, VD = 64, QL = 256, KVL = 128, ROPE = 32;
constexpr int SGW = 256, LRW = 256, DIN = 1440, DINP = 1536;
constexpr int DFF = 2816, NE = 8, DFE = 1408;
constexpr int ECAP = 16384;
constexpr int MAXT = 136;
constexpr float LOG2E = 1.4426950408889634f;
constexpr float QSCALE = 0.10206207261596577f * LOG2E;

typedef __bf16 bf16x2_t __attribute__((ext_vector_type(2)));
__device__ __forceinline__ unsigned cvt_pk(float lo, float hi) { f32x2 v = {lo, hi}; bf16x2_t b = __builtin_convertvector(v, bf16x2_t); return __builtin_bit_cast(unsigned, b); }
__device__ __forceinline__ float bf2f(unsigned short v) { return __uint_as_float((unsigned)v << 16); }
__device__ __forceinline__ float bflo(unsigned v) { return __uint_as_float(v << 16); }
__device__ __forceinline__ float bfhi(unsigned v) { return __uint_as_float(v & 0xffff0000u); }
__device__ __forceinline__ float fexp2(float x) { return __builtin_amdgcn_exp2f(x); }
__device__ __forceinline__ float frcp(float x) { return __builtin_amdgcn_rcpf(x); }
__device__ __forceinline__ float sigmoidf_(float x) { return frcp(1.0f + fexp2(-x * LOG2E)); }
__device__ __forceinline__ float siluf_(float x) { return x * sigmoidf_(x); }
__device__ __forceinline__ float gelu_tanh(float x) { const float u = 0.7978845608028654f * (x + 0.044715f * x * x * x); return x * frcp(1.0f + fexp2(-2.0f * LOG2E * u)); }
__device__ __forceinline__ float shx(float v, int lane, int o) { return __builtin_bit_cast(float, __builtin_amdgcn_ds_bpermute((lane ^ o) << 2, __builtin_bit_cast(int, v))); }
__device__ __forceinline__ float wave_sum_dpp(float v) {
    int x = __builtin_bit_cast(int, v);
#define DPP_ADD(ctrl, rmask) x = __builtin_bit_cast(int, __builtin_bit_cast(float, x) + __builtin_bit_cast(float, __builtin_amdgcn_update_dpp(0, x, (ctrl), (rmask), 0xf, false)))
    DPP_ADD(0x111, 0xf); DPP_ADD(0x112, 0xf); DPP_ADD(0x114, 0xf); DPP_ADD(0x118, 0xf);
    DPP_ADD(0x142, 0xa);
    DPP_ADD(0x143, 0xc);
#undef DPP_ADD
    return __builtin_bit_cast(float, __builtin_amdgcn_readlane(x, 63));
}
__device__ __forceinline__ float wave_max_dpp(float v) {
    int x = __builtin_bit_cast(int, v);
#define DPP_MAX(ctrl, rmask) x = __builtin_bit_cast(int, __builtin_fmaxf(__builtin_bit_cast(float, x), __builtin_bit_cast(float, __builtin_amdgcn_update_dpp(0, x, (ctrl), (rmask), 0xf, false))))
    DPP_MAX(0x111, 0xf); DPP_MAX(0x112, 0xf); DPP_MAX(0x114, 0xf); DPP_MAX(0x118, 0xf);
    DPP_MAX(0x142, 0xa);
    DPP_MAX(0x143, 0xc);
#undef DPP_MAX
    return __builtin_bit_cast(float, __builtin_amdgcn_readlane(x, 63));
}
__device__ __forceinline__ float wave_sum(float v, int lane) {
#pragma unroll
    for (int o = 1; o < 64; o <<= 1) v += shx(v, lane, o);
    return v;
}
__device__ __forceinline__ int opaque_tid() { int t = threadIdx.x; asm volatile("" : "+v"(t)); return t; }
#define LDS_WAIT() asm volatile("s_waitcnt lgkmcnt(0)" ::: "memory")
#define VM_WAIT() asm volatile("s_waitcnt vmcnt(0)" ::: "memory")

#define XB_TMO      128
#define XB_XCNT(j)  (256  + 64 * (j))
#define XB_XSUB(j)  (1280 + 64 * (j))
#define XB_XGEN(j)  (2304 + 64 * (j))
#define XB_TOP      3328
#define XB_TOPGEN   3392
#define XB_PTOP(p)  (3456 + 64 * (p))
#define XB_PGEN(p)  (3712 + 64 * (p))
#define XCD_BAR_WORDS 3456
#define XB_SPIN_CAP (1u << 18)

__device__ __forceinline__ unsigned xb_ld(unsigned* p)              { return __hip_atomic_load(p, __ATOMIC_RELAXED, __HIP_MEMORY_SCOPE_AGENT); }
__device__ __forceinline__ unsigned xb_add(unsigned* p, unsigned v) { return __hip_atomic_fetch_add(p, v, __ATOMIC_RELAXED, __HIP_MEMORY_SCOPE_AGENT); }
__device__ __forceinline__ unsigned xb_xcc_id() { return (unsigned)__builtin_amdgcn_s_getreg((3 << 11) | 20) & 0xFu; }
#define XB_SPIN(cond, bar) do { unsigned _sp = 0; while (cond) { __builtin_amdgcn_s_sleep(1); \
    if ((++_sp & 255u) == 0u) { if (xb_ld(&(bar)[XB_TMO])) break; if (_sp > XB_SPIN_CAP) { atomicAdd(&(bar)[XB_TMO], 1u); break; } } } } while (0)

struct XcdBarrier {
    unsigned* bar; unsigned x;
    volatile LAS unsigned* st;
};

__device__ __forceinline__ XcdBarrier xcd_barrier_post(unsigned* bar, volatile LAS unsigned* st) {
    XcdBarrier b; b.bar = bar; b.x = xb_xcc_id(); b.st = st;
    if (opaque_tid() == 0) (void)xb_add(&bar[XB_XCNT(b.x)], 1u);
    return b;
}
__device__ __forceinline__ void xcd_barrier_complete(unsigned* bar, unsigned x, unsigned& nloc, unsigned& nx) {
    const unsigned G = 256u;
    unsigned sum, cnt, mine, sp = 0u;
    for (;;) {
        sum = 0u; cnt = 0u; mine = 0u;
#pragma unroll
        for (unsigned j = 0; j < 16; ++j) { const unsigned c = xb_ld(&bar[XB_XCNT(j)]); sum += c; cnt += (c > 0u) ? 1u : 0u; mine = (j == x) ? c : mine; }
        if (sum == G) break;
        __builtin_amdgcn_s_sleep(1);
        if ((++sp & 255u) == 0u) { if (xb_ld(&bar[XB_TMO])) break; if (sp > XB_SPIN_CAP) { atomicAdd(&bar[XB_TMO], 1u); break; } }
    }
    nloc = mine > 0u ? mine : 1u; nx = cnt > 0u ? cnt : 1u;
}

__device__ __forceinline__ void xcd_barrier(const XcdBarrier& b) {
    asm volatile("s_waitcnt vmcnt(0)" ::: "memory");
    __syncthreads();
    if (opaque_tid() == 0) {
        unsigned* bar = b.bar;
        __builtin_amdgcn_s_waitcnt(0);
        unsigned nloc = b.st[0], nx = b.st[1];
        if (nloc == 0u) { xcd_barrier_complete(bar, b.x, nloc, nx); b.st[0] = nloc; b.st[1] = nx; }
        const unsigned old = xb_add(&bar[XB_XSUB(b.x)], 1u);
        const unsigned gen = old / nloc;
        if (old + 1u == (gen + 1u) * nloc) {
            __builtin_amdgcn_fence(__ATOMIC_RELEASE, "agent");
            asm volatile("s_waitcnt vmcnt(0)" ::: "memory");
            const unsigned og = xb_add(&bar[XB_TOP], 1u);
            const unsigned tg = og / nx;
            if (og + 1u == (tg + 1u) * nx) xb_add(&bar[XB_TOPGEN], 1u);
            else XB_SPIN(xb_ld(&bar[XB_TOPGEN]) == tg, bar);
            __builtin_amdgcn_fence(__ATOMIC_ACQUIRE, "agent");
            xb_add(&bar[XB_XGEN(b.x)], 1u);
            asm volatile("s_waitcnt vmcnt(0)" ::: "memory");
        } else {
            XB_SPIN(xb_ld(&bar[XB_XGEN(b.x)]) == gen, bar);
            __builtin_amdgcn_fence(__ATOMIC_ACQUIRE, "agent");
            asm volatile("s_waitcnt vmcnt(0)" ::: "memory");
        }
    }
    __syncthreads();
}

__device__ __forceinline__ void xcd_pair_barrier(const XcdBarrier& b, unsigned p) {
    asm volatile("s_waitcnt vmcnt(0)" ::: "memory");
    __syncthreads();
    if (opaque_tid() == 0) {
        unsigned* bar = b.bar;
        __builtin_amdgcn_s_waitcnt(0);
        const unsigned nloc = b.st[0];
        const unsigned old = xb_add(&bar[XB_XSUB(b.x)], 1u);
        const unsigned gen = old / nloc;
        if (old + 1u == (gen + 1u) * nloc) {
            __builtin_amdgcn_fence(__ATOMIC_RELEASE, "agent");
            asm volatile("s_waitcnt vmcnt(0)" ::: "memory");
            const unsigned og = xb_add(&bar[XB_PTOP(p)], 1u);
            const unsigned tg = og / 2u;
            if (og + 1u == (tg + 1u) * 2u) xb_add(&bar[XB_PGEN(p)], 1u);
            else XB_SPIN(xb_ld(&bar[XB_PGEN(p)]) == tg, bar);
            __builtin_amdgcn_fence(__ATOMIC_ACQUIRE, "agent");
            xb_add(&bar[XB_XGEN(b.x)], 1u);
            asm volatile("s_waitcnt vmcnt(0)" ::: "memory");
        } else {
            XB_SPIN(xb_ld(&bar[XB_XGEN(b.x)]) == gen, bar);
            __builtin_amdgcn_fence(__ATOMIC_ACQUIRE, "agent");
            asm volatile("s_waitcnt vmcnt(0)" ::: "memory");
        }
    }
    __syncthreads();
}
__device__ __forceinline__ void xcd_local_barrier(const XcdBarrier& b) {
    asm volatile("s_waitcnt vmcnt(0)" ::: "memory");
    __syncthreads();
    if (opaque_tid() == 0) {
        unsigned* bar = b.bar;
        __builtin_amdgcn_s_waitcnt(0);
        const unsigned nloc = b.st[0];
        const unsigned old = xb_add(&bar[XB_XSUB(b.x)], 1u);
        const unsigned gen = old / nloc;
        if (old + 1u == (gen + 1u) * nloc) xb_add(&bar[XB_XGEN(b.x)], 1u);
        else XB_SPIN(xb_ld(&bar[XB_XGEN(b.x)]) == gen, bar);
        __builtin_amdgcn_fence(__ATOMIC_ACQUIRE, "agent");
        asm volatile("s_waitcnt vmcnt(0)" ::: "memory");
    }
    __syncthreads();
}

constexpr size_t MiB = 1u << 20;
constexpr size_t WS_CTL = 0, CTL_ZERO_BYTES = 65536;
constexpr int CW_CURSOR = 4096;
constexpr size_t WS_MOD = 65536;
constexpr size_t WS_COS = WS_MOD + 393216, WS_SIN = WS_COS + 262144;
constexpr size_t WS_SSQQ = WS_SIN + 262144, WS_SSQK = WS_SSQQ + 131072;
constexpr size_t WS_IDX = WS_SSQK + 131072;
constexpr size_t WS_SLOT = WS_IDX + 524288, WS_GATEW = WS_SLOT + 131072;
static_assert(WS_GATEW + 131072 <= 2 * MiB, "small arrays");
constexpr size_t WS_W = 2 * MiB;
constexpr size_t LW_WIN = 0, LW_WUQ = LW_WIN + (size_t)DINP * D, LW_WUK = LW_WUQ + 768 * 256, LW_WUV = LW_WUK + 512 * 256, LW_WO = LW_WUV + 512 * 256,
                 LW_SGW = LW_WO + (size_t)D * D, LW_LWA = LW_SGW + 4 * 128 * 128, LW_LWX = LW_LWA + 4 * 64 * 64, LW_SIZE = ((LW_LWX + 4 * 64 * 64 + 65535) / 65536) * 65536;
static_assert(WS_W % 131072 == 0 && (LW_SIZE * 2) % 131072 == 0 && (LW_WUQ * 2) % 131072 == 0 && (LW_WUK * 2) % 131072 == 0 && (LW_WUV * 2) % 131072 == 0, "q/k/v tile alignment");
constexpr size_t DW_GU = 0, DW_D = DW_GU + (size_t)2 * DFF * D, DW_SIZE = DW_D + (size_t)D * DFF;
constexpr size_t MW_GU = 0, MW_D = MW_GU + (size_t)NE * 2 * DFE * D, MW_SIZE = MW_D + (size_t)NE * D * DFE;
constexpr int DFEP = 1536;
constexpr size_t DW8_GU = 0, DW8_D = DW8_GU + (size_t)2 * DFF * D;
constexpr size_t MW8_GU = 0, MW8_D = MW8_GU + (size_t)NE * 2 * DFE * D;
static_assert(MW8_D + (size_t)NE * D * DFEP <= ((size_t)NE * 2 * DFE * D + (size_t)NE * D * DFE) * 2, "fp8 MoE block fits");
constexpr size_t DW8_CS = 12 * MiB;
constexpr size_t DW8_RS = 13 * MiB, DW8_RSS = 14 * MiB;
constexpr size_t MW8_CS = 40 * MiB;
static_assert(DW8_D + (size_t)D * DFF <= DW8_CS && DW8_RSS + (size_t)8 * ECAP * 4 <= ((size_t)2 * DFF * D + (size_t)D * DFF) * 2, "dense block slack");
static_assert(MW8_D + (size_t)NE * D * DFEP <= MW8_CS && MW8_CS + (size_t)NE * 2 * DFE * 4 <= ((size_t)NE * 2 * DFE * D + (size_t)NE * D * DFE) * 2, "MoE block slack");
constexpr size_t WOFF_DENSE = 4 * LW_SIZE, WOFF_MOE = WOFF_DENSE + 2 * DW_SIZE, W_ELEMS = WOFF_MOE + 2 * MW_SIZE;
static_assert(WS_W + W_ELEMS * 2 <= 192 * MiB, "weight arena");
constexpr size_t WS_H = 192 * MiB, WS_YO = 224 * MiB, WS_RA = 288 * MiB;
constexpr size_t WS_ZQ = WS_RA, WS_ZKV = WS_ZQ + 8 * MiB, WS_KR = WS_ZKV + 8 * MiB, WS_U = WS_KR + 1 * MiB, WS_GV = WS_U + 8 * MiB, WS_ZX = WS_GV + 8 * MiB, WS_GY = WS_ZX + 8 * MiB,
                 WS_Q = WS_GY + 8 * MiB, WS_KN = WS_Q + 24 * MiB, WS_VT = WS_KN + 16 * MiB, WS_Y = WS_VT + 16 * MiB, WS_HL = WS_Y + 32 * MiB, WS_PP = WS_HL + 16 * MiB, WS_END = WS_PP + 16 * MiB;
constexpr size_t WS_ACT = WS_RA, WS_YD = WS_RA + 94 * MiB;
constexpr size_t WS_ACTD = WS_END, WS_END2 = WS_ACTD + 44 * MiB;
static_assert((size_t)M * DFF <= 44 * MiB, "dense activation buffer");
static_assert((size_t)MAXT * 256 * DFE * 2 <= 94 * MiB && (size_t)M * DFF * 2 <= 94 * MiB && WS_YD + (size_t)MAXT * 256 * D * 2 <= WS_END, "FFN overlay");

constexpr int RING_BYTES = 131072;
constexpr int MISC_OFF = RING_BYTES;
constexpr int LDS_BYTES = 147456;


namespace pg8 {
constexpr int BM = 256, BK = 64, HALF = 128, HTB = HALF * BK * 2  , STAGE_BYTES = 8 * HTB, NXCD = 8, WGM = 8;
__device__ __forceinline__ int lds_byte(int r, int c) { const int st = (r >> 4) * 2 + (c >> 5), rr = r & 15, cc = c & 31, ob = rr * 64 + cc * 2; return st * 1024 + (ob ^ (((ob >> 9) & 1) << 5)); }
__device__ __forceinline__ void stage_rc(int b, int& R, int& C) { const int st = b / 1024, sb = b % 1024, swz = sb ^ (((sb >> 9) & 1) << 5); R = (st >> 1) * 16 + swz / 64; C = (st & 1) * 32 + (swz % 64) / 2; }
__device__ __forceinline__ int perm32(int rho) { const int n = rho >> 4, i = rho & 15; return 8 * (i >> 2) + 4 * n + (i & 3); }

typedef int i32x8 __attribute__((ext_vector_type(8)));
typedef int i32x4v __attribute__((ext_vector_type(4)));
__device__ __forceinline__ i32x8 cat8(const bf16x8 a, const bf16x8 b) { const i32x4v x = __builtin_bit_cast(i32x4v, a), y = __builtin_bit_cast(i32x4v, b); return __builtin_shufflevector(x, y, 0, 1, 2, 3, 4, 5, 6, 7); }
__device__ __forceinline__ unsigned pk4_fp8(const f32x4 v) {
    float lim = 448.f; asm volatile("" : "+s"(lim));
    const float a = __builtin_fminf(__builtin_fmaxf(v[0], -lim), lim), b = __builtin_fminf(__builtin_fmaxf(v[1], -lim), lim), c = __builtin_fminf(__builtin_fmaxf(v[2], -lim), lim), d = __builtin_fminf(__builtin_fmaxf(v[3], -lim), lim);
    int w = __builtin_amdgcn_cvt_pk_fp8_f32(a, b, 0, false); w = __builtin_amdgcn_cvt_pk_fp8_f32(c, d, w, true); return (unsigned)w; }
__device__ __forceinline__ unsigned pk4_i8(const f32x4 v) {
    const unsigned b0 = __builtin_bit_cast(unsigned, v[0] + 12582912.0f), b1 = __builtin_bit_cast(unsigned, v[1] + 12582912.0f), b2 = __builtin_bit_cast(unsigned, v[2] + 12582912.0f), b3 = __builtin_bit_cast(unsigned, v[3] + 12582912.0f);
    const unsigned lo = __builtin_amdgcn_perm(b1, b0, 0x0c0c0400u), hi = __builtin_amdgcn_perm(b3, b2, 0x0c0c0400u);
    return __builtin_amdgcn_perm(hi, lo, 0x05040100u); }
__device__ __forceinline__ f32x4 i2f4(const f32x4 a) { const i32x4v q = __builtin_bit_cast(i32x4v, a); return (f32x4){(float)q[0], (float)q[1], (float)q[2], (float)q[3]}; }
constexpr float F8_WSC = 64.0f, F8_HSC = 4.0f, F8_ASC = 8.0f;
struct Unit { int pm, pn, x0, x1, x2, x3, co; };
struct Gemm { const void* A; const void* Bt; int K; int ld = 0; };

struct StaticOrder {
    static constexpr bool GATHER = false;
    int nM, nN, nwg, G, c, lim;
    __device__ void init(int Mr, int N, int G_, int c_) { nM = Mr / BM; nN = N / BM; nwg = nM * nN; G = G_; c = c_; lim = nwg; }
    __device__ bool next_tail(Unit& u) const { const int L = lim + 8 * ((c >> 3) >> 1) + (c & 7); if (L >= nwg) return false; map(L, u); u.co = ((c >> 3) & 1) * HALF; return true; }
    __device__ bool next(int i, Unit& u) const {
        const long L = (long)i * G + c; if (L >= lim) return false;
        map((int)L, u); return true; }
    __device__ void map(int Lq, Unit& u) const {
        int wgid = Lq; { const int q = nwg / NXCD, r = nwg % NXCD, xcd = wgid % NXCD, off = wgid / NXCD; wgid = (xcd < r ? xcd * (q + 1) : r * (q + 1) + (xcd - r) * q) + off; }
        const int nig = WGM * nN, gid = wgid / nig, fm = gid * WGM, gsz = (nM - fm) < WGM ? (nM - fm) : WGM;
        u.pm = fm + ((wgid % nig) % gsz); u.pn = (wgid % nig) / gsz; u.x0 = u.pm; u.x1 = u.pn; u.x2 = 0; u.x3 = 0; u.co = 0;
    }
    __device__ __forceinline__ int src_row(const Unit&, int) const { return 0; }
};

struct QkvOrder {
    static constexpr bool GATHER = false;
    int G, c, tq_a, tq_b, tk_a, tk_b, tv_a, tv_b;
    __device__ bool next(int i, Unit& u) const {
        const int L = i * G + c; if (L >= 448) return false;
        if (L < 192) { const int pm = L / 3, pn = L - 3 * pm; u.pm = tq_a + pm; u.pn = tq_b + pn; u.x0 = pm; u.x1 = pn; u.x2 = 0; }
        else if (L < 320) { const int j = L - 192, pm = j >> 1, pn = j & 1; u.pm = tk_a + pm; u.pn = tk_b + pn; u.x0 = pm; u.x1 = pn; u.x2 = 1; }
        else { const int j = L - 320, pn = j >> 1, pm = j & 1; u.pm = tv_a + pm; u.pn = tv_b + pn; u.x0 = pm; u.x1 = pn; u.x2 = 2; }
        u.x3 = 0; return true;
    }
    __device__ __forceinline__ int src_row(const Unit&, int) const { return 0; }
};
template <class S> struct TailOrder {
    static constexpr bool GATHER = false;
    const S& s;
    __device__ __forceinline__ bool next(int i, Unit& u) const { return i == 0 && s.next_tail(u); }
    __device__ __forceinline__ int src_row(const Unit&, int) const { return 0; }
};

template <class Epi, class Sched, bool ALIGN_EPI, int NBJ = 2, int QM = 0>
__device__ __forceinline__ void gemm_phase(LAS unsigned char* lds, const Gemm g, const Sched& S, const Epi& E) {
    const int tid = opaque_tid(), wid = __builtin_amdgcn_readfirstlane(tid >> 6), lane = tid & 63, wr = wid >> 2, wc = wid & 3, fr = lane & 15, fq = lane >> 4;
    constexpr bool F8 = (QM == 1); const int K = g.K, LD = g.ld ? g.ld : g.K, RB = QM ? LD : 2 * LD  , nt = (QM ? K : 2 * K) / 128;
    constexpr bool GA = Sched::GATHER;
    unsigned voffA, voffB;
    { int R, C; stage_rc(tid * 16, R, C); const int Rb = Epi::PERM ? ((R & ~31) + perm32(R & 31)) : R; voffA = (unsigned)(R * RB + 2 * C); voffB = (unsigned)(Rb * RB + 2 * C); }
    const size_t dstep = (size_t)64 * RB;
    u32x4 vG;
    LAS u32x4* gstash = (LAS u32x4*)(lds + STAGE_BYTES + 4096 + tid * 16);
    const size_t kstep = (size_t)(BK * 2);
    const size_t hstep = GA ? 0 : (size_t)HALF * RB;
    const size_t tstep = (size_t)BM * RB;
    const unsigned ldsw = (unsigned)wid * 1024u;
    const int aoff = lds_byte(wr * 64 + fr, fq * 8), boff = lds_byte(wc * 32 + fr, fq * 8);
#define PG8_SA(b, h) (((b) * 2 + (h)) * HTB)
#define PG8_SB(b, h) ((4 + (b) * 2 + (h)) * HTB)
#define PG8_STAGE(bufoff, gbase, voff) do { _Pragma("unroll") for (int _i = 0; _i < 2; ++_i) \
        __builtin_amdgcn_global_load_lds((const unsigned*)((const char*)(gbase) + _i * dstep + (voff)), (LAS unsigned*)(lds + (bufoff) + ldsw + _i * 8192), 16, 0, 0); } while (0)
#define PG8_STAGE_A(bufoff, gbase, h, NX) do { if constexpr (GA) { _Pragma("unroll") for (int _i = 0; _i < 2; ++_i) \
            __builtin_amdgcn_global_load_lds((const unsigned*)((const char*)(gbase) + vG[(h) * 2 + _i]), (LAS unsigned*)(lds + (bufoff) + ldsw + _i * 8192), 16, 0, 0); } \
        else { PG8_STAGE(bufoff, (const char*)(gbase) + (h) * hstep, voffA); } } while (0)
#define PG8_LDA(dst, b, h) do { _Pragma("unroll") for (int m = 0; m < 4; ++m) _Pragma("unroll") for (int k = 0; k < 2; ++k) dst[m][k] = *(const LAS bf16x8*)(lds + PG8_SA(b, h) + aoff + m * 2048 + k * 1024); } while (0)
#define PG8_LDB(dst, b, h) do { _Pragma("unroll") for (int n = 0; n < 2; ++n) _Pragma("unroll") for (int k = 0; k < 2; ++k) dst[n][k] = *(const LAS bf16x8*)(lds + PG8_SB(b, h) + boff + n * 2048 + k * 1024); } while (0)
#define PG8_MMA(ai, bj, At, Bt) do { __builtin_amdgcn_s_setprio(1); _Pragma("unroll") for (int m = 0; m < 4; ++m) _Pragma("unroll") for (int n = 0; n < 2; ++n) { \
        if constexpr (F8) acc[ai][bj][m][n] = __builtin_amdgcn_mfma_scale_f32_16x16x128_f8f6f4(cat8(Bt[n][0], Bt[n][1]), cat8(At[m][0], At[m][1]), acc[ai][bj][m][n], 0, 0, 0, 0, 0, 0);     \
        else if constexpr (QM == 2) { _Pragma("unroll") for (int k = 0; k < 2; ++k) acc[ai][bj][m][n] = __builtin_bit_cast(f32x4, __builtin_amdgcn_mfma_i32_16x16x64_i8(__builtin_bit_cast(i32x4v, Bt[n][k]), __builtin_bit_cast(i32x4v, At[m][k]), __builtin_bit_cast(i32x4v, acc[ai][bj][m][n]), 0, 0, 0)); } \
        else { _Pragma("unroll") for (int k = 0; k < 2; ++k) acc[ai][bj][m][n] = __builtin_amdgcn_mfma_f32_16x16x32_bf16(Bt[n][k], At[m][k], acc[ai][bj][m][n], 0, 0, 0); } } __builtin_amdgcn_s_setprio(0); } while (0)
#define PG8_WAIT_V(n) asm volatile("s_waitcnt vmcnt(" #n ")" ::: "memory")
#define PG8_WAIT_L(n) asm volatile("s_waitcnt lgkmcnt(" #n ")" ::: "memory")
#define PG8_WAIT_VN do { if constexpr (NBJ == 2) PG8_WAIT_V(8); else PG8_WAIT_V(6); } while (0)
#define PG8_BAR __builtin_amdgcn_s_barrier()
#define PG8_SCHED __builtin_amdgcn_sched_barrier(0)
#define PG8_GOFF(dst, u) do { if constexpr (GA) { int _t = tid, _R, _C; asm volatile("" : "+v"(_t)); stage_rc(_t * 16, _R, _C);     \
        _Pragma("unroll") for (int _h = 0; _h < 2; ++_h) _Pragma("unroll") for (int _i = 0; _i < 2; ++_i) \
        dst[_h * 2 + _i] = (unsigned)S.src_row(u, _h * HALF + _i * 64 + _R) * (unsigned)RB + 2u * (unsigned)_C; } } while (0)
    Unit cur, nxt; int ui = 0;
    if (!S.next(0, cur)) return;
    f32x4 acc[2][2][4][2];
#pragma unroll
    for (int a = 0; a < 2; ++a)
#pragma unroll
        for (int b = 0; b < 2; ++b)
#pragma unroll
            for (int m = 0; m < 4; ++m)
#pragma unroll
                for (int n = 0; n < 2; ++n) acc[a][b][m][n] = (f32x4){0.f, 0.f, 0.f, 0.f};
    bf16x8 At[4][2], B0[2][2], B1[2][2];
    const char* cA = (const char*)g.A + (GA ? (size_t)0 : (size_t)cur.pm * tstep); const char* cB = (const char*)g.Bt + (size_t)cur.pn * tstep + (size_t)(cur.co / HALF) * ((size_t)HALF * RB);
    PG8_GOFF(vG, cur);
    PG8_STAGE(PG8_SB(0, 0), cB, voffB); if constexpr (NBJ == 2) PG8_STAGE(PG8_SB(0, 1), cB + (size_t)HALF * RB, voffB); PG8_STAGE_A(PG8_SA(0, 0), cA, 0, false); PG8_STAGE_A(PG8_SA(0, 1), cA, 1, false);
    if (wr == 1) PG8_BAR;
    PG8_WAIT_V(2); PG8_BAR;
    PG8_STAGE(PG8_SB(1, 0), cB + kstep, voffB); PG8_STAGE_A(PG8_SA(1, 0), cA + kstep, 0, false); if constexpr (NBJ == 2) PG8_STAGE(PG8_SB(1, 1), cB + (size_t)HALF * RB + kstep, voffB);
    if constexpr (NBJ == 2) PG8_WAIT_V(6); else PG8_WAIT_V(4);
    PG8_BAR;
    const size_t bh = (size_t)HALF * RB;
    for (;;) {
        const bool has_next = S.next(ui + 1, nxt);
        if constexpr (GA) { u32x4 nx = vG; if (has_next) { PG8_GOFF(nx, nxt); } *gstash = nx; }
        const char* nA = has_next ? (const char*)g.A + (GA ? (size_t)0 : (size_t)nxt.pm * tstep) : cA; const char* nB = has_next ? (const char*)g.Bt + (size_t)nxt.pn * tstep + (size_t)(nxt.co / HALF) * ((size_t)HALF * RB) : cB;
#pragma nounroll
        for (int t = 0; t < nt; t += 2) {
            const bool last = (t == nt - 2);
            const bool tail = last && !has_next;
            if constexpr (GA) asm volatile("" : "+v"(voffB), "+v"(vG));
            else asm volatile("" : "+v"(voffA), "+v"(voffB));
            const char* a1 = cA + (size_t)(t + 1) * kstep;
            const char* a2 = last ? nA : cA + (size_t)(t + 2) * kstep; const char* b2 = last ? nB : cB + (size_t)(t + 2) * kstep;
            const char* a3 = a2 + kstep; const char* b3 = b2 + kstep;
            PG8_LDB(B0, 0, 0); if constexpr (NBJ == 2) PG8_LDB(B1, 0, 1); PG8_SCHED; PG8_LDA(At, 0, 0); PG8_STAGE_A(PG8_SA(1, 1), a1, 1, false);
            if constexpr (GA) { if (last) vG = *gstash; }
            PG8_WAIT_VN; PG8_WAIT_L(0); PG8_BAR; PG8_MMA(0, 0, At, B0); if constexpr (NBJ == 2) PG8_MMA(0, 1, At, B1); PG8_BAR; PG8_SCHED;
            PG8_LDA(At, 0, 1); if (!tail) { PG8_STAGE(PG8_SB(0, 0), b2, voffB); if constexpr (NBJ == 2) PG8_STAGE(PG8_SB(0, 1), b2 + bh, voffB); PG8_STAGE_A(PG8_SA(0, 0), a2, 0, last); }
            if (tail) PG8_WAIT_V(2); else PG8_WAIT_VN;
            PG8_WAIT_L(0); PG8_BAR; PG8_MMA(1, 0, At, B0); if constexpr (NBJ == 2) PG8_MMA(1, 1, At, B1); PG8_BAR; PG8_SCHED;
            PG8_LDB(B0, 1, 0); if constexpr (NBJ == 2) PG8_LDB(B1, 1, 1); PG8_SCHED; PG8_LDA(At, 1, 0); if (!tail) PG8_STAGE_A(PG8_SA(0, 1), a2, 1, last);
            if (tail) PG8_WAIT_V(0); else PG8_WAIT_VN;
            PG8_WAIT_L(0); PG8_BAR; PG8_MMA(0, 0, At, B0); if constexpr (NBJ == 2) PG8_MMA(0, 1, At, B1); PG8_BAR; PG8_SCHED;
            PG8_LDA(At, 1, 1); if (!tail) { PG8_STAGE(PG8_SB(1, 0), b3, voffB); if constexpr (NBJ == 2) PG8_STAGE(PG8_SB(1, 1), b3 + bh, voffB); PG8_STAGE_A(PG8_SA(1, 0), a3, 0, last); }
            if (tail) PG8_WAIT_V(0); else PG8_WAIT_VN;
            PG8_WAIT_L(0); PG8_BAR; PG8_MMA(1, 0, At, B0); if constexpr (NBJ == 2) PG8_MMA(1, 1, At, B1); PG8_BAR; PG8_SCHED;
        }
        if constexpr (ALIGN_EPI) { if (wr == 0) PG8_BAR; }
        { int l2 = lane; asm volatile("" : "+v"(l2)); E.template operator()<NBJ>(acc, cur, wr, wc, l2 & 15, l2 >> 4); }
        if (!has_next) break;
#pragma unroll
        for (int a = 0; a < 2; ++a)
#pragma unroll
            for (int b = 0; b < 2; ++b)
#pragma unroll
                for (int m = 0; m < 4; ++m)
#pragma unroll
                    for (int n = 0; n < 2; ++n) acc[a][b][m][n] = (f32x4){0.f, 0.f, 0.f, 0.f};
        cur = nxt; cA = nA; cB = nB; ++ui;
        if constexpr (ALIGN_EPI) { if (wr == 1) PG8_BAR; }
    }
    PG8_WAIT_V(0);
    if constexpr (!ALIGN_EPI) { if (wr == 0) PG8_BAR; }
    PG8_BAR;
#undef PG8_SA
#undef PG8_SB
#undef PG8_STAGE
#undef PG8_STAGE_A
#undef PG8_LDA
#undef PG8_LDB
#undef PG8_MMA
#undef PG8_WAIT_V
#undef PG8_WAIT_L
#undef PG8_WAIT_VN
#undef PG8_BAR
#undef PG8_SCHED
#undef PG8_GOFF
}

typedef f32x4 AccT[2][2][4][2];
__device__ __forceinline__ u32x4 pack8(const f32x4 v0, const f32x4 v1) { u32x4 w; w.x = cvt_pk(v0[0], v0[1]); w.y = cvt_pk(v0[2], v0[3]); w.z = cvt_pk(v1[0], v1[1]); w.w = cvt_pk(v1[2], v1[3]); return w; }
__device__ __forceinline__ float rstd_from(u64 ssq, float inv_n) { return __builtin_amdgcn_rsqf((float)ssq * (1.0f / 4294967296.0f) * inv_n + 1e-6f); }
__device__ __forceinline__ f32x4 gelu4(f32x4 v) {
    constexpr float K1 = -2.0f * LOG2E * 0.7978845608028654f, K2 = K1 * 0.044715f;
    typedef float f32x2_ __attribute__((ext_vector_type(2)));
    f32x2_ k1 = (f32x2_){K1, K1}, k2 = (f32x2_){K2, K2}; asm volatile("" : "+s"(k1), "+s"(k2));
    const f32x4 k1v = __builtin_shufflevector(k1, k1, 0, 1, 0, 1), k2v = __builtin_shufflevector(k2, k2, 0, 1, 0, 1);
    const f32x4 t = v * ((v * v) * k2v + k1v);
    f32x4 d = (f32x4){fexp2(t[0]), fexp2(t[1]), fexp2(t[2]), fexp2(t[3])}; d = d + 1.0f;
    const f32x4 s = (f32x4){frcp(d[0]), frcp(d[1]), frcp(d[2]), frcp(d[3])};
    return v * s; }

struct EpiF32 {
    static constexpr bool PERM = false;
    float* O; int ldc;
    template <int NBJ = 2> __device__ __forceinline__ void operator()(const AccT& acc, const Unit& u, int wr, int wc, int fr, int fq) const {
#pragma unroll
        for (int ai = 0; ai < 2; ++ai)
#pragma unroll
            for (int m = 0; m < 4; ++m) { float* rowp = O + (size_t)(u.x0 * BM + ai * HALF + wr * 64 + m * 16 + fr) * ldc + u.x1 * BM + wc * 32 + 4 * fq;
#pragma unroll
                for (int bj = 0; bj < 2; ++bj)
#pragma unroll
                    for (int n = 0; n < 2; ++n) *(f32x4*)(rowp + bj * HALF + n * 16) = acc[ai][bj][m][n]; }
    }
};
struct EpiBf {
    static constexpr bool PERM = true;
    bf16* O; int ldc;
    template <int NBJ = 2> __device__ __forceinline__ void operator()(const AccT& acc, const Unit& u, int wr, int wc, int fr, int fq) const {
#pragma unroll
        for (int ai = 0; ai < 2; ++ai)
#pragma unroll
            for (int m = 0; m < 4; ++m) { bf16* rowp = O + (size_t)(u.x0 * BM + ai * HALF + wr * 64 + m * 16 + fr) * ldc + u.x1 * BM + wc * 32 + 8 * fq;
#pragma unroll
                for (int bj = 0; bj < NBJ; ++bj) *(u32x4*)(rowp + u.co + bj * HALF) = pack8(acc[ai][bj][m][0], acc[ai][bj][m][1]); }
    }
};
struct EpiSwiglu {
    static constexpr bool PERM = true;
    bf16* O; int ldc;
    template <int NBJ = 2> __device__ __forceinline__ void operator()(const AccT& acc, const Unit& u, int wr, int wc, int fr, int fq) const {
#pragma unroll
        for (int ai = 0; ai < 2; ++ai)
#pragma unroll
            for (int m = 0; m < 4; ++m) { bf16* rowp = O + (size_t)(u.x0 * BM + ai * HALF + wr * 64 + m * 16 + fr) * ldc + u.x1 * HALF + wc * 32 + 8 * fq;
                f32x4 a0, a1;
#pragma unroll
                for (int e = 0; e < 4; ++e) { a0[e] = siluf_(acc[ai][0][m][0][e]) * acc[ai][1][m][0][e]; a1[e] = siluf_(acc[ai][0][m][1][e]) * acc[ai][1][m][1][e]; }
                *(u32x4*)rowp = pack8(a0, a1); }
    }
};
struct EpiBfS {
    static constexpr bool PERM = true;
    bf16* O; int ldc; float sc;
    template <int NBJ = 2> __device__ __forceinline__ void operator()(const AccT& acc, const Unit& u, int wr, int wc, int fr, int fq) const {
#pragma unroll
        for (int ai = 0; ai < 2; ++ai)
#pragma unroll
            for (int m = 0; m < 4; ++m) { bf16* rowp = O + (size_t)(u.x0 * BM + ai * HALF + wr * 64 + m * 16 + fr) * ldc + u.x1 * BM + wc * 32 + 8 * fq;
#pragma unroll
                for (int bj = 0; bj < NBJ; ++bj) *(u32x4*)(rowp + u.co + bj * HALF) = pack8(acc[ai][bj][m][0] * sc, acc[ai][bj][m][1] * sc); }
    }
};
struct EpiSwiglu8 {
    static constexpr bool PERM = true;
    unsigned char* O; int ldc, zt;
    template <int NBJ = 2> __device__ __forceinline__ void operator()(const AccT& acc, const Unit& u, int wr, int wc, int fr, int fq) const {
        constexpr float sg = 1.0f / (F8_HSC * F8_WSC), su = F8_ASC / (F8_HSC * F8_WSC);
#pragma unroll
        for (int ai = 0; ai < 2; ++ai)
#pragma unroll
            for (int m = 0; m < 4; ++m) { unsigned char* rowp = O + (size_t)(u.x0 * BM + ai * HALF + wr * 64 + m * 16 + fr) * ldc + u.x1 * HALF + wc * 32 + 8 * fq;
                f32x4 a0, a1;
#pragma unroll
                for (int e = 0; e < 4; ++e) { a0[e] = siluf_(acc[ai][0][m][0][e] * sg) * (acc[ai][1][m][0][e] * su); a1[e] = siluf_(acc[ai][0][m][1][e] * sg) * (acc[ai][1][m][1][e] * su); }
                u32x2 w; w.x = pk4_fp8(a0); w.y = pk4_fp8(a1); *(u32x2*)rowp = w;
                if (u.x1 == zt) *(u32x2*)(rowp + HALF) = (u32x2){0u, 0u}; }
    }
};
template <bool SLOT> struct EpiSwigluI8 {
    static constexpr bool PERM = true;
    unsigned char* O; int ldc, zt; const float* rs; const float* cs;
    template <int NBJ = 2> __device__ __forceinline__ void operator()(const AccT& acc, const Unit& u, int wr, int wc, int fr, int fq) const {
        const float* cp = cs + (size_t)u.pn * BM + wc * 32 + 8 * fq;
        const f32x4 cg0 = *(const f32x4*)cp, cg1 = *(const f32x4*)(cp + 4), cu0 = *(const f32x4*)(cp + HALF) * F8_ASC, cu1 = *(const f32x4*)(cp + HALF + 4) * F8_ASC;
        float rr[2][4];
#pragma unroll
        for (int ai = 0; ai < 2; ++ai)
#pragma unroll
            for (int m = 0; m < 4; ++m) { const int rl = ai * HALF + wr * 64 + m * 16 + fr; rr[ai][m] = SLOT ? ((rl < u.x3) ? rs[u.x2 + rl] : 0.f) : rs[u.x0 * BM + rl]; }
#pragma unroll
        for (int ai = 0; ai < 2; ++ai)
#pragma unroll
            for (int m = 0; m < 4; ++m) { const int rl = ai * HALF + wr * 64 + m * 16 + fr;
                unsigned char* rowp = O + (size_t)(u.x0 * BM + rl) * ldc + u.x1 * HALF + wc * 32 + 8 * fq;
                const float r = rr[ai][m];
                const f32x4 g0 = i2f4(acc[ai][0][m][0]) * (cg0 * r), g1 = i2f4(acc[ai][0][m][1]) * (cg1 * r), u0 = i2f4(acc[ai][1][m][0]) * (cu0 * r), u1 = i2f4(acc[ai][1][m][1]) * (cu1 * r);
                f32x4 nl2 = (f32x4){-LOG2E, -LOG2E, -LOG2E, -LOG2E}; asm volatile("" : "+v"(nl2));
                const f32x4 t0 = g0 * nl2, t1 = g1 * nl2;
                f32x4 d0, d1;
#pragma unroll
                for (int e = 0; e < 4; ++e) { d0[e] = fexp2(t0[e]); d1[e] = fexp2(t1[e]); }
                d0 = d0 + 1.0f; d1 = d1 + 1.0f;
                f32x4 s0, s1;
#pragma unroll
                for (int e = 0; e < 4; ++e) { s0[e] = frcp(d0[e]); s1[e] = frcp(d1[e]); }
                f32x4 a0 = (g0 * u0) * s0, a1 = (g1 * u1) * s1;
                float lim = 448.f; asm volatile("" : "+v"(lim));
#pragma unroll
                for (int e = 0; e < 4; ++e) { a0[e] = __builtin_amdgcn_fmed3f(a0[e], -lim, lim); a1[e] = __builtin_amdgcn_fmed3f(a1[e], -lim, lim); }
                u32x2 w;
                { int w0 = __builtin_amdgcn_cvt_pk_fp8_f32(a0[0], a0[1], 0, false); w0 = __builtin_amdgcn_cvt_pk_fp8_f32(a0[2], a0[3], w0, true);
                  int w1 = __builtin_amdgcn_cvt_pk_fp8_f32(a1[0], a1[1], 0, false); w1 = __builtin_amdgcn_cvt_pk_fp8_f32(a1[2], a1[3], w1, true); w.x = (unsigned)w0; w.y = (unsigned)w1; }
                *(u32x2*)rowp = w; }
        if constexpr (SLOT) { if (u.x1 == zt) {
#pragma unroll
            for (int ai = 0; ai < 2; ++ai)
#pragma unroll
                for (int m = 0; m < 4; ++m) *(u32x2*)(O + (size_t)(u.x0 * BM + ai * HALF + wr * 64 + m * 16 + fr) * ldc + u.x1 * HALF + wc * 32 + 8 * fq + HALF) = (u32x2){0u, 0u}; } }
    }
};
struct EpiIn {
    static constexpr bool PERM = true;
    unsigned char* ws; const float* rs; const float* cs;
    template <int NBJ = 2> __device__ __forceinline__ void operator()(const AccT& acc, const Unit& u, int wr, int wc, int fr, int fq) const {
        const int pn = u.pn;
        f32x4 c0[NBJ], c1[NBJ];
        { const float* cp = cs + (size_t)pn * BM + u.co + wc * 32 + 8 * fq;
#pragma unroll
          for (int bj = 0; bj < NBJ; ++bj) { c0[bj] = *(const f32x4*)(cp + bj * HALF); c1[bj] = *(const f32x4*)(cp + bj * HALF + 4); } }
        float rr[2][4];
#pragma unroll
        for (int ai = 0; ai < 2; ++ai)
#pragma unroll
            for (int m = 0; m < 4; ++m) rr[ai][m] = rs[u.pm * BM + ai * HALF + wr * 64 + m * 16 + fr];
        bf16 *ZQ = (bf16*)(ws + WS_ZQ), *ZKV = (bf16*)(ws + WS_ZKV), *KR = (bf16*)(ws + WS_KR), *U = (bf16*)(ws + WS_U), *GV = (bf16*)(ws + WS_GV), *ZX = (bf16*)(ws + WS_ZX), *GY = (bf16*)(ws + WS_GY);
        u64 *ssq_q = (u64*)(ws + WS_SSQQ), *ssq_kv = (u64*)(ws + WS_SSQK); const float *cosT = (const float*)(ws + WS_COS), *sinT = (const float*)(ws + WS_SIN);
        const bool krope = (pn == 1 && wc == 0 && (NBJ == 2 || (u.co >> 7) == 1));
#pragma unroll
        for (int ai = 0; ai < 2; ++ai) {
            f32x4 cc[4], sn[4];
            if (krope) {
#pragma unroll
                for (int m = 0; m < 4; ++m) { const int pos = (u.pm * BM + ai * HALF + wr * 64 + m * 16 + fr) & (SEQ - 1); cc[m] = *(const f32x4*)(cosT + pos * 16 + 4 * fq); sn[m] = *(const f32x4*)(sinT + pos * 16 + 4 * fq); } }
#pragma unroll
            for (int m = 0; m < 4; ++m) {
                const int row = u.pm * BM + ai * HALF + wr * 64 + m * 16 + fr; const int cl = wc * 32 + 8 * fq; const float rsc = rr[ai][m];
                const int hb = u.co >> 7;
                if (pn == 0 || pn == 1) {
                    bf16* dst = (pn == 0 ? ZQ : ZKV) + (size_t)row * 256 + cl;
                    float ss = 0.f;
#pragma unroll
                    for (int bj = 0; bj < NBJ; ++bj) { const f32x4 v0 = i2f4(acc[ai][bj][m][0]) * (c0[bj] * rsc), v1 = i2f4(acc[ai][bj][m][1]) * (c1[bj] * rsc);
                        *(u32x4*)(dst + (bj + hb) * HALF) = pack8(v0, v1);
                        if (pn == 0 || bj + hb == 0) ss += (v0[0] * v0[0] + v0[1] * v0[1]) + (v0[2] * v0[2] + v0[3] * v0[3]) + (v1[0] * v1[0] + v1[1] * v1[1]) + (v1[2] * v1[2] + v1[3] * v1[3]); }
                    ss += shx(ss, fq * 16 + fr, 16); ss += shx(ss, fq * 16 + fr, 32);
                    if (fq == 0 && (pn == 0 || hb == 0)) atomicAdd((pn == 0 ? ssq_q : ssq_kv) + row, (u64)(ss * 4294967296.0f));
                    if (krope) {
                        const f32x4 x1 = i2f4(acc[ai][NBJ == 2 ? 1 : 0][m][0]) * (c0[NBJ == 2 ? 1 : 0] * rsc), x2 = i2f4(acc[ai][NBJ == 2 ? 1 : 0][m][1]) * (c1[NBJ == 2 ? 1 : 0] * rsc);
                        const f32x4 c = cc[m], s = sn[m];
                        const f32x4 o1 = x1 * c - x2 * s, o2 = x2 * c + x1 * s;
                        u32x2 w1, w2; w1.x = cvt_pk(o1[0], o1[1]); w1.y = cvt_pk(o1[2], o1[3]); w2.x = cvt_pk(o2[0], o2[1]); w2.y = cvt_pk(o2[2], o2[3]);
                        *(u32x2*)(KR + (size_t)row * 32 + 4 * fq) = w1; *(u32x2*)(KR + (size_t)row * 32 + 16 + 4 * fq) = w2; }
                } else {
                    bf16* dst = (pn == 2 ? U : pn == 3 ? GV : pn == 4 ? ZX : GY) + (size_t)row * 256 + cl;
#pragma unroll
                    for (int bj = 0; bj < NBJ; ++bj) { f32x4 v0 = i2f4(acc[ai][bj][m][0]) * (c0[bj] * rsc), v1 = i2f4(acc[ai][bj][m][1]) * (c1[bj] * rsc);
                        if (pn != 4) { v0 = gelu4(v0); v1 = gelu4(v1); }
                        *(u32x4*)(dst + (bj + hb) * HALF) = pack8(v0, v1); }
                }
            }
        }
    }
};
struct EpiQ {
    static constexpr bool PERM = true;
    unsigned char* ws;
    template <int NBJ = 2> __device__ __forceinline__ void operator()(const AccT& acc, const Unit& u, int wr, int wc, int fr, int fq) const {
        bf16* Q = (bf16*)(ws + WS_Q); const u64* ssq = (const u64*)(ws + WS_SSQQ); const float *cosT = (const float*)(ws + WS_COS), *sinT = (const float*)(ws + WS_SIN);
        u64 sq[2][4];
#pragma unroll
        for (int ai = 0; ai < 2; ++ai)
#pragma unroll
            for (int m = 0; m < 4; ++m) sq[ai][m] = ssq[u.x0 * BM + ai * HALF + wr * 64 + m * 16 + fr];
        const bool rope = ((u.x1 * 8 + wc) % 3 == 2) || ((u.x1 * 8 + 4 + wc) % 3 == 2);
#pragma unroll
        for (int ai = 0; ai < 2; ++ai) {
            f32x4 cc[4], sn[4];
            if (rope) {
#pragma unroll
                for (int m = 0; m < 4; ++m) { const int pos = (u.x0 * BM + ai * HALF + wr * 64 + m * 16 + fr) & (SEQ - 1); cc[m] = *(const f32x4*)(cosT + pos * 16 + 4 * fq); sn[m] = *(const f32x4*)(sinT + pos * 16 + 4 * fq); } }
#pragma unroll
            for (int m = 0; m < 4; ++m) {
                const int row = u.x0 * BM + ai * HALF + wr * 64 + m * 16 + fr; const float sc = rstd_from(sq[ai][m], 1.0f / 256.0f) * QSCALE;
#pragma unroll
                for (int bj = 0; bj < 2; ++bj) {
                    const int c32 = u.x1 * 8 + bj * 4 + wc, head = c32 / 3, part = c32 - 3 * head;
                    const f32x4 v0 = acc[ai][bj][m][0] * sc, v1 = acc[ai][bj][m][1] * sc; bf16* dst = Q + (size_t)row * 768 + head * 96;
                    if (part < 2) *(u32x4*)(dst + part * 32 + 8 * fq) = pack8(v0, v1);
                    else { const f32x4 c = cc[m], s = sn[m];
                        const f32x4 o1 = v0 * c - v1 * s, o2 = v1 * c + v0 * s;
                        u32x2 w1, w2; w1.x = cvt_pk(o1[0], o1[1]); w1.y = cvt_pk(o1[2], o1[3]); w2.x = cvt_pk(o2[0], o2[1]); w2.y = cvt_pk(o2[2], o2[3]);
                        *(u32x2*)(dst + 64 + 4 * fq) = w1; *(u32x2*)(dst + 80 + 4 * fq) = w2; }
                }
            }
            asm volatile("" ::: "memory");
        }
    }
};
struct EpiK {
    static constexpr bool PERM = true;
    unsigned char* ws;
    template <int NBJ = 2> __device__ __forceinline__ void operator()(const AccT& acc, const Unit& u, int wr, int wc, int fr, int fq) const {
        bf16* KN = (bf16*)(ws + WS_KN); const u64* ssq = (const u64*)(ws + WS_SSQK);
        u64 sq[2][4];
#pragma unroll
        for (int ai = 0; ai < 2; ++ai)
#pragma unroll
            for (int m = 0; m < 4; ++m) sq[ai][m] = ssq[u.x0 * BM + ai * HALF + wr * 64 + m * 16 + fr];
#pragma unroll
        for (int ai = 0; ai < 2; ++ai)
#pragma unroll
            for (int m = 0; m < 4; ++m) {
                const int row = u.x0 * BM + ai * HALF + wr * 64 + m * 16 + fr; const float sc = rstd_from(sq[ai][m], 1.0f / 128.0f);
                bf16* dst = KN + (size_t)row * 512 + u.x1 * BM + wc * 32 + 8 * fq;
#pragma unroll
                for (int bj = 0; bj < 2; ++bj) *(u32x4*)(dst + bj * HALF) = pack8(acc[ai][bj][m][0] * sc, acc[ai][bj][m][1] * sc);
            }
    }
};
struct EpiVT {
    static constexpr bool PERM = true;
    unsigned char* ws;
    template <int NBJ = 2> __device__ __forceinline__ void operator()(const AccT& acc, const Unit& u, int wr, int wc, int fr, int fq) const {
        bf16* VT = (bf16*)(ws + WS_VT); const u64* ssq = (const u64*)(ws + WS_SSQK);
#pragma unroll
        for (int bj = 0; bj < 2; ++bj) {
            const int tk = u.x1 * BM + bj * HALF + wc * 32 + 8 * fq; f32x4 s0, s1;
#pragma unroll
            for (int e = 0; e < 4; ++e) { s0[e] = rstd_from(ssq[tk + e], 1.0f / 128.0f); s1[e] = rstd_from(ssq[tk + 4 + e], 1.0f / 128.0f); }
#pragma unroll
            for (int ai = 0; ai < 2; ++ai)
#pragma unroll
                for (int m = 0; m < 4; ++m) { const int vr = u.x0 * BM + ai * HALF + wr * 64 + m * 16 + fr;
                    *(u32x4*)(VT + (size_t)vr * M + tk) = pack8(acc[ai][bj][m][0] * s0, acc[ai][bj][m][1] * s1); }
        }
    }
};
struct EpiQKV {
    static constexpr bool PERM = true;
    unsigned char* ws;
    template <int NBJ = 2> __device__ __forceinline__ void operator()(const AccT& acc, const Unit& u, int wr, int wc, int fr, int fq) const {
        if (u.x2 == 0) { EpiQ e{ws}; e(acc, u, wr, wc, fr, fq); }
        else if (u.x2 == 1) { EpiK e{ws}; e(acc, u, wr, wc, fr, fq); }
        else { EpiVT e{ws}; e(acc, u, wr, wc, fr, fq); }
    }
};
}

namespace att {
constexpr int KP = 208, VP = 144;
constexpr int KT = 64 * KP, VTB = 64 * VP;
constexpr int LDS_NEED = 2 * KT + 2 * VTB;
constexpr float THR = 8.0f;
__device__ __forceinline__ float max3(float a, float b, float c) { return __builtin_fmaxf(__builtin_fmaxf(a, b), c); }
__device__ __forceinline__ float rowmax32(const f32x16& p0, const f32x16& p1) {
    float a = max3(p0[0], p0[1], p1[0]), b = max3(p0[2], p0[3], p1[1]); a = max3(a, p1[2], p1[3]);
#pragma unroll
    for (int r = 4; r < 16; r += 4) { a = max3(a, p0[r], p0[r + 1]); b = max3(b, p0[r + 2], p0[r + 3]); a = max3(a, p1[r], p1[r + 1]); b = max3(b, p1[r + 2], p1[r + 3]); }
    const float m = __builtin_fmaxf(a, b);
    auto rr = __builtin_amdgcn_permlane32_swap(__float_as_uint(m), __float_as_uint(m), false, false);
    return __builtin_fmaxf(__uint_as_float(rr[0]), __uint_as_float(rr[1]));
}
__device__ __forceinline__ void attn_unit(LAS unsigned char* lds, int b, int h, int qb, const bf16* __restrict__ Q, const bf16* __restrict__ KN, const bf16* __restrict__ KR, const bf16* __restrict__ VT, bf16* __restrict__ Y) {
    const int tid = opaque_tid(), lane = tid & 63, r32 = lane & 31, hi = lane >> 5, w = __builtin_amdgcn_readfirstlane(tid >> 6);
    const int mrow = b * SEQ + qb * 256 + w * 32 + r32;
    const int nt_wg = 4 * qb + 4, nt_w = 4 * qb + (w >> 1) + 1;
    bf16x8 qf[6];
#pragma unroll
    for (int s = 0; s < 6; ++s) qf[s] = *(const bf16x8*)(Q + (size_t)mrow * 768 + h * 96 + 16 * s + 8 * hi);
    f32x16 o0 = {}, o1 = {}; float mref = 0.f, lsum = 0.f;
    const int kr0 = tid / 12, kc0 = tid % 12, kr1 = (tid + 512) / 12, kc1 = (tid + 512) % 12; const bool k2 = tid < 256;
    const int vd = tid >> 3, vc = tid & 7;
    const bf16* kp0 = (kc0 < 8) ? KN + ((size_t)b * SEQ + kr0) * 512 + h * 64 + kc0 * 8 : KR + ((size_t)b * SEQ + kr0) * 32 + (kc0 - 8) * 8; const size_t ks0 = (kc0 < 8) ? 64 * 512 : 64 * 32;
    const bf16* kp1 = (kc1 < 8) ? KN + ((size_t)b * SEQ + kr1) * 512 + h * 64 + kc1 * 8 : KR + ((size_t)b * SEQ + kr1) * 32 + (kc1 - 8) * 8; const size_t ks1 = (kc1 < 8) ? 64 * 512 : 64 * 32;
    const bf16* vp = VT + (size_t)(h * 64 + vd) * M + (size_t)b * SEQ + vc * 8;
    const int kw0 = kr0 * KP + kc0 * 16, kw1 = kr1 * KP + kc1 * 16, vw = 2 * KT + vd * VP + (vc >> 1) * 32 + (vc & 1) * 8;
    u32x4 kgA0, kgA1, vgA, kgB0, kgB1, vgB;
#define AT_GLOADK(S, t) do { kg##S##0 = *(const u32x4*)(kp0 + (size_t)(t) * ks0); if (k2) kg##S##1 = *(const u32x4*)(kp1 + (size_t)(t) * ks1); } while (0)
#define AT_GLOADV(S, t) do { vg##S = *(const u32x4*)(vp + (size_t)(t) * 64); } while (0)
#define AT_WRITEK(S, buf) do { *(LAS u32x4*)(lds + (buf) * KT + kw0) = kg##S##0; if (k2) *(LAS u32x4*)(lds + (buf) * KT + kw1) = kg##S##1; } while (0)
#define AT_WRITEV(S, buf) do { *(LAS u32x2*)(lds + (buf) * VTB + vw) = (u32x2){vg##S.x, vg##S.y}; *(LAS u32x2*)(lds + (buf) * VTB + vw + 16) = (u32x2){vg##S.z, vg##S.w}; } while (0)
    const int kro = r32 * KP + 16 * hi, vro = 2 * KT + r32 * VP + 16 * hi;
#define AT_QK(P0, P1, kb_, CIN) do { const LAS unsigned char* kb__ = lds + (kb_) * KT + kro; \
        _Pragma("unroll") for (int s = 0; s < 6; ++s) { const bf16x8 ka0 = *(const LAS bf16x8*)(kb__ + 32 * s), ka1 = *(const LAS bf16x8*)(kb__ + 32 * KP + 32 * s); \
            if (s == 0) { P0 = __builtin_amdgcn_mfma_f32_32x32x16_bf16(ka0, qf[0], CIN, 0, 0, 0); P1 = __builtin_amdgcn_mfma_f32_32x32x16_bf16(ka1, qf[0], CIN, 0, 0, 0); } \
            else { P0 = __builtin_amdgcn_mfma_f32_32x32x16_bf16(ka0, qf[s], P0, 0, 0, 0); P1 = __builtin_amdgcn_mfma_f32_32x32x16_bf16(ka1, qf[s], P1, 0, 0, 0); } } } while (0)
    AT_GLOADK(A, 0); AT_GLOADV(A, 0); AT_WRITEK(A, 0); AT_WRITEV(A, 0); AT_GLOADK(A, 1); AT_WRITEK(A, 1);
    AT_GLOADK(B, 2); AT_GLOADV(B, 1);
    __syncthreads();
    f32x16 pA, pB, negm = {};
    AT_QK(pA, pB, 0, negm);
    float rm = rowmax32(pA, pB);
    mref = rm;
    f32x16 pA1 = pB;
    f32x16 pB1 = {};
#pragma unroll
    for (int r = 0; r < 16; ++r) { pA[r] -= rm; pA1[r] -= rm; negm[r] = -rm; }
    rm = 0.f;
    __syncthreads();
#define AT_STEP(C0, C1, N0, N1, t, LS, WS) do { \
        if ((t) + 3 < nt_wg) AT_GLOADK(LS, (t) + 3); \
        if ((t) + 2 < nt_wg) AT_GLOADV(LS, (t) + 2); \
        if ((t) < nt_w) { \
            if ((t) > 0 && __builtin_amdgcn_ballot_w64(rm > THR) != 0ull) {     \
                const float dl = __builtin_fmaxf(rm, 0.f), f = fexp2(-dl); mref += dl; lsum *= f; \
                _Pragma("unroll") for (int r = 0; r < 16; ++r) { C0[r] -= dl; C1[r] -= dl; o0[r] *= f; o1[r] *= f; negm[r] = -mref; } } \
            AT_QK(N0, N1, ((t) + 1) & 1, negm);                   \
            _Pragma("unroll") for (int r = 0; r < 16; ++r) { C0[r] = fexp2(C0[r]); C1[r] = fexp2(C1[r]); } \
            bf16x8 pb[4]; \
            _Pragma("unroll") for (int ks = 0; ks < 2; ++ks) { u32x4 wv, wx; \
                wv.x = cvt_pk(C0[8 * ks + 0], C0[8 * ks + 1]); wv.y = cvt_pk(C0[8 * ks + 2], C0[8 * ks + 3]); wv.z = cvt_pk(C0[8 * ks + 4], C0[8 * ks + 5]); wv.w = cvt_pk(C0[8 * ks + 6], C0[8 * ks + 7]); \
                wx.x = cvt_pk(C1[8 * ks + 0], C1[8 * ks + 1]); wx.y = cvt_pk(C1[8 * ks + 2], C1[8 * ks + 3]); wx.z = cvt_pk(C1[8 * ks + 4], C1[8 * ks + 5]); wx.w = cvt_pk(C1[8 * ks + 6], C1[8 * ks + 7]); \
                pb[ks] = __builtin_bit_cast(bf16x8, wv); pb[2 + ks] = __builtin_bit_cast(bf16x8, wx); } \
            { const LAS unsigned char* vb__ = lds + ((t) & 1) * VTB + vro; \
              _Pragma("unroll") for (int ks = 0; ks < 4; ++ks) { \
                const bf16x8 va0 = *(const LAS bf16x8*)(vb__ + 32 * ks), va1 = *(const LAS bf16x8*)(vb__ + 32 * VP + 32 * ks); \
                o0 = __builtin_amdgcn_mfma_f32_32x32x16_bf16(va0, pb[ks], o0, 0, 0, 0); o1 = __builtin_amdgcn_mfma_f32_32x32x16_bf16(va1, pb[ks], o1, 0, 0, 0); } } \
            { float sa = 0.f, sb = 0.f; \
              _Pragma("unroll") for (int r = 0; r < 16; r += 2) { sa += C0[r] + C1[r]; sb += C0[r + 1] + C1[r + 1]; } \
              lsum += sa + sb; } \
            rm = rowmax32(N0, N1); \
              \
            __builtin_amdgcn_sched_group_barrier(0x100, 5, 0);     \
            _Pragma("unroll") for (int g_ = 0; g_ < 12; ++g_) { __builtin_amdgcn_sched_group_barrier(0x008, 1, 0); __builtin_amdgcn_sched_group_barrier(0x100, 1, 0); __builtin_amdgcn_sched_group_barrier(0x402, 4, 0); } \
            _Pragma("unroll") for (int g_ = 0; g_ < 8; ++g_) { __builtin_amdgcn_sched_group_barrier(0x008, 1, 0); __builtin_amdgcn_sched_group_barrier(0x100, 1, 0); __builtin_amdgcn_sched_group_barrier(0x402, 6, 0); } \
        } \
        if ((t) + 2 < nt_wg) AT_WRITEK(WS, (t) & 1); \
        if ((t) + 1 < nt_wg) AT_WRITEV(WS, ((t) + 1) & 1); \
        __syncthreads(); \
    } while (0)
    for (int t = 0; t < nt_wg; t += 2) {
        AT_STEP(pA, pA1, pB, pB1, t, A, B);
        AT_STEP(pB, pB1, pA, pA1, t + 1, B, A);
    }
#undef AT_STEP
#undef AT_QK
#undef AT_GLOADK
#undef AT_GLOADV
#undef AT_WRITEK
#undef AT_WRITEV
    float ltot = lsum; { auto rr = __builtin_amdgcn_permlane32_swap(__float_as_uint(lsum), __float_as_uint(lsum), false, false); ltot = __uint_as_float(rr[0]) + __uint_as_float(rr[1]); }
    const float inv = 1.0f / ltot;
    bf16* yrow = Y + (size_t)mrow * D + h * 64 + 4 * hi;
#pragma unroll
    for (int i = 0; i < 4; ++i) {
        u32x2 w0, w1; w0.x = cvt_pk(o0[4 * i] * inv, o0[4 * i + 1] * inv); w0.y = cvt_pk(o0[4 * i + 2] * inv, o0[4 * i + 3] * inv);
        w1.x = cvt_pk(o1[4 * i] * inv, o1[4 * i + 1] * inv); w1.y = cvt_pk(o1[4 * i + 2] * inv, o1[4 * i + 3] * inv);
        *(u32x2*)(yrow + 8 * i) = w0; *(u32x2*)(yrow + 32 + 8 * i) = w1;
    }
}
}

namespace sgu {
constexpr int VTP = 272;
constexpr int LDS_NEED = 128 * VTP;
__device__ __forceinline__ void unit(LAS unsigned char* lds, int m0, int gh, const bf16* __restrict__ GV, const bf16* __restrict__ U, const bf16* __restrict__ WS, const float* __restrict__ ln_g, const float* __restrict__ ln_b, const float* __restrict__ sb, bf16* __restrict__ Y) {
    const int tid = opaque_tid(), lane = tid & 63, r32 = lane & 31, hi = lane >> 5, w = __builtin_amdgcn_readfirstlane(tid >> 6);
    {
        const int cg = lane & 15, rsub = lane >> 4; const bool mine = (cg >> 3) == gh; const int cl = 16 * (cg & 7);
        f32x4 gq[4], bq[4];
#pragma unroll
        for (int q = 0; q < 4; ++q) { gq[q] = *(const f32x4*)(ln_g + 16 * cg + 4 * q); bq[q] = *(const f32x4*)(ln_b + 16 * cg + 4 * q); }
#pragma unroll
        for (int it = 0; it < 4; ++it) {
            const int s = w * 16 + it * 4 + rsub; const u32x4 r0 = *(const u32x4*)(GV + (size_t)(m0 + s) * 256 + 16 * cg), r1 = *(const u32x4*)(GV + (size_t)(m0 + s) * 256 + 16 * cg + 8);
            f32x4 x[4] = {{bflo(r0.x), bfhi(r0.x), bflo(r0.y), bfhi(r0.y)}, {bflo(r0.z), bfhi(r0.z), bflo(r0.w), bfhi(r0.w)}, {bflo(r1.x), bfhi(r1.x), bflo(r1.y), bfhi(r1.y)}, {bflo(r1.z), bfhi(r1.z), bflo(r1.w), bfhi(r1.w)}};
            float sm = 0.f;
#pragma unroll
            for (int q = 0; q < 4; ++q) sm += (x[q][0] + x[q][1]) + (x[q][2] + x[q][3]);
#pragma unroll
            for (int o = 1; o < 16; o <<= 1) sm += shx(sm, lane, o);
            const float mean = sm * (1.0f / 256.0f); float sq = 0.f;
#pragma unroll
            for (int q = 0; q < 4; ++q) { x[q] = x[q] - mean; sq += (x[q][0] * x[q][0] + x[q][1] * x[q][1]) + (x[q][2] * x[q][2] + x[q][3] * x[q][3]); }
#pragma unroll
            for (int o = 1; o < 16; o <<= 1) sq += shx(sq, lane, o);
            const float rstd = __builtin_amdgcn_rsqf(sq * (1.0f / 256.0f) + 1e-5f);
            if (mine) {
#pragma unroll
                for (int q = 0; q < 4; ++q) { const f32x4 y = x[q] * rstd * gq[q] + bq[q];
#pragma unroll
                    for (int e = 0; e < 4; ++e) *(LAS bf16*)(lds + (cl + 4 * q + e) * VTP + s * 2) = (bf16)(cvt_pk(y[e], 0.f) & 0xffffu); } }
        }
    }
    __syncthreads();
    const int gl = w >> 2, g = 2 * gh + gl, T = w & 3, nks = 2 * (T + 1);
    const bf16* wrow = WS + ((size_t)g * 128 + 32 * T + r32) * 128 + 8 * hi;
    bf16x8 af[8];
#pragma unroll
    for (int ks = 0; ks < 8; ++ks) af[ks] = (ks < nks) ? *(const bf16x8*)(wrow + 16 * ks) : (bf16x8){0, 0, 0, 0, 0, 0, 0, 0};
    f32x16 acc[2] = {};
#pragma unroll
    for (int ks = 0; ks < 8; ++ks) if (ks < nks) {
#pragma unroll
        for (int cb = 0; cb < 2; ++cb) { const bf16x8 bv = *(const LAS bf16x8*)(lds + (gl * 64 + 32 * cb + r32) * VTP + (16 * ks + 8 * hi) * 2);
            acc[cb] = __builtin_amdgcn_mfma_f32_32x32x16_bf16(af[ks], bv, acc[cb], 0, 0, 0); } }
    {
        constexpr int SP = 144;
        LAS unsigned char* sc = lds + 40960 + w * (32 * SP);
        const bf16* urow = U + (size_t)(m0 + 32 * T) * 256 + g * 64; bf16* yrow = Y + (size_t)(m0 + 32 * T) * D + 512 + g * 64;
#pragma unroll
        for (int i = 0; i < 4; ++i) { const int t = i * 8 + (lane >> 3), ch = lane & 7; *(LAS u32x4*)(sc + t * SP + ch * 16) = *(const u32x4*)(urow + (size_t)t * 256 + ch * 8); }
        float bv[16];
#pragma unroll
        for (int r = 0; r < 16; ++r) bv[r] = sb[g * 128 + 32 * T + (r & 3) + 8 * (r >> 2) + 4 * hi];
        asm volatile("" ::: "memory");
#pragma unroll
        for (int cb = 0; cb < 2; ++cb)
#pragma unroll
            for (int r = 0; r < 16; ++r) { const int t = (r & 3) + 8 * (r >> 2) + 4 * hi; LAS bf16* p = (LAS bf16*)(sc + t * SP + (32 * cb + r32) * 2);
                const float y = bf2f(*p) * (acc[cb][r] + bv[r]); *p = (bf16)(cvt_pk(y, 0.f) & 0xffffu); }
        asm volatile("" ::: "memory");
#pragma unroll
        for (int i = 0; i < 4; ++i) { const int t = i * 8 + (lane >> 3), ch = lane & 7; *(u32x4*)(yrow + (size_t)t * D + ch * 8) = *(const LAS u32x4*)(sc + t * SP + ch * 16); }
    }
    __syncthreads();
}
}

namespace lru {
constexpr int XP = 528;
constexpr int AP = 132;
constexpr int OFF_A = 64 * XP, OFF_B = OFF_A + 64 * AP * 4, LDS_NEED = OFF_B + 64 * AP * 4;
__device__ __forceinline__ void local_unit(LAS unsigned char* lds, int b, int c, const bf16* ZX, const float* conv_w, const float* conv_b, const bf16* WA, const bf16* WX,
                                           const float* ba, const float* bx, const float* lam, float* HL, float* PP) {
    const int tid = opaque_tid(), lane = tid & 63, r32 = lane & 31, hi = lane >> 5, w = __builtin_amdgcn_readfirstlane(tid >> 6);
    const int m0 = b * SEQ + c * 64;
    {
        const int cp = tid & 127, tq = tid >> 7, ch = 2 * cp;
        float w0[4], w1[4];
#pragma unroll
        for (int k = 0; k < 4; ++k) { w0[k] = conv_w[k * 256 + ch]; w1[k] = conv_w[k * 256 + ch + 1]; }
        const float cb0 = conv_b[ch], cb1 = conv_b[ch + 1];
        float z0[3], z1[3];
#pragma unroll
        for (int k = 0; k < 3; ++k) { const int tt = c * 64 + tq * 16 - 3 + k; unsigned raw = 0u; if (tt >= 0) raw = *(const unsigned*)(ZX + (size_t)(b * SEQ + tt) * 256 + ch); z0[k] = bflo(raw); z1[k] = bfhi(raw); }
#pragma unroll
        for (int i = 0; i < 16; ++i) { const int t = tq * 16 + i; const unsigned raw = *(const unsigned*)(ZX + (size_t)(m0 + t) * 256 + ch); const float a0 = bflo(raw), a1 = bfhi(raw);
            const float x0 = cb0 + z0[0] * w0[0] + z0[1] * w0[1] + z0[2] * w0[2] + a0 * w0[3], x1 = cb1 + z1[0] * w1[0] + z1[1] * w1[1] + z1[2] * w1[2] + a1 * w1[3];
            *(LAS unsigned*)(lds + t * XP + ch * 2) = cvt_pk(x0, x1);
            z0[0] = z0[1]; z0[1] = z0[2]; z0[2] = a0; z1[0] = z1[1]; z1[1] = z1[2]; z1[2] = a1; }
    }
    __syncthreads();
    LAS float* A32 = (LAS float*)(lds + OFF_A); LAS float* B32 = (LAS float*)(lds + OFF_B);
    for (int half = 0; half < 2; ++half) {
        {
            const int head = 2 * half + (w >> 2), tb = (w >> 1) & 1, jb = w & 1;
            f32x16 ar = {}, ai = {};
            bf16x8 wa[4], wx[4];
#pragma unroll
            for (int ks = 0; ks < 4; ++ks) { wa[ks] = *(const bf16x8*)(WA + ((size_t)head * 64 + 32 * jb + r32) * 64 + 16 * ks + 8 * hi); wx[ks] = *(const bf16x8*)(WX + ((size_t)head * 64 + 32 * jb + r32) * 64 + 16 * ks + 8 * hi); }
#pragma unroll
            for (int ks = 0; ks < 4; ++ks) {
                const bf16x8 xa = *(const LAS bf16x8*)(lds + (32 * tb + r32) * XP + (head * 64 + 16 * ks + 8 * hi) * 2);
                ar = __builtin_amdgcn_mfma_f32_32x32x16_bf16(xa, wa[ks], ar, 0, 0, 0); ai = __builtin_amdgcn_mfma_f32_32x32x16_bf16(xa, wx[ks], ai, 0, 0, 0);
            }
            const int ch = head * 64 + 32 * jb + r32, chl = ch - 128 * half;
            const float bav = ba[ch], bxv = bx[ch], lm = lam[ch];
            const float nsp = -8.0f * (fmaxf(-lm, 0.f) + log1pf(__expf(-fabsf(lm))));
#pragma unroll
            for (int r = 0; r < 16; ++r) { const int t = 32 * tb + (r & 3) + 8 * (r >> 2) + 4 * hi;
                const float rg = sigmoidf_(ar[r] + bav), ig = sigmoidf_(ai[r] + bxv), la = rg * nsp;
                const float x2 = 2.0f * la;
                const float a = __expf(la);
                const float om = (x2 > -0.25f) ? -x2 * (1.0f + x2 * (0.5f + x2 * (0.16666667f + x2 * (0.041666668f + x2 * (0.0083333338f + x2 * 0.0013888889f))))) : 1.0f - a * a;
                const float s = sqrtf(fmaxf(om, 0.f));
                const float xc = bf2f(*(const LAS bf16*)(lds + t * XP + ch * 2));
                A32[t * AP + chl] = a; B32[t * AP + chl] = s * (ig * xc); }
        }
        __syncthreads();
        {
            const int chs = tid & 127, seg = tid >> 7; LAS float* sum = (LAS float*)(lds + LDS_NEED);
            float av[16], bv[16];
#pragma unroll
            for (int i = 0; i < 16; ++i) { av[i] = A32[(16 * seg + i) * AP + chs]; bv[i] = B32[(16 * seg + i) * AP + chs]; }
            float hh = 0.f, pp = 1.f;
#pragma unroll
            for (int i = 0; i < 16; ++i) { hh = av[i] * hh + bv[i]; pp *= av[i]; bv[i] = hh; av[i] = pp; }
            sum[(seg * 2) * 128 + chs] = hh; sum[(seg * 2 + 1) * 128 + chs] = pp;
            __syncthreads();
            float Hin = 0.f, Pin = 1.f;
#pragma unroll
            for (int s = 0; s < 3; ++s) if (s < seg) { const float hs = sum[(s * 2) * 128 + chs], ps = sum[(s * 2 + 1) * 128 + chs]; Hin = ps * Hin + hs; Pin *= ps; }
            float* hl = HL + (size_t)(m0 + 16 * seg) * 256 + 128 * half + chs; float* pq = PP + (size_t)(m0 + 16 * seg) * 256 + 128 * half + chs;
#pragma unroll
            for (int i = 0; i < 16; ++i) { hl[(size_t)i * 256] = bv[i] + av[i] * Hin; pq[(size_t)i * 256] = av[i] * Pin; }
        }
        __syncthreads();
    }
}
__device__ __forceinline__ void fix_unit(LAS unsigned char* lds, int b, int c, const float* __restrict__ HL, const float* __restrict__ PP, const bf16* __restrict__ GY, bf16* __restrict__ Y) {
    const int tid = opaque_tid(); const int m0 = b * SEQ + c * 64; LAS float* hin = (LAS float*)lds;
    {
        const int ch = tid & 255, half = tid >> 8, c0 = half ? (c >> 1) : 0, c1 = half ? c : (c >> 1);
        float h = 0.f, pa = 1.f; const float* pq = PP + (size_t)(b * SEQ + 63) * 256 + ch; const float* hq = HL + (size_t)(b * SEQ + 63) * 256 + ch;
        int cc = c0;
        for (; cc + 8 <= c1; cc += 8) { float pv[8], hv[8];
#pragma unroll
            for (int j = 0; j < 8; ++j) { pv[j] = pq[(size_t)(cc + j) * 64 * 256]; hv[j] = hq[(size_t)(cc + j) * 64 * 256]; }
#pragma unroll
            for (int j = 0; j < 8; ++j) { h = pv[j] * h + hv[j]; pa *= pv[j]; } }
        for (; cc < c1; ++cc) { const float pv = pq[(size_t)cc * 64 * 256]; h = pv * h + hq[(size_t)cc * 64 * 256]; pa *= pv; }
        if (half) { hin[256 + ch] = h; hin[512 + ch] = pa; }
        __syncthreads();
        if (!half) hin[ch] = hin[512 + ch] * h + hin[256 + ch];
    }
    __syncthreads();
#pragma unroll
    for (int k = 0; k < 8; ++k) { const int item = tid + 512 * k, t = item >> 6, cg = item & 63; const size_t mo = (size_t)(m0 + t) * 256 + 4 * cg;
        const f32x4 hl = *(const f32x4*)(HL + mo), pp = *(const f32x4*)(PP + mo), hi4 = *(const LAS f32x4*)(hin + 4 * cg); const u32x2 gy = *(const u32x2*)(GY + mo);
        const f32x4 hv = hl + pp * hi4; u32x2 o; o.x = cvt_pk(hv[0] * bflo(gy.x), hv[1] * bfhi(gy.x)); o.y = cvt_pk(hv[2] * bflo(gy.y), hv[3] * bfhi(gy.y));
        *(u32x2*)(Y + (size_t)(m0 + t) * D + 768 + 4 * cg) = o; }
    __syncthreads();
}
}

struct MoeOrder {
    static constexpr bool GATHER = false;
    const volatile LAS int* tab; int npn, G, c, lim;
    __device__ __forceinline__ bool next_tail(pg8::Unit& u) const { const int L = lim + (c >> 1); if (L >= __builtin_amdgcn_readfirstlane(tab[24]) * npn) return false; map(L, u); u.co = (c & 1) * pg8::HALF; return true; }
    __device__ __forceinline__ bool next(int i, pg8::Unit& u) const {
        const int L = i * G + c, TT = __builtin_amdgcn_readfirstlane(tab[24]); if (L >= TT * npn || L >= lim) return false;
        map(L, u); return true; }
    __device__ __forceinline__ void map(int L, pg8::Unit& u) const {
        const int ti = L / npn, pnl = L - ti * npn; int e = 0;
#pragma unroll
        for (int j = 1; j < 8; ++j) e += (ti >= tab[16 + j]) ? 1 : 0;
        e = __builtin_amdgcn_readfirstlane(e);
        const int lt = ti - __builtin_amdgcn_readfirstlane(tab[16 + e]);
        u.pm = ti; u.pn = e * npn + pnl; u.x0 = ti; u.x1 = pnl; u.x2 = e * ECAP + lt * 256; u.x3 = __builtin_amdgcn_readfirstlane(tab[32 + e]) - lt * 256; u.co = 0;
    }
    __device__ __forceinline__ int src_row(const pg8::Unit&, int) const { return 0; }
};
struct MoeGatherOrder : MoeOrder {
    static constexpr bool GATHER = true;
    const int* idx;
    __device__ __forceinline__ int src_row(const pg8::Unit& u, int r) const { return (r < u.x3) ? idx[u.x2 + r] : 0; }
};

struct RowArgs {
    const float* xin; float* X; bf16* Xb; const bf16* Ysrc; const bf16* YD;     const int* slot; const float* gatew;
    const float* gate; const float* postg;
    const float* preg; const float* sc; const float* sh;
    bf16* H; const float* router; unsigned* cursor; int* idx; int* slot_w; float* gatew_w; u64* ssq_q; u64* ssq_kv; float* rs; float* rss;
};
template <int MODE>
__device__ __forceinline__ void row_phase(LAS unsigned char* lds, const volatile LAS int* tab, int vcu, const RowArgs& a, bool need_h, bool route) {
    const int tid = opaque_tid(), lane = tid & 63, w = __builtin_amdgcn_readfirstlane(tid >> 6);
    LAS float* rt = (LAS float*)lds; LAS int* e01 = (LAS int*)(lds + 32768); LAS float* rsl = (LAS float*)(lds + 32768 + 256);
    if (route) { for (int i = tid; i < 8192; i += 512) rt[(i & 7) * 1024 + (i >> 3)] = a.router[i]; __syncthreads(); }
    f32x4 cg[4], cb[4], cs[4];
#pragma unroll
#define RC(j) (512 * ((j) >> 1) + 8 * lane + 4 * ((j) & 1))
    for (int j = 0; j < 4; ++j) { const int col = RC(j);
        if (MODE != 0) cg[j] = *(const f32x4*)(a.gate + col) * *(const f32x4*)(a.postg + col);
        if (need_h) { cb[j] = *(const f32x4*)(a.preg + col) * (*(const f32x4*)(a.sc + col) + 1.0f); cs[j] = *(const f32x4*)(a.sh + col); } }
    const int row0 = vcu * 64 + w * 8;
    int slotv0 = 0, slotv1 = 0; float gv0 = 0.f, gv1 = 0.f;
    if (MODE == 3) { const int rr = row0 + (lane & 7); slotv0 = a.slot[rr * 2]; slotv1 = a.slot[rr * 2 + 1]; gv0 = a.gatew[rr * 2]; gv1 = a.gatew[rr * 2 + 1]; }
    f32x4 nx0[2][4]; u32x4 nxb[2][2], nyp[2][2], nyq[2][2];
#define ROW_LOAD(S, rw, ii) do { \
        if (MODE == 0) { _Pragma("unroll") for (int j = 0; j < 4; ++j) nx0[S][j] = __builtin_nontemporal_load((const f32x4*)(a.xin + (size_t)(rw) * D + RC(j))); } \
        else { _Pragma("unroll") for (int jj = 0; jj < 2; ++jj) nxb[S][jj] = __builtin_nontemporal_load((const u32x4*)(a.Xb + (size_t)(rw) * D + 512 * jj + 8 * lane)); } \
        if (MODE == 3) { const int s0_ = __builtin_amdgcn_readlane(slotv0, (ii)), s1_ = __builtin_amdgcn_readlane(slotv1, (ii)); \
            const size_t r0_ = (size_t)tab[16 + (s0_ >> 14)] * 256 + (s0_ & (ECAP - 1)), r1_ = (size_t)tab[16 + (s1_ >> 14)] * 256 + (s1_ & (ECAP - 1)); \
            _Pragma("unroll") for (int jj = 0; jj < 2; ++jj) { nyp[S][jj] = __builtin_nontemporal_load((const u32x4*)(a.YD + r0_ * D + 512 * jj + 8 * lane)); nyq[S][jj] = __builtin_nontemporal_load((const u32x4*)(a.YD + r1_ * D + 512 * jj + 8 * lane)); } } \
        else if (MODE != 0) { _Pragma("unroll") for (int jj = 0; jj < 2; ++jj) nyp[S][jj] = __builtin_nontemporal_load((const u32x4*)(a.Ysrc + (size_t)(rw) * D + 512 * jj + 8 * lane)); } } while (0)
    float my_rs = 0.f, my_g0 = 0.f, my_g1 = 0.f; int my_pk = 0;
    ROW_LOAD(0, row0, 0); ROW_LOAD(1, row0 + 1, 1);
#pragma unroll
    for (int i = 0; i < 8; ++i) {
        const int row = row0 + i; constexpr int dummy_ = 0; (void)dummy_;
        f32x4 x[4]; u32x2 yp[4], yq[4];
#pragma unroll
        for (int jj = 0; jj < 2; ++jj) {
            if (MODE == 0) { x[2 * jj] = nx0[i & 1][2 * jj]; x[2 * jj + 1] = nx0[i & 1][2 * jj + 1]; }
            else { const u32x4 q_ = nxb[i & 1][jj]; x[2 * jj] = (f32x4){bflo(q_.x), bfhi(q_.x), bflo(q_.y), bfhi(q_.y)}; x[2 * jj + 1] = (f32x4){bflo(q_.z), bfhi(q_.z), bflo(q_.w), bfhi(q_.w)}; }
            yp[2 * jj] = (u32x2){nyp[i & 1][jj].x, nyp[i & 1][jj].y}; yp[2 * jj + 1] = (u32x2){nyp[i & 1][jj].z, nyp[i & 1][jj].w}; yq[2 * jj] = (u32x2){nyq[i & 1][jj].x, nyq[i & 1][jj].y}; yq[2 * jj + 1] = (u32x2){nyq[i & 1][jj].z, nyq[i & 1][jj].w}; }
        if (i + 2 < 8) { if (i & 1) ROW_LOAD(1, row + 2, i + 2); else ROW_LOAD(0, row + 2, i + 2); }
        if (MODE != 0) {
            f32x4 y[4];
            if (MODE == 3) {
                const float g0 = __builtin_bit_cast(float, __builtin_amdgcn_readlane(__builtin_bit_cast(int, gv0), i)), g1 = __builtin_bit_cast(float, __builtin_amdgcn_readlane(__builtin_bit_cast(int, gv1), i));
#pragma unroll
                for (int j = 0; j < 4; ++j) y[j] = (f32x4){bflo(yp[j].x), bfhi(yp[j].x), bflo(yp[j].y), bfhi(yp[j].y)} * g0 + (f32x4){bflo(yq[j].x), bfhi(yq[j].x), bflo(yq[j].y), bfhi(yq[j].y)} * g1;
            } else {
#pragma unroll
                for (int j = 0; j < 4; ++j) y[j] = (f32x4){bflo(yp[j].x), bfhi(yp[j].x), bflo(yp[j].y), bfhi(yp[j].y)};
            }
            float ss = 0.f;
#pragma unroll
            for (int j = 0; j < 4; ++j) ss += (y[j][0] * y[j][0] + y[j][1] * y[j][1]) + (y[j][2] * y[j][2] + y[j][3] * y[j][3]);
            const float r = __builtin_amdgcn_rsqf(wave_sum_dpp(ss) * (1.0f / D) + 1e-6f);
#pragma unroll
            for (int j = 0; j < 4; ++j) x[j] = x[j] + cg[j] * (y[j] * r);
        }
        if (a.X) {
#pragma unroll
            for (int j = 0; j < 4; ++j) *(f32x4*)(a.X + (size_t)row * D + RC(j)) = x[j];
        } else {
#pragma unroll
            for (int jj = 0; jj < 2; ++jj) __builtin_nontemporal_store(pg8::pack8(x[2 * jj], x[2 * jj + 1]), (u32x4*)(a.Xb + (size_t)row * D + 512 * jj + 8 * lane)); }
        if (need_h) {
            float ss = 0.f;
#pragma unroll
            for (int j = 0; j < 4; ++j) ss += (x[j][0] * x[j][0] + x[j][1] * x[j][1]) + (x[j][2] * x[j][2] + x[j][3] * x[j][3]);
            const float r = __builtin_amdgcn_rsqf(wave_sum_dpp(ss) * (1.0f / D) + 1e-6f);
            f32x4 hv[4];
#pragma unroll
            for (int j = 0; j < 4; ++j) hv[j] = (x[j] * r) * cb[j] + cs[j];
            float qinv = 0.f;
            {
                float am = 0.f;
#pragma unroll
                for (int j = 0; j < 4; ++j) am = __builtin_fmaxf(am, __builtin_fmaxf(__builtin_fmaxf(__builtin_fabsf(hv[j][0]), __builtin_fabsf(hv[j][1])), __builtin_fmaxf(__builtin_fabsf(hv[j][2]), __builtin_fabsf(hv[j][3]))));
                am = __builtin_fmaxf(wave_max_dpp(am), 1e-30f); qinv = 127.0f / am;
                { const float s = am * (1.0f / 127.0f); if (lane == i) my_rs = s; } }
#pragma unroll
            for (int jj = 0; jj < 2; ++jj) {
                u32x2 o; o.x = pg8::pk4_i8(hv[2 * jj] * qinv); o.y = pg8::pk4_i8(hv[2 * jj + 1] * qinv); *(u32x2*)((unsigned char*)a.H + (size_t)row * D + 512 * jj + 8 * lane) = o; }
            if (route) {
                float pe[8];
#pragma unroll
                for (int e = 0; e < 8; ++e) { float p = 0.f;
#pragma unroll
                    for (int j = 0; j < 4; ++j) { const f32x4 rv = *(const LAS f32x4*)(rt + e * 1024 + RC(j)); p += (hv[j][0] * rv[0] + hv[j][1] * rv[1]) + (hv[j][2] * rv[2] + hv[j][3] * rv[3]); }
                    pe[e] = p; }
                float q4[4], q2[2], q1;
                { const bool up = (lane & 32) != 0;
#pragma unroll
                  for (int j = 0; j < 4; ++j) { const float keep = up ? pe[4 + j] : pe[j], give = up ? pe[j] : pe[4 + j]; q4[j] = keep + shx(give, lane, 32); } }
                { const bool up = (lane & 16) != 0;
#pragma unroll
                  for (int j = 0; j < 2; ++j) { const float keep = up ? q4[2 + j] : q4[j], give = up ? q4[j] : q4[2 + j]; q2[j] = keep + shx(give, lane, 16); } }
                { const bool up = (lane & 8) != 0; const float keep = up ? q2[1] : q2[0], give = up ? q2[0] : q2[1]; q1 = keep + shx(give, lane, 8); }
                q1 += shx(q1, lane, 4); q1 += shx(q1, lane, 2); q1 += shx(q1, lane, 1);
                float lg[8];
#pragma unroll
                for (int e = 0; e < 8; ++e) lg[e] = __builtin_bit_cast(float, __builtin_amdgcn_readlane(__builtin_bit_cast(int, q1), 8 * e));
                int e0 = 0; float v0 = lg[0];
#pragma unroll
                for (int e = 1; e < 8; ++e) if (lg[e] > v0) { v0 = lg[e]; e0 = e; }
                int e1 = -1; float v1 = -3.0e38f;
#pragma unroll
                for (int e = 0; e < 8; ++e) if (e != e0 && lg[e] > v1) { v1 = lg[e]; e1 = e; }
                const float g0 = 1.0f / (1.0f + __expf(v1 - v0)), g1 = 1.0f - g0;
                if (lane == i) { my_pk = e0 | (e1 << 8); my_g0 = g0; my_g1 = g1; }
            }
        }
        asm volatile("" ::: "memory");
    }
    if (lane < 8) {
        if (need_h) a.rs[row0 + lane] = my_rs;
        if (MODE == 1) { a.ssq_q[row0 + lane] = 0ull; a.ssq_kv[row0 + lane] = 0ull; }
        if (route) { rsl[w * 8 + lane] = my_rs; e01[w * 8 + lane] = my_pk; a.gatew_w[(row0 + lane) * 2] = my_g0; a.gatew_w[(row0 + lane) * 2 + 1] = my_g1; } }
    if (route) {
        __syncthreads();
        if (w == 0) {
            const int pk = e01[lane], e0 = pk & 255, e1 = pk >> 8, token = vcu * 64 + lane; const u64 lt = (1ull << lane) - 1ull;
            int p0 = 0, p1 = 0, mycnt = 0;
#pragma unroll
            for (int e = 0; e < 8; ++e) {
                const u64 m0 = __ballot(e0 == e), m1 = __ballot(e1 == e); const int c0 = __popcll(m0), c1 = __popcll(m1);
                if (lane == e) mycnt = c0 + c1;
                if (e0 == e) p0 = __popcll(m0 & lt);
                if (e1 == e) p1 = c0 + __popcll(m1 & lt);
            }
            unsigned mybase = 0u; if (lane < 8 && mycnt > 0) mybase = atomicAdd(a.cursor + lane, (unsigned)mycnt);
#pragma unroll
            for (int e = 0; e < 8; ++e) { const int base = __builtin_amdgcn_readlane((int)mybase, e); if (e0 == e) p0 += base; if (e1 == e) p1 += base; }
            a.idx[e0 * ECAP + p0] = token; a.idx[e1 * ECAP + p1] = token;
            a.slot_w[token * 2] = e0 * ECAP + p0; a.slot_w[token * 2 + 1] = e1 * ECAP + p1;
            { const float s = rsl[lane]; a.rss[e0 * ECAP + p0] = s; a.rss[e1 * ECAP + p1] = s; }
        }
        __syncthreads();
    }
}

__device__ __forceinline__ int rperm(int jj) { return 8 * ((jj & 15) >> 2) + 4 * (jj >> 4) + (jj & 3); }
__device__ __forceinline__ int map_row(int kind, int n) {
    if (kind == 1) return 256 * (n >> 7) + (n & 127);
    if (kind == 2) return 256 * (n >> 7) + 128 + (n & 127);
    if (kind == 3) return n < 384 ? n : (n < 416 ? 384 + rperm(n - 384) : n + 96);
    if (kind == 4) { const int h = n / 96, j = n - 96 * h; return j < 64 ? n : h * 96 + 64 + rperm(j - 64); }
    return n;
}
template <bool F8 = false>
__device__ __forceinline__ void tr_item(const float* W, int ldn, void* WTv, int ldk, const float* gain, int kind, LAS float* scr, int kb, int nb, int lane) {
    const int k0 = 64 * kb, n0 = 32 * nb;
#pragma unroll
    for (int i = 0; i < 32; ++i) { const int kk = 2 * i + (lane >> 5); float v = __builtin_nontemporal_load(W + (size_t)(k0 + kk) * ldn + n0 + (lane & 31)); if (gain) v *= gain[k0 + kk]; scr[kk * 33 + (lane & 31)] = v; }
    LDS_WAIT(); asm volatile("" ::: "memory");
    const int c = lane & 7;
#pragma unroll
    for (int j = 0; j < 4; ++j) { const int n = (lane >> 3) + 8 * j; const LAS float* s = scr + (8 * c) * 33 + n;
        if constexpr (F8) { u32x2 o; o.x = pg8::pk4_fp8((f32x4){s[0 * 33], s[1 * 33], s[2 * 33], s[3 * 33]} * pg8::F8_WSC); o.y = pg8::pk4_fp8((f32x4){s[4 * 33], s[5 * 33], s[6 * 33], s[7 * 33]} * pg8::F8_WSC);
            *(u32x2*)((unsigned char*)WTv + (size_t)map_row(kind, n0 + n) * ldk + k0 + 8 * c) = o; }
        else { bf16* WT = (bf16*)WTv; u32x4 o; o.x = cvt_pk(s[0 * 33], s[1 * 33]); o.y = cvt_pk(s[2 * 33], s[3 * 33]); o.z = cvt_pk(s[4 * 33], s[5 * 33]); o.w = cvt_pk(s[6 * 33], s[7 * 33]);
            *(u32x4*)(WT + (size_t)map_row(kind, n0 + n) * ldk + k0 + 8 * c) = o; } }
    LDS_WAIT(); asm volatile("" ::: "memory");
}
__device__ __forceinline__ void colq_item(const float* W, int ldn, unsigned char* WT, float* CS, int kind, int nb, LAS float* red, int tid) {
    const int lane = tid & 63, w = tid >> 6, n = lane & 31, kh = lane >> 5, kb = 128 * w + 64 * kh;
    const float* src = W + (size_t)kb * ldn + nb * 32 + n;
    float v[64];
#pragma unroll
    for (int j = 0; j < 64; ++j) v[j] = __builtin_nontemporal_load(src + (size_t)j * ldn);
    float m = 0.f;
#pragma unroll
    for (int j = 0; j < 64; ++j) m = __builtin_fmaxf(m, __builtin_fabsf(v[j]));
    m = __builtin_fmaxf(m, shx(m, lane, 32));
    if (kh == 0) red[w * 32 + n] = m;
    __syncthreads();
    float cm = red[n];
#pragma unroll
    for (int ww = 1; ww < 8; ++ww) cm = __builtin_fmaxf(cm, red[ww * 32 + n]);
    cm = __builtin_fmaxf(cm, 1e-30f);
    const float inv = 127.0f / cm; const int row = map_row(kind, nb * 32 + n);
    if (w == 0 && kh == 0) CS[row] = cm * (1.0f / 127.0f);
    unsigned char* dst = WT + (size_t)row * 1024 + kb;
#pragma unroll
    for (int c = 0; c < 4; ++c) { u32x4 o;
        o.x = pg8::pk4_i8((f32x4){v[16 * c + 0], v[16 * c + 1], v[16 * c + 2], v[16 * c + 3]} * inv); o.y = pg8::pk4_i8((f32x4){v[16 * c + 4], v[16 * c + 5], v[16 * c + 6], v[16 * c + 7]} * inv);
        o.z = pg8::pk4_i8((f32x4){v[16 * c + 8], v[16 * c + 9], v[16 * c + 10], v[16 * c + 11]} * inv); o.w = pg8::pk4_i8((f32x4){v[16 * c + 12], v[16 * c + 13], v[16 * c + 14], v[16 * c + 15]} * inv);
        *(u32x4*)(dst + 16 * c) = o; }
    __syncthreads();
}
__device__ __forceinline__ void sincos_acc(float ang, float& s, float& c) {
    const double a = (double)ang; const double kq = __builtin_rint(a * 0.63661977236758134308); const double r = (a - kq * 1.57079632679489655800e+00) - kq * 6.12323399573676603587e-17;
    const float x = (float)r, x2 = x * x;
    const float sp = x + x * x2 * (-1.6666667163e-01f + x2 * (8.3333337680e-03f + x2 * (-1.9841270114e-04f + x2 * 2.7557314297e-06f)));
    const float cp = 1.0f + x2 * (-0.5f + x2 * (4.1666667908e-02f + x2 * (-1.3888889225e-03f + x2 * (2.4801587642e-05f + x2 * -2.7557314297e-07f))));
    const int q = ((int)kq) & 3;
    s = (q == 0) ? sp : (q == 1) ? cp : (q == 2) ? -sp : -cp;
    c = (q == 0) ? cp : (q == 1) ? -sp : (q == 2) ? -cp : sp;
}

struct Args { const float* in[32]; float* out; unsigned char* ws; };
enum { I_X = 0, I_C, I_WMOD, I_BMOD, I_PREMIX, I_POSTMIX, I_WIN, I_QNG, I_WUQ, I_KVNG, I_WUKV, I_SGLNG, I_SGLNB, I_SGW, I_SGB, I_CONVW, I_CONVB, I_LWA, I_LBA, I_LWX, I_LBX, I_LAM,
       I_WO, I_PREFFN, I_POSTFFN, I_FG, I_FU, I_FD, I_ROUTER, I_MG, I_MU, I_MD };

#define WSL GAS unsigned char* wslg_ = (GAS unsigned char*)args.ws; int zi_ = 0, bxo = bx_, vcuo = vcu_, Go = G_; asm volatile("" : "+s"(wslg_), "+s"(zi_), "+s"(bxo), "+s"(vcuo), "+s"(Go)); unsigned char* wsl = (unsigned char*)wslg_
#define AIN(i) ((const float*)(GAS const float*)args.in[(i) + zi_])
#define W_ctl ((unsigned*)(wsl + WS_CTL))
#define W_MOD ((float*)(wsl + WS_MOD))
#define W_cosT ((float*)(wsl + WS_COS))
#define W_sinT ((float*)(wsl + WS_SIN))
#define W_ssq_q ((u64*)(wsl + WS_SSQQ))
#define W_ssq_kv ((u64*)(wsl + WS_SSQK))
#define W_IDX ((int*)(wsl + WS_IDX))
#define W_SLOT ((int*)(wsl + WS_SLOT))
#define W_GATEW ((float*)(wsl + WS_GATEW))
#define W_WB ((bf16*)(wsl + WS_W))
#define W_H ((bf16*)(wsl + WS_H))
#define W_YO ((bf16*)(wsl + WS_YO))
#define W_ZQ ((bf16*)(wsl + WS_ZQ))
#define W_ZKV ((bf16*)(wsl + WS_ZKV))
#define W_KR ((bf16*)(wsl + WS_KR))
#define W_U ((bf16*)(wsl + WS_U))
#define W_GV ((bf16*)(wsl + WS_GV))
#define W_ZX ((bf16*)(wsl + WS_ZX))
#define W_GY ((bf16*)(wsl + WS_GY))
#define W_Q ((bf16*)(wsl + WS_Q))
#define W_KN ((bf16*)(wsl + WS_KN))
#define W_VT ((bf16*)(wsl + WS_VT))
#define W_Y ((bf16*)(wsl + WS_Y))
#define W_HL ((float*)(wsl + WS_HL))
#define W_PP ((float*)(wsl + WS_PP))
#define W_ACT ((bf16*)(wsl + WS_ACT))
#define W_YD ((bf16*)(wsl + WS_YD))
#define W_DW8(i) ((unsigned char*)(W_WB + WOFF_DENSE + (size_t)(i) * DW_SIZE))
#define W_MW8(i) ((unsigned char*)(W_WB + WOFF_MOE + (size_t)(i) * MW_SIZE))
#define W_ACT8 ((unsigned char*)(wsl + WS_ACT))
#define W_ACT8D ((unsigned char*)(wsl + WS_ACTD))
#define W_X ((float*)(GAS float*)args.out)
#define W_XB ((bf16*)(wsl + WS_YO + 32 * MiB))
__global__ void __launch_bounds__(512, 2) trunk_fwd(Args args) {
    extern __shared__ __attribute__((aligned(16))) unsigned char lds_raw[];
    LAS unsigned char* lds = (LAS unsigned char*)lds_raw;
    volatile LAS unsigned* MISC = (volatile LAS unsigned*)(lds + MISC_OFF);
    const volatile LAS int* tab = (const volatile LAS int*)(lds + MISC_OFF);
    const int wave = __builtin_amdgcn_readfirstlane(threadIdx.x >> 6);
    constexpr int G_ = 256;
    if (gridDim.x != G_) return;
    const int bx_ = blockIdx.x, vcu_ = (bx_ % 8) * (G_ / 8) + bx_ / 8;
    for (int u = threadIdx.x; u < (LDS_BYTES - MISC_OFF) / 4; u += 512) MISC[u] = 0u;
    __syncthreads();
    { WSL; (void)xcd_barrier_post(W_ctl, MISC); }
    { WSL; if (opaque_tid() == 0 && bx_ < 8) __hip_atomic_store(W_ctl + 6000 + bx_, xb_xcc_id() + 1u, __ATOMIC_RELAXED, __HIP_MEMORY_SCOPE_AGENT); }
#define GRID_BAR() do { WSL; XcdBarrier b_; b_.bar = W_ctl; b_.x = xb_xcc_id(); b_.st = MISC; xcd_barrier(b_); } while (0)
#define GRID_BAR_P() do { WSL; XcdBarrier b_; b_.bar = W_ctl; b_.x = xb_xcc_id(); b_.st = MISC; if (MISC[9]) xcd_pair_barrier(b_, (unsigned)((bx_ & 7) >> 1)); else xcd_barrier(b_); } while (0)
#define GRID_BAR_L() do { WSL; XcdBarrier b_; b_.bar = W_ctl; b_.x = xb_xcc_id(); b_.st = MISC; if (MISC[8]) xcd_local_barrier(b_); else xcd_barrier(b_); } while (0)

    {
        WSL; const int tid = opaque_tid(), lane = tid & 63;
        LAS float* scr = (LAS float*)(lds + wave * 8448);
        const int gw = vcuo * 8 + wave, NGW = Go * 8;
        constexpr int N0 = 4 * 720, N1 = 4 * 96, N2 = 4 * 64, N3 = 4 * 512, N4 = 2 * 1408, N7 = 16 * 704;
        constexpr int NITEMS = N1 + N2 + N3 + N4 + N7;
        { LAS float* red = (LAS float*)(lds + 102400);
          for (int it = vcuo; it < 352 + 1408 + 180; it += Go) {
              if (it >= 352 + 1408) { const int r = it - 1760, l = r / 45, nb = r % 45; unsigned char* wt = (unsigned char*)(W_WB + l * LW_SIZE + LW_WIN);
                  colq_item(AIN(I_WIN) + (size_t)l * D * DIN, DIN, wt, (float*)(wt + (size_t)DINP * D), 3, nb, red, tid); }
              else if (it < 352) { const int i = it / 176, r = it % 176, kind = 1 + r / 88, nb = r % 88;
                  colq_item(AIN(kind == 1 ? I_FG : I_FU) + (size_t)i * D * DFF, DFF, W_DW8(i) + DW8_GU, (float*)(W_DW8(i) + DW8_CS), kind, nb, red, tid); }
              else { const int r = it - 352, ie = r / 88, q = r % 88, kind = 1 + q / 44, nb = q % 44;
                  colq_item(AIN(kind == 1 ? I_MG : I_MU) + (size_t)ie * D * DFE, DFE, W_MW8(ie >> 3) + MW8_GU + (size_t)(ie & 7) * 2 * DFE * D, (float*)(W_MW8(ie >> 3) + MW8_CS) + (ie & 7) * 2 * DFE, kind, nb, red, tid); } } }
        for (int it = gw; it < NITEMS; it += NGW) {
            int r = it;
            if (r < N1) { const int l = r / 96, q = r % 96; tr_item(AIN(I_WUQ) + (size_t)l * 256 * 768, 768, W_WB + l * LW_SIZE + LW_WUQ, 256, AIN(I_QNG) + l * 256, 4, scr, q / 24, q % 24, lane); continue; } r -= N1;
            if (r < N2) { const int l = r / 64, q = r % 64, kb = q / 32, nb = q % 32;
                const bool isv = ((nb & 3) >= 2); bf16* dst = W_WB + l * LW_SIZE + (isv ? LW_WUV : LW_WUK) + (size_t)((nb >> 2) * 64 + (nb & 1) * 32) * 256;
                tr_item(AIN(I_WUKV) + (size_t)l * 128 * 1024 + nb * 32, 1024, dst, 256, AIN(I_KVNG) + l * 128, 0, scr, kb, 0, lane); continue; } r -= N2;
            if (r < N3) { const int l = r / 512, q = r % 512; tr_item(AIN(I_WO) + (size_t)l * D * D, D, W_WB + l * LW_SIZE + LW_WO, D, nullptr, 0, scr, q / 32, q % 32, lane); continue; } r -= N3;
            if (r < N4) { const int i = r / 1408, q = r % 1408; tr_item<true>(AIN(I_FD) + (size_t)i * DFF * D, D, W_DW8(i) + DW8_D, DFF, nullptr, 0, scr, q / 32, q % 32, lane); continue; } r -= N4;
            { const int ie = r / 704, q = r % 704, i = ie >> 3, e = ie & 7; tr_item<true>(AIN(I_MD) + (size_t)ie * DFE * D, D, W_MW8(i) + MW8_D + (size_t)e * D * DFEP, DFEP, nullptr, 0, scr, q / 32, q % 32, lane); }
        }
        const int gt = vcuo * 512 + tid, NGT = Go * 512;
        for (int i = gt; i < 4 * 96 * 64; i += NGT) {
            const int l = i / (96 * 64), q = i % (96 * 64); unsigned char* wt = (unsigned char*)(W_WB + l * LW_SIZE + LW_WIN);
            *(u32x4*)(wt + (size_t)(416 + q / 64) * D + (q % 64) * 16) = (u32x4){0u, 0u, 0u, 0u}; if ((q % 64) == 0) ((float*)(wt + (size_t)DINP * D))[416 + q / 64] = 0.f; }
        for (int i = gt; i < 4 * 2 * 512 * 16; i += NGT) {
            const int l = i / (2 * 512 * 16), q = i % (2 * 512 * 16), mtx = q / (512 * 16), rr = (q / 16) % 512, ch = q % 16;
            *(u32x4*)(W_WB + l * LW_SIZE + (mtx ? LW_WUV : LW_WUK) + (size_t)rr * 256 + 128 + ch * 8) = (u32x4){0u, 0u, 0u, 0u}; }
        for (int i = gt; i < 2 * NE * D * 8; i += NGT) {
            const int ie = i / (D * 8), q = i % (D * 8); *(u32x4*)(W_MW8(ie >> 3) + MW8_D + ((size_t)(ie & 7) * D + (q >> 3)) * DFEP + DFE + (q & 7) * 16) = (u32x4){0u, 0u, 0u, 0u}; }
        for (int i = gt; i < 4 * 4 * 128 * 128; i += NGT) {
            const int l = i / 65536, q = i % 65536, t = (q >> 7) & 127, s = q & 127; const float v = (s <= t) ? AIN(I_SGW)[i] : 0.f;
            W_WB[l * LW_SIZE + LW_SGW + q] = (bf16)(cvt_pk(v, 0.f) & 0xffffu); }
        for (int i = gt; i < 4 * 2 * 4 * 64 * 64; i += NGT) {
            const int l = i / 32768, q = i % 32768, mtx = q / 16384, hq = (q / 4096) & 3, j = (q >> 6) & 63, ii = q & 63;
            const float v = AIN(mtx ? I_LWX : I_LWA)[(size_t)l * 16384 + hq * 4096 + ii * 64 + j];
            W_WB[l * LW_SIZE + (mtx ? LW_LWX : LW_LWA) + hq * 4096 + j * 64 + ii] = (bf16)(cvt_pk(v, 0.f) & 0xffffu); }
        for (int i = gt; i < SEQ * 16; i += NGT) {
            const int pos = i >> 4, j = i & 15; const float inv = exp2f(-(float)j * (13.287712379549449f / 16.0f)); float s, c; sincos_acc((float)pos * inv, s, c); W_cosT[i] = c; W_sinT[i] = s; }
        __syncthreads();
        LAS float* cond = (LAS float*)(lds + 69632); LAS float* red = (LAS float*)(lds + 69632 + 16384);
        for (int i = tid; i < NB * D; i += 512) cond[i] = siluf_(AIN(I_C)[i]);
        __syncthreads();
        for (int item = vcuo; item < 4 * 96; item += Go) {
            const int l = item / 96, c0 = (item % 96) * 64; const float* Wm = AIN(I_WMOD) + (size_t)l * D * 6144 + c0 + lane;
            float a0 = 0.f, a1 = 0.f, a2 = 0.f, a3 = 0.f;
#pragma unroll 16
            for (int k = wave * 128; k < wave * 128 + 128; ++k) { const float wv = __builtin_nontemporal_load(Wm + (size_t)k * 6144); a0 += cond[k] * wv; a1 += cond[D + k] * wv; a2 += cond[2 * D + k] * wv; a3 += cond[3 * D + k] * wv; }
            red[(wave * 4 + 0) * 64 + lane] = a0; red[(wave * 4 + 1) * 64 + lane] = a1; red[(wave * 4 + 2) * 64 + lane] = a2; red[(wave * 4 + 3) * 64 + lane] = a3;
            __syncthreads();
            if (tid < 256) { const int b = tid >> 6, col = tid & 63; float s = AIN(I_BMOD)[l * 6144 + c0 + col];
#pragma unroll
                for (int ww = 0; ww < 8; ++ww) s += red[(ww * 4 + b) * 64 + col];
                W_MOD[(size_t)(l * 4 + b) * 6144 + c0 + col] = s; }
            __syncthreads();
        }
    }
    { WSL; if (opaque_tid() == 0) { unsigned gx; XB_SPIN((gx = xb_ld(W_ctl + 6000 + (bx_ & 7))) == 0u, W_ctl); if (gx != xb_xcc_id() + 1u) atomicOr(W_ctl + 6016, 1u); } }
    GRID_BAR();
    { WSL; if (opaque_tid() == 0) { const unsigned ok = (xb_ld(W_ctl + 6016) == 0u) ? 1u : 0u; unsigned pok = 1u;
#pragma unroll
        for (unsigned j = 0; j < 16; ++j) { const unsigned c = xb_ld(W_ctl + XB_XCNT(j)); if (c != 0u && c != 32u) pok = 0u; }
        MISC[8] = ok; MISC[9] = ok & pok; } } __syncthreads();
    {
        WSL; const int tid = opaque_tid();
        const int b = vcuo >> 6; const float* md = W_MOD + (size_t)(0 * 4 + b) * 6144;
        RowArgs ra{}; ra.xin = AIN(I_X); ra.X = nullptr; ra.Xb = W_XB; ra.preg = AIN(I_PREMIX); ra.sc = md + 1024; ra.sh = md; ra.H = W_H; ra.ssq_q = W_ssq_q; ra.ssq_kv = W_ssq_kv; ra.rs = (float*)(W_DW8(0) + DW8_RS);
        row_phase<0>(lds, tab, vcuo, ra, true, false);
        if (tid < 64) { W_ssq_q[vcuo * 64 + tid] = 0ull; W_ssq_kv[vcuo * 64 + tid] = 0ull; }
    }
    GRID_BAR_L();


    { constexpr int l = 0;

        const bool moe = (l & 1) != 0; const int fi = l >> 1;
#define LW (W_WB + (size_t)l * LW_SIZE)
#define md (W_MOD + (size_t)(l * 4 + (vcuo >> 6)) * 6144)
        { WSL; pg8::Gemm g{W_H, LW + LW_WIN, D}; pg8::StaticOrder S; S.init(M, DINP, Go, bxo); S.lim = (S.nwg / Go) * Go;
          pg8::EpiIn E{wsl, (const float*)(W_DW8(0) + DW8_RS), (const float*)((unsigned char*)(LW + LW_WIN) + (size_t)DINP * D)};
          pg8::gemm_phase<pg8::EpiIn, pg8::StaticOrder, true, 2, 2>(lds, g, S, E);
          pg8::TailOrder<pg8::StaticOrder> T{S};
          pg8::gemm_phase<pg8::EpiIn, pg8::TailOrder<pg8::StaticOrder>, false, 1, 2>(lds, g, T, E); }
        if (l == 2) GRID_BAR(); else GRID_BAR_L();
        { WSL; pg8::Gemm g{W_ZQ, LW + LW_WUQ, 256}; pg8::StaticOrder S; S.init(M, 768, Go, bxo); pg8::EpiQ E{wsl};
          pg8::gemm_phase<pg8::EpiQ, pg8::StaticOrder, true>(lds, g, S, E); }
        { WSL; pg8::Gemm g{W_ZKV, LW + LW_WUK, 128, 256};     pg8::StaticOrder S; S.init(M, 512, Go, (bxo + 64) % Go); pg8::EpiK E{wsl};
          pg8::gemm_phase<pg8::EpiK, pg8::StaticOrder, true>(lds, g, S, E); }
        { WSL; pg8::Gemm g{LW + LW_WUV, W_ZKV, 128, 256}; pg8::StaticOrder S; S.init(512, M, Go, (bxo + 192) % Go); pg8::EpiVT E{wsl};
          pg8::gemm_phase<pg8::EpiVT, pg8::StaticOrder, true>(lds, g, S, E); }
        { WSL; for (int uu = vcuo; uu < 256; uu += Go) {
            sgu::unit(lds, (uu >> 1) * 128, uu & 1, W_GV, W_U, LW + LW_SGW, AIN(I_SGLNG) + l * 256, AIN(I_SGLNB) + l * 256, AIN(I_SGB) + l * 512, W_Y); } }
        { WSL; for (int uu = vcuo; uu < 256; uu += Go) {
            lru::local_unit(lds, uu >> 6, uu & 63, W_ZX, AIN(I_CONVW) + l * 1024, AIN(I_CONVB) + l * 256, LW + LW_LWA, LW + LW_LWX,
                            AIN(I_LBA) + l * 256, AIN(I_LBX) + l * 256, AIN(I_LAM) + l * 256, W_HL, W_PP); } }
        GRID_BAR_P();
        { WSL; for (int uu = vcuo; uu < 256; uu += Go) { lru::fix_unit(lds, uu >> 6, uu & 63, W_HL, W_PP, W_GY, W_Y); } }
        { WSL; for (int uu = vcuo; uu < 256; uu += Go) { const int bh = uu >> 3, s = uu & 7;
            att::attn_unit(lds, bh >> 3, bh & 7, 15 - s, W_Q, W_KN, W_KR, W_VT, W_Y);
            att::attn_unit(lds, bh >> 3, bh & 7, s, W_Q, W_KN, W_KR, W_VT, W_Y); } }
        GRID_BAR_P();
        { WSL; pg8::Gemm g{W_Y, LW + LW_WO, D}; pg8::StaticOrder S; S.init(M, D, Go, bxo); pg8::EpiBf E{W_YO, D};
          pg8::gemm_phase<pg8::EpiBf, pg8::StaticOrder, false>(lds, g, S, E); }
        GRID_BAR_L();
        { WSL; RowArgs ra{}; ra.X = nullptr; ra.Xb = W_XB; ra.Ysrc = W_YO; ra.gate = md + 2048; ra.postg = AIN(I_POSTMIX) + l * D; ra.preg = AIN(I_PREFFN) + l * D; ra.sc = md + 4096; ra.sh = md + 3072; ra.H = W_H;
          ra.router = AIN(I_ROUTER) + (size_t)fi * D * NE; ra.cursor = W_ctl + CW_CURSOR + 64 * fi; ra.idx = W_IDX; ra.slot_w = W_SLOT; ra.gatew_w = W_GATEW; ra.ssq_q = W_ssq_q; ra.ssq_kv = W_ssq_kv; ra.rs = (float*)(W_DW8(0) + DW8_RS); ra.rss = (float*)(W_DW8(0) + DW8_RSS);
          row_phase<1>(lds, tab, vcuo, ra, true, moe); }
        if (moe) GRID_BAR(); else GRID_BAR_L();
        if (!moe) {
#define DW (W_WB + WOFF_DENSE + (size_t)fi * DW_SIZE)
            { WSL; pg8::Gemm g{W_H, W_DW8(fi) + DW8_GU, D}; pg8::StaticOrder S; S.init(M, 2 * DFF, Go, bxo); pg8::EpiSwigluI8<false> E{W_ACT8D, DFF, -1, (const float*)(W_DW8(0) + DW8_RS), (const float*)(W_DW8(fi) + DW8_CS)};
              pg8::gemm_phase<pg8::EpiSwigluI8<false>, pg8::StaticOrder, true, 2, 2>(lds, g, S, E); }
            GRID_BAR_L();
            { WSL; pg8::Gemm g{W_ACT8D, W_DW8(fi) + DW8_D, DFF}; pg8::StaticOrder S; S.init(M, D, Go, bxo); pg8::EpiBfS E{W_YO, D, 1.0f / (pg8::F8_ASC * pg8::F8_WSC)};
              pg8::gemm_phase<pg8::EpiBfS, pg8::StaticOrder, false, 2, 1>(lds, g, S, E); }
            GRID_BAR_L();
        } else {
#define MW (W_WB + WOFF_MOE + (size_t)fi * MW_SIZE)
            { const int ln = opaque_tid(); if (ln < 64) { WSL; volatile LAS int* tw = (volatile LAS int*)(lds + MISC_OFF);
                const int cnt = (ln < 8) ? (int)__hip_atomic_load(W_ctl + CW_CURSOR + 64 * fi + ln, __ATOMIC_RELAXED, __HIP_MEMORY_SCOPE_AGENT) : 0;
                const int nt = (cnt + 255) >> 8; int T = 0, tot = 0;
#pragma unroll
                for (int e = 0; e < 8; ++e) { const int v = __builtin_amdgcn_readlane(nt, e); if (e < ln) T += v; tot += v; }
                if (ln < 8) { tw[16 + ln] = T; tw[32 + ln] = cnt; }
                if (ln == 0) tw[24] = tot; } }
            __syncthreads();
            { WSL; pg8::Gemm g{W_H, W_MW8(fi) + MW8_GU, D}; MoeGatherOrder S{{tab, 11, Go, vcuo, 1 << 30}, W_IDX}; pg8::EpiSwigluI8<true> E{W_ACT8, DFEP, 10, (const float*)(W_DW8(0) + DW8_RSS), (const float*)(W_MW8(fi) + MW8_CS)};
              pg8::gemm_phase<pg8::EpiSwigluI8<true>, MoeGatherOrder, true, 2, 2>(lds, g, S, E); }
            GRID_BAR();
            { WSL; pg8::Gemm g{W_ACT8, W_MW8(fi) + MW8_D, DFEP}; MoeOrder S{tab, 4, Go, vcuo, 2 * Go}; pg8::EpiBfS E{W_YD, D, 1.0f / (pg8::F8_ASC * pg8::F8_WSC)};
              pg8::gemm_phase<pg8::EpiBfS, MoeOrder, true, 2, 1>(lds, g, S, E);
              pg8::TailOrder<MoeOrder> T{S};
              pg8::gemm_phase<pg8::EpiBfS, pg8::TailOrder<MoeOrder>, false, 1, 1>(lds, g, T, E); }
            GRID_BAR();
        }
        { WSL; const bool last = (l == DEPTH - 1); const float* mdn = W_MOD + (size_t)((last ? l : l + 1) * 4 + (vcuo >> 6)) * 6144;
          RowArgs ra{}; ra.X = last ? W_X : nullptr; ra.Xb = W_XB; ra.Ysrc = W_YO; ra.YD = W_YD; ra.slot = W_SLOT; ra.gatew = W_GATEW; ra.gate = md + 5120; ra.postg = AIN(I_POSTFFN) + l * D;
          ra.preg = AIN(I_PREMIX) + (last ? l : l + 1) * D; ra.sc = mdn + 1024; ra.sh = mdn; ra.H = W_H; ra.ssq_q = W_ssq_q; ra.ssq_kv = W_ssq_kv; ra.rs = (float*)(W_DW8(0) + DW8_RS);
          if (!moe) row_phase<2>(lds, tab, vcuo, ra, !last, false); else row_phase<3>(lds, tab, vcuo, ra, !last, false);
          if (!last) GRID_BAR_L(); }

    }
#undef LW
#undef md
#undef DW
#undef MW
    { constexpr int l = 1;

        const bool moe = (l & 1) != 0; const int fi = l >> 1;
#define LW (W_WB + (size_t)l * LW_SIZE)
#define md (W_MOD + (size_t)(l * 4 + (vcuo >> 6)) * 6144)
        { WSL; pg8::Gemm g{W_H, LW + LW_WIN, D}; pg8::StaticOrder S; S.init(M, DINP, Go, bxo); S.lim = (S.nwg / Go) * Go;
          pg8::EpiIn E{wsl, (const float*)(W_DW8(0) + DW8_RS), (const float*)((unsigned char*)(LW + LW_WIN) + (size_t)DINP * D)};
          pg8::gemm_phase<pg8::EpiIn, pg8::StaticOrder, true, 2, 2>(lds, g, S, E);
          pg8::TailOrder<pg8::StaticOrder> T{S};
          pg8::gemm_phase<pg8::EpiIn, pg8::TailOrder<pg8::StaticOrder>, false, 1, 2>(lds, g, T, E); }
        if (l == 2) GRID_BAR(); else GRID_BAR_L();
        { WSL; pg8::Gemm g{W_ZQ, LW + LW_WUQ, 256}; pg8::StaticOrder S; S.init(M, 768, Go, bxo); pg8::EpiQ E{wsl};
          pg8::gemm_phase<pg8::EpiQ, pg8::StaticOrder, true>(lds, g, S, E); }
        { WSL; pg8::Gemm g{W_ZKV, LW + LW_WUK, 128, 256};     pg8::StaticOrder S; S.init(M, 512, Go, (bxo + 64) % Go); pg8::EpiK E{wsl};
          pg8::gemm_phase<pg8::EpiK, pg8::StaticOrder, true>(lds, g, S, E); }
        { WSL; pg8::Gemm g{LW + LW_WUV, W_ZKV, 128, 256}; pg8::StaticOrder S; S.init(512, M, Go, (bxo + 192) % Go); pg8::EpiVT E{wsl};
          pg8::gemm_phase<pg8::EpiVT, pg8::StaticOrder, true>(lds, g, S, E); }
        { WSL; for (int uu = vcuo; uu < 256; uu += Go) {
            sgu::unit(lds, (uu >> 1) * 128, uu & 1, W_GV, W_U, LW + LW_SGW, AIN(I_SGLNG) + l * 256, AIN(I_SGLNB) + l * 256, AIN(I_SGB) + l * 512, W_Y); } }
        { WSL; for (int uu = vcuo; uu < 256; uu += Go) {
            lru::local_unit(lds, uu >> 6, uu & 63, W_ZX, AIN(I_CONVW) + l * 1024, AIN(I_CONVB) + l * 256, LW + LW_LWA, LW + LW_LWX,
                            AIN(I_LBA) + l * 256, AIN(I_LBX) + l * 256, AIN(I_LAM) + l * 256, W_HL, W_PP); } }
        GRID_BAR_P();
        { WSL; for (int uu = vcuo; uu < 256; uu += Go) { lru::fix_unit(lds, uu >> 6, uu & 63, W_HL, W_PP, W_GY, W_Y); } }
        { WSL; for (int uu = vcuo; uu < 256; uu += Go) { const int bh = uu >> 3, s = uu & 7;
            att::attn_unit(lds, bh >> 3, bh & 7, 15 - s, W_Q, W_KN, W_KR, W_VT, W_Y);
            att::attn_unit(lds, bh >> 3, bh & 7, s, W_Q, W_KN, W_KR, W_VT, W_Y); } }
        GRID_BAR_P();
        { WSL; pg8::Gemm g{W_Y, LW + LW_WO, D}; pg8::StaticOrder S; S.init(M, D, Go, bxo); pg8::EpiBf E{W_YO, D};
          pg8::gemm_phase<pg8::EpiBf, pg8::StaticOrder, false>(lds, g, S, E); }
        GRID_BAR_L();
        { WSL; RowArgs ra{}; ra.X = nullptr; ra.Xb = W_XB; ra.Ysrc = W_YO; ra.gate = md + 2048; ra.postg = AIN(I_POSTMIX) + l * D; ra.preg = AIN(I_PREFFN) + l * D; ra.sc = md + 4096; ra.sh = md + 3072; ra.H = W_H;
          ra.router = AIN(I_ROUTER) + (size_t)fi * D * NE; ra.cursor = W_ctl + CW_CURSOR + 64 * fi; ra.idx = W_IDX; ra.slot_w = W_SLOT; ra.gatew_w = W_GATEW; ra.ssq_q = W_ssq_q; ra.ssq_kv = W_ssq_kv; ra.rs = (float*)(W_DW8(0) + DW8_RS); ra.rss = (float*)(W_DW8(0) + DW8_RSS);
          row_phase<1>(lds, tab, vcuo, ra, true, moe); }
        if (moe) GRID_BAR(); else GRID_BAR_L();
        if (!moe) {
#define DW (W_WB + WOFF_DENSE + (size_t)fi * DW_SIZE)
            { WSL; pg8::Gemm g{W_H, W_DW8(fi) + DW8_GU, D}; pg8::StaticOrder S; S.init(M, 2 * DFF, Go, bxo); pg8::EpiSwigluI8<false> E{W_ACT8D, DFF, -1, (const float*)(W_DW8(0) + DW8_RS), (const float*)(W_DW8(fi) + DW8_CS)};
              pg8::gemm_phase<pg8::EpiSwigluI8<false>, pg8::StaticOrder, true, 2, 2>(lds, g, S, E); }
            GRID_BAR_L();
            { WSL; pg8::Gemm g{W_ACT8D, W_DW8(fi) + DW8_D, DFF}; pg8::StaticOrder S; S.init(M, D, Go, bxo); pg8::EpiBfS E{W_YO, D, 1.0f / (pg8::F8_ASC * pg8::F8_WSC)};
              pg8::gemm_phase<pg8::EpiBfS, pg8::StaticOrder, false, 2, 1>(lds, g, S, E); }
            GRID_BAR_L();
        } else {
#define MW (W_WB + WOFF_MOE + (size_t)fi * MW_SIZE)
            { const int ln = opaque_tid(); if (ln < 64) { WSL; volatile LAS int* tw = (volatile LAS int*)(lds + MISC_OFF);
                const int cnt = (ln < 8) ? (int)__hip_atomic_load(W_ctl + CW_CURSOR + 64 * fi + ln, __ATOMIC_RELAXED, __HIP_MEMORY_SCOPE_AGENT) : 0;
                const int nt = (cnt + 255) >> 8; int T = 0, tot = 0;
#pragma unroll
                for (int e = 0; e < 8; ++e) { const int v = __builtin_amdgcn_readlane(nt, e); if (e < ln) T += v; tot += v; }
                if (ln < 8) { tw[16 + ln] = T; tw[32 + ln] = cnt; }
                if (ln == 0) tw[24] = tot; } }
            __syncthreads();
            { WSL; pg8::Gemm g{W_H, W_MW8(fi) + MW8_GU, D}; MoeGatherOrder S{{tab, 11, Go, vcuo, 1 << 30}, W_IDX}; pg8::EpiSwigluI8<true> E{W_ACT8, DFEP, 10, (const float*)(W_DW8(0) + DW8_RSS), (const float*)(W_MW8(fi) + MW8_CS)};
              pg8::gemm_phase<pg8::EpiSwigluI8<true>, MoeGatherOrder, true, 2, 2>(lds, g, S, E); }
            GRID_BAR();
            { WSL; pg8::Gemm g{W_ACT8, W_MW8(fi) + MW8_D, DFEP}; MoeOrder S{tab, 4, Go, vcuo, 2 * Go}; pg8::EpiBfS E{W_YD, D, 1.0f / (pg8::F8_ASC * pg8::F8_WSC)};
              pg8::gemm_phase<pg8::EpiBfS, MoeOrder, true, 2, 1>(lds, g, S, E);
              pg8::TailOrder<MoeOrder> T{S};
              pg8::gemm_phase<pg8::EpiBfS, pg8::TailOrder<MoeOrder>, false, 1, 1>(lds, g, T, E); }
            GRID_BAR();
        }
        { WSL; const bool last = (l == DEPTH - 1); const float* mdn = W_MOD + (size_t)((last ? l : l + 1) * 4 + (vcuo >> 6)) * 6144;
          RowArgs ra{}; ra.X = last ? W_X : nullptr; ra.Xb = W_XB; ra.Ysrc = W_YO; ra.YD = W_YD; ra.slot = W_SLOT; ra.gatew = W_GATEW; ra.gate = md + 5120; ra.postg = AIN(I_POSTFFN) + l * D;
          ra.preg = AIN(I_PREMIX) + (last ? l : l + 1) * D; ra.sc = mdn + 1024; ra.sh = mdn; ra.H = W_H; ra.ssq_q = W_ssq_q; ra.ssq_kv = W_ssq_kv; ra.rs = (float*)(W_DW8(0) + DW8_RS);
          if (!moe) row_phase<2>(lds, tab, vcuo, ra, !last, false); else row_phase<3>(lds, tab, vcuo, ra, !last, false);
          if (!last) GRID_BAR_L(); }

    }
#undef LW
#undef md
#undef DW
#undef MW
    { constexpr int l = 2;

        const bool moe = (l & 1) != 0; const int fi = l >> 1;
#define LW (W_WB + (size_t)l * LW_SIZE)
#define md (W_MOD + (size_t)(l * 4 + (vcuo >> 6)) * 6144)
        { WSL; pg8::Gemm g{W_H, LW + LW_WIN, D}; pg8::StaticOrder S; S.init(M, DINP, Go, bxo); S.lim = (S.nwg / Go) * Go;
          pg8::EpiIn E{wsl, (const float*)(W_DW8(0) + DW8_RS), (const float*)((unsigned char*)(LW + LW_WIN) + (size_t)DINP * D)};
          pg8::gemm_phase<pg8::EpiIn, pg8::StaticOrder, true, 2, 2>(lds, g, S, E);
          pg8::TailOrder<pg8::StaticOrder> T{S};
          pg8::gemm_phase<pg8::EpiIn, pg8::TailOrder<pg8::StaticOrder>, false, 1, 2>(lds, g, T, E); }
        if (l == 2) GRID_BAR(); else GRID_BAR_L();
        { WSL; pg8::Gemm g{W_ZQ, LW + LW_WUQ, 256}; pg8::StaticOrder S; S.init(M, 768, Go, bxo); pg8::EpiQ E{wsl};
          pg8::gemm_phase<pg8::EpiQ, pg8::StaticOrder, true>(lds, g, S, E); }
        { WSL; pg8::Gemm g{W_ZKV, LW + LW_WUK, 128, 256};     pg8::StaticOrder S; S.init(M, 512, Go, (bxo + 64) % Go); pg8::EpiK E{wsl};
          pg8::gemm_phase<pg8::EpiK, pg8::StaticOrder, true>(lds, g, S, E); }
        { WSL; pg8::Gemm g{LW + LW_WUV, W_ZKV, 128, 256}; pg8::StaticOrder S; S.init(512, M, Go, (bxo + 192) % Go); pg8::EpiVT E{wsl};
          pg8::gemm_phase<pg8::EpiVT, pg8::StaticOrder, true>(lds, g, S, E); }
        { WSL; for (int uu = vcuo; uu < 256; uu += Go) {
            sgu::unit(lds, (uu >> 1) * 128, uu & 1, W_GV, W_U, LW + LW_SGW, AIN(I_SGLNG) + l * 256, AIN(I_SGLNB) + l * 256, AIN(I_SGB) + l * 512, W_Y); } }
        { WSL; for (int uu = vcuo; uu < 256; uu += Go) {
            lru::local_unit(lds, uu >> 6, uu & 63, W_ZX, AIN(I_CONVW) + l * 1024, AIN(I_CONVB) + l * 256, LW + LW_LWA, LW + LW_LWX,
                            AIN(I_LBA) + l * 256, AIN(I_LBX) + l * 256, AIN(I_LAM) + l * 256, W_HL, W_PP); } }
        GRID_BAR_P();
        { WSL; for (int uu = vcuo; uu < 256; uu += Go) { lru::fix_unit(lds, uu >> 6, uu & 63, W_HL, W_PP, W_GY, W_Y); } }
        { WSL; for (int uu = vcuo; uu < 256; uu += Go) { const int bh = uu >> 3, s = uu & 7;
            att::attn_unit(lds, bh >> 3, bh & 7, 15 - s, W_Q, W_KN, W_KR, W_VT, W_Y);
            att::attn_unit(lds, bh >> 3, bh & 7, s, W_Q, W_KN, W_KR, W_VT, W_Y); } }
        GRID_BAR_P();
        { WSL; pg8::Gemm g{W_Y, LW + LW_WO, D}; pg8::StaticOrder S; S.init(M, D, Go, bxo); pg8::EpiBf E{W_YO, D};
          pg8::gemm_phase<pg8::EpiBf, pg8::StaticOrder, false>(lds, g, S, E); }
        GRID_BAR_L();
        { WSL; RowArgs ra{}; ra.X = nullptr; ra.Xb = W_XB; ra.Ysrc = W_YO; ra.gate = md + 2048; ra.postg = AIN(I_POSTMIX) + l * D; ra.preg = AIN(I_PREFFN) + l * D; ra.sc = md + 4096; ra.sh = md + 3072; ra.H = W_H;
          ra.router = AIN(I_ROUTER) + (size_t)fi * D * NE; ra.cursor = W_ctl + CW_CURSOR + 64 * fi; ra.idx = W_IDX; ra.slot_w = W_SLOT; ra.gatew_w = W_GATEW; ra.ssq_q = W_ssq_q; ra.ssq_kv = W_ssq_kv; ra.rs = (float*)(W_DW8(0) + DW8_RS); ra.rss = (float*)(W_DW8(0) + DW8_RSS);
          row_phase<1>(lds, tab, vcuo, ra, true, moe); }
        if (moe) GRID_BAR(); else GRID_BAR_L();
        if (!moe) {
#define DW (W_WB + WOFF_DENSE + (size_t)fi * DW_SIZE)
            { WSL; pg8::Gemm g{W_H, W_DW8(fi) + DW8_GU, D}; pg8::StaticOrder S; S.init(M, 2 * DFF, Go, bxo); pg8::EpiSwigluI8<false> E{W_ACT8D, DFF, -1, (const float*)(W_DW8(0) + DW8_RS), (const float*)(W_DW8(fi) + DW8_CS)};
              pg8::gemm_phase<pg8::EpiSwigluI8<false>, pg8::StaticOrder, true, 2, 2>(lds, g, S, E); }
            GRID_BAR_L();
            { WSL; pg8::Gemm g{W_ACT8D, W_DW8(fi) + DW8_D, DFF}; pg8::StaticOrder S; S.init(M, D, Go, bxo); pg8::EpiBfS E{W_YO, D, 1.0f / (pg8::F8_ASC * pg8::F8_WSC)};
              pg8::gemm_phase<pg8::EpiBfS, pg8::StaticOrder, false, 2, 1>(lds, g, S, E); }
            GRID_BAR_L();
        } else {
#define MW (W_WB + WOFF_MOE + (size_t)fi * MW_SIZE)
            { const int ln = opaque_tid(); if (ln < 64) { WSL; volatile LAS int* tw = (volatile LAS int*)(lds + MISC_OFF);
                const int cnt = (ln < 8) ? (int)__hip_atomic_load(W_ctl + CW_CURSOR + 64 * fi + ln, __ATOMIC_RELAXED, __HIP_MEMORY_SCOPE_AGENT) : 0;
                const int nt = (cnt + 255) >> 8; int T = 0, tot = 0;
#pragma unroll
                for (int e = 0; e < 8; ++e) { const int v = __builtin_amdgcn_readlane(nt, e); if (e < ln) T += v; tot += v; }
                if (ln < 8) { tw[16 + ln] = T; tw[32 + ln] = cnt; }
                if (ln == 0) tw[24] = tot; } }
            __syncthreads();
            { WSL; pg8::Gemm g{W_H, W_MW8(fi) + MW8_GU, D}; MoeGatherOrder S{{tab, 11, Go, vcuo, 1 << 30}, W_IDX}; pg8::EpiSwigluI8<true> E{W_ACT8, DFEP, 10, (const float*)(W_DW8(0) + DW8_RSS), (const float*)(W_MW8(fi) + MW8_CS)};
              pg8::gemm_phase<pg8::EpiSwigluI8<true>, MoeGatherOrder, true, 2, 2>(lds, g, S, E); }
            GRID_BAR();
            { WSL; pg8::Gemm g{W_ACT8, W_MW8(fi) + MW8_D, DFEP}; MoeOrder S{tab, 4, Go, vcuo, 2 * Go}; pg8::EpiBfS E{W_YD, D, 1.0f / (pg8::F8_ASC * pg8::F8_WSC)};
              pg8::gemm_phase<pg8::EpiBfS, MoeOrder, true, 2, 1>(lds, g, S, E);
              pg8::TailOrder<MoeOrder> T{S};
              pg8::gemm_phase<pg8::EpiBfS, pg8::TailOrder<MoeOrder>, false, 1, 1>(lds, g, T, E); }
            GRID_BAR();
        }
        { WSL; const bool last = (l == DEPTH - 1); const float* mdn = W_MOD + (size_t)((last ? l : l + 1) * 4 + (vcuo >> 6)) * 6144;
          RowArgs ra{}; ra.X = last ? W_X : nullptr; ra.Xb = W_XB; ra.Ysrc = W_YO; ra.YD = W_YD; ra.slot = W_SLOT; ra.gatew = W_GATEW; ra.gate = md + 5120; ra.postg = AIN(I_POSTFFN) + l * D;
          ra.preg = AIN(I_PREMIX) + (last ? l : l + 1) * D; ra.sc = mdn + 1024; ra.sh = mdn; ra.H = W_H; ra.ssq_q = W_ssq_q; ra.ssq_kv = W_ssq_kv; ra.rs = (float*)(W_DW8(0) + DW8_RS);
          if (!moe) row_phase<2>(lds, tab, vcuo, ra, !last, false); else row_phase<3>(lds, tab, vcuo, ra, !last, false);
          if (!last) GRID_BAR_L(); }

    }
#undef LW
#undef md
#undef DW
#undef MW
    { constexpr int l = 3;

        const bool moe = (l & 1) != 0; const int fi = l >> 1;
#define LW (W_WB + (size_t)l * LW_SIZE)
#define md (W_MOD + (size_t)(l * 4 + (vcuo >> 6)) * 6144)
        { WSL; pg8::Gemm g{W_H, LW + LW_WIN, D}; pg8::StaticOrder S; S.init(M, DINP, Go, bxo); S.lim = (S.nwg / Go) * Go;
          pg8::EpiIn E{wsl, (const float*)(W_DW8(0) + DW8_RS), (const float*)((unsigned char*)(LW + LW_WIN) + (size_t)DINP * D)};
          pg8::gemm_phase<pg8::EpiIn, pg8::StaticOrder, true, 2, 2>(lds, g, S, E);
          pg8::TailOrder<pg8::StaticOrder> T{S};
          pg8::gemm_phase<pg8::EpiIn, pg8::TailOrder<pg8::StaticOrder>, false, 1, 2>(lds, g, T, E); }
        if (l == 2) GRID_BAR(); else GRID_BAR_L();
        { WSL; pg8::Gemm g{W_ZQ, LW + LW_WUQ, 256}; pg8::StaticOrder S; S.init(M, 768, Go, bxo); pg8::EpiQ E{wsl};
          pg8::gemm_phase<pg8::EpiQ, pg8::StaticOrder, true>(lds, g, S, E); }
        { WSL; pg8::Gemm g{W_ZKV, LW + LW_WUK, 128, 256};     pg8::StaticOrder S; S.init(M, 512, Go, (bxo + 64) % Go); pg8::EpiK E{wsl};
          pg8::gemm_phase<pg8::EpiK, pg8::StaticOrder, true>(lds, g, S, E); }
        { WSL; pg8::Gemm g{LW + LW_WUV, W_ZKV, 128, 256}; pg8::StaticOrder S; S.init(512, M, Go, (bxo + 192) % Go); pg8::EpiVT E{wsl};
          pg8::gemm_phase<pg8::EpiVT, pg8::StaticOrder, true>(lds, g, S, E); }
        { WSL; for (int uu = vcuo; uu < 256; uu += Go) {
            sgu::unit(lds, (uu >> 1) * 128, uu & 1, W_GV, W_U, LW + LW_SGW, AIN(I_SGLNG) + l * 256, AIN(I_SGLNB) + l * 256, AIN(I_SGB) + l * 512, W_Y); } }
        { WSL; for (int uu = vcuo; uu < 256; uu += Go) {
            lru::local_unit(lds, uu >> 6, uu & 63, W_ZX, AIN(I_CONVW) + l * 1024, AIN(I_CONVB) + l * 256, LW + LW_LWA, LW + LW_LWX,
                            AIN(I_LBA) + l * 256, AIN(I_LBX) + l * 256, AIN(I_LAM) + l * 256, W_HL, W_PP); } }
        GRID_BAR_P();
        { WSL; for (int uu = vcuo; uu < 256; uu += Go) { lru::fix_unit(lds, uu >> 6, uu & 63, W_HL, W_PP, W_GY, W_Y); } }
        { WSL; for (int uu = vcuo; uu < 256; uu += Go) { const int bh = uu >> 3, s = uu & 7;
            att::attn_unit(lds, bh >> 3, bh & 7, 15 - s, W_Q, W_KN, W_KR, W_VT, W_Y);
            att::attn_unit(lds, bh >> 3, bh & 7, s, W_Q, W_KN, W_KR, W_VT, W_Y); } }
        GRID_BAR_P();
        { WSL; pg8::Gemm g{W_Y, LW + LW_WO, D}; pg8::StaticOrder S; S.init(M, D, Go, bxo); pg8::EpiBf E{W_YO, D};
          pg8::gemm_phase<pg8::EpiBf, pg8::StaticOrder, false>(lds, g, S, E); }
        GRID_BAR_L();
        { WSL; RowArgs ra{}; ra.X = nullptr; ra.Xb = W_XB; ra.Ysrc = W_YO; ra.gate = md + 2048; ra.postg = AIN(I_POSTMIX) + l * D; ra.preg = AIN(I_PREFFN) + l * D; ra.sc = md + 4096; ra.sh = md + 3072; ra.H = W_H;
          ra.router = AIN(I_ROUTER) + (size_t)fi * D * NE; ra.cursor = W_ctl + CW_CURSOR + 64 * fi; ra.idx = W_IDX; ra.slot_w = W_SLOT; ra.gatew_w = W_GATEW; ra.ssq_q = W_ssq_q; ra.ssq_kv = W_ssq_kv; ra.rs = (float*)(W_DW8(0) + DW8_RS); ra.rss = (float*)(W_DW8(0) + DW8_RSS);
          row_phase<1>(lds, tab, vcuo, ra, true, moe); }
        if (moe) GRID_BAR(); else GRID_BAR_L();
        if (!moe) {
#define DW (W_WB + WOFF_DENSE + (size_t)fi * DW_SIZE)
            { WSL; pg8::Gemm g{W_H, W_DW8(fi) + DW8_GU, D}; pg8::StaticOrder S; S.init(M, 2 * DFF, Go, bxo); pg8::EpiSwigluI8<false> E{W_ACT8D, DFF, -1, (const float*)(W_DW8(0) + DW8_RS), (const float*)(W_DW8(fi) + DW8_CS)};
              pg8::gemm_phase<pg8::EpiSwigluI8<false>, pg8::StaticOrder, true, 2, 2>(lds, g, S, E); }
            GRID_BAR_L();
            { WSL; pg8::Gemm g{W_ACT8D, W_DW8(fi) + DW8_D, DFF}; pg8::StaticOrder S; S.init(M, D, Go, bxo); pg8::EpiBfS E{W_YO, D, 1.0f / (pg8::F8_ASC * pg8::F8_WSC)};
              pg8::gemm_phase<pg8::EpiBfS, pg8::StaticOrder, false, 2, 1>(lds, g, S, E); }
            GRID_BAR_L();
        } else {
#define MW (W_WB + WOFF_MOE + (size_t)fi * MW_SIZE)
            { const int ln = opaque_tid(); if (ln < 64) { WSL; volatile LAS int* tw = (volatile LAS int*)(lds + MISC_OFF);
                const int cnt = (ln < 8) ? (int)__hip_atomic_load(W_ctl + CW_CURSOR + 64 * fi + ln, __ATOMIC_RELAXED, __HIP_MEMORY_SCOPE_AGENT) : 0;
                const int nt = (cnt + 255) >> 8; int T = 0, tot = 0;
#pragma unroll
                for (int e = 0; e < 8; ++e) { const int v = __builtin_amdgcn_readlane(nt, e); if (e < ln) T += v; tot += v; }
                if (ln < 8) { tw[16 + ln] = T; tw[32 + ln] = cnt; }
                if (ln == 0) tw[24] = tot; } }
            __syncthreads();
            { WSL; pg8::Gemm g{W_H, W_MW8(fi) + MW8_GU, D}; MoeGatherOrder S{{tab, 11, Go, vcuo, 1 << 30}, W_IDX}; pg8::EpiSwigluI8<true> E{W_ACT8, DFEP, 10, (const float*)(W_DW8(0) + DW8_RSS), (const float*)(W_MW8(fi) + MW8_CS)};
              pg8::gemm_phase<pg8::EpiSwigluI8<true>, MoeGatherOrder, true, 2, 2>(lds, g, S, E); }
            GRID_BAR();
            { WSL; pg8::Gemm g{W_ACT8, W_MW8(fi) + MW8_D, DFEP}; MoeOrder S{tab, 4, Go, vcuo, 2 * Go}; pg8::EpiBfS E{W_YD, D, 1.0f / (pg8::F8_ASC * pg8::F8_WSC)};
              pg8::gemm_phase<pg8::EpiBfS, MoeOrder, true, 2, 1>(lds, g, S, E);
              pg8::TailOrder<MoeOrder> T{S};
              pg8::gemm_phase<pg8::EpiBfS, pg8::TailOrder<MoeOrder>, false, 1, 1>(lds, g, T, E); }
            GRID_BAR();
        }
        { WSL; const bool last = (l == DEPTH - 1); const float* mdn = W_MOD + (size_t)((last ? l : l + 1) * 4 + (vcuo >> 6)) * 6144;
          RowArgs ra{}; ra.X = last ? W_X : nullptr; ra.Xb = W_XB; ra.Ysrc = W_YO; ra.YD = W_YD; ra.slot = W_SLOT; ra.gatew = W_GATEW; ra.gate = md + 5120; ra.postg = AIN(I_POSTFFN) + l * D;
          ra.preg = AIN(I_PREMIX) + (last ? l : l + 1) * D; ra.sc = mdn + 1024; ra.sh = mdn; ra.H = W_H; ra.ssq_q = W_ssq_q; ra.ssq_kv = W_ssq_kv; ra.rs = (float*)(W_DW8(0) + DW8_RS);
          if (!moe) row_phase<2>(lds, tab, vcuo, ra, !last, false); else row_phase<3>(lds, tab, vcuo, ra, !last, false);
          if (!last) GRID_BAR_L(); }

    }
#undef LW
#undef md
#undef DW
#undef MW
#undef GRID_BAR
}

extern "C" void kernel_launch(void* const* d_in, const int* in_sizes, int n_in, void* d_out, int out_size, void* d_ws, size_t ws_size, hipStream_t stream) {
    static int grid = 0;
    if (grid == 0) {
        if (n_in != 32 || in_sizes[0] != M * D || out_size != M * D || ws_size < WS_END2) { fprintf(stderr, "kernel_launch: unexpected problem (n_in %d, in0 %d, out %d, ws %zu < %zu); nothing launched\n", n_in, n_in > 0 ? in_sizes[0] : -1, out_size, ws_size, (size_t)WS_END); grid = -1; return; }
        int dev = 0, cus = 0, per_cu = 0;
        if (hipGetDevice(&dev) != hipSuccess || hipDeviceGetAttribute(&cus, hipDeviceAttributeMultiprocessorCount, dev) != hipSuccess) { grid = -1; return; }
        if (hipFuncSetAttribute((const void*)trunk_fwd, hipFuncAttributeMaxDynamicSharedMemorySize, LDS_BYTES) != hipSuccess) { fprintf(stderr, "kernel_launch: hipFuncSetAttribute failed\n"); grid = -1; return; }
        if (hipOccupancyMaxActiveBlocksPerMultiprocessor(&per_cu, (const void*)trunk_fwd, 512, LDS_BYTES) != hipSuccess || per_cu < 1) fprintf(stderr, "kernel_launch: note: occupancy query reports %d workgroups per CU\n", per_cu);
        (void)hipGetLastError();
        if (cus < 256) { fprintf(stderr, "kernel_launch: this kernel is laid out for 256 CUs (one workgroup each, 64 token rows per workgroup in the row phases); device has %d; nothing launched\n", cus); grid = -1; return; }
        grid = 256;
    }
    if (grid < 0) return;
    if (hipMemsetAsync((char*)d_ws + WS_CTL, 0, CTL_ZERO_BYTES, stream) != hipSuccess) return;
    Args a{};
    for (int i = 0; i < 32; ++i) a.in[i] = (const float*)d_in[i];
    a.out = (float*)d_out; a.ws = (unsigned char*)d_ws;
    hipLaunchKernelGGL(trunk_fwd, dim3(grid), dim3(512), LDS_BYTES, stream, a);
}
```
